# Optimizing an MI355X kernel written in HIP

```python
import jax
import jax.numpy as jnp
from jax import lax
import numpy as np

D_MODEL = 1024
BATCH = 2
SEQ = 8192
DEPTH = 2

F32 = jnp.float32
GRID_W = 64
CTX_LEN = 256
D_FF = 4 * D_MODEL
MIX_WIDTH = D_MODEL
NORM_EPS = 1e-6
GN_EPS = 64e-5
ROPE_THETA = 10000.0

ML_HEAD_DIM = 128
ML_HEADS = (MIX_WIDTH // 2) // ML_HEAD_DIM
ML_WIDTH = ML_HEADS * ML_HEAD_DIM
ML_CHUNK = 128

RW_HEAD_DIM = 64
RW_HEADS = (MIX_WIDTH - ML_WIDTH) // RW_HEAD_DIM
RW_WIDTH = RW_HEADS * RW_HEAD_DIM
RW_DECAY_RANK = 64
RW_ICLR_RANK = 64
RW_GATE_RANK = 128
RW_SHIFT_WIDTH = 3

REC_SPLITS = (ML_WIDTH,) * 4 + (ML_HEADS,) * 4 + (RW_WIDTH,) * 3 + (RW_DECAY_RANK,) * 2 + (RW_ICLR_RANK,) * 2 + (RW_GATE_RANK,)
REC_IN = sum(REC_SPLITS)

ATT_HEAD_DIM = 64
WIN_Q_HEADS = (MIX_WIDTH // 2) // ATT_HEAD_DIM
WIN_KV_HEADS = WIN_Q_HEADS // 4
GLB_Q_HEADS = (MIX_WIDTH - WIN_Q_HEADS * ATT_HEAD_DIM) // ATT_HEAD_DIM
GLB_KV_HEADS = GLB_Q_HEADS // 4
WINDOW = 128
Q_BLOCK = 128
ATT_SPLITS = (WIN_Q_HEADS * ATT_HEAD_DIM, WIN_KV_HEADS * ATT_HEAD_DIM, WIN_KV_HEADS * ATT_HEAD_DIM,
              GLB_Q_HEADS * ATT_HEAD_DIM, GLB_KV_HEADS * ATT_HEAD_DIM, GLB_KV_HEADS * ATT_HEAD_DIM)
ATT_IN = sum(ATT_SPLITS)

N_REC_LAYERS = (DEPTH + 1) // 2
N_ATT_LAYERS = DEPTH // 2

kernel_name = 'hybrid_mlstm_rwkv7_swa_gqa_dit'


def split_cols(z, sizes):
    return jnp.split(z, [int(i) for i in np.cumsum(sizes)[:-1]], axis=-1)


def rms_norm(x, g):
    xf = x.astype(F32)
    y = xf * lax.rsqrt(jnp.mean(xf * xf, -1, keepdims=True) + NORM_EPS)
    return (y * g.astype(F32)).astype(x.dtype)


def head_layernorm(y, g):
    yc = y - jnp.mean(y, -1, keepdims=True)
    y = yc * lax.rsqrt(jnp.mean(yc * yc, -1, keepdims=True) + GN_EPS)
    return y.reshape(y.shape[:2] + (-1,)) * g


def adaln(cvec, w_mod, b_mod):
    m = jax.nn.silu(cvec) @ w_mod + b_mod
    return jnp.split(m, 6, axis=-1)


def sq_relu_mlp(h, w1, w2):
    return jnp.square(jax.nn.relu(h @ w1)) @ w2


def centred_dwconv(z, w):
    pad = w.shape[0] // 2
    return lax.conv_general_dilated(z, w[:, None, :], window_strides=(1,), padding=[(pad, pad)],
                                    dimension_numbers=('NWC', 'WIO', 'NWC'), feature_group_count=z.shape[-1])


def mlstm_chunkwise(q, k, v, ig, fg, state):
    B, T, H, dk = q.shape
    dv = v.shape[-1]
    L = ML_CHUNK
    nc = T // L

    def chunks(a):
        a = a.reshape((B, nc, L, H) + a.shape[3:])
        return jnp.moveaxis(jnp.moveaxis(a, 1, 0), 2, 3)

    xs = (chunks(q), chunks(k * dk ** -0.5), chunks(v), chunks(ig), chunks(jax.nn.log_sigmoid(fg)))
    causal = jnp.tril(jnp.ones((L, L), dtype=bool))

    def step(carry, inp):
        C, n, m = carry
        qb, kb, vb, ib, lf = inp
        b = jnp.cumsum(lf, axis=-1)
        d_in = jnp.where(causal, b[..., :, None] - b[..., None, :] + ib[..., None, :], -jnp.inf)
        d_prev = b + m[..., None]
        m_t = jnp.maximum(d_prev, jnp.max(d_in, axis=-1))
        s = jnp.einsum('bhtd,bhsd->bhts', qb, kb) * jnp.exp(d_in - m_t[..., None])
        w_prev = jnp.exp(d_prev - m_t)
        num = jnp.einsum('bhts,bhsv->bhtv', s, vb) + w_prev[..., None] * jnp.einsum('bhtd,bhdv->bhtv', qb, C)
        den = jnp.sum(s, -1) + w_prev * jnp.einsum('bhtd,bhd->bht', qb, n)
        h = num / jnp.maximum(jnp.abs(den), jnp.exp(-m_t))[..., None]
        b_end = b[..., -1]
        d_end = b_end[..., None] - b + ib
        m_new = jnp.maximum(b_end + m, jnp.max(d_end, -1))
        w_end = jnp.exp(d_end - m_new[..., None])
        keep = jnp.exp(b_end + m - m_new)
        C = keep[..., None, None] * C + jnp.einsum('bhs,bhsd,bhsv->bhdv', w_end, kb, vb)
        n = keep[..., None] * n + jnp.einsum('bhs,bhsd->bhd', w_end, kb)
        return (C, n, m_new), h

    state, hs = lax.scan(step, state, xs)
    h = jnp.swapaxes(jnp.moveaxis(hs, 0, 1), 2, 3).reshape(B, T, H, dv)
    return h, state


def rwkv7_scan(r, decay, k, v, kk, a, state, reverse):
    def step(S, inp):
        r_t, w_t, k_t, v_t, kk_t, a_t = inp
        s_kk = jnp.einsum('bhij,bhj->bhi', S, kk_t)
        S = S * w_t[:, :, None, :] - s_kk[..., None] * (kk_t * a_t)[:, :, None, :] + v_t[..., None] * k_t[:, :, None, :]
        return S, jnp.einsum('bhij,bhj->bhi', S, r_t)

    xs = tuple(jnp.moveaxis(t, 1, 0) for t in (r, decay, k, v, kk, a))
    state, ys = lax.scan(step, state, xs, reverse=reverse)
    return jnp.moveaxis(ys, 0, 1), state


def recurrent_streams(h, w_in, gate_b, conv_w, w0, w2, a0, a2, k_k, k_a):
    B, T, _ = h.shape
    (q, k, v, o, i_f, f_f, i_b, f_b, r, kr, vr,
     wd_f, wd_b, ad_f, ad_b, gd) = split_cols((h @ w_in).astype(F32), REC_SPLITS)
    r, kr, vr = jnp.split(centred_dwconv(jnp.concatenate([r, kr, vr], -1), conv_w.astype(F32)), 3, axis=-1)
    ml = lambda z: z.reshape(B, T, ML_HEADS, ML_HEAD_DIM)
    rw = lambda z: z.reshape(B, T, RW_HEADS, RW_HEAD_DIM)
    kk = rw(kr * k_k)
    kk = kk * lax.rsqrt(jnp.sum(kk * kk, -1, keepdims=True) + NORM_EPS)
    decay, iclr, key = [], [], []
    for d, (wd, ad) in enumerate(((wd_f, ad_f), (wd_b, ad_b))):
        w_log = -jax.nn.softplus(-(w0[d] + jnp.tanh(wd) @ w2[d])) - 0.5
        a = jax.nn.sigmoid(a0[d] + ad @ a2[d])
        decay.append(rw(jnp.exp(-jnp.exp(w_log))))
        iclr.append(rw(a))
        key.append(rw(kr * (1.0 + (a - 1.0) * k_a)))
    return {'q': ml(q), 'k': ml(k), 'v': ml(v), 'o': o,
            'ig': (i_f + gate_b[0], i_b + gate_b[2]), 'fg': (f_f + gate_b[1], f_b + gate_b[3]),
            'r': rw(r), 'k_raw': rw(kr), 'v_rw': rw(vr), 'kk': kk,
            'decay': decay, 'iclr': iclr, 'key': key, 'gd': gd}


def recurrent_mix(h_lat, h_ctx, w_in, gate_b, ml_norm_g, conv_w, w0, w2, a0, a2, g2, k_k, k_a, r_k,
                  rw_norm_g, w_out, need_ctx):
    sc = recurrent_streams(h_ctx, w_in, gate_b, conv_w, w0, w2, a0, a2, k_k, k_a)
    sl = recurrent_streams(h_lat, w_in, gate_b, conv_w, w0, w2, a0, a2, k_k, k_a)
    B = h_lat.shape[0]
    ml_c, ml_l, rw_c, rw_l = [], [], [], []
    for d, reverse in enumerate((False, True)):
        flip = (lambda z: jnp.flip(z, 1)) if reverse else (lambda z: z)
        st = (jnp.zeros((B, ML_HEADS, ML_HEAD_DIM, ML_HEAD_DIM), F32),
              jnp.zeros((B, ML_HEADS, ML_HEAD_DIM), F32), jnp.zeros((B, ML_HEADS), F32))
        h_c, st = mlstm_chunkwise(flip(sc['q']), flip(sc['k']), flip(sc['v']), flip(sc['ig'][d]), flip(sc['fg'][d]), st)
        h_l, _ = mlstm_chunkwise(flip(sl['q']), flip(sl['k']), flip(sl['v']), flip(sl['ig'][d]), flip(sl['fg'][d]), st)
        ml_c.append(flip(h_c))
        ml_l.append(flip(h_l))
        S = jnp.zeros((B, RW_HEADS, RW_HEAD_DIM, RW_HEAD_DIM), F32)
        y_c, S = rwkv7_scan(sc['r'], sc['decay'][d], sc['key'][d], sc['v_rw'], sc['kk'], sc['iclr'][d], S, reverse)
        y_l, _ = rwkv7_scan(sl['r'], sl['decay'][d], sl['key'][d], sl['v_rw'], sl['kk'], sl['iclr'][d], S, reverse)
        rw_c.append(y_c)
        rw_l.append(y_l)

    def merge(s, ml_h, rw_y):
        ml_out = head_layernorm(ml_h[0] + ml_h[1], ml_norm_g) * jax.nn.sigmoid(s['o'])
        bonus = jnp.sum(s['r'] * s['k_raw'] * r_k.reshape(RW_HEADS, RW_HEAD_DIM), -1, keepdims=True) * s['v_rw']
        rw_out = (head_layernorm(rw_y[0] + rw_y[1], rw_norm_g) + bonus.reshape(bonus.shape[:2] + (RW_WIDTH,))) \
            * (jax.nn.sigmoid(s['gd']) @ g2)
        return jnp.concatenate([ml_out, rw_out], -1) @ w_out

    y_lat = merge(sl, ml_l, rw_l).astype(h_lat.dtype)
    y_ctx = merge(sc, ml_c, rw_c).astype(h_ctx.dtype) if need_ctx else None
    return y_lat, y_ctx


def axial_rope(n_tokens, head_dim):
    rows = n_tokens // GRID_W
    row = jnp.repeat(jnp.arange(rows), GRID_W).astype(F32)
    col = jnp.tile(jnp.arange(GRID_W), rows).astype(F32)
    n_freq = head_dim // 4
    inv_freq = ROPE_THETA ** (-jnp.arange(n_freq, dtype=F32) / n_freq)
    ang = jnp.concatenate([row[:, None] * inv_freq, col[:, None] * inv_freq], -1)
    return jnp.cos(ang), jnp.sin(ang)


def apply_rope(x, cos, sin):
    xp = x.reshape(x.shape[:-1] + (-1, 2))
    x0, x1 = xp[..., 0], xp[..., 1]
    c, s = cos[None, :, None, :], sin[None, :, None, :]
    return jnp.stack([x0 * c - x1 * s, x0 * s + x1 * c], -1).reshape(x.shape).astype(x.dtype)


def qk_rms(z, g):
    zf = z.astype(F32)
    return (zf * lax.rsqrt(jnp.mean(zf * zf, -1, keepdims=True) + NORM_EPS) * g.astype(F32)).astype(z.dtype)


def attention_streams(h, w_in, win_q_norm, win_k_norm, glb_q_norm, glb_k_norm, rope):
    B, T, _ = h.shape
    qw, kw, vw, qg, kg, vg = split_cols(h @ w_in, ATT_SPLITS)
    hd = lambda z: z.reshape(B, T, -1, ATT_HEAD_DIM)
    qw, kw = qk_rms(hd(qw), win_q_norm), qk_rms(hd(kw), win_k_norm)
    qg, kg = qk_rms(hd(qg), glb_q_norm), qk_rms(hd(kg), glb_k_norm)
    if rope is not None:
        cos, sin = rope
        qw, kw, qg, kg = (apply_rope(t, cos, sin) for t in (qw, kw, qg, kg))
    grp = lambda z, kvh: z.reshape(B, T, kvh, -1, ATT_HEAD_DIM)
    return grp(qw, WIN_KV_HEADS), kw, hd(vw), grp(qg, GLB_KV_HEADS), kg, hd(vg)


def window_attention(q, k, v, k_ctx, v_ctx, sink):
    B, T, KV, G, dh = q.shape
    L = Q_BLOCK
    nb = T // L
    Lc = k_ctx.shape[1]
    scale = dh ** -0.5
    qb = q.reshape(B, nb, L, KV, G, dh)

    def band(z):
        zp = jnp.pad(z, ((0, 0), (L, L), (0, 0), (0, 0))).reshape(B, nb + 2, L, KV, dh)
        return jnp.concatenate([zp[:, :-2], zp[:, 1:-1], zp[:, 2:]], axis=2)

    kb, vb = band(k), band(v)
    s_loc = jnp.einsum('bnqkgd,bnskd->bnkgqs', qb, kb).astype(F32) * scale
    q_pos = jnp.arange(nb)[:, None] * L + jnp.arange(L)[None, :]
    k_pos = jnp.arange(nb)[:, None] * L + jnp.arange(3 * L)[None, :] - L
    valid = ((jnp.abs(k_pos[:, None, :] - q_pos[:, :, None]) <= WINDOW)
             & (k_pos >= 0)[:, None, :] & (k_pos < T)[:, None, :])
    s_loc = jnp.where(valid[None, :, None, None], s_loc, -jnp.inf)
    s_ctx = jnp.einsum('bnqkgd,bckd->bnkgqc', qb, k_ctx).astype(F32) * scale
    s_sink = jnp.broadcast_to(sink.astype(F32).reshape(KV, G)[None, None, :, :, None, None], s_loc.shape[:-1] + (1,))
    p = jax.nn.softmax(jnp.concatenate([s_loc, s_ctx, s_sink], -1), axis=-1).astype(v.dtype)
    o = (jnp.einsum('bnkgqs,bnskd->bnqkgd', p[..., :3 * L], vb)
         + jnp.einsum('bnkgqc,bckd->bnqkgd', p[..., 3 * L:3 * L + Lc], v_ctx))
    return o.reshape(B, T, KV * G * dh)


def global_attention(q, k, v, k_ctx, v_ctx):
    B, T, KV, G, dh = q.shape
    L = Q_BLOCK
    nb = T // L
    scale = dh ** -0.5
    keys = jnp.concatenate([k, k_ctx], axis=1)
    vals = jnp.concatenate([v, v_ctx], axis=1)
    qb = jnp.moveaxis(q.reshape(B, nb, L, KV, G, dh), 1, 0)

    def block(q_blk):
        s = jnp.einsum('bqkgd,bskd->bkgqs', q_blk, keys).astype(F32) * scale
        p = jax.nn.softmax(s, axis=-1).astype(vals.dtype)
        return jnp.einsum('bkgqs,bskd->bqkgd', p, vals)

    o = lax.map(block, qb)
    return jnp.moveaxis(o, 0, 1).reshape(B, T, KV * G * dh)


def context_attention(q, k, v, sink):
    B, Lc, KV, G, dh = q.shape
    s = jnp.einsum('bqkgd,bskd->bkgqs', q, k).astype(F32) * dh ** -0.5
    if sink is not None:
        s = jnp.concatenate([s, jnp.broadcast_to(sink.astype(F32).reshape(KV, G)[None, :, :, None, None], s.shape[:-1] + (1,))], -1)
    p = jax.nn.softmax(s, axis=-1)[..., :Lc].astype(v.dtype)
    return jnp.einsum('bkgqs,bskd->bqkgd', p, v).reshape(B, Lc, KV * G * dh)


def attention_mix(h_lat, h_ctx, w_in, win_q_norm, win_k_norm, win_sink, glb_q_norm, glb_k_norm, w_out, need_ctx):
    rope = axial_rope(h_lat.shape[1], ATT_HEAD_DIM)
    qw, kw, vw, qg, kg, vg = attention_streams(h_lat, w_in, win_q_norm, win_k_norm, glb_q_norm, glb_k_norm, rope)
    cqw, ckw, cvw, cqg, ckg, cvg = attention_streams(h_ctx, w_in, win_q_norm, win_k_norm, glb_q_norm, glb_k_norm, None)
    y_lat = jnp.concatenate([window_attention(qw, kw, vw, ckw, cvw, win_sink),
                             global_attention(qg, kg, vg, ckg, cvg)], -1) @ w_out
    y_ctx = None
    if need_ctx:
        y_ctx = jnp.concatenate([context_attention(cqw, ckw, cvw, win_sink),
                                 context_attention(cqg, ckg, cvg, None)], -1) @ w_out
    return y_lat, y_ctx


def setup_inputs(seed: int = 0) -> dict:
    key = jax.random.key(seed)
    keys = iter(jax.random.split(key, 40))

    def nrm(shape, scale):
        return jax.random.normal(next(keys), shape, F32) * scale

    def gain(shape):
        return 1.0 + nrm(shape, 0.02)

    nr, na = N_REC_LAYERS, N_ATT_LAYERS
    f_bias = jnp.linspace(3.0, 6.0, ML_HEADS, dtype=F32)
    zero_b = jnp.zeros((ML_HEADS,), F32)
    gate_base = jnp.stack([zero_b, f_bias, zero_b, f_bias])
    w0_base = jnp.tile(jnp.linspace(-6.0, -1.0, RW_HEAD_DIM, dtype=F32), RW_HEADS)
    conv_base = jnp.where(jnp.arange(RW_SHIFT_WIDTH) == RW_SHIFT_WIDTH // 2, 0.5, 0.25).astype(F32)[:, None]
    return {
        'x': nrm((BATCH, SEQ, D_MODEL), 1.0),
        'c': nrm((BATCH, D_MODEL), 1.0),
        'ctx': nrm((BATCH, CTX_LEN, D_MODEL), 1.0),
        'c_ctx': nrm((D_MODEL,), 1.0),
        'norm_mix': gain((DEPTH, D_MODEL)),
        'norm_ffn': gain((DEPTH, D_MODEL)),
        'mod_w': nrm((DEPTH, D_MODEL, 6 * D_MODEL), 0.5 * D_MODEL ** -0.5),
        'mod_b': nrm((DEPTH, 6 * D_MODEL), 0.02),
        'out_w': nrm((DEPTH, MIX_WIDTH, D_MODEL), MIX_WIDTH ** -0.5),
        'ffn_w1': nrm((DEPTH, D_MODEL, D_FF), D_MODEL ** -0.5),
        'ffn_w2': nrm((DEPTH, D_FF, D_MODEL), D_FF ** -0.5),
        'rec_in_w': nrm((nr, D_MODEL, REC_IN), D_MODEL ** -0.5),
        'ml_gate_b': gate_base[None] + nrm((nr, 4, ML_HEADS), 0.1),
        'ml_norm_g': gain((nr, ML_WIDTH)),
        'rw_conv': conv_base[None] + nrm((nr, RW_SHIFT_WIDTH, 3 * RW_WIDTH), 0.1),
        'rw_w0': w0_base[None, None] + nrm((nr, 2, RW_WIDTH), 0.1),
        'rw_w2': nrm((nr, 2, RW_DECAY_RANK, RW_WIDTH), 0.5 * RW_DECAY_RANK ** -0.5),
        'rw_a0': nrm((nr, 2, RW_WIDTH), 0.1),
        'rw_a2': nrm((nr, 2, RW_ICLR_RANK, RW_WIDTH), 0.5 * RW_ICLR_RANK ** -0.5),
        'rw_g2': nrm((nr, RW_GATE_RANK, RW_WIDTH), RW_GATE_RANK ** -0.5),
        'rw_kk': 0.85 + nrm((nr, RW_WIDTH), 0.05),
        'rw_ka': 1.0 + nrm((nr, RW_WIDTH), 0.05),
        'rw_rk': nrm((nr, RW_WIDTH), 0.05),
        'rw_norm_g': gain((nr, RW_WIDTH)),
        'att_in_w': nrm((na, D_MODEL, ATT_IN), D_MODEL ** -0.5),
        'win_q_norm': gain((na, ATT_HEAD_DIM)),
        'win_k_norm': gain((na, ATT_HEAD_DIM)),
        'win_sink': nrm((na, WIN_Q_HEADS), 0.5),
        'glb_q_norm': gain((na, ATT_HEAD_DIM)),
        'glb_k_norm': gain((na, ATT_HEAD_DIM)),
    }


def reference(x, c, ctx, c_ctx, norm_mix, norm_ffn, mod_w, mod_b, out_w, ffn_w1, ffn_w2,
              rec_in_w, ml_gate_b, ml_norm_g, rw_conv, rw_w0, rw_w2, rw_a0, rw_a2, rw_g2, rw_kk, rw_ka, rw_rk,
              rw_norm_g, att_in_w, win_q_norm, win_k_norm, win_sink, glb_q_norm, glb_k_norm):
    x_ctx = ctx
    for layer in range(DEPTH):
        need_ctx = layer < DEPTH - 1
        j = layer // 2
        sh1, sc1, g1, sh2, sc2, g2 = adaln(c[:, None, :], mod_w[layer], mod_b[layer])
        csh1, csc1, cg1, csh2, csc2, cg2 = adaln(c_ctx[None, None, :], mod_w[layer], mod_b[layer])
        h_lat = rms_norm(x, norm_mix[layer]) * (1.0 + sc1) + sh1
        h_ctx = rms_norm(x_ctx, norm_mix[layer]) * (1.0 + csc1) + csh1
        if layer % 2 == 0:
            y_lat, y_ctx = recurrent_mix(h_lat, h_ctx, rec_in_w[j], ml_gate_b[j], ml_norm_g[j], rw_conv[j],
                                         rw_w0[j], rw_w2[j], rw_a0[j], rw_a2[j], rw_g2[j], rw_kk[j], rw_ka[j],
                                         rw_rk[j], rw_norm_g[j], out_w[layer], need_ctx)
        else:
            y_lat, y_ctx = attention_mix(h_lat, h_ctx, att_in_w[j], win_q_norm[j], win_k_norm[j], win_sink[j],
                                         glb_q_norm[j], glb_k_norm[j], out_w[layer], need_ctx)
        x = x + g1 * y_lat
        x = x + g2 * sq_relu_mlp(rms_norm(x, norm_ffn[layer]) * (1.0 + sc2) + sh2, ffn_w1[layer], ffn_w2[layer])
        if need_ctx:
            x_ctx = x_ctx + cg1 * y_ctx
            x_ctx = x_ctx + cg2 * sq_relu_mlp(rms_norm(x_ctx, norm_ffn[layer]) * (1.0 + csc2) + csh2,
                                              ffn_w1[layer], ffn_w2[layer])
    return x
```

```cpp
#include <hip/hip_runtime.h>
#include <hip/hip_bf16.h>
#include <cstdio>
#include <cstdint>
#include <cmath>
namespace pg8 {
#define PG8_LAS __attribute__((address_space(3)))
typedef unsigned short bf16_t;
typedef short bf16x8 __attribute__((ext_vector_type(8)));
typedef float f32x4 __attribute__((ext_vector_type(4)));
typedef unsigned u32x4 __attribute__((ext_vector_type(4)));
constexpr int BM = 256, BK = 64, HALF = 128, HTB = HALF * BK * 2  , STAGE_BYTES = 8 * HTB, NXCD = 8, WGM = 8;

__host__ __device__ __forceinline__ int lds_byte(int r, int c) { const int st = (r >> 4) * 2 + (c >> 5), rr = r & 15, cc = c & 31, ob = rr * 64 + cc * 2; return st * 1024 + (ob ^ (((ob >> 9) & 1) << 5)); }
__host__ __device__ __forceinline__ void stage_rc(int b, int& R, int& C) { const int st = b / 1024, sb = b % 1024, swz = sb ^ (((sb >> 9) & 1) << 5); R = (st >> 1) * 16 + swz / 64; C = (st & 1) * 32 + (swz % 64) / 2; }
__host__ __device__ __forceinline__ int perm32(int rho) { const int n = rho >> 4, i = rho & 15; return 8 * (i >> 2) + 4 * n + (i & 3); }

struct Unit { int pm, pn; };
struct Gemm { const bf16_t* A; const bf16_t* Bt; int M, N, K; };

struct StaticOrder {
    int nM, nN, nwg, G, c;
    __host__ __device__ void init(int M, int N, int G_, int c_) { nM = M / BM; nN = N / BM; nwg = nM * nN; G = G_; c = c_; }
    __host__ __device__ bool next(int i, Unit& u) const {
        const long L = (long)i * G + c; if (L >= nwg) return false;
        int wgid = (int)L; { const int q = nwg / NXCD, r = nwg % NXCD, xcd = wgid % NXCD, off = wgid / NXCD; wgid = (xcd < r ? xcd * (q + 1) : r * (q + 1) + (xcd - r) * q) + off; }
        const int nig = WGM * nN, gid = wgid / nig, fm = gid * WGM, gsz = (nM - fm) < WGM ? (nM - fm) : WGM;
        u.pm = fm + ((wgid % nig) % gsz); u.pn = (wgid % nig) / gsz; return true;
    }
    __device__ __forceinline__ void a_ready(const Unit&) const {}
    __device__ __forceinline__ void done(const Unit&) const {}
};

__device__ __forceinline__ unsigned cvt_pk_bf16(float lo, float hi) { unsigned r; asm volatile("v_cvt_pk_bf16_f32 %0, %1, %2" : "=v"(r) : "v"(lo), "v"(hi)); return r; }
typedef float f32x2 __attribute__((ext_vector_type(2)));
__device__ __forceinline__ f32x2 gelu_pk(f32x2 v) {
    const f32x2 av = __builtin_elementwise_abs(v), d = av * 0.2316418882f + 1.0f;
    f32x2 t; t.x = __builtin_amdgcn_rcpf(d.x); t.y = __builtin_amdgcn_rcpf(d.y);
    f32x2 q = t * 0.5307027145f + (-0.7265760135f); q = q * t + 0.7107068705f; q = q * t + (-0.142248368f); q = q * t + 0.127414796f; q = q * t;
    const f32x2 s = (v * v) * (-0.72134752044f);
    f32x2 e; e.x = __builtin_amdgcn_exp2f(s.x); e.y = __builtin_amdgcn_exp2f(s.y);
    const f32x2 m = v * (q * e), r = v - m;
    f32x2 o; o.x = v.x < 0.f ? m.x : r.x; o.y = v.y < 0.f ? m.y : r.y; return o;
}

template <int ACT  > struct EpiBf16 {
    static constexpr bool PERM = true, AFTER_DRAIN = false; static_assert(ACT == 0 || ACT == 1, "EpiBf16: ACT is 0 (none) or 1 (gelu_pk)");
    bf16_t* O; int ldc; const float* bias; int split_cols; size_t split_stride; float scale0;
    __device__ __forceinline__ void operator()(const f32x4 (&acc)[2][2][4][2], const Unit& u, int wr, int wc, int fr, int fq) const {
        const int row0 = u.pm * BM + wr * 64 + fr; int colt = u.pn * BM; bf16_t* base = O;
        float sc = 1.f; if (split_cols) { const int t = colt / split_cols; base += (size_t)t * split_stride; colt -= t * split_cols; if (t == 0) sc = scale0; }
        const int col0 = colt + wc * 32 + 8 * fq, bcol0 = u.pn * BM + wc * 32 + 8 * fq;
        f32x4 bv[2][2];
#pragma unroll
        for (int bj = 0; bj < 2; ++bj)
#pragma unroll
            for (int n = 0; n < 2; ++n) bv[bj][n] = bias ? *(const f32x4*)(bias + bcol0 + bj * HALF + 4 * n) : (f32x4){0.f, 0.f, 0.f, 0.f};
#pragma unroll
        for (int ai = 0; ai < 2; ++ai)
#pragma unroll
            for (int m = 0; m < 4; ++m) { bf16_t* rowp = base + (size_t)(row0 + ai * HALF + m * 16) * ldc + col0;
#pragma unroll
                for (int bj = 0; bj < 2; ++bj) { f32x4 v0 = acc[ai][bj][m][0] + bv[bj][0], v1 = acc[ai][bj][m][1] + bv[bj][1];
                    if (ACT == 1) { f32x2 a = gelu_pk((f32x2){v0[0], v0[1]}), b = gelu_pk((f32x2){v0[2], v0[3]}), c = gelu_pk((f32x2){v1[0], v1[1]}), d = gelu_pk((f32x2){v1[2], v1[3]});
                        v0 = (f32x4){a.x, a.y, b.x, b.y}; v1 = (f32x4){c.x, c.y, d.x, d.y}; }
                    v0 = v0 * sc; v1 = v1 * sc; u32x4 w; w.x = cvt_pk_bf16(v0[0], v0[1]); w.y = cvt_pk_bf16(v0[2], v0[3]); w.z = cvt_pk_bf16(v1[0], v1[1]); w.w = cvt_pk_bf16(v1[2], v1[3]);
                    *(u32x4*)(rowp + bj * HALF) = w; } }
    }
};

struct PanelStats {
    unsigned* xbuf;
    unsigned* cnt;
    unsigned* tmo;
    int ntn; float eps;
    unsigned code;
    __device__ __forceinline__ bool run(const f32x4 (&v)[2][2][4][2], const Unit& u, int wr, int wc, int fr, int fq, PG8_LAS unsigned char* lds, int wid, int lane) const {
        typedef float f32x2v __attribute__((ext_vector_type(2)));
        PG8_LAS f32x2v* P = (PG8_LAS f32x2v*)lds;
        PG8_LAS f32x2v* S = (PG8_LAS f32x2v*)(lds + 8192);
        PG8_LAS unsigned* flag = (PG8_LAS unsigned*)(lds + 8192 + 2048);
#pragma unroll
        for (int ai = 0; ai < 2; ++ai)
#pragma unroll
            for (int m = 0; m < 4; ++m) {
                float s = 0.f;
#pragma unroll
                for (int bj = 0; bj < 2; ++bj)
#pragma unroll
                    for (int n = 0; n < 2; ++n) { const f32x4 x = v[ai][bj][m][n]; s += (x[0] + x[1]) + (x[2] + x[3]); }
                s += __shfl_xor(s, 16); s += __shfl_xor(s, 32);
                const float mw = s * (1.0f / 64.0f); float q = 0.f;
#pragma unroll
                for (int bj = 0; bj < 2; ++bj)
#pragma unroll
                    for (int n = 0; n < 2; ++n) { const f32x4 d = v[ai][bj][m][n] - mw; q += (d[0] * d[0] + d[1] * d[1]) + (d[2] * d[2] + d[3] * d[3]); }
                q += __shfl_xor(q, 16); q += __shfl_xor(q, 32);
                if (fq == 0) P[(ai * HALF + wr * 64 + m * 16 + fr) * 4 + wc] = (f32x2v){mw, q};
            }
        asm volatile("s_waitcnt lgkmcnt(0)" ::: "memory"); __builtin_amdgcn_s_barrier(); asm volatile("" ::: "memory");
#if defined(BROKEN_EXCHANGE_NO_WAIT)
#warning BROKEN CONTROL BUILD: the row-statistics exchange does not wait; results are wrong by design
        if (blockIdx.x >= 64) { const long long t0_ = clock64(); while (clock64() - t0_ < 60000) __builtin_amdgcn_s_sleep(8); }
#endif
        const int row = wid * 32 + (lane & 31);
        if (lane < 32) {
            const f32x2v a = P[row * 4 + 0], b = P[row * 4 + 1], c = P[row * 4 + 2], d = P[row * 4 + 3];
            const float mt = (a.x + b.x + c.x + d.x) * 0.25f;
            const float da = a.x - mt, db = b.x - mt, dc = c.x - mt, dd = d.x - mt;
            const float m2 = (a.y + b.y) + (c.y + d.y) + 64.0f * ((da * da + db * db) + (dc * dc + dd * dd));
            unsigned long long* slot = (unsigned long long*)xbuf + ((size_t)(u.pm * BM + row) * 4 + u.pn);
            __hip_atomic_store(slot, ((unsigned long long)__float_as_uint(m2) << 32) | __float_as_uint(mt), __ATOMIC_RELAXED, __HIP_MEMORY_SCOPE_AGENT);
        }
        asm volatile("s_waitcnt vmcnt(0)" ::: "memory");
        if (lane == 0) __hip_atomic_fetch_add(cnt + 64 * u.pm, 1u, __ATOMIC_RELAXED, __HIP_MEMORY_SCOPE_AGENT);
        if (wid == 0) {
            bool dead = false; const unsigned long long t0 = __builtin_amdgcn_s_memrealtime(); const unsigned want = 8u * (unsigned)ntn;
            for (;;) {
#if defined(BROKEN_EXCHANGE_NO_WAIT)
                break;
#endif
                if ((unsigned)__builtin_amdgcn_readfirstlane(__hip_atomic_load(cnt + 64 * u.pm, __ATOMIC_RELAXED, __HIP_MEMORY_SCOPE_AGENT)) >= want) break;
                if (__builtin_amdgcn_s_memrealtime() - t0 > 2000000ull) {
                    if (lane == 0) { unsigned expect = 0u; __hip_atomic_compare_exchange_strong(tmo + 1, &expect, code | (unsigned)(u.pm & 0xff), __ATOMIC_RELAXED, __ATOMIC_RELAXED, __HIP_MEMORY_SCOPE_AGENT);
                                     __hip_atomic_store(tmo, 1u, __ATOMIC_RELAXED, __HIP_MEMORY_SCOPE_AGENT); }
                    dead = true; break; }
                __builtin_amdgcn_s_sleep(2);
            }
            __builtin_amdgcn_fence(__ATOMIC_ACQUIRE, "agent");
            if (lane == 0) flag[0] = dead ? 1u : 0u;
        }
        asm volatile("s_waitcnt vmcnt(0) lgkmcnt(0)" ::: "memory"); __builtin_amdgcn_s_barrier(); asm volatile("" ::: "memory");
        const bool bad = flag[0] != 0u;
        if (lane < 32) {
            const unsigned long long* slot = (const unsigned long long*)xbuf + (size_t)(u.pm * BM + row) * 4; float mt[4], m2[4]; float ms = 0.f;
#pragma unroll
            for (int t = 0; t < 4; ++t) { if (t < ntn) { const unsigned long long w = __hip_atomic_load(slot + t, __ATOMIC_RELAXED, __HIP_MEMORY_SCOPE_AGENT); mt[t] = __uint_as_float((unsigned)w); m2[t] = __uint_as_float((unsigned)(w >> 32)); } else { mt[t] = 0.f; m2[t] = 0.f; } ms += mt[t]; }
            const float mean = ms / (float)ntn; float q = 0.f;
#pragma unroll
            for (int t = 0; t < 4; ++t) if (t < ntn) { const float dm = mt[t] - mean; q += m2[t] + 256.0f * dm * dm; }
            S[row] = (f32x2v){mean, 1.0f / sqrtf(q / (256.0f * (float)ntn) + eps)};
        }
        asm volatile("s_waitcnt lgkmcnt(0)" ::: "memory"); __builtin_amdgcn_s_barrier(); asm volatile("" ::: "memory");
        return bad;
    }
};
struct EpiLnRes {
    static constexpr bool PERM = false, AFTER_DRAIN = true;
    const float* base; float* out; int ldc; const float* bias; PanelStats st; unsigned poison;
    __device__ __forceinline__ void fused(f32x4 (&acc)[2][2][4][2], const Unit& u, int wr, int wc, int fr, int fq, PG8_LAS unsigned char* lds, int wid, int lane) const {
        typedef float f32x2v __attribute__((ext_vector_type(2)));
        const PG8_LAS f32x2v* S = (const PG8_LAS f32x2v*)(lds + 8192);
        const int col0 = u.pn * BM + wc * 32 + 4 * fq;
#pragma unroll
        for (int bj = 0; bj < 2; ++bj)
#pragma unroll
            for (int n = 0; n < 2; ++n) { const f32x4 bv = bias ? *(const f32x4*)(bias + col0 + bj * HALF + n * 16) : (f32x4){0.f, 0.f, 0.f, 0.f};
#pragma unroll
                for (int ai = 0; ai < 2; ++ai)
#pragma unroll
                    for (int m = 0; m < 4; ++m) acc[ai][bj][m][n] += bv; }
        f32x4 pre[4][2][2];
#pragma unroll
        for (int m = 0; m < 4; ++m) { const size_t off = (size_t)(u.pm * BM + wr * 64 + m * 16 + fr) * ldc + col0;
#pragma unroll
            for (int bj = 0; bj < 2; ++bj)
#pragma unroll
                for (int n = 0; n < 2; ++n) pre[m][bj][n] = *(const f32x4*)(base + off + bj * HALF + n * 16); }
        const bool bad = st.run(acc, u, wr, wc, fr, fq, lds, wid, lane) || poison != 0u;
        const float qnan = __builtin_nanf("");
#pragma unroll
        for (int ai = 0; ai < 2; ++ai)
#pragma unroll
            for (int m = 0; m < 4; ++m) { const int r = ai * HALF + wr * 64 + m * 16 + fr; const f32x2v sr = S[r]; const size_t off = (size_t)(u.pm * BM + r) * ldc + col0;
#pragma unroll
                for (int bj = 0; bj < 2; ++bj)
#pragma unroll
                    for (int n = 0; n < 2; ++n) { const f32x4 bs = ai == 0 ? pre[m][bj][n] : *(const f32x4*)(base + off + bj * HALF + n * 16); f32x4 o = bs + (acc[ai][bj][m][n] - sr.x) * sr.y;
                        if (bad) o = (f32x4){qnan, qnan, qnan, qnan}; *(f32x4*)(out + off + bj * HALF + n * 16) = o; }
                if (m & 1) asm volatile("" ::: "memory"); }
    }
};
struct EpiLnResLn {
    static constexpr bool PERM = false, AFTER_DRAIN = true;
    const float* base; float* out; bf16_t* xn; int ldc; const float* bias; PanelStats st1, st2; unsigned poison;
    __device__ __forceinline__ void fused(f32x4 (&acc)[2][2][4][2], const Unit& u, int wr, int wc, int fr, int fq, PG8_LAS unsigned char* lds, int wid, int lane) const {
        typedef float f32x2v __attribute__((ext_vector_type(2))); typedef unsigned u32x2v __attribute__((ext_vector_type(2)));
        const PG8_LAS f32x2v* S = (const PG8_LAS f32x2v*)(lds + 8192);
        const int col0 = u.pn * BM + wc * 32 + 4 * fq;
#pragma unroll
        for (int bj = 0; bj < 2; ++bj)
#pragma unroll
            for (int n = 0; n < 2; ++n) { const f32x4 bv = bias ? *(const f32x4*)(bias + col0 + bj * HALF + n * 16) : (f32x4){0.f, 0.f, 0.f, 0.f};
#pragma unroll
                for (int ai = 0; ai < 2; ++ai)
#pragma unroll
                    for (int m = 0; m < 4; ++m) acc[ai][bj][m][n] += bv; }
        bool bad = st1.run(acc, u, wr, wc, fr, fq, lds, wid, lane) || poison != 0u;
        const float qnan = __builtin_nanf("");
#pragma unroll
        for (int ai = 0; ai < 2; ++ai)
#pragma unroll
            for (int m = 0; m < 4; ++m) { const int r = ai * HALF + wr * 64 + m * 16 + fr; const f32x2v sr = S[r]; const size_t off = (size_t)(u.pm * BM + r) * ldc + col0;
#pragma unroll
                for (int bj = 0; bj < 2; ++bj)
#pragma unroll
                    for (int n = 0; n < 2; ++n) { const f32x4 bs = *(const f32x4*)(base + off + bj * HALF + n * 16); acc[ai][bj][m][n] = bs + (acc[ai][bj][m][n] - sr.x) * sr.y; }
                asm volatile("" : "+v"(acc[ai][0][m][0]), "+v"(acc[ai][0][m][1]), "+v"(acc[ai][1][m][0]), "+v"(acc[ai][1][m][1]));
                if (m & 1) asm volatile("" ::: "memory"); }
        const bool bad1 = bad;
        bad = st2.run(acc, u, wr, wc, fr, fq, lds, wid, lane) || bad;
#pragma unroll
        for (int ai = 0; ai < 2; ++ai)
#pragma unroll
            for (int m = 0; m < 4; ++m) { const int r = ai * HALF + wr * 64 + m * 16 + fr; const f32x2v sr = S[r]; const size_t off = (size_t)(u.pm * BM + r) * ldc + col0;
#pragma unroll
                for (int bj = 0; bj < 2; ++bj)
#pragma unroll
                    for (int n = 0; n < 2; ++n) { const f32x4 x1 = acc[ai][bj][m][n]; *(f32x4*)(out + off + bj * HALF + n * 16) = bad1 ? (f32x4){qnan, qnan, qnan, qnan} : x1;
                        const f32x4 o = (x1 - sr.x) * sr.y; u32x2v w; w.x = cvt_pk_bf16(o[0], o[1]); w.y = cvt_pk_bf16(o[2], o[3]);
                        if (bad) { w.x = 0x7fc07fc0u; w.y = 0x7fc07fc0u; } *(u32x2v*)(xn + off + bj * HALF + n * 16) = w; }
                asm volatile("" ::: "memory"); }
    }
};

template <class Epi, class Sched, bool ALIGN_EPI = false, bool SP2 = false>
__device__ __forceinline__ void gemm_phase(PG8_LAS unsigned char* lds, const Gemm g, const Sched& S, const Epi& E) {
    const int tid = threadIdx.x, wid = __builtin_amdgcn_readfirstlane(tid >> 6), lane = tid & 63, wr = wid >> 2, wc = wid & 3, fr = lane & 15, fq = lane >> 4;
    const int K = g.K, nt = K / BK;
    unsigned voffA[2], voffB[2];
#pragma unroll
    for (int i = 0; i < 2; ++i) { int R, C; stage_rc(tid * 16 + i * 8192, R, C); const int Rb = Epi::PERM ? ((R & ~31) + perm32(R & 31)) : R;
        voffA[i] = (unsigned)(R * K + C) * 2u; voffB[i] = (unsigned)(Rb * K + C) * 2u; }
    const size_t kstep = (size_t)(BK * 2);
    const size_t hstep = (size_t)HALF * K * 2;
    const size_t tstep = 2 * hstep;
    const unsigned ldsw = (unsigned)wid * 1024u;
    const int aoff = lds_byte(wr * 64 + fr, fq * 8), boff = lds_byte(wc * 32 + fr, fq * 8);
#define PG8_SA(b, h) (((b) * 2 + (h)) * HTB)
#define PG8_SB(b, h) ((4 + (b) * 2 + (h)) * HTB)
#define PG8_STAGE(bufoff, gbase, voff) do { _Pragma("unroll") for (int _i = 0; _i < 2; ++_i) \
        __builtin_amdgcn_global_load_lds((const unsigned*)((const char*)(gbase) + (voff)[_i]), (PG8_LAS unsigned*)(lds + (bufoff) + ldsw + _i * 8192), 16, 0, 0); } while (0)
#define PG8_LDA(dst, b, h) do { _Pragma("unroll") for (int m = 0; m < 4; ++m) _Pragma("unroll") for (int k = 0; k < 2; ++k) dst[m][k] = *(const PG8_LAS bf16x8*)(lds + PG8_SA(b, h) + aoff + m * 2048 + k * 1024); } while (0)
#define PG8_LDB(dst, b, h) do { _Pragma("unroll") for (int n = 0; n < 2; ++n) _Pragma("unroll") for (int k = 0; k < 2; ++k) dst[n][k] = *(const PG8_LAS bf16x8*)(lds + PG8_SB(b, h) + boff + n * 2048 + k * 1024); } while (0)
#define PG8_MMA(ai, bj, At, Bt) do { __builtin_amdgcn_s_setprio(1); _Pragma("unroll") for (int m = 0; m < 4; ++m) _Pragma("unroll") for (int n = 0; n < 2; ++n) _Pragma("unroll") for (int k = 0; k < 2; ++k) \
        acc[ai][bj][m][n] = __builtin_amdgcn_mfma_f32_16x16x32_bf16(Bt[n][k], At[m][k], acc[ai][bj][m][n], 0, 0, 0); __builtin_amdgcn_s_setprio(0); } while (0)
#define PG8_WAIT_V(n) asm volatile("s_waitcnt vmcnt(" #n ")" ::: "memory")
#define PG8_WAIT_L(n) asm volatile("s_waitcnt lgkmcnt(" #n ")" ::: "memory")
#define PG8_BAR __builtin_amdgcn_s_barrier()
#define PG8_SCHED __builtin_amdgcn_sched_barrier(0)
    Unit cur, nxt; int ui = 0;
    if (!S.next(0, cur)) return;
    f32x4 acc[2][2][4][2];
#pragma unroll
    for (int a = 0; a < 2; ++a)
#pragma unroll
        for (int b = 0; b < 2; ++b)
#pragma unroll
            for (int m = 0; m < 4; ++m)
#pragma unroll
                for (int n = 0; n < 2; ++n) acc[a][b][m][n] = (f32x4){0.f, 0.f, 0.f, 0.f};
    bf16x8 At[4][2], B0[2][2], B1[2][2];
    const char* cA = (const char*)g.A + (size_t)cur.pm * tstep; const char* cB = (const char*)g.Bt + (size_t)cur.pn * tstep;
    S.a_ready(cur);
    if constexpr (SP2) {
        PG8_STAGE(PG8_SB(0, 0), cB, voffB); PG8_STAGE(PG8_SB(0, 1), cB + hstep, voffB); PG8_STAGE(PG8_SA(0, 0), cA, voffA); PG8_STAGE(PG8_SA(0, 1), cA + hstep, voffA);
        if (wr == 1) PG8_BAR;
        PG8_WAIT_V(2); PG8_BAR;
        PG8_STAGE(PG8_SB(1, 0), cB + kstep, voffB); PG8_STAGE(PG8_SA(1, 0), cA + kstep, voffA); PG8_STAGE(PG8_SB(1, 1), cB + hstep + kstep, voffB);
        PG8_WAIT_V(6); PG8_BAR;
    } else {
        PG8_STAGE(PG8_SB(0, 0), cB, voffB); PG8_STAGE(PG8_SA(0, 0), cA, voffA); PG8_STAGE(PG8_SB(0, 1), cB + hstep, voffB); PG8_STAGE(PG8_SA(0, 1), cA + hstep, voffA);
        if (wr == 1) PG8_BAR;
        PG8_WAIT_V(4); PG8_BAR;
        PG8_STAGE(PG8_SB(1, 0), cB + kstep, voffB); PG8_STAGE(PG8_SA(1, 0), cA + kstep, voffA); PG8_STAGE(PG8_SB(1, 1), cB + hstep + kstep, voffB);
        PG8_WAIT_V(6); PG8_BAR;
    }
    for (;;) {
        const bool has_next = S.next(ui + 1, nxt);
        const char* nA = has_next ? (const char*)g.A + (size_t)nxt.pm * tstep : cA; const char* nB = has_next ? (const char*)g.Bt + (size_t)nxt.pn * tstep : cB;
        for (int t = 0; t < nt; t += 2) {
            const bool last = (t == nt - 2);
            const char* a1 = cA + (size_t)(t + 1) * kstep;
            const char* a2 = last ? nA : cA + (size_t)(t + 2) * kstep; const char* b2 = last ? nB : cB + (size_t)(t + 2) * kstep;
            const char* a3 = a2 + kstep; const char* b3 = b2 + kstep;
            if (last && has_next) S.a_ready(nxt);
            if constexpr (SP2) {
            PG8_LDB(B0, 0, 0); PG8_LDB(B1, 0, 1); PG8_SCHED; PG8_LDA(At, 0, 0); PG8_STAGE(PG8_SA(1, 1), a1 + hstep, voffA);
            PG8_WAIT_V(8); PG8_WAIT_L(0); PG8_BAR; PG8_MMA(0, 0, At, B0); PG8_MMA(0, 1, At, B1); PG8_BAR; PG8_SCHED;
            PG8_LDA(At, 0, 1); PG8_STAGE(PG8_SB(0, 0), b2, voffB); PG8_STAGE(PG8_SB(0, 1), b2 + hstep, voffB); PG8_STAGE(PG8_SA(0, 0), a2, voffA);
            PG8_WAIT_V(8); PG8_WAIT_L(0); PG8_BAR; PG8_MMA(1, 0, At, B0); PG8_MMA(1, 1, At, B1); PG8_BAR; PG8_SCHED;
            PG8_LDB(B0, 1, 0); PG8_LDB(B1, 1, 1); PG8_SCHED; PG8_LDA(At, 1, 0); PG8_STAGE(PG8_SA(0, 1), a2 + hstep, voffA);
            PG8_WAIT_V(8); PG8_WAIT_L(0); PG8_BAR; PG8_MMA(0, 0, At, B0); PG8_MMA(0, 1, At, B1); PG8_BAR; PG8_SCHED;
            PG8_LDA(At, 1, 1); PG8_STAGE(PG8_SB(1, 0), b3, voffB); PG8_STAGE(PG8_SB(1, 1), b3 + hstep, voffB); PG8_STAGE(PG8_SA(1, 0), a3, voffA);
            PG8_WAIT_V(8); PG8_WAIT_L(0); PG8_BAR; PG8_MMA(1, 0, At, B0); PG8_MMA(1, 1, At, B1); PG8_BAR; PG8_SCHED;
            } else {
            PG8_LDB(B0, 0, 0); PG8_SCHED; PG8_LDA(At, 0, 0); PG8_STAGE(PG8_SA(1, 1), a1 + hstep, voffA);
            PG8_WAIT_L(8); PG8_BAR; PG8_WAIT_L(0); PG8_MMA(0, 0, At, B0); PG8_BAR; PG8_SCHED;
            PG8_LDB(B1, 0, 1); PG8_STAGE(PG8_SB(0, 0), b2, voffB);
            PG8_BAR; PG8_WAIT_L(0); PG8_MMA(0, 1, At, B1); PG8_BAR;
            PG8_LDA(At, 0, 1); PG8_STAGE(PG8_SA(0, 0), a2, voffA);
            PG8_BAR; PG8_WAIT_L(0); PG8_MMA(1, 0, At, B0); PG8_BAR; PG8_SCHED;
            PG8_STAGE(PG8_SB(0, 1), b2 + hstep, voffB);
            PG8_WAIT_V(6); PG8_BAR; PG8_MMA(1, 1, At, B1); PG8_BAR;
            PG8_LDB(B0, 1, 0); PG8_SCHED; PG8_LDA(At, 1, 0); PG8_STAGE(PG8_SA(0, 1), a2 + hstep, voffA);
            PG8_WAIT_L(8); PG8_BAR; PG8_WAIT_L(0); PG8_MMA(0, 0, At, B0); PG8_BAR; PG8_SCHED;
            PG8_LDB(B1, 1, 1); PG8_STAGE(PG8_SB(1, 0), b3, voffB);
            PG8_BAR; PG8_WAIT_L(0); PG8_MMA(0, 1, At, B1); PG8_BAR;
            PG8_LDA(At, 1, 1); PG8_STAGE(PG8_SA(1, 0), a3, voffA);
            PG8_BAR; PG8_WAIT_L(0); PG8_MMA(1, 0, At, B0); PG8_BAR; PG8_SCHED;
            PG8_STAGE(PG8_SB(1, 1), b3 + hstep, voffB);
            PG8_WAIT_V(6); PG8_BAR; PG8_MMA(1, 1, At, B1); PG8_BAR;
            }
        }
        if constexpr (ALIGN_EPI) { if (wr == 0) PG8_BAR; }
        if constexpr (!Epi::AFTER_DRAIN) { E(acc, cur, wr, wc, fr, fq); S.done(cur); }
        if (!has_next) break;
#pragma unroll
        for (int a = 0; a < 2; ++a)
#pragma unroll
            for (int b = 0; b < 2; ++b)
#pragma unroll
                for (int m = 0; m < 4; ++m)
#pragma unroll
                    for (int n = 0; n < 2; ++n) acc[a][b][m][n] = (f32x4){0.f, 0.f, 0.f, 0.f};
        cur = nxt; cA = nA; cB = nB; ++ui;
        if constexpr (ALIGN_EPI) { if (wr == 1) PG8_BAR; }
    }
    PG8_WAIT_V(0);
    if constexpr (!ALIGN_EPI) { if (wr == 0) PG8_BAR; }
    PG8_BAR;
    if constexpr (Epi::AFTER_DRAIN) { E.fused(acc, cur, wr, wc, fr, fq, lds, wid, lane); S.done(cur); }
#undef PG8_SA
#undef PG8_SB
#undef PG8_STAGE
#undef PG8_LDA
#undef PG8_LDB
#undef PG8_MMA
#undef PG8_WAIT_V
#undef PG8_WAIT_L
#undef PG8_BAR
#undef PG8_SCHED
}
}
namespace pg8 {
__device__ __forceinline__ int erow(int ai, int m, int wr, int fr) { return ai * HALF + wr * 64 + m * 16 + fr; }
template <bool PERM> __device__ __forceinline__ int ecol(int bj, int n, int wc, int fq) { return PERM ? (bj * HALF + wc * 32 + 8 * fq + 4 * n) : (bj * HALF + wc * 32 + 16 * n + 4 * fq); }
typedef unsigned u32x2e __attribute__((ext_vector_type(2)));
__device__ __forceinline__ u32x2e pack4(f32x4 v) { u32x2e w; w.x = cvt_pk_bf16(v[0], v[1]); w.y = cvt_pk_bf16(v[2], v[3]); return w; }
__device__ __forceinline__ float sigm(float x) { return 1.0f / (1.0f + __expf(-x)); }
__device__ __forceinline__ float tanh_(float x) { return 1.0f - 2.0f / (1.0f + __expf(2.0f * x)); }

struct EpiRecIn {
    static constexpr bool PERM = false, AFTER_DRAIN = false;
    bf16_t *QM  , *RAWb, *TWAD, *SGD; float* GATES;
    __device__ __forceinline__ void operator()(const f32x4 (&acc)[2][2][4][2], const Unit& u, int wr, int wc, int fr, int fq) const {
        const int pn = u.pn;
#pragma unroll
        for (int ai = 0; ai < 2; ++ai)
#pragma unroll
            for (int m = 0; m < 4; ++m) {
                const size_t row = (size_t)u.pm * BM + erow(ai, m, wr, fr);
#pragma unroll
                for (int bj = 0; bj < 2; ++bj)
#pragma unroll
                    for (int n = 0; n < 2; ++n) {
                        const int c = ecol<false>(bj, n, wc, fq); f32x4 v = acc[ai][bj][m][n];
                        if (pn < 6) {
                            bf16_t* base = QM + (size_t)(pn >> 1) * ((size_t)16896 * 512);
                            if (pn == 2 || pn == 3) v = v * 0.08838834764831845f;
                            *(u32x2e*)(base + row * 512 + (pn & 1) * 256 + c) = pack4(v);
                        } else if (pn < 12) {
                            *(u32x2e*)(RAWb + row * 1536 + (pn - 6) * 256 + c) = pack4(v);
                        } else if (pn == 12) {
                            if (c < 128) { v[0] = tanh_(v[0]); v[1] = tanh_(v[1]); v[2] = tanh_(v[2]); v[3] = tanh_(v[3]); }
                            *(u32x2e*)(TWAD + row * 256 + c) = pack4(v);
                        } else {
                            if (c < 128) { v[0] = sigm(v[0]); v[1] = sigm(v[1]); v[2] = sigm(v[2]); v[3] = sigm(v[3]); *(u32x2e*)(SGD + row * 128 + c) = pack4(v); }
                            else if (c < 144) { *(f32x4*)(GATES + row * 16 + (c - 128)) = v; }
                        }
                    }
            }
    }
};
template <int ldc> struct EpiStoreBf16 {
    static constexpr bool PERM = true, AFTER_DRAIN = false;
    bf16_t* O; int scale_pm; float scale;
    __device__ __forceinline__ void operator()(const f32x4 (&acc)[2][2][4][2], const Unit& u, int wr, int wc, int fr, int fq) const {
        const float sc = (u.pm < scale_pm) ? scale : 1.0f;
#pragma unroll
        for (int ai = 0; ai < 2; ++ai)
#pragma unroll
            for (int m = 0; m < 4; ++m) {
                bf16_t* rowp = O + ((size_t)u.pm * BM + erow(ai, m, wr, fr)) * ldc + (size_t)u.pn * BM;
#pragma unroll
                for (int bj = 0; bj < 2; ++bj) {
                    const f32x4 v0 = acc[ai][bj][m][0] * sc, v1 = acc[ai][bj][m][1] * sc;
                    u32x4 w; w.x = cvt_pk_bf16(v0[0], v0[1]); w.y = cvt_pk_bf16(v0[2], v0[3]); w.z = cvt_pk_bf16(v1[0], v1[1]); w.w = cvt_pk_bf16(v1[2], v1[3]);
                    *(u32x4*)(rowp + ecol<true>(bj, 0, wc, fq)) = w;
                }
            }
    }
};
template <int ldc> struct EpiSqRelu {
    static constexpr bool PERM = true, AFTER_DRAIN = false;
    bf16_t* O;
    __device__ __forceinline__ void operator()(const f32x4 (&acc)[2][2][4][2], const Unit& u, int wr, int wc, int fr, int fq) const {
#pragma unroll
        for (int ai = 0; ai < 2; ++ai)
#pragma unroll
            for (int m = 0; m < 4; ++m) {
                bf16_t* rowp = O + ((size_t)u.pm * BM + erow(ai, m, wr, fr)) * ldc + (size_t)u.pn * BM;
#pragma unroll
                for (int bj = 0; bj < 2; ++bj) {
                    f32x4 v0 = acc[ai][bj][m][0], v1 = acc[ai][bj][m][1];
#pragma unroll
                    for (int e = 0; e < 4; ++e) { const float a = fmaxf(v0[e], 0.f), b = fmaxf(v1[e], 0.f); v0[e] = a * a; v1[e] = b * b; }
                    u32x4 w; w.x = cvt_pk_bf16(v0[0], v0[1]); w.y = cvt_pk_bf16(v0[2], v0[3]); w.z = cvt_pk_bf16(v1[0], v1[1]); w.w = cvt_pk_bf16(v1[2], v1[3]);
                    *(u32x4*)(rowp + ecol<true>(bj, 0, wc, fq)) = w;
                }
            }
    }
};
struct EpiResid {
    static constexpr bool PERM = false, AFTER_DRAIN = false;
    const float* src_lat; const float* src_ctx; float* dst_lat; float* dst_ctx; const float* gate;
    __device__ __forceinline__ void operator()(const f32x4 (&acc)[2][2][4][2], const Unit& u, int wr, int wc, int fr, int fq) const {
        const int row0 = u.pm * BM; const bool isctx = row0 >= 16384;
        const float* s = isctx ? src_ctx + (size_t)(row0 - 16384) * 1024 : src_lat + (size_t)row0 * 1024;
        float* d = isctx ? dst_ctx + (size_t)(row0 - 16384) * 1024 : dst_lat + (size_t)row0 * 1024;
        const float* g = gate + (isctx ? 2 : (row0 >> 13)) * 6144 + u.pn * BM;
        f32x4 gv[2][2];
#pragma unroll
        for (int bj = 0; bj < 2; ++bj)
#pragma unroll
            for (int n = 0; n < 2; ++n) gv[bj][n] = *(const f32x4*)(g + ecol<false>(bj, n, wc, fq));
#pragma unroll
        for (int ai = 0; ai < 2; ++ai)
#pragma unroll
            for (int m = 0; m < 4; ++m) {
                const size_t off = (size_t)erow(ai, m, wr, fr) * 1024 + (size_t)u.pn * BM;
#pragma unroll
                for (int bj = 0; bj < 2; ++bj)
#pragma unroll
                    for (int n = 0; n < 2; ++n) { const int c = ecol<false>(bj, n, wc, fq); const f32x4 x = *(const f32x4*)(s + off + c); *(f32x4*)(d + off + c) = x + gv[bj][n] * acc[ai][bj][m][n]; }
            }
    }
};
template <int ldc> struct EpiStoreF32 {
    static constexpr bool PERM = false, AFTER_DRAIN = false;
    float* O;
    __device__ __forceinline__ void operator()(const f32x4 (&acc)[2][2][4][2], const Unit& u, int wr, int wc, int fr, int fq) const {
#pragma unroll
        for (int ai = 0; ai < 2; ++ai)
#pragma unroll
            for (int m = 0; m < 4; ++m) {
                float* rowp = O + ((size_t)u.pm * BM + erow(ai, m, wr, fr)) * ldc + (size_t)u.pn * BM;
#pragma unroll
                for (int bj = 0; bj < 2; ++bj)
#pragma unroll
                    for (int n = 0; n < 2; ++n) *(f32x4*)(rowp + ecol<false>(bj, n, wc, fq)) = acc[ai][bj][m][n];
            }
    }
};
}
#include <hip/hip_bf16.h>
#include <cmath>
namespace attn_body {
using bf16=__hip_bfloat16;
using bf16x8=__attribute__((ext_vector_type(8)))short;
using s16x4=__attribute__((ext_vector_type(4)))short;
using f32x16=__attribute__((ext_vector_type(16)))float;
using u32x4=__attribute__((ext_vector_type(4)))unsigned;
constexpr int BATCH=2,NHEAD=16,SEQ=8192,CTXL=256,KVP=64,D=64,DM=NHEAD*D;
constexpr int NW=8,QBLK=32,QB=QBLK*NW,KVBLK=64,NQB=SEQ/QB;
constexpr int ATTN_PITCH=DM, ATTN_UNIT_ROWS=QB;
__device__ __forceinline__ int crow(int r,int hi){return (r&3)+8*(r>>2)+4*hi;}
#define SBAR() __builtin_amdgcn_sched_barrier(0)
__device__ __forceinline__ void cmask(f32x16&p0,f32x16&p1,int jb,int qrel,int hi){
  const float NEG=-INFINITY; int kb=64*jb+4*hi;
  #pragma unroll
  for(int r=0;r<16;++r){int kv=kb+(r&3)+8*(r>>2); if(kv>qrel)p0[r]=NEG; if(kv+32>qrel)p1[r]=NEG;}
}

__device__ __forceinline__ void wmask(f32x16&p0,f32x16&p1,int dbase,int hi){
  const float NEG=-INFINITY; const int kb=dbase+4*hi;
  #pragma unroll
  for(int r=0;r<16;++r){int d=kb+(r&3)+8*(r>>2); if(d>128||d<-128)p0[r]=NEG; if(d+32>128||d+32<-128)p1[r]=NEG;}
}
constexpr int NSLOT=3, SLOTB=8192;
constexpr int LDS_K=0, LDS_V=NSLOT*SLOTB, LDS_WS=2*NSLOT*SLOTB, LDS_OST=LDS_WS+NW*64*4, LDS_BYTES=LDS_OST+NW*4096;
constexpr float C2=0.125f*1.4426950408889634f;
__device__ __forceinline__ void glds16(const void*gsrc,unsigned lds_dst){unsigned keep;
  asm volatile("s_mov_b32 %0, m0\n\ts_mov_b32 m0, %2\n\ts_nop 0\n\tglobal_load_lds_dwordx4 %1, off\n\ts_mov_b32 m0, %0":"=&s"(keep):"v"(gsrc),"s"(lds_dst):"memory");}
__device__ __forceinline__ float max3f(float a,float b,float c){float r;asm("v_max3_f32 %0, %1, %2, %3":"=v"(r):"v"(a),"v"(b),"v"(c));return r;}
__device__ __forceinline__ float max2f(float a,float b){float r;asm("v_max_f32_e32 %0, %1, %2":"=v"(r):"v"(a),"v"(b));return r;}
__device__ __forceinline__ float fadd_s(float a,float b){float r;asm("v_add_f32_e32 %0, %1, %2":"=v"(r):"v"(a),"v"(b));return r;}
__device__ __forceinline__ float fsub_s(float a,float b){float r;asm("v_sub_f32_e32 %0, %1, %2":"=v"(r):"v"(a),"v"(b));return r;}
typedef float f32x2_t __attribute__((ext_vector_type(2))); typedef __bf16 bf16x2_t __attribute__((ext_vector_type(2)));
__device__ __forceinline__ unsigned cvtpk_s(float lo,float hi){f32x2_t v={lo,hi};bf16x2_t b=__builtin_convertvector(v,bf16x2_t);return __builtin_bit_cast(unsigned,b);}
#define WAIT_BAR(N) asm volatile("s_waitcnt vmcnt(" #N ") lgkmcnt(0)\n\ts_barrier":::"memory")

__device__ __forceinline__ void qkt(f32x16&p0,f32x16&p1,const char*Kslot,const bf16x8*qr,const f32x16&negm,int r32,int hi){
  const char*kb=Kslot+hi*1024+r32*16;
  #pragma unroll
  for(int d0=0;d0<4;++d0){
    const bf16x8 b0=*reinterpret_cast<const bf16x8*>(kb+d0*2048);
    const bf16x8 b1=*reinterpret_cast<const bf16x8*>(kb+d0*2048+512);
    if(d0==0){p0=__builtin_amdgcn_mfma_f32_32x32x16_bf16(b0,qr[0],negm,0,0,0);p1=__builtin_amdgcn_mfma_f32_32x32x16_bf16(b1,qr[0],negm,0,0,0);}
    else{p0=__builtin_amdgcn_mfma_f32_32x32x16_bf16(b0,qr[d0],p0,0,0,0);p1=__builtin_amdgcn_mfma_f32_32x32x16_bf16(b1,qr[d0],p1,0,0,0);}}
}
typedef __attribute__((address_space(3))) const char* lds_cptr;
typedef short v4i16_t __attribute__((ext_vector_type(4)));
__device__ __forceinline__ void kload8(bf16x8*kf,lds_cptr kp){
  kf[0]=*(const __attribute__((address_space(3))) bf16x8*)(kp);      kf[1]=*(const __attribute__((address_space(3))) bf16x8*)(kp+512);
  kf[2]=*(const __attribute__((address_space(3))) bf16x8*)(kp+2048); kf[3]=*(const __attribute__((address_space(3))) bf16x8*)(kp+2560);
  kf[4]=*(const __attribute__((address_space(3))) bf16x8*)(kp+4096); kf[5]=*(const __attribute__((address_space(3))) bf16x8*)(kp+4608);
  kf[6]=*(const __attribute__((address_space(3))) bf16x8*)(kp+6144); kf[7]=*(const __attribute__((address_space(3))) bf16x8*)(kp+6656);
}
__device__ __forceinline__ void kload2(bf16x8*kf,lds_cptr kp,int j){ kf[2*j]=*(const __attribute__((address_space(3))) bf16x8*)(kp+j*2048); kf[2*j+1]=*(const __attribute__((address_space(3))) bf16x8*)(kp+j*2048+512); }
__device__ __forceinline__ s16x4 vtr(lds_cptr p){ return __builtin_bit_cast(s16x4,__builtin_amdgcn_ds_read_tr16_b64_v4i16((__attribute__((address_space(3))) v4i16_t*)p)); }
__device__ __forceinline__ float rowmax(const f32x16&p0,const f32x16&p1){
  float a=max3f(p0[0],p0[1],p1[0]),b=max3f(p0[2],p0[3],p1[1]);a=max3f(a,p1[2],p1[3]);
  #pragma unroll
  for(int r=4;r<16;r+=4){a=max3f(a,p0[r],p0[r+1]);b=max3f(b,p0[r+2],p0[r+3]);a=max3f(a,p1[r],p1[r+1]);b=max3f(b,p1[r+2],p1[r+3]);}
  const float m=max2f(a,b);
  auto rr=__builtin_amdgcn_permlane32_swap(__float_as_uint(m),__float_as_uint(m),false,false);
  return max2f(__uint_as_float(rr[0]),__uint_as_float(rr[1]));
}
__device__ __forceinline__ void pv(f32x16*o,int vb,bf16x8 pa0,bf16x8 pa1,bf16x8 pa2,bf16x8 pa3){
  #pragma unroll
  for(int d0=0;d0<2;++d0){s16x4 lo[4],hi[4];
    #pragma unroll
    for(int ks=0;ks<4;++ks){
      asm volatile("ds_read_b64_tr_b16 %0,%1 offset:%c2":"=&v"(lo[ks]):"v"(vb),"i"(d0*4096+ks*1024):"memory");
      asm volatile("ds_read_b64_tr_b16 %0,%1 offset:%c2":"=&v"(hi[ks]):"v"(vb),"i"(d0*4096+ks*1024+512):"memory");}
    asm volatile("s_waitcnt lgkmcnt(0)":::"memory");SBAR();
    #define PK(k) (bf16x8){lo[k][0],lo[k][1],lo[k][2],lo[k][3],hi[k][0],hi[k][1],hi[k][2],hi[k][3]}
    o[d0]=__builtin_amdgcn_mfma_f32_32x32x16_bf16(pa0,PK(0),o[d0],0,0,0);
    o[d0]=__builtin_amdgcn_mfma_f32_32x32x16_bf16(pa1,PK(1),o[d0],0,0,0);
    o[d0]=__builtin_amdgcn_mfma_f32_32x32x16_bf16(pa2,PK(2),o[d0],0,0,0);
    o[d0]=__builtin_amdgcn_mfma_f32_32x32x16_bf16(pa3,PK(3),o[d0],0,0,0);
    #undef PK
  }
}

#ifndef ATTN_STORE16
#define ATTN_STORE16(p,v) (*(u32x4*)(p)=(v))
#endif
template<int THRL,int MODE> __device__ __forceinline__ void attn_unit(int b,int h,int qb,const bf16*Q,const bf16*__restrict__ Kh,const bf16*__restrict__ Vh,bf16*O,char*shm,float sink_l2){
  const int tid=threadIdx.x,lane=tid&63,r32=lane&31,hi=lane>>5; const int wid=__builtin_amdgcn_readfirstlane(tid>>6);
  const long rowbase=(long)b*SEQ; const int q0=qb*QB;
  const bf16*Qw=Q+(rowbase+q0+wid*QBLK)*DM+h*D;
  const int wlo=(MODE==1)?(q0>=128?q0-128:0):0, whi=(MODE==1)?((q0+QB+128<=SEQ)?q0+QB+128:SEQ):0;
  #define TROW(t) ((MODE==1)?(((t)<4)?(SEQ+64*(t)):(wlo+64*((t)-4))):(64*(t)))
  const unsigned lds0=(unsigned)(uintptr_t)shm;
  float*wsf=(float*)(shm+LDS_WS)+wid*64;
  const bf16*ksrc=Kh+(long)lane*KVP+wid*8;
  const bf16*vsrc=Vh+(long)(16*(wid&3)+(lane>>2))*KVP+(wid>>2)*32+(lane&3)*8;
  const unsigned kdst=lds0+LDS_K+wid*1024, vdst=lds0+LDS_V+wid*1024;
  #define DMA_K(t,slot) glds16(ksrc+(long)TROW(t)*KVP,(unsigned)__builtin_amdgcn_readfirstlane(kdst+(slot)))
  #define DMA_V(t,slot) glds16(vsrc+(long)TROW(t)*KVP,(unsigned)__builtin_amdgcn_readfirstlane(vdst+(slot)))
  const int vb0=(int)(lds0+LDS_V)+((lane>>4)&1)*32+(lane&3)*8+(4*hi+((lane&15)>>2))*64;
  const char*Kbase=shm+LDS_K; bf16x8 kf[8];
  const lds_cptr shm3=(lds_cptr)shm; const lds_cptr kp0=shm3+LDS_K+hi*1024+r32*16; const lds_cptr vp0=shm3+LDS_V+((lane>>4)&1)*32+(lane&3)*8+(4*hi+((lane&15)>>2))*64;
  const int NT=(MODE==1)?(4+(whi-wlo)/KVBLK):((SEQ+CTXL)/KVBLK);
  DMA_K(0,0);DMA_V(0,0);DMA_K(1,SLOTB);
  bf16x8 qr[4];
  #pragma unroll
  for(int d0=0;d0<4;++d0)qr[d0]=*reinterpret_cast<const bf16x8*>(&Qw[(long)r32*DM+d0*16+hi*8]);
  float mhat=0.f,l_reg=0.f;f32x16 o[2];o[0]=f32x16{};o[1]=f32x16{};f32x16 negm=f32x16{};asm volatile("":"+v"(negm));
  const int qrel=wid*QBLK+r32;
  #define CMASK(P0,P1,t) do{ if(MODE==1&&(t)>=4) wmask(P0,P1,TROW(t)-(q0+qrel),hi); }while(0)
  bool resc=false;
  #define START(P0,P1) do{ const float rm=rowmax(P0,P1); resc=false; \
    { const float dl=rm; mhat=fadd_s(mhat,dl); \
      _Pragma("unroll") for(int r=0;r<16;++r){P0[r]=fsub_s(P0[r],dl);P1[r]=fsub_s(P1[r],dl);} \
      _Pragma("unroll") for(int r=0;r<16;++r)negm[r]=-mhat; asm volatile("":"+v"(negm)); } \
    _Pragma("unroll") for(int r=0;r<16;++r)P0[r]=__builtin_amdgcn_exp2f(P0[r]); }while(0)
  #define RESC() do{ if(resc){ asm volatile("s_waitcnt lgkmcnt(0)":::"memory"); \
      _Pragma("unroll") for(int d_=0;d_<2;++d_) _Pragma("unroll") for(int r=0;r<16;++r)o[d_][r]*=wsf[crow(r,hi)]; } }while(0)
  f32x16 pA0,pA1,pB0,pB1;
  int sl_prev=0,sl_cur=0,sl_next=SLOTB;
  #define ROT() do{sl_prev=sl_cur;sl_cur=sl_next;sl_next=(sl_next==(NSLOT-1)*SLOTB)?0:sl_next+SLOTB;}while(0)
  DMA_K(2,2*SLOTB);
  WAIT_BAR(3);
  qkt(pA0,pA1,Kbase,qr,negm,r32,hi);asm volatile("s_nop 15\n\ts_nop 7":"+v"(pA0),"+v"(pA1));CMASK(pA0,pA1,0);
  START(pA0,pA1);
  _Pragma("unroll") for(int r=0;r<16;++r)pA1[r]=__builtin_amdgcn_exp2f(pA1[r]);
  WAIT_BAR(0);
  DMA_K(3,0);DMA_V(1,SLOTB);
  ROT();
  kload8(kf,kp0+sl_cur);
  WAIT_BAR(2);
  s16x4 vlo[8],vhi[8]; u32x4 pw0,pw1,pw2,pw3;
  #define PKW(P,B) cvtpk_s(P[B],P[B+1])
  #define PAF(k) __builtin_bit_cast(bf16x8,pw##k)
  #define VFR(i) (bf16x8){vlo[i][0],vlo[i][1],vlo[i][2],vlo[i][3],vhi[i][0],vhi[i][1],vhi[i][2],vhi[i][3]}
  #define PIN(x) asm volatile("":"+v"(x))
  #define MX3(a,b,c) __builtin_fmaxf(__builtin_fmaxf((a),(b)),(c))
  #define GAPA(MF,A0,A1,A2,A3,W0,W1,PW) do{ MF; sacc+=A0; sacc+=A1; sacc+=A2; sacc+=A3; PIN(sacc); W0; W1; PIN(PW); SBAR(); }while(0)
  #define EX(v) __builtin_amdgcn_exp2f(v)
  #define GAPB(MF,X,B) do{ MF; X[B]=EX(X[B]); X[B+1]=EX(X[B+1]); X[B+2]=EX(X[B+2]); X[B+3]=EX(X[B+3]); PIN(X); SBAR(); }while(0)
  #define VRD(i) do{ vlo[i]=vtr(vp_+(((i)>>2)*4096+((i)&3)*1024)); vhi[i]=vtr(vp_+(((i)>>2)*4096+((i)&3)*1024+512)); }while(0)
  #define KRD(G,j) do{ if(G){ kload2(kf,kp0+sl_next,j); SBAR(); } }while(0)
  #define STEP(C0,C1,P0,P1,t,GK,GV,GL) do{ SBAR(); \
    const lds_cptr vp_=vp0+sl_prev; \
    VRD(0); SBAR(); float sacc=(P0[0]+P0[1]); \
    GAPA(C0=__builtin_amdgcn_mfma_f32_32x32x16_bf16(kf[0],qr[0],negm,0,0,0), P0[2],P0[3],P0[4],P0[5],     pw0[0]=PKW(P0,0), pw0[1]=PKW(P0,2), pw0); \
    VRD(4); SBAR(); GAPA(C1=__builtin_amdgcn_mfma_f32_32x32x16_bf16(kf[1],qr[0],negm,0,0,0), P0[6],P0[7],P0[8],P0[9],     pw0[2]=PKW(P0,4), pw0[3]=PKW(P0,6), pw0); \
    VRD(1); SBAR(); GAPA(C0=__builtin_amdgcn_mfma_f32_32x32x16_bf16(kf[2],qr[1],C0,0,0,0),   P0[10],P0[11],P0[12],P0[13], pw1[0]=PKW(P0,8), pw1[1]=PKW(P0,10), pw1); \
    VRD(5); SBAR(); GAPA(C1=__builtin_amdgcn_mfma_f32_32x32x16_bf16(kf[3],qr[1],C1,0,0,0),   P0[14],P0[15],P1[0],P1[1],   pw1[2]=PKW(P0,12),pw1[3]=PKW(P0,14), pw1); \
    VRD(2); SBAR(); GAPA(C0=__builtin_amdgcn_mfma_f32_32x32x16_bf16(kf[4],qr[2],C0,0,0,0),   P1[2],P1[3],P1[4],P1[5],     pw2[0]=PKW(P1,0), pw2[1]=PKW(P1,2), pw2); \
    VRD(6); SBAR(); GAPA(C1=__builtin_amdgcn_mfma_f32_32x32x16_bf16(kf[5],qr[2],C1,0,0,0),   P1[6],P1[7],P1[8],P1[9],     pw2[2]=PKW(P1,4), pw2[3]=PKW(P1,6), pw2); \
    VRD(3); SBAR(); GAPA(C0=__builtin_amdgcn_mfma_f32_32x32x16_bf16(kf[6],qr[3],C0,0,0,0),   P1[10],P1[11],P1[12],P1[13], pw3[0]=PKW(P1,8), pw3[1]=PKW(P1,10), pw3); \
    VRD(7); SBAR(); GAPA(C1=__builtin_amdgcn_mfma_f32_32x32x16_bf16(kf[7],qr[3],C1,0,0,0),   P1[14],P1[15],0.f,0.f,       pw3[2]=PKW(P1,12),pw3[3]=PKW(P1,14), pw3); \
    l_reg+=sacc; \
    if(GK){DMA_K((t)+3,sl_cur);} if(GV){DMA_V((t)+1,sl_next);} \
    CMASK(C0,C1,t); \
    { float a=MX3(C0[0],C0[1],C1[0]),b=MX3(C0[2],C0[3],C1[1]); a=MX3(a,C1[2],C1[3]); \
      _Pragma("unroll") for(int r=4;r<16;r+=4){a=MX3(a,C0[r],C0[r+1]);b=MX3(b,C0[r+2],C0[r+3]);a=MX3(a,C1[r],C1[r+1]);b=MX3(b,C1[r+2],C1[r+3]);} \
      float rm=__builtin_fmaxf(a,b); { auto rr=__builtin_amdgcn_permlane32_swap(__float_as_uint(rm),__float_as_uint(rm),false,false); rm=__builtin_fmaxf(__uint_as_float(rr[0]),__uint_as_float(rr[1])); } \
      resc=false; \
      if(__builtin_expect(__any(rm>(float)THRL),0)){ const float dl=__builtin_fmaxf(rm,0.f); mhat+=dl; \
        _Pragma("unroll") for(int r=0;r<16;++r){C0[r]-=dl;C1[r]-=dl;} \
        _Pragma("unroll") for(int r=0;r<16;++r)negm[r]=-mhat; asm volatile("":"+v"(negm)); \
        const float f=__builtin_amdgcn_exp2f(-dl); l_reg*=f; if(hi==0)wsf[r32]=f; resc=true; } } \
    SBAR(); \
    GAPB(o[0]=__builtin_amdgcn_mfma_f32_32x32x16_bf16(PAF(0),VFR(0),o[0],0,0,0), C0,0); \
    GAPB(o[1]=__builtin_amdgcn_mfma_f32_32x32x16_bf16(PAF(0),VFR(4),o[1],0,0,0), C0,4); \
    KRD(GL,0); GAPB(o[0]=__builtin_amdgcn_mfma_f32_32x32x16_bf16(PAF(1),VFR(1),o[0],0,0,0), C0,8); \
    KRD(GL,1); GAPB(o[1]=__builtin_amdgcn_mfma_f32_32x32x16_bf16(PAF(1),VFR(5),o[1],0,0,0), C0,12); \
    KRD(GL,2); GAPB(o[0]=__builtin_amdgcn_mfma_f32_32x32x16_bf16(PAF(2),VFR(2),o[0],0,0,0), C1,0); \
    KRD(GL,3); GAPB(o[1]=__builtin_amdgcn_mfma_f32_32x32x16_bf16(PAF(2),VFR(6),o[1],0,0,0), C1,4); \
    GAPB(o[0]=__builtin_amdgcn_mfma_f32_32x32x16_bf16(PAF(3),VFR(3),o[0],0,0,0), C1,8); \
    GAPB(o[1]=__builtin_amdgcn_mfma_f32_32x32x16_bf16(PAF(3),VFR(7),o[1],0,0,0), C1,12); \
    }while(0)
  int t=1;
  #undef CMASK
  #define CMASK(P0,P1,t) do{ if(MODE==1&&(t)>=4) wmask(P0,P1,TROW(t)-(q0+qrel),hi); }while(0)
  for(;t+5<NT;t+=2){
    STEP(pB0,pB1,pA0,pA1,t,true,true,true);     WAIT_BAR(2); RESC(); ROT();
    STEP(pA0,pA1,pB0,pB1,t+1,true,true,true);   WAIT_BAR(2); RESC(); ROT();
  }
  #undef CMASK
  #define CMASK(P0,P1,t) do{ if(MODE==1&&(t)>=4) wmask(P0,P1,TROW(t)-(q0+qrel),hi); }while(0)
  #define ENDW(tt) do{ if((tt)+3<NT){WAIT_BAR(2);} else if((tt)+2<NT){WAIT_BAR(1);} else {WAIT_BAR(0);} }while(0)
  for(;t+1<NT;t+=2){
    STEP(pB0,pB1,pA0,pA1,t,(t+3<NT),(t+1<NT),(t+1<NT));       ENDW(t);   RESC(); ROT();
    STEP(pA0,pA1,pB0,pB1,t+1,(t+4<NT),(t+2<NT),(t+2<NT));     ENDW(t+1); RESC(); ROT();
  }
  STEP(pB0,pB1,pA0,pA1,NT-1,false,false,false); RESC();
  { float sacc=pB0[0]+pB0[1]; _Pragma("unroll") for(int r=2;r<16;++r)sacc+=pB0[r]; _Pragma("unroll") for(int r=0;r<16;++r)sacc+=pB1[r]; l_reg+=sacc;
    pw0=(u32x4){PKW(pB0,0),PKW(pB0,2),PKW(pB0,4),PKW(pB0,6)};pw1=(u32x4){PKW(pB0,8),PKW(pB0,10),PKW(pB0,12),PKW(pB0,14)};pw2=(u32x4){PKW(pB1,0),PKW(pB1,2),PKW(pB1,4),PKW(pB1,6)};pw3=(u32x4){PKW(pB1,8),PKW(pB1,10),PKW(pB1,12),PKW(pB1,14)};
    SBAR(); pv(o,vb0+sl_cur,PAF(0),PAF(1),PAF(2),PAF(3)); }
  #undef PKW
  #undef PAF
  #undef VFR
  #undef PIN
  #undef MX3
  #undef GAPA
  #undef GAPB
  #undef EX
  #undef VRD
  #undef KRD
  #undef STEP
  #undef ENDW
  {auto rr=__builtin_amdgcn_permlane32_swap(__float_as_uint(l_reg),__float_as_uint(l_reg),false,false);l_reg=__uint_as_float(rr[0])+__uint_as_float(rr[1]);}
  if(MODE==1) l_reg+=__builtin_amdgcn_exp2f(sink_l2-mhat);
  if(hi==0)wsf[32+r32]=l_reg;asm volatile("s_waitcnt lgkmcnt(0)":::"memory");
  float rli[16];
  #pragma unroll
  for(int r=0;r<16;++r)rli[r]=__builtin_amdgcn_rcpf(wsf[32+crow(r,hi)]);
  bf16*Ow=O+(rowbase+q0+wid*QBLK)*DM+h*D;
  { bf16*stg=(bf16*)(shm+LDS_OST)+wid*2048;
    #pragma unroll
    for(int r=0;r<16;++r){const int orow=crow(r,hi);
      #pragma unroll
      for(int d0=0;d0<2;++d0)stg[orow*64+d0*32+r32]=__float2bfloat16(o[d0][r]*rli[r]);}
    asm volatile("s_waitcnt lgkmcnt(0)":::"memory");
    #pragma unroll
    for(int i=0;i<4;++i){const int row=i*8+(lane>>3),ch=lane&7; const u32x4 v=*(const u32x4*)(stg+row*64+ch*8); ATTN_STORE16(Ow+(long)row*DM+ch*8,v);} }
  asm volatile("s_waitcnt lgkmcnt(0)\n\ts_barrier":::"memory");
  #undef DMA_K
  #undef DMA_V
  #undef CMASK
  #undef START
  #undef RESC
  #undef ROT
  #undef TROW
}
constexpr int ATTN_LDS_BYTES=LDS_BYTES;
#undef SBAR
#undef WAIT_BAR
}
#define GAS __attribute__((address_space(1)))
#define LAS __attribute__((address_space(3)))
typedef unsigned short bf16;
typedef unsigned v4u __attribute__((ext_vector_type(4)));
typedef float f32x4 __attribute__((ext_vector_type(4)));
typedef short bf16x8 __attribute__((ext_vector_type(8)));
typedef GAS unsigned gu32;
typedef GAS unsigned long long gu64;
#define RLX_AGENT __ATOMIC_RELAXED, __HIP_MEMORY_SCOPE_AGENT
#define LDS_WAIT() asm volatile("s_waitcnt lgkmcnt(0)" ::: "memory")
#define VM_WAIT() asm volatile("s_waitcnt vmcnt(0)" ::: "memory")
__device__ __forceinline__ unsigned long long rt() { return __builtin_amdgcn_s_memrealtime(); }
__device__ __forceinline__ unsigned f2bf(float f) { unsigned u = __builtin_bit_cast(unsigned, f); return (u + 0x7fffu + ((u >> 16) & 1u)) >> 16; }
__device__ __forceinline__ unsigned pk2(float lo, float hi) { return f2bf(lo) | (f2bf(hi) << 16); }

#define XB_TMO      128
#define XB_XCNT(j)  (256  + 64 * (j))
#define XB_XSUB(j)  (1280 + 64 * (j))
#define XB_XGEN(j)  (2304 + 64 * (j))
#define XB_TOP      3328
#define XB_TOPGEN   3392
#define XCD_BAR_WORDS 3456
#define XB_SPIN_CAP (1u << 18)

__device__ __forceinline__ unsigned xb_ld(unsigned* p)              { return __hip_atomic_load(p, __ATOMIC_RELAXED, __HIP_MEMORY_SCOPE_AGENT); }
__device__ __forceinline__ unsigned xb_add(unsigned* p, unsigned v) { return __hip_atomic_fetch_add(p, v, __ATOMIC_RELAXED, __HIP_MEMORY_SCOPE_AGENT); }
__device__ __forceinline__ unsigned xb_xcc_id() { return (unsigned)__builtin_amdgcn_s_getreg((3 << 11) | 20) & 0xFu; }
#define XB_SPIN(cond, bar) do { unsigned _sp = 0; while (cond) { __builtin_amdgcn_s_sleep(1); \
    if ((++_sp & 255u) == 0u) { if (xb_ld(&(bar)[XB_TMO])) break; if (_sp > XB_SPIN_CAP) { atomicAdd(&(bar)[XB_TMO], 1u); break; } } } } while (0)

struct XcdBarrier {
    unsigned* bar; unsigned x;
    volatile LAS unsigned* st;
};

__device__ __forceinline__ XcdBarrier xcd_barrier_post(unsigned* bar, volatile LAS unsigned* st) {
    XcdBarrier b; b.bar = bar; b.x = xb_xcc_id(); b.st = st;
    if (threadIdx.x == 0) (void)xb_add(&bar[XB_XCNT(b.x)], 1u);
    return b;
}
__device__ __forceinline__ void xcd_barrier_complete(unsigned* bar, unsigned x, unsigned& nloc, unsigned& nx) {
    const unsigned G = gridDim.x * gridDim.y * gridDim.z;
    unsigned sum, cnt, mine, sp = 0u;
    for (;;) {
        sum = 0u; cnt = 0u; mine = 0u;
#pragma unroll
        for (unsigned j = 0; j < 16; ++j) { const unsigned c = xb_ld(&bar[XB_XCNT(j)]); sum += c; cnt += (c > 0u) ? 1u : 0u; mine = (j == x) ? c : mine; }
        if (sum == G) break;
        __builtin_amdgcn_s_sleep(1);
        if ((++sp & 255u) == 0u) { if (xb_ld(&bar[XB_TMO])) break; if (sp > XB_SPIN_CAP) { atomicAdd(&bar[XB_TMO], 1u); break; } }
    }
    nloc = mine > 0u ? mine : 1u; nx = cnt > 0u ? cnt : 1u;
}

__device__ __forceinline__ void xcd_barrier(const XcdBarrier& b) {
    asm volatile("s_waitcnt vmcnt(0)" ::: "memory");
    __syncthreads();
    if (threadIdx.x == 0) {
        unsigned* bar = b.bar;
        __builtin_amdgcn_s_waitcnt(0);
        unsigned nloc = b.st[0], nx = b.st[1];
        if (nloc == 0u) { xcd_barrier_complete(bar, b.x, nloc, nx); b.st[0] = nloc; b.st[1] = nx; }
        const unsigned old = xb_add(&bar[XB_XSUB(b.x)], 1u);
        const unsigned gen = old / nloc;
        if (old + 1u == (gen + 1u) * nloc) {
            __builtin_amdgcn_fence(__ATOMIC_RELEASE, "agent");
            asm volatile("s_waitcnt vmcnt(0)" ::: "memory");
            const unsigned og = xb_add(&bar[XB_TOP], 1u);
            const unsigned tg = og / nx;
            if (og + 1u == (tg + 1u) * nx) xb_add(&bar[XB_TOPGEN], 1u);
            else XB_SPIN(xb_ld(&bar[XB_TOPGEN]) == tg, bar);
            __builtin_amdgcn_fence(__ATOMIC_ACQUIRE, "agent");
            xb_add(&bar[XB_XGEN(b.x)], 1u);
            asm volatile("s_waitcnt vmcnt(0)" ::: "memory");
        } else {
            XB_SPIN(xb_ld(&bar[XB_XGEN(b.x)]) == gen, bar);
            __builtin_amdgcn_fence(__ATOMIC_ACQUIRE, "agent");
            asm volatile("s_waitcnt vmcnt(0)" ::: "memory");
        }
    }
    __syncthreads();
}
constexpr int NWAVES = 8, NTHREADS = 512;
constexpr int BATCH = 2, T = 8192, D = 1024, CTXL = 256, FF = 4096;
constexpr int ML_ROWS = BATCH * T;
constexpr int MC_ROWS = BATCH * CTXL;
constexpr int MA_ROWS = ML_ROWS + MC_ROWS;
constexpr int REC_N = 3584;
constexpr int ATT_N = 1536;
constexpr int KV_LEN = T + CTXL;
constexpr int NCHUNK = KV_LEN / 128;
constexpr int NCHAIN_ML = 16;
constexpr int NITEM_ML = NCHAIN_ML * NCHUNK;
constexpr int NCHAIN_RW = 32;
constexpr float NORM_EPS = 1e-6f, GN_EPS = 64e-5f;

constexpr size_t MiB = 1u << 20;
constexpr size_t WS_CTL = 0, CTL_ZERO_BYTES = 1 * MiB;
constexpr size_t WS_MODP = 1 * MiB;
constexpr size_t WS_MOD = 4 * MiB;
constexpr size_t WS_MISC = 5 * MiB;
constexpr size_t WS_WREC = 8 * MiB;
constexpr size_t WS_WKV = 15 * MiB;
constexpr size_t WS_WATT = 17 * MiB;
constexpr size_t WS_WOUT = 20 * MiB;
constexpr size_t WS_W1 = 24 * MiB;
constexpr size_t WS_W2 = 40 * MiB;
constexpr size_t WS_WG2 = 56 * MiB;
constexpr size_t WS_XC = 57 * MiB;
constexpr size_t WS_XN = 59 * MiB;
constexpr size_t WS_R = 92 * MiB;
constexpr size_t WS_END = 256 * MiB;
constexpr size_t SZ_A = (size_t)MA_ROWS * 512 * 2;
constexpr size_t R_QM = WS_R, R_KM = R_QM + SZ_A, R_OM = R_KM + SZ_A, R_KVT = R_OM + SZ_A;
constexpr size_t R_RAW = R_KVT + 2 * SZ_A;
constexpr size_t R_TWAD = R_RAW + 3 * SZ_A;
constexpr size_t R_SGD = R_TWAD + SZ_A / 2;
constexpr size_t R_GATES = R_SGD + SZ_A / 4;
constexpr size_t R_YRW0 = R_GATES + (size_t)MA_ROWS * 16 * 4;
static_assert(R_YRW0 + SZ_A <= WS_END, "recurrent map");
constexpr size_t R_GATE = R_KVT;
constexpr size_t R_MIX = R_QM;
constexpr size_t R_HML = WS_XN;
constexpr size_t DO_CST = 0, DO_YRW1 = 34 * MiB;
static_assert((size_t)NITEM_ML * 16384 * 2 <= DO_YRW1 && DO_YRW1 + SZ_A <= (size_t)ML_ROWS * D * 4, "d_out scratch map");
constexpr size_t R_ATT = WS_R;
constexpr size_t R_QB = R_ATT + (size_t)MA_ROWS * ATT_N * 4;
constexpr size_t SZ_KV = (size_t)BATCH * 2 * KV_LEN * 64 * 2;
constexpr size_t R_KW = R_QB + (size_t)ML_ROWS * D * 2, R_VW = R_KW + SZ_KV, R_KG = R_VW + SZ_KV, R_VG = R_KG + SZ_KV;
static_assert(R_VG + SZ_KV <= WS_END, "attention map");
constexpr size_t R_H = WS_R;
static_assert(R_H + (size_t)MA_ROWS * FF * 2 <= WS_END, "ffn map");
constexpr size_t MI_BT = WS_MISC;
constexpr size_t MI_AT = MI_BT + (size_t)8 * MA_ROWS * 4;
constexpr size_t MI_CHS = MI_AT + (size_t)8 * MA_ROWS * 4;
constexpr size_t MI_MCH = MI_CHS + 16 * 66 * 2 * 4;
constexpr size_t MI_DN = MI_MCH + 16 * 66 * 4 + 256;
static_assert(MI_DN + (size_t)NITEM_ML * 128 * 4 <= WS_WREC, "misc map");

constexpr int CW_TMO = 0, CW_CODE = 1;
constexpr int CW_BAR = 4096;
constexpr int CW_DBG = 65536;

constexpr int RING_OFF = 0, RING_BYTES = 131072;
constexpr int LDSCTL_OFF = RING_BYTES, MISC_OFF = LDSCTL_OFF + 320;
constexpr int LDS_BYTES = 147456;
struct Frame {
    LAS unsigned char* lds;
    volatile LAS unsigned* MISC;
    gu32* ctl;
    int tid, lane, wave;
    int vcu, G;
    unsigned char* ws; float* out;
};
__device__ __forceinline__ float bf2f(bf16 b) { return __uint_as_float((unsigned)b << 16); }
__device__ __forceinline__ float wave_sum(float v) {
#pragma unroll
    for (int o = 1; o < 64; o <<= 1) v += __shfl_xor(v, o);
    return v;
}
__device__ __forceinline__ float wave_max(float v) {
#pragma unroll
    for (int o = 1; o < 64; o <<= 1) v = fmaxf(v, __shfl_xor(v, o));
    return v;
}
__device__ __forceinline__ float sigmoidf_(float x) { return 1.0f / (1.0f + __expf(-x)); }
typedef float f32x2v __attribute__((ext_vector_type(2)));
typedef unsigned u32x2v __attribute__((ext_vector_type(2)));
#define MFMA16(a, b, c) __builtin_amdgcn_mfma_f32_16x16x32_bf16(a, b, c, 0, 0, 0)

enum { I_X = 0, I_C, I_CTX, I_CCTX, I_NORM_MIX, I_NORM_FFN, I_MOD_W, I_MOD_B, I_OUT_W, I_FFN_W1, I_FFN_W2, I_REC_IN_W, I_ML_GATE_B, I_ML_NORM_G, I_RW_CONV,
       I_RW_W0, I_RW_W2, I_RW_A0, I_RW_A2, I_RW_G2, I_RW_KK, I_RW_KA, I_RW_RK, I_RW_NORM_G, I_ATT_IN_W, I_WIN_Q_NORM, I_WIN_K_NORM, I_WIN_SINK, I_GLB_Q_NORM, I_GLB_K_NORM, N_IN };
struct Args { const float* in[N_IN]; float* out; unsigned char* ws; int ph_lo, ph_hi, li, pad; };

template <int MAP> __device__ __forceinline__ int src_col(int n) {
    if (MAP == 0) return n;
    if (MAP == 2) return n + 512;
    if (n < 1024) return n;
    if (n < 1536) return n + 512;
    if (n < 3456) return n + 528;
    if (n < 3472) return n - 1408;
    return -1;
}
template <int MAP> __device__ __forceinline__ void p0_transpose_item(const float* W, int K, int srcN, int dstN, bf16* WT, LAS float* scr, int item, int lane) {
    const int nblk = dstN / 32, kb = item / nblk, nb = item % nblk, k0 = 64 * kb, n0 = 32 * nb;
    const int sc = src_col<MAP>(n0 + (lane & 31));
#pragma unroll 8
    for (int i = 0; i < 32; ++i) { const int kk = 2 * i + (lane >> 5); scr[kk * 33 + (lane & 31)] = (sc >= 0) ? W[(size_t)(k0 + kk) * srcN + sc] : 0.f; }
    LDS_WAIT(); asm volatile("" ::: "memory");
    const int c = lane & 7;
#pragma unroll
    for (int j = 0; j < 4; ++j) { const int n = (lane >> 3) + 8 * j; const LAS float* s = scr + (8 * c) * 33 + n;
        v4u o; o.x = pk2(s[0 * 33], s[1 * 33]); o.y = pk2(s[2 * 33], s[3 * 33]); o.z = pk2(s[4 * 33], s[5 * 33]); o.w = pk2(s[6 * 33], s[7 * 33]);
        *(GAS v4u*)(WT + (size_t)(n0 + n) * K + k0 + 8 * c) = o; }
    LDS_WAIT(); asm volatile("" ::: "memory");
}
__device__ __forceinline__ void p0_prologue(Frame& F, const Args& A) {
    LAS float* scr = (LAS float*)(F.lds + RING_OFF + F.wave * 16384);
    const int gw = F.vcu * NWAVES + F.wave, NGW = F.G * NWAVES;
    constexpr int I_REC = (D / 64) * (REC_N / 32), I_KV = (D / 64) * (1024 / 32), I_ATT = (D / 64) * (ATT_N / 32), I_OUT = (D / 64) * (D / 32), I_1 = (D / 64) * (FF / 32), I_2 = (FF / 64) * (D / 32), I_G2 = (128 / 64) * (512 / 32);
    constexpr int NITEMS = I_REC + I_KV + I_ATT + 2 * I_OUT + 2 * I_1 + 2 * I_2 + I_G2;
    unsigned char* ws = F.ws;
    for (int it = gw; it < NITEMS; it += NGW) {
        int r = it;
        if (r < I_REC) { p0_transpose_item<1>(A.in[I_REC_IN_W], D, 3984, REC_N, (bf16*)(ws + WS_WREC), scr, r, F.lane); continue; } r -= I_REC;
        if (r < I_KV) { p0_transpose_item<2>(A.in[I_REC_IN_W], D, 3984, 1024, (bf16*)(ws + WS_WKV), scr, r, F.lane); continue; } r -= I_KV;
        if (r < I_ATT) { p0_transpose_item<0>(A.in[I_ATT_IN_W], D, ATT_N, ATT_N, (bf16*)(ws + WS_WATT), scr, r, F.lane); continue; } r -= I_ATT;
        if (r < 2 * I_OUT) { const int l = r / I_OUT; p0_transpose_item<0>(A.in[I_OUT_W] + (size_t)l * D * D, D, D, D, (bf16*)(ws + WS_WOUT) + (size_t)l * D * D, scr, r % I_OUT, F.lane); continue; } r -= 2 * I_OUT;
        if (r < 2 * I_1) { const int l = r / I_1; p0_transpose_item<0>(A.in[I_FFN_W1] + (size_t)l * D * FF, D, FF, FF, (bf16*)(ws + WS_W1) + (size_t)l * D * FF, scr, r % I_1, F.lane); continue; } r -= 2 * I_1;
        if (r < 2 * I_2) { const int l = r / I_2; p0_transpose_item<0>(A.in[I_FFN_W2] + (size_t)l * D * FF, FF, D, D, (bf16*)(ws + WS_W2) + (size_t)l * D * FF, scr, r % I_2, F.lane); continue; } r -= 2 * I_2;
        p0_transpose_item<0>(A.in[I_RW_G2], 128, 512, 512, (bf16*)(ws + WS_WG2), scr, r, F.lane);
    }
    float* MODP = (float*)(ws + WS_MODP);
    for (int it = gw; it < 2 * 24 * 16; it += NGW) {
        const int l = it / (24 * 16), cc = (it / 16) % 24, kc = it % 16;
        float sv[3];
#pragma unroll
        for (int v = 0; v < 3; ++v) { const float cvv = (v < 2) ? A.in[I_C][v * D + kc * 64 + F.lane] : A.in[I_CCTX][kc * 64 + F.lane]; sv[v] = cvv * sigmoidf_(cvv); }
        const float* Wp = A.in[I_MOD_W] + ((size_t)l * D + kc * 64) * 6144 + cc * 256 + 4 * F.lane;
        f32x4 a0 = {0, 0, 0, 0}, a1 = a0, a2 = a0;
#pragma unroll 8
        for (int k = 0; k < 64; ++k) { const f32x4 w = *(const f32x4*)(Wp + (size_t)k * 6144); a0 += w * __shfl(sv[0], k); a1 += w * __shfl(sv[1], k); a2 += w * __shfl(sv[2], k); }
        float* o = MODP + ((size_t)(l * 16 + kc) * 3) * 6144 + cc * 256 + 4 * F.lane;
        *(f32x4*)(o) = a0; *(f32x4*)(o + 6144) = a1; *(f32x4*)(o + 2 * 6144) = a2;
    }
}
__device__ __forceinline__ void p1_mod_finalize(Frame& F, const Args& A) {
    const float* MODP = (const float*)(F.ws + WS_MODP); float* MOD = (float*)(F.ws + WS_MOD);
    for (int i = F.vcu * NTHREADS + F.tid; i < 2 * 3 * 6144; i += F.G * NTHREADS) {
        const int l = i / (3 * 6144), v = (i / 6144) % 3, n = i % 6144;
        float s = A.in[I_MOD_B][l * 6144 + n];
#pragma unroll
        for (int kc = 0; kc < 16; ++kc) s += MODP[((size_t)(l * 16 + kc) * 3 + v) * 6144 + n];
        MOD[i] = s;
    }
}
__device__ __forceinline__ void norm_rows(Frame& F, const Args& A, const float* lat, const float* ctx, int nrows, const float* g, const float* mod, int ch_shift, int ch_scale, bf16* XN) {
    const int gw = F.vcu * NWAVES + F.wave, NGW = F.G * NWAVES;
    for (int row = gw; row < nrows; row += NGW) {
        const float* src = (row < ML_ROWS) ? lat + (size_t)row * D : ctx + (size_t)(row - ML_ROWS) * D;
        const float* mv = mod + ((row < ML_ROWS) ? (row >> 13) : 2) * 6144;
        f32x4 v[4]; float ss = 0.f;
#pragma unroll
        for (int j = 0; j < 4; ++j) { v[j] = *(const f32x4*)(src + 256 * j + 4 * F.lane); ss += (v[j].x * v[j].x + v[j].y * v[j].y) + (v[j].z * v[j].z + v[j].w * v[j].w); }
        const float rs = 1.0f / sqrtf(wave_sum(ss) * (1.f / D) + NORM_EPS);
        unsigned long long* o8 = (unsigned long long*)(XN + (size_t)row * D);
#pragma unroll
        for (int j = 0; j < 4; ++j) {
            const int c = 256 * j + 4 * F.lane;
            const f32x4 gg = *(const f32x4*)(g + c), sc = *(const f32x4*)(mv + ch_scale * 1024 + c), sh = *(const f32x4*)(mv + ch_shift * 1024 + c);
            const f32x4 y = (v[j] * rs) * gg * (sc + 1.0f) + sh;
            o8[64 * j + F.lane] = (unsigned long long)pk2(y.x, y.y) | ((unsigned long long)pk2(y.z, y.w) << 32);
        }
    }
}

__device__ __forceinline__ int ml_chunk_base(int d, int b, int c) {
    if (c < 2) return ML_ROWS + b * CTXL + (d == 0 ? 128 * c : 128 * (1 - c));
    const int cc = c - 2; return b * T + (d == 0 ? 128 * cc : T - 128 * (cc + 1));
}
__device__ __forceinline__ void ml_pass_a(Frame& F, const Args& A) {
    unsigned char* ws = F.ws;
    const bf16* KVT = (const bf16*)(ws + R_KVT); const float* GATES = (const float*)(ws + R_GATES);
    float* BT = (float*)(ws + MI_BT); float* AT = (float*)(ws + MI_AT); float* CHS = (float*)(ws + MI_CHS); float* DN = (float*)(ws + MI_DN);
    bf16* CST = (bf16*)((unsigned char*)F.out + DO_CST);
    LAS float* wl = (LAS float*)(F.lds);
    const int lane = F.lane, w = F.wave;
    for (int item = F.vcu; item < NITEM_ML; item += F.G) {
        const int chain = item / NCHUNK, c = item % NCHUNK, d = chain >> 3, b = (chain >> 2) & 1, h = chain & 3;
        const int base = ml_chunk_base(d, b, c);
        __syncthreads();
        if (w == 0) {
            const float bi = A.in[I_ML_GATE_B][(2 * d) * 4 + h], bfg = A.in[I_ML_GATE_B][(2 * d + 1) * 4 + h];
            float iv[2], lf[2];
#pragma unroll
            for (int e = 0; e < 2; ++e) { const int s = 2 * lane + e, o = d == 0 ? s : 127 - s; const float* gp = GATES + (size_t)(base + o) * 16 + 8 * d + h;
                iv[e] = gp[0] + bi; const float f = gp[4] + bfg; lf[e] = (f >= 0.f) ? -log1pf(__expf(-f)) : f - log1pf(__expf(f)); }
            const float pair = lf[0] + lf[1]; float incl = pair;
#pragma unroll
            for (int o = 1; o < 64; o <<= 1) { const float t_ = __shfl_up(incl, o); if (lane >= o) incl += t_; }
            const float excl = incl - pair; float bb[2] = {excl + lf[0], excl + pair}; float aa[2] = {iv[0] - bb[0], iv[1] - bb[1]};
            const float amax = wave_max(fmaxf(aa[0], aa[1])); const float bend = __shfl(bb[1], 63);
#pragma unroll
            for (int e = 0; e < 2; ++e) { const int s = 2 * lane + e, o = d == 0 ? s : 127 - s; const size_t gi = (size_t)(d * 4 + h) * MA_ROWS + base + o; BT[gi] = bb[e]; AT[gi] = aa[e]; wl[o] = __expf(aa[e] - amax); }
            if (lane == 0) { CHS[(chain * NCHUNK + c) * 2] = bend; CHS[(chain * NCHUNK + c) * 2 + 1] = amax; }
        }
        __syncthreads();
        f32x4 acc[8];
#pragma unroll
        for (int n8 = 0; n8 < 8; ++n8) acc[n8] = (f32x4){0.f, 0.f, 0.f, 0.f};
        const bf16* vrow = KVT + (size_t)(512 + h * 128 + 16 * w + (lane & 15)) * MA_ROWS + base + 8 * (lane >> 4);
        const bf16* krow = KVT + (size_t)(h * 128 + (lane & 15)) * MA_ROWS + base + 8 * (lane >> 4);
#pragma unroll
        for (int kk = 0; kk < 4; ++kk) {
            const v4u vraw = *(const GAS v4u*)(vrow + 32 * kk); const int s0 = 32 * kk + 8 * (lane >> 4);
            v4u vs; { const unsigned* pv_ = (const unsigned*)&vraw; unsigned* po = (unsigned*)&vs;
#pragma unroll
                for (int q = 0; q < 4; ++q) { const float lo = __uint_as_float(pv_[q] << 16) * wl[s0 + 2 * q], hi_ = __uint_as_float(pv_[q] & 0xffff0000u) * wl[s0 + 2 * q + 1]; po[q] = pk2(lo, hi_); } }
            const bf16x8 vf = __builtin_bit_cast(bf16x8, vs);
#pragma unroll
            for (int n8 = 0; n8 < 8; ++n8) { const bf16x8 kf = __builtin_bit_cast(bf16x8, *(const GAS v4u*)(krow + (size_t)(16 * n8) * MA_ROWS + 32 * kk)); acc[n8] = MFMA16(kf, vf, acc[n8]); }
        }
        bf16* cst = CST + (size_t)item * 16384 + (size_t)(16 * w + (lane & 15)) * 128 + 4 * (lane >> 4);
#pragma unroll
        for (int n8 = 0; n8 < 8; ++n8) { u32x2v o; o.x = pk2(acc[n8][0], acc[n8][1]); o.y = pk2(acc[n8][2], acc[n8][3]); *(u32x2v*)(cst + 16 * n8) = o; }
        { const int dk = F.tid >> 2, q = F.tid & 3; const bf16* kp = KVT + (size_t)(h * 128 + dk) * MA_ROWS + base + 32 * q; float s = 0.f;
#pragma unroll
            for (int j = 0; j < 4; ++j) { const v4u kv = *(const GAS v4u*)(kp + 8 * j); const unsigned* pk_ = (const unsigned*)&kv;
#pragma unroll
                for (int e = 0; e < 4; ++e) { const int so = 32 * q + 8 * j + 2 * e; s += __uint_as_float(pk_[e] << 16) * wl[so] + __uint_as_float(pk_[e] & 0xffff0000u) * wl[so + 1]; } }
            s += __shfl_xor(s, 1); s += __shfl_xor(s, 2);
            if (q == 0) DN[(size_t)item * 128 + dk] = s; }
    }
    __syncthreads();
}
__device__ __forceinline__ void ml_pass_b(Frame& F, const Args& A) {
    unsigned char* ws = F.ws;
    const float* CHS = (const float*)(ws + MI_CHS); float* MCH = (float*)(ws + MI_MCH); float* DN = (float*)(ws + MI_DN);
    unsigned* CST = (unsigned*)((unsigned char*)F.out + DO_CST);
    constexpr int PER_CHAIN = 8192 + 128, NWORK = NCHAIN_ML * PER_CHAIN;
    for (int wi = F.vcu * NTHREADS + F.tid; wi < NWORK; wi += F.G * NTHREADS) {
        const int chain = wi / PER_CHAIN, e = wi % PER_CHAIN;
        float m = 0.f, c0 = 0.f, c1 = 0.f;
        if (e < 8192) {
            unsigned* p = CST + (size_t)chain * NCHUNK * 8192 + e;
            unsigned nxt = p[0];
            for (int c = 0; c < NCHUNK; ++c) {
                const unsigned dlt = nxt; if (c + 1 < NCHUNK) nxt = p[(size_t)(c + 1) * 8192];
                const float bend = CHS[(chain * NCHUNK + c) * 2], amax = CHS[(chain * NCHUNK + c) * 2 + 1];
                p[(size_t)c * 8192] = pk2(c0, c1);
                if (e == 0) MCH[chain * NCHUNK + c] = m;
                const float g = fmaxf(m, amax), so = __expf(m - g), sn = __expf(amax - g);
                c0 = so * c0 + sn * __uint_as_float(dlt << 16); c1 = so * c1 + sn * __uint_as_float(dlt & 0xffff0000u);
                m = bend + g;
            }
        } else {
            float* p = DN + (size_t)chain * NCHUNK * 128 + (e - 8192);
            for (int c = 0; c < NCHUNK; ++c) {
                const float dlt = p[(size_t)c * 128];
                const float bend = CHS[(chain * NCHUNK + c) * 2], amax = CHS[(chain * NCHUNK + c) * 2 + 1];
                p[(size_t)c * 128] = c0;
                const float g = fmaxf(m, amax), so = __expf(m - g), sn = __expf(amax - g);
                c0 = so * c0 + sn * dlt; m = bend + g;
            }
        }
    }
}
__device__ __forceinline__ void ml_pass_c(Frame& F, const Args& A) {
    unsigned char* ws = F.ws;
    const bf16* KVT = (const bf16*)(ws + R_KVT); const bf16* QM = (const bf16*)(ws + R_QM); const bf16* KM = (const bf16*)(ws + R_KM);
    const float* BT = (const float*)(ws + MI_BT); const float* AT = (const float*)(ws + MI_AT); const float* MCH = (const float*)(ws + MI_MCH); const float* NST = (const float*)(ws + MI_DN);
    const bf16* CST = (const bf16*)((unsigned char*)F.out + DO_CST);
    bf16* HML = (bf16*)(ws + R_HML);
    LAS float* aw = (LAS float*)(F.lds); LAS float* gq = aw + 128; LAS float* bq = gq + 128;
    LAS bf16* Sl = (LAS bf16*)(F.lds + 2048) + F.wave * (16 * 136);
    const int lane = F.lane, w = F.wave, l15 = lane & 15, l4 = lane >> 4;
    for (int item = F.vcu; item < NITEM_ML; item += F.G) {
        const int chain = item / NCHUNK, c = item % NCHUNK, d = chain >> 3, b = (chain >> 2) & 1, h = chain & 3;
        const int base = ml_chunk_base(d, b, c);
        const float m = MCH[chain * NCHUNK + c];
        __syncthreads();
        if (w == 0) {
            float aa[2], bb[2];
#pragma unroll
            for (int e = 0; e < 2; ++e) { const int s = 2 * lane + e, o = d == 0 ? s : 127 - s; const size_t gi = (size_t)(d * 4 + h) * MA_ROWS + base + o; aa[e] = AT[gi]; bb[e] = BT[gi]; }
            const float pm = fmaxf(aa[0], aa[1]); float incl = pm;
#pragma unroll
            for (int o = 1; o < 64; o <<= 1) { const float t_ = __shfl_up(incl, o); if (lane >= o) incl = fmaxf(incl, t_); }
            float excl = __shfl_up(incl, 1); if (lane == 0) excl = -INFINITY;
            const float g0 = fmaxf(m, fmaxf(excl, aa[0])), g1 = fmaxf(m, incl);
#pragma unroll
            for (int e = 0; e < 2; ++e) { const int s = 2 * lane + e, o = d == 0 ? s : 127 - s; aw[o] = aa[e]; gq[o] = e == 0 ? g0 : g1; bq[o] = bb[e]; }
        }
        __syncthreads();
        const int to = 16 * w + l15;
        const float gt = gq[to], bt = bq[to];
        bf16x8 qf[4];
        const bf16* qp = QM + (size_t)(base + to) * 512 + h * 128 + 8 * l4;
#pragma unroll
        for (int kk = 0; kk < 4; ++kk) qf[kk] = __builtin_bit_cast(bf16x8, *(const GAS v4u*)(qp + 32 * kk));
        float den = 0.f;
        const bf16* kp = KM + (size_t)(base + l15) * 512 + h * 128 + 8 * l4;
#pragma unroll
        for (int m8 = 0; m8 < 8; ++m8) {
            f32x4 st = {0.f, 0.f, 0.f, 0.f};
#pragma unroll
            for (int kk = 0; kk < 4; ++kk) { const bf16x8 kf = __builtin_bit_cast(bf16x8, *(const GAS v4u*)(kp + (size_t)(16 * m8) * 512 + 32 * kk)); st = MFMA16(kf, qf[kk], st); }
            float vv[4];
#pragma unroll
            for (int r = 0; r < 4; ++r) { const int so = 16 * m8 + 4 * l4 + r; const bool valid = d == 0 ? (so <= to) : (so >= to); const float wgt = valid ? __expf(aw[so] - gt) : 0.f; vv[r] = st[r] * wgt; den += vv[r]; }
            u32x2v o; o.x = pk2(vv[0], vv[1]); o.y = pk2(vv[2], vv[3]);
            *(LAS u32x2v*)(Sl + l15 * 136 + 16 * m8 + 4 * l4) = o;
        }
        den += __shfl_xor(den, 16); den += __shfl_xor(den, 32);
        float qn = 0.f;
        { const float* np = NST + (size_t)item * 128 + 8 * l4;
#pragma unroll
            for (int kk = 0; kk < 4; ++kk) { const unsigned* pq = (const unsigned*)&qf[kk];
#pragma unroll
                for (int e = 0; e < 4; ++e) qn += __uint_as_float(pq[e] << 16) * np[32 * kk + 2 * e] + __uint_as_float(pq[e] & 0xffff0000u) * np[32 * kk + 2 * e + 1]; }
            qn += __shfl_xor(qn, 16); qn += __shfl_xor(qn, 32); }
        asm volatile("s_waitcnt lgkmcnt(0)" ::: "memory"); __builtin_amdgcn_wave_barrier();
        bf16x8 sf[4];
#pragma unroll
        for (int kk = 0; kk < 4; ++kk) sf[kk] = *(const LAS bf16x8*)(Sl + l15 * 136 + 32 * kk + 8 * l4);
        const float wprev = __expf(m - gt);
        const float dent = den + wprev * qn;
        const float rdn = 1.0f / fmaxf(fabsf(dent), __expf(-(bt + gt)));
        const bf16* vp = KVT + (size_t)(512 + h * 128 + l15) * MA_ROWS + base + 8 * l4;
        const bf16* cp = CST + (size_t)item * 16384 + (size_t)l15 * 128 + 8 * l4;
        bf16* hp = HML + ((size_t)d * MA_ROWS + base + to) * 512 + h * 128 + 4 * l4;
#pragma unroll
        for (int v8 = 0; v8 < 8; ++v8) {
            f32x4 an = {0.f, 0.f, 0.f, 0.f}, ai = {0.f, 0.f, 0.f, 0.f};
#pragma unroll
            for (int kk = 0; kk < 4; ++kk) {
                const bf16x8 vf = __builtin_bit_cast(bf16x8, *(const GAS v4u*)(vp + (size_t)(16 * v8) * MA_ROWS + 32 * kk));
                an = MFMA16(vf, sf[kk], an);
                const bf16x8 cf = __builtin_bit_cast(bf16x8, *(const GAS v4u*)(cp + (size_t)(16 * v8) * 128 + 32 * kk));
                ai = MFMA16(cf, qf[kk], ai);
            }
            u32x2v o; o.x = pk2((an[0] + wprev * ai[0]) * rdn, (an[1] + wprev * ai[1]) * rdn); o.y = pk2((an[2] + wprev * ai[2]) * rdn, (an[3] + wprev * ai[3]) * rdn);
            *(u32x2v*)(hp + 16 * v8) = o;
        }
    }
    __syncthreads();
}
__device__ __forceinline__ void rw_seq_rows(int d, int b, int p, int& R, int& idx, int& len, int& sbase) {
    if (p < CTXL) { idx = d == 0 ? p : CTXL - 1 - p; len = CTXL; sbase = ML_ROWS + b * CTXL; }
    else { const int q = p - CTXL; idx = d == 0 ? q : T - 1 - q; len = T; sbase = b * T; }
    R = sbase + idx;
}
__device__ __forceinline__ void rw_scan(Frame& F, const Args& A) {
    unsigned char* ws = F.ws;
    const bf16* RAWb = (const bf16*)(ws + R_RAW); const bf16* TWAD = (const bf16*)(ws + R_TWAD);
    LAS float* w2h = (LAS float*)(F.lds); LAS float* a2h = w2h + 4096; LAS float* vecs = a2h + 4096;
    LAS float* ybuf = vecs + 32 * 384; LAS float* twl = ybuf + 2048; LAS float* adl = twl + 2048;
    const int tid = F.tid, lane = F.lane, wv = F.wave;
    for (int chain = F.vcu; chain < NCHAIN_RW; chain += F.G) {
        const int d = chain >> 4, b = (chain >> 3) & 1, h = chain & 7;
        bf16* YRW = d == 0 ? (bf16*)(ws + R_YRW0) : (bf16*)((unsigned char*)F.out + DO_YRW1);
        __syncthreads();
        for (int i = tid; i < 4096; i += NTHREADS) { const int ii = i >> 6, ch = i & 63; w2h[i] = A.in[I_RW_W2][((size_t)d * 64 + ii) * 512 + h * 64 + ch]; a2h[i] = A.in[I_RW_A2][((size_t)d * 64 + ii) * 512 + h * 64 + ch]; }
        const int ppos = tid >> 4, chq = tid & 15, ch0 = 4 * chq, hc = h * 64 + ch0;
        float cw[3][3][4], kkw[4], kaw[4], w0v[4], a0v[4];
#pragma unroll
        for (int k = 0; k < 3; ++k)
#pragma unroll
            for (int g = 0; g < 3; ++g)
#pragma unroll
                for (int e = 0; e < 4; ++e) cw[k][g][e] = A.in[I_RW_CONV][k * 1536 + g * 512 + hc + e];
#pragma unroll
        for (int e = 0; e < 4; ++e) { kkw[e] = A.in[I_RW_KK][hc + e]; kaw[e] = A.in[I_RW_KA][hc + e]; w0v[e] = A.in[I_RW_W0][d * 512 + hc + e]; a0v[e] = A.in[I_RW_A0][d * 512 + hc + e]; }
        float S[8];
#pragma unroll
        for (int j = 0; j < 8; ++j) S[j] = 0.f;
        const int row_i = 8 * wv + (lane >> 3), j0 = 8 * (lane & 7);
        for (int blk = 0; blk < KV_LEN / 32; ++blk) {
            int R, idx, len, sbase; rw_seq_rows(d, b, 32 * blk + ppos, R, idx, len, sbase);
            __syncthreads();
            { const u32x2v tw = *(const GAS u32x2v*)(TWAD + (size_t)R * 256 + d * 64 + ch0), ad = *(const GAS u32x2v*)(TWAD + (size_t)R * 256 + 128 + d * 64 + ch0);
              LAS float* t_ = twl + ppos * 64 + ch0; LAS float* a_ = adl + ppos * 64 + ch0;
              t_[0] = __uint_as_float(tw.x << 16); t_[1] = __uint_as_float(tw.x & 0xffff0000u); t_[2] = __uint_as_float(tw.y << 16); t_[3] = __uint_as_float(tw.y & 0xffff0000u);
              a_[0] = __uint_as_float(ad.x << 16); a_[1] = __uint_as_float(ad.x & 0xffff0000u); a_[2] = __uint_as_float(ad.y << 16); a_[3] = __uint_as_float(ad.y & 0xffff0000u); }
            float cv[3][4];
#pragma unroll
            for (int g = 0; g < 3; ++g)
#pragma unroll
                for (int e = 0; e < 4; ++e) cv[g][e] = 0.f;
#pragma unroll
            for (int k = 0; k < 3; ++k) { const int ii = idx + k - 1; if (ii >= 0 && ii < len) {
#pragma unroll
                for (int g = 0; g < 3; ++g) { const u32x2v x = *(const GAS u32x2v*)(RAWb + (size_t)(sbase + ii) * 1536 + g * 512 + hc);
                    cv[g][0] += cw[k][g][0] * __uint_as_float(x.x << 16); cv[g][1] += cw[k][g][1] * __uint_as_float(x.x & 0xffff0000u); cv[g][2] += cw[k][g][2] * __uint_as_float(x.y << 16); cv[g][3] += cw[k][g][3] * __uint_as_float(x.y & 0xffff0000u); } } }
            float kkv[4], ss = 0.f;
#pragma unroll
            for (int e = 0; e < 4; ++e) { kkv[e] = cv[1][e] * kkw[e]; ss += kkv[e] * kkv[e]; }
            ss += __shfl_xor(ss, 1); ss += __shfl_xor(ss, 2); ss += __shfl_xor(ss, 4); ss += __shfl_xor(ss, 8);
            const float rn = 1.0f / sqrtf(ss + NORM_EPS);
            __syncthreads();
            float wl_[4], al_[4];
#pragma unroll
            for (int e = 0; e < 4; ++e) { wl_[e] = w0v[e]; al_[e] = a0v[e]; }
            for (int i = 0; i < 64; ++i) { const float tv = twl[ppos * 64 + i], av = adl[ppos * 64 + i]; const f32x4 w2 = *(const LAS f32x4*)(w2h + i * 64 + ch0), a2 = *(const LAS f32x4*)(a2h + i * 64 + ch0);
#pragma unroll
                for (int e = 0; e < 4; ++e) { wl_[e] += tv * w2[e]; al_[e] += av * a2[e]; } }
            LAS float* vb = vecs + ppos * 384 + ch0;
#pragma unroll
            for (int e = 0; e < 4; ++e) {
                const float wdec = __expf(-0.6065306597126334f * sigmoidf_(wl_[e])), a = sigmoidf_(al_[e]), kk = kkv[e] * rn;
                vb[e] = wdec; vb[64 + e] = kk * a; vb[128 + e] = cv[1][e] * (1.0f + (a - 1.0f) * kaw[e]); vb[192 + e] = kk; vb[256 + e] = cv[0][e]; vb[320 + e] = cv[2][e];
            }
            __syncthreads();
            for (int pp = 0; pp < 32; ++pp) {
                const LAS float* v_ = vecs + pp * 384;
                const f32x4 k0 = *(const LAS f32x4*)(v_ + 192 + j0), k1 = *(const LAS f32x4*)(v_ + 192 + j0 + 4);
                float skk = S[0] * k0[0] + S[1] * k0[1] + S[2] * k0[2] + S[3] * k0[3] + S[4] * k1[0] + S[5] * k1[1] + S[6] * k1[2] + S[7] * k1[3];
                skk += __shfl_xor(skk, 1); skk += __shfl_xor(skk, 2); skk += __shfl_xor(skk, 4);
                const f32x4 w0_ = *(const LAS f32x4*)(v_ + j0), w1_ = *(const LAS f32x4*)(v_ + j0 + 4), b0 = *(const LAS f32x4*)(v_ + 64 + j0), b1 = *(const LAS f32x4*)(v_ + 64 + j0 + 4);
                const f32x4 e0 = *(const LAS f32x4*)(v_ + 128 + j0), e1 = *(const LAS f32x4*)(v_ + 128 + j0 + 4), r0 = *(const LAS f32x4*)(v_ + 256 + j0), r1 = *(const LAS f32x4*)(v_ + 256 + j0 + 4);
                const float vi = v_[320 + row_i];
                float y = 0.f;
#pragma unroll
                for (int j = 0; j < 4; ++j) { S[j] = S[j] * w0_[j] - skk * b0[j] + vi * e0[j]; S[4 + j] = S[4 + j] * w1_[j] - skk * b1[j] + vi * e1[j]; y += S[j] * r0[j] + S[4 + j] * r1[j]; }
                y += __shfl_xor(y, 1); y += __shfl_xor(y, 2); y += __shfl_xor(y, 4);
                if ((lane & 7) == 0) ybuf[pp * 64 + row_i] = y;
            }
            __syncthreads();
            { const LAS float* yb = ybuf + ppos * 64 + ch0; u32x2v o; o.x = pk2(yb[0], yb[1]); o.y = pk2(yb[2], yb[3]); *(u32x2v*)(YRW + (size_t)R * 512 + hc) = o; }
        }
    }
    __syncthreads();
}

__device__ __forceinline__ void merge_rows(Frame& F, const Args& A) {
    unsigned char* ws = F.ws;
    const bf16* HML = (const bf16*)(ws + R_HML); const bf16* OM = (const bf16*)(ws + R_OM); const bf16* RAWb = (const bf16*)(ws + R_RAW); const bf16* GATE = (const bf16*)(ws + R_GATE);
    const bf16* YRW0 = (const bf16*)(ws + R_YRW0); const bf16* YRW1 = (const bf16*)((unsigned char*)F.out + DO_YRW1);
    bf16* MIX = (bf16*)(ws + R_MIX);
    const int gw = F.vcu * NWAVES + F.wave, NGW = F.G * NWAVES, lane = F.lane, c8 = 8 * lane;
    for (int row = gw; row < MA_ROWS; row += NGW) {
        float y[8];
        { const v4u a = *(const GAS v4u*)(HML + (size_t)row * 512 + c8), b_ = *(const GAS v4u*)(HML + ((size_t)MA_ROWS + row) * 512 + c8); const unsigned* pa = (const unsigned*)&a; const unsigned* pb = (const unsigned*)&b_;
#pragma unroll
            for (int q = 0; q < 4; ++q) { y[2 * q] = __uint_as_float(pa[q] << 16) + __uint_as_float(pb[q] << 16); y[2 * q + 1] = __uint_as_float(pa[q] & 0xffff0000u) + __uint_as_float(pb[q] & 0xffff0000u); } }
        float s = 0.f;
#pragma unroll
        for (int e = 0; e < 8; ++e) s += y[e];
        s += __shfl_xor(s, 1); s += __shfl_xor(s, 2); s += __shfl_xor(s, 4); s += __shfl_xor(s, 8);
        const float mean = s * (1.f / 128.f); float q2 = 0.f;
#pragma unroll
        for (int e = 0; e < 8; ++e) { y[e] -= mean; q2 += y[e] * y[e]; }
        q2 += __shfl_xor(q2, 1); q2 += __shfl_xor(q2, 2); q2 += __shfl_xor(q2, 4); q2 += __shfl_xor(q2, 8);
        const float rstd = 1.0f / sqrtf(q2 * (1.f / 128.f) + GN_EPS);
        { const v4u og = *(const GAS v4u*)(OM + (size_t)row * 512 + c8); const unsigned* po = (const unsigned*)&og; float o[8];
#pragma unroll
            for (int q = 0; q < 4; ++q) { o[2 * q] = __uint_as_float(po[q] << 16); o[2 * q + 1] = __uint_as_float(po[q] & 0xffff0000u); }
            v4u w; unsigned* pw = (unsigned*)&w;
#pragma unroll
            for (int q = 0; q < 4; ++q) { const float g0 = A.in[I_ML_NORM_G][c8 + 2 * q], g1 = A.in[I_ML_NORM_G][c8 + 2 * q + 1];
                pw[q] = pk2(y[2 * q] * rstd * g0 * sigmoidf_(o[2 * q]), y[2 * q + 1] * rstd * g1 * sigmoidf_(o[2 * q + 1])); }
            *(GAS v4u*)(MIX + (size_t)row * D + c8) = w; }
        float z[8];
        { const v4u a = *(const GAS v4u*)(YRW0 + (size_t)row * 512 + c8), b_ = *(const GAS v4u*)(YRW1 + (size_t)row * 512 + c8); const unsigned* pa = (const unsigned*)&a; const unsigned* pb = (const unsigned*)&b_;
#pragma unroll
            for (int q = 0; q < 4; ++q) { z[2 * q] = __uint_as_float(pa[q] << 16) + __uint_as_float(pb[q] << 16); z[2 * q + 1] = __uint_as_float(pa[q] & 0xffff0000u) + __uint_as_float(pb[q] & 0xffff0000u); } }
        s = 0.f;
#pragma unroll
        for (int e = 0; e < 8; ++e) s += z[e];
        s += __shfl_xor(s, 1); s += __shfl_xor(s, 2); s += __shfl_xor(s, 4);
        const float mean2 = s * (1.f / 64.f); q2 = 0.f;
#pragma unroll
        for (int e = 0; e < 8; ++e) { z[e] -= mean2; q2 += z[e] * z[e]; }
        q2 += __shfl_xor(q2, 1); q2 += __shfl_xor(q2, 2); q2 += __shfl_xor(q2, 4);
        const float rstd2 = 1.0f / sqrtf(q2 * (1.f / 64.f) + GN_EPS);
        int idx, len, sbase; if (row < ML_ROWS) { idx = row & (T - 1); len = T; sbase = row - idx; } else { idx = (row - ML_ROWS) & (CTXL - 1); len = CTXL; sbase = row - idx; }
        float cv[3][8];
#pragma unroll
        for (int g = 0; g < 3; ++g)
#pragma unroll
            for (int e = 0; e < 8; ++e) cv[g][e] = 0.f;
#pragma unroll
        for (int k = 0; k < 3; ++k) { const int ii = idx + k - 1; if (ii >= 0 && ii < len) {
#pragma unroll
            for (int g = 0; g < 3; ++g) { const v4u x = *(const GAS v4u*)(RAWb + (size_t)(sbase + ii) * 1536 + g * 512 + c8); const unsigned* px = (const unsigned*)&x; const float* cwp = A.in[I_RW_CONV] + k * 1536 + g * 512 + c8;
#pragma unroll
                for (int q = 0; q < 4; ++q) { cv[g][2 * q] += cwp[2 * q] * __uint_as_float(px[q] << 16); cv[g][2 * q + 1] += cwp[2 * q + 1] * __uint_as_float(px[q] & 0xffff0000u); } } } }
        float bs = 0.f;
#pragma unroll
        for (int e = 0; e < 8; ++e) bs += cv[0][e] * cv[1][e] * A.in[I_RW_RK][c8 + e];
        bs += __shfl_xor(bs, 1); bs += __shfl_xor(bs, 2); bs += __shfl_xor(bs, 4);
        { const v4u gg = *(const GAS v4u*)(GATE + (size_t)row * 512 + c8); const unsigned* pg = (const unsigned*)&gg; v4u w; unsigned* pw = (unsigned*)&w;
#pragma unroll
            for (int q = 0; q < 4; ++q) { const float g0 = __uint_as_float(pg[q] << 16), g1 = __uint_as_float(pg[q] & 0xffff0000u);
                const float o0 = (z[2 * q] * rstd2 * A.in[I_RW_NORM_G][c8 + 2 * q] + bs * cv[2][2 * q]) * g0, o1 = (z[2 * q + 1] * rstd2 * A.in[I_RW_NORM_G][c8 + 2 * q + 1] + bs * cv[2][2 * q + 1]) * g1;
                pw[q] = pk2(o0, o1); }
            *(GAS v4u*)(MIX + (size_t)row * D + 512 + c8) = w; }
    }
}

__device__ __forceinline__ void qk_prep(Frame& F, const Args& A) {
    unsigned char* ws = F.ws;
    const float* ATT = (const float*)(ws + R_ATT);
    bf16* QB = (bf16*)(ws + R_QB); bf16* KW = (bf16*)(ws + R_KW); bf16* VW = (bf16*)(ws + R_VW); bf16* KG = (bf16*)(ws + R_KG); bf16* VG = (bf16*)(ws + R_VG);
    const int gw = F.vcu * NWAVES + F.wave, NGW = F.G * NWAVES, lane = F.lane;
    const float invf = exp2f(-(float)((lane >> 1) & 15) * (13.287712379549449f / 16.0f));
    const float gwq = A.in[I_WIN_Q_NORM][lane], gwk = A.in[I_WIN_K_NORM][lane], ggq = A.in[I_GLB_Q_NORM][lane], ggk = A.in[I_GLB_K_NORM][lane];
    for (int row = gw; row < MA_ROWS; row += NGW) {
        const bool lat = row < ML_ROWS; const int b = lat ? (row >> 13) : ((row - ML_ROWS) >> 8); const int t = lat ? (row & (T - 1)) : 0;
        const int pos = lat ? t : T + ((row - ML_ROWS) & (CTXL - 1));
        float cs = 1.f, sn = 0.f;
        if (lat) { const float ang = (float)(((lane >> 1) < 16) ? (t >> 6) : (t & 63)) * invf; sincosf(ang, &sn, &cs); }
        const float* ar = ATT + (size_t)row * ATT_N;
#pragma unroll 1
        for (int hh = 0; hh < 20; ++hh) {
            const bool isq = (hh < 8) || (hh >= 10 && hh < 18);
            if (isq && !lat) continue;
            const int off = hh < 8 ? hh * 64 : hh < 10 ? 512 + (hh - 8) * 64 : hh < 18 ? 768 + (hh - 10) * 64 : 1280 + (hh - 18) * 64;
            const float g = hh < 8 ? gwq : hh < 10 ? gwk : hh < 18 ? ggq : ggk;
            const float x = ar[off + lane];
            const float rs = 1.0f / sqrtf(wave_sum(x * x) * (1.f / 64.f) + NORM_EPS);
            float xn = x * rs * g;
            if (lat) { const float pr = __shfl_xor(xn, 1); xn = (lane & 1) ? (pr * sn + xn * cs) : (xn * cs - pr * sn); }
            if (hh < 8) QB[(size_t)row * D + hh * 64 + lane] = (bf16)f2bf(xn * attn_body::C2);
            else if (hh < 10) KW[((size_t)(b * 2 + (hh - 8)) * KV_LEN + pos) * 64 + lane] = (bf16)f2bf(xn);
            else if (hh < 18) QB[(size_t)row * D + 512 + (hh - 10) * 64 + lane] = (bf16)f2bf(xn * attn_body::C2);
            else KG[((size_t)(b * 2 + (hh - 18)) * KV_LEN + pos) * 64 + lane] = (bf16)f2bf(xn);
        }
#pragma unroll
        for (int kvh = 0; kvh < 2; ++kvh) {
            VW[((size_t)(b * 2 + kvh) * KV_LEN + pos) * 64 + lane] = (bf16)f2bf(ar[640 + kvh * 64 + lane]);
            VG[((size_t)(b * 2 + kvh) * KV_LEN + pos) * 64 + lane] = (bf16)f2bf(ar[1408 + kvh * 64 + lane]);
        }
    }
}

__device__ __forceinline__ void attn_phase(Frame& F, const Args& A, char* lds_generic) {
    unsigned char* ws = F.ws;
    const attn_body::bf16* QB = (const attn_body::bf16*)(ws + R_QB);
    for (int k = 0; k < 4; ++k) {
        const int uid = k * F.G + F.vcu; if (uid >= 1024) break;
        const int grp = uid >> 9, gi = uid & 511;
        int bh, qb;
        if (F.G == 256) { bh = (gi & 255) >> 4; qb = 2 * ((gi & 255) & 15) + (gi >> 8); } else { bh = gi >> 5; qb = gi & 31; }
        const int b = bh >> 3, hq = bh & 7, kvh = hq >> 2;
        if (grp == 0) {
            const attn_body::bf16* Kh = (const attn_body::bf16*)(ws + R_KG) + (size_t)(b * 2 + kvh) * KV_LEN * 64; const attn_body::bf16* Vh = (const attn_body::bf16*)(ws + R_VG) + (size_t)(b * 2 + kvh) * KV_LEN * 64;
            attn_body::attn_unit<8, 0>(b, 8 + hq, qb, QB, Kh, Vh, (attn_body::bf16*)QB, lds_generic, 0.f);
        } else {
            const attn_body::bf16* Kh = (const attn_body::bf16*)(ws + R_KW) + (size_t)(b * 2 + kvh) * KV_LEN * 64; const attn_body::bf16* Vh = (const attn_body::bf16*)(ws + R_VW) + (size_t)(b * 2 + kvh) * KV_LEN * 64;
            attn_body::attn_unit<8, 1>(b, hq, qb, QB, Kh, Vh, (attn_body::bf16*)QB, lds_generic, A.in[I_WIN_SINK][hq] * 1.4426950408889634f);
        }
    }
}
#ifndef MK_N_LAUNCHES
#define MK_N_LAUNCHES 21
#endif
constexpr int NPHASE = 21;
#ifndef PHMASK
#define PHMASK 0xffffffffu
#endif
#define PH_ON(k) (((PHMASK) >> (k)) & 1u)
__global__ void __launch_bounds__(NTHREADS, 2) mk_fwd(Args args) {
    extern __shared__ __attribute__((aligned(16))) unsigned char lds[];
    Frame F;
    F.lds = (LAS unsigned char*)lds;
    F.MISC = (volatile LAS unsigned*)(F.lds + MISC_OFF);
    F.tid = threadIdx.x; F.lane = F.tid & 63; F.wave = __builtin_amdgcn_readfirstlane(F.tid >> 6);
    F.G = gridDim.x; { const int bx = blockIdx.x; F.vcu = (F.G % 8 == 0) ? (bx % 8) * (F.G / 8) + bx / 8 : bx; }
    F.ws = args.ws; F.out = args.out; const Args& A = args;
    unsigned char* ws = args.ws;
    F.ctl = (gu32*)(ws + WS_CTL);
    for (int u = F.tid; u < (LDS_BYTES - LDSCTL_OFF) / 4; u += NTHREADS) ((LAS unsigned*)(F.lds + LDSCTL_OFF))[u] = 0u;
    __syncthreads();
    const bool use_bar = (args.ph_hi - args.ph_lo) > 1;
    XcdBarrier bar; bar.bar = (unsigned*)(F.ctl + CW_BAR) + args.li * XCD_BAR_WORDS; bar.x = 0; bar.st = nullptr;
    if (use_bar) bar = xcd_barrier_post((unsigned*)(F.ctl + CW_BAR) + args.li * XCD_BAR_WORDS, F.MISC + 8);
    const float* MOD = (const float*)(ws + WS_MOD);
    bf16* XN = (bf16*)(ws + WS_XN);
    float* XC = (float*)(ws + WS_XC);
    const int bid = (int)blockIdx.x;
    const int lo = args.ph_lo, hi = args.ph_hi;
#define IN(k) (PH_ON(k) && lo <= (k) && (k) < hi)
#define SEAM(k) do { if ((k) + 1 < hi) xcd_barrier(bar); } while (0)
    if (IN(0)) { p0_prologue(F, A); SEAM(0); }
    if (IN(1)) { p1_mod_finalize(F, A); SEAM(1); }
    if (IN(2)) { norm_rows(F, A, A.in[I_X], A.in[I_CTX], MA_ROWS, A.in[I_NORM_MIX], MOD, 0, 1, XN); SEAM(2); }
    if (IN(3)) { {
#ifndef NO_REC
            { pg8::Gemm g{XN, (const bf16*)(ws + WS_WREC), MA_ROWS, REC_N, D}; pg8::StaticOrder S; S.init(MA_ROWS, REC_N, F.G, bid);
              pg8::EpiRecIn E{(bf16*)(ws + R_QM), (bf16*)(ws + R_RAW), (bf16*)(ws + R_TWAD), (bf16*)(ws + R_SGD), (float*)(ws + R_GATES)};
              pg8::gemm_phase<pg8::EpiRecIn, pg8::StaticOrder, true, true>(F.lds + RING_OFF, g, S, E); }
#endif
#ifndef NO_KVT
            { pg8::Gemm g{(const bf16*)(ws + WS_WKV), XN, 1024, MA_ROWS, D}; pg8::StaticOrder S; S.init(1024, MA_ROWS, F.G, bid);
              pg8::EpiStoreBf16<MA_ROWS> E{(bf16*)(ws + R_KVT), 2, 0.08838834764831845f};
              pg8::gemm_phase<pg8::EpiStoreBf16<MA_ROWS>, pg8::StaticOrder, true, true>(F.lds + RING_OFF, g, S, E); }
#endif
        } SEAM(3); }
    if (IN(4)) { ml_pass_a(F, A); SEAM(4); }
    if (IN(5)) { ml_pass_b(F, A); SEAM(5); }
    if (IN(6)) { ml_pass_c(F, A); SEAM(6); }
    if (IN(7)) { {
#ifndef NO_RW
            rw_scan(F, A);
#endif
#ifndef NO_GG
            { int kg = 128; asm volatile("" : "+s"(kg)); pg8::Gemm g{(const bf16*)(ws + R_SGD), (const bf16*)(ws + WS_WG2), MA_ROWS, 512, kg}; pg8::StaticOrder S; S.init(MA_ROWS, 512, F.G, bid);
              pg8::EpiStoreBf16<512> E{(bf16*)(ws + R_GATE), 0, 1.f};
              pg8::gemm_phase<pg8::EpiStoreBf16<512>, pg8::StaticOrder, true, true>(F.lds + RING_OFF, g, S, E); }
#endif
        } SEAM(7); }
    if (IN(8)) { merge_rows(F, A); SEAM(8); }
    if (IN(9)) { { pg8::Gemm g{(const bf16*)(ws + R_MIX), (const bf16*)(ws + WS_WOUT), MA_ROWS, D, D}; pg8::StaticOrder S; S.init(MA_ROWS, D, F.G, bid);
            pg8::EpiResid E{A.in[I_X], A.in[I_CTX], F.out, XC, MOD + 2 * 1024};
            pg8::gemm_phase<pg8::EpiResid, pg8::StaticOrder, true, true>(F.lds + RING_OFF, g, S, E); } SEAM(9); }
    if (IN(10)) { norm_rows(F, A, F.out, XC, MA_ROWS, A.in[I_NORM_FFN], MOD, 3, 4, XN); SEAM(10); }
    if (IN(11)) { { pg8::Gemm g{XN, (const bf16*)(ws + WS_W1), MA_ROWS, FF, D}; pg8::StaticOrder S; S.init(MA_ROWS, FF, F.G, bid);
            pg8::EpiSqRelu<FF> E{(bf16*)(ws + R_H)};
            pg8::gemm_phase<pg8::EpiSqRelu<FF>, pg8::StaticOrder, true, true>(F.lds + RING_OFF, g, S, E); } SEAM(11); }
    if (IN(12)) { { pg8::Gemm g{(const bf16*)(ws + R_H), (const bf16*)(ws + WS_W2), MA_ROWS, D, FF}; pg8::StaticOrder S; S.init(MA_ROWS, D, F.G, bid);
            pg8::EpiResid E{F.out, XC, F.out, XC, MOD + 5 * 1024};
            pg8::gemm_phase<pg8::EpiResid, pg8::StaticOrder, true, true>(F.lds + RING_OFF, g, S, E); } SEAM(12); }
    if (IN(13)) { norm_rows(F, A, F.out, XC, MA_ROWS, A.in[I_NORM_MIX] + D, MOD + 3 * 6144, 0, 1, XN); SEAM(13); }
    if (IN(14)) { { pg8::Gemm g{XN, (const bf16*)(ws + WS_WATT), MA_ROWS, ATT_N, D}; pg8::StaticOrder S; S.init(MA_ROWS, ATT_N, F.G, bid);
            pg8::EpiStoreF32<ATT_N> E{(float*)(ws + R_ATT)};
            pg8::gemm_phase<pg8::EpiStoreF32<ATT_N>, pg8::StaticOrder, true, true>(F.lds + RING_OFF, g, S, E); } SEAM(14); }
    if (IN(15)) { qk_prep(F, A); SEAM(15); }
    if (IN(16)) { attn_phase(F, A, (char*)lds + RING_OFF); SEAM(16); }
    if (IN(17)) { { pg8::Gemm g{(const bf16*)(ws + R_QB), (const bf16*)(ws + WS_WOUT) + (size_t)D * D, ML_ROWS, D, D}; pg8::StaticOrder S; S.init(ML_ROWS, D, F.G, bid);
            pg8::EpiResid E{F.out, XC, F.out, XC, MOD + 3 * 6144 + 2 * 1024};
            pg8::gemm_phase<pg8::EpiResid, pg8::StaticOrder, true, true>(F.lds + RING_OFF, g, S, E); } SEAM(17); }
    if (IN(18)) { norm_rows(F, A, F.out, XC, ML_ROWS, A.in[I_NORM_FFN] + D, MOD + 3 * 6144, 3, 4, XN); SEAM(18); }
    if (IN(19)) { { pg8::Gemm g{XN, (const bf16*)(ws + WS_W1) + (size_t)D * FF, ML_ROWS, FF, D}; pg8::StaticOrder S; S.init(ML_ROWS, FF, F.G, bid);
            pg8::EpiSqRelu<FF> E{(bf16*)(ws + R_H)};
            pg8::gemm_phase<pg8::EpiSqRelu<FF>, pg8::StaticOrder, true, true>(F.lds + RING_OFF, g, S, E); } SEAM(19); }
    if (IN(20)) { { pg8::Gemm g{(const bf16*)(ws + R_H), (const bf16*)(ws + WS_W2) + (size_t)D * FF, ML_ROWS, D, FF}; pg8::StaticOrder S; S.init(ML_ROWS, D, F.G, bid);
            pg8::EpiResid E{F.out, XC, F.out, XC, MOD + 3 * 6144 + 5 * 1024};
            pg8::gemm_phase<pg8::EpiResid, pg8::StaticOrder, true, true>(F.lds + RING_OFF, g, S, E); } SEAM(20); }
#undef IN
#undef SEAM
}

extern "C" void kernel_launch(void* const* d_in, const int* in_sizes, int n_in, void* d_out, int out_size, void* d_ws, size_t ws_size, hipStream_t stream) {
    static int grid = 0;
    if (grid == 0) {
        if (n_in != N_IN || out_size != ML_ROWS * D || ws_size < WS_END) { fprintf(stderr, "kernel_launch: unexpected shapes (n_in %d, out %d, ws %zu); nothing launched\n", n_in, out_size, ws_size); grid = -1; return; }
        int dev = 0, cus = 0, per_cu = 0;
        if (hipGetDevice(&dev) != hipSuccess || hipDeviceGetAttribute(&cus, hipDeviceAttributeMultiprocessorCount, dev) != hipSuccess) { grid = -1; return; }
        if (hipFuncSetAttribute((const void*)mk_fwd, hipFuncAttributeMaxDynamicSharedMemorySize, LDS_BYTES) != hipSuccess) { fprintf(stderr, "kernel_launch: hipFuncSetAttribute failed\n"); grid = -1; return; }
        if (hipOccupancyMaxActiveBlocksPerMultiprocessor(&per_cu, (const void*)mk_fwd, NTHREADS, LDS_BYTES) != hipSuccess || per_cu < 1) { fprintf(stderr, "kernel_launch: occupancy query says %d blocks per CU\n", per_cu); per_cu = 1; }
        (void)hipGetLastError();
        grid = cus;
    }
    if (grid < 0) return;
    (void)hipMemsetAsync((char*)d_ws + WS_CTL, 0, CTL_ZERO_BYTES, stream);
    Args a{};
    for (int i = 0; i < N_IN; ++i) a.in[i] = (const float*)d_in[i];
    a.out = (float*)d_out; a.ws = (unsigned char*)d_ws;
#if MK_N_LAUNCHES == 1
    a.ph_lo = 0; a.ph_hi = NPHASE; a.li = 0;
    { void* kargs[] = {&a}; hipError_t e = hipLaunchCooperativeKernel((const void*)mk_fwd, dim3(grid), dim3(NTHREADS), kargs, LDS_BYTES, stream);
      if (e != hipSuccess) fprintf(stderr, "kernel_launch: cooperative launch failed: %s\n", hipGetErrorString(e)); }
#else
    for (int p = 0; p < NPHASE; ++p) { a.ph_lo = p; a.ph_hi = p + 1; a.li = 0; hipLaunchKernelGGL(mk_fwd, dim3(grid), dim3(NTHREADS), LDS_BYTES, stream, a); }
#endif
}
```

```cpp
#include <hip/hip_runtime.h>
#include <hip/hip_bf16.h>
#include <cstdio>
#include <cstdint>
#include <cmath>
namespace pg8 {
#define PG8_LAS __attribute__((address_space(3)))
typedef unsigned short bf16_t;
typedef short bf16x8 __attribute__((ext_vector_type(8)));
typedef float f32x4 __attribute__((ext_vector_type(4)));
typedef unsigned u32x4 __attribute__((ext_vector_type(4)));
constexpr int BM = 256, BK = 64, HALF = 128, HTB = HALF * BK * 2  , STAGE_BYTES = 8 * HTB, NXCD = 8, WGM = 8;

__host__ __device__ __forceinline__ int lds_byte(int r, int c) { const int st = (r >> 4) * 2 + (c >> 5), rr = r & 15, cc = c & 31, ob = rr * 64 + cc * 2; return st * 1024 + (ob ^ (((ob >> 9) & 1) << 5)); }
__host__ __device__ __forceinline__ void stage_rc(int b, int& R, int& C) { const int st = b / 1024, sb = b % 1024, swz = sb ^ (((sb >> 9) & 1) << 5); R = (st >> 1) * 16 + swz / 64; C = (st & 1) * 32 + (swz % 64) / 2; }
__host__ __device__ __forceinline__ int perm32(int rho) { const int n = rho >> 4, i = rho & 15; return 8 * (i >> 2) + 4 * n + (i & 3); }

struct Unit { int pm, pn; };
struct Gemm { const bf16_t* A; const bf16_t* Bt; int M, N, K; };

struct StaticOrder {
    int nM, nN, nwg, G, c;
    __host__ __device__ void init(int M, int N, int G_, int c_) { nM = M / BM; nN = N / BM; nwg = nM * nN; G = G_; c = c_; }
    __host__ __device__ bool next(int i, Unit& u) const {
        const long L = (long)i * G + c; if (L >= nwg) return false;
        int wgid = (int)L; { const int q = nwg / NXCD, r = nwg % NXCD, xcd = wgid % NXCD, off = wgid / NXCD; wgid = (xcd < r ? xcd * (q + 1) : r * (q + 1) + (xcd - r) * q) + off; }
        const int nig = WGM * nN, gid = wgid / nig, fm = gid * WGM, gsz = (nM - fm) < WGM ? (nM - fm) : WGM;
        u.pm = fm + ((wgid % nig) % gsz); u.pn = (wgid % nig) / gsz; return true;
    }
    __device__ __forceinline__ void a_ready(const Unit&) const {}
    __device__ __forceinline__ void done(const Unit&) const {}
};

__device__ __forceinline__ unsigned cvt_pk_bf16(float lo, float hi) { unsigned r; asm volatile("v_cvt_pk_bf16_f32 %0, %1, %2" : "=v"(r) : "v"(lo), "v"(hi)); return r; }
typedef float f32x2 __attribute__((ext_vector_type(2)));
__device__ __forceinline__ f32x2 gelu_pk(f32x2 v) {
    const f32x2 av = __builtin_elementwise_abs(v), d = av * 0.2316418882f + 1.0f;
    f32x2 t; t.x = __builtin_amdgcn_rcpf(d.x); t.y = __builtin_amdgcn_rcpf(d.y);
    f32x2 q = t * 0.5307027145f + (-0.7265760135f); q = q * t + 0.7107068705f; q = q * t + (-0.142248368f); q = q * t + 0.127414796f; q = q * t;
    const f32x2 s = (v * v) * (-0.72134752044f);
    f32x2 e; e.x = __builtin_amdgcn_exp2f(s.x); e.y = __builtin_amdgcn_exp2f(s.y);
    const f32x2 m = v * (q * e), r = v - m;
    f32x2 o; o.x = v.x < 0.f ? m.x : r.x; o.y = v.y < 0.f ? m.y : r.y; return o;
}

template <int ACT  > struct EpiBf16 {
    static constexpr bool PERM = true, AFTER_DRAIN = false; static_assert(ACT == 0 || ACT == 1, "EpiBf16: ACT is 0 (none) or 1 (gelu_pk)");
    bf16_t* O; int ldc; const float* bias; int split_cols; size_t split_stride; float scale0;
    __device__ __forceinline__ void operator()(const f32x4 (&acc)[2][2][4][2], const Unit& u, int wr, int wc, int fr, int fq) const {
        const int row0 = u.pm * BM + wr * 64 + fr; int colt = u.pn * BM; bf16_t* base = O;
        float sc = 1.f; if (split_cols) { const int t = colt / split_cols; base += (size_t)t * split_stride; colt -= t * split_cols; if (t == 0) sc = scale0; }
        const int col0 = colt + wc * 32 + 8 * fq, bcol0 = u.pn * BM + wc * 32 + 8 * fq;
        f32x4 bv[2][2];
#pragma unroll
        for (int bj = 0; bj < 2; ++bj)
#pragma unroll
            for (int n = 0; n < 2; ++n) bv[bj][n] = bias ? *(const f32x4*)(bias + bcol0 + bj * HALF + 4 * n) : (f32x4){0.f, 0.f, 0.f, 0.f};
#pragma unroll
        for (int ai = 0; ai < 2; ++ai)
#pragma unroll
            for (int m = 0; m < 4; ++m) { bf16_t* rowp = base + (size_t)(row0 + ai * HALF + m * 16) * ldc + col0;
#pragma unroll
                for (int bj = 0; bj < 2; ++bj) { f32x4 v0 = acc[ai][bj][m][0] + bv[bj][0], v1 = acc[ai][bj][m][1] + bv[bj][1];
                    if (ACT == 1) { f32x2 a = gelu_pk((f32x2){v0[0], v0[1]}), b = gelu_pk((f32x2){v0[2], v0[3]}), c = gelu_pk((f32x2){v1[0], v1[1]}), d = gelu_pk((f32x2){v1[2], v1[3]});
                        v0 = (f32x4){a.x, a.y, b.x, b.y}; v1 = (f32x4){c.x, c.y, d.x, d.y}; }
                    v0 = v0 * sc; v1 = v1 * sc; u32x4 w; w.x = cvt_pk_bf16(v0[0], v0[1]); w.y = cvt_pk_bf16(v0[2], v0[3]); w.z = cvt_pk_bf16(v1[0], v1[1]); w.w = cvt_pk_bf16(v1[2], v1[3]);
                    *(u32x4*)(rowp + bj * HALF) = w; } }
    }
};

struct PanelStats {
    unsigned* xbuf;
    unsigned* cnt;
    unsigned* tmo;
    int ntn; float eps;
    unsigned code;
    __device__ __forceinline__ bool run(const f32x4 (&v)[2][2][4][2], const Unit& u, int wr, int wc, int fr, int fq, PG8_LAS unsigned char* lds, int wid, int lane) const {
        typedef float f32x2v __attribute__((ext_vector_type(2)));
        PG8_LAS f32x2v* P = (PG8_LAS f32x2v*)lds;
        PG8_LAS f32x2v* S = (PG8_LAS f32x2v*)(lds + 8192);
        PG8_LAS unsigned* flag = (PG8_LAS unsigned*)(lds + 8192 + 2048);
#pragma unroll
        for (int ai = 0; ai < 2; ++ai)
#pragma unroll
            for (int m = 0; m < 4; ++m) {
                float s = 0.f;
#pragma unroll
                for (int bj = 0; bj < 2; ++bj)
#pragma unroll
                    for (int n = 0; n < 2; ++n) { const f32x4 x = v[ai][bj][m][n]; s += (x[0] + x[1]) + (x[2] + x[3]); }
                s += __shfl_xor(s, 16); s += __shfl_xor(s, 32);
                const float mw = s * (1.0f / 64.0f); float q = 0.f;
#pragma unroll
                for (int bj = 0; bj < 2; ++bj)
#pragma unroll
                    for (int n = 0; n < 2; ++n) { const f32x4 d = v[ai][bj][m][n] - mw; q += (d[0] * d[0] + d[1] * d[1]) + (d[2] * d[2] + d[3] * d[3]); }
                q += __shfl_xor(q, 16); q += __shfl_xor(q, 32);
                if (fq == 0) P[(ai * HALF + wr * 64 + m * 16 + fr) * 4 + wc] = (f32x2v){mw, q};
            }
        asm volatile("s_waitcnt lgkmcnt(0)" ::: "memory"); __builtin_amdgcn_s_barrier(); asm volatile("" ::: "memory");
#if defined(BROKEN_EXCHANGE_NO_WAIT)
#warning BROKEN CONTROL BUILD: the row-statistics exchange does not wait; results are wrong by design
        if (blockIdx.x >= 64) { const long long t0_ = clock64(); while (clock64() - t0_ < 60000) __builtin_amdgcn_s_sleep(8); }
#endif
        const int row = wid * 32 + (lane & 31);
        if (lane < 32) {
            const f32x2v a = P[row * 4 + 0], b = P[row * 4 + 1], c = P[row * 4 + 2], d = P[row * 4 + 3];
            const float mt = (a.x + b.x + c.x + d.x) * 0.25f;
            const float da = a.x - mt, db = b.x - mt, dc = c.x - mt, dd = d.x - mt;
            const float m2 = (a.y + b.y) + (c.y + d.y) + 64.0f * ((da * da + db * db) + (dc * dc + dd * dd));
            unsigned long long* slot = (unsigned long long*)xbuf + ((size_t)(u.pm * BM + row) * 4 + u.pn);
            __hip_atomic_store(slot, ((unsigned long long)__float_as_uint(m2) << 32) | __float_as_uint(mt), __ATOMIC_RELAXED, __HIP_MEMORY_SCOPE_AGENT);
        }
        asm volatile("s_waitcnt vmcnt(0)" ::: "memory");
        if (lane == 0) __hip_atomic_fetch_add(cnt + 64 * u.pm, 1u, __ATOMIC_RELAXED, __HIP_MEMORY_SCOPE_AGENT);
        if (wid == 0) {
            bool dead = false; const unsigned long long t0 = __builtin_amdgcn_s_memrealtime(); const unsigned want = 8u * (unsigned)ntn;
            for (;;) {
#if defined(BROKEN_EXCHANGE_NO_WAIT)
                break;
#endif
                if ((unsigned)__builtin_amdgcn_readfirstlane(__hip_atomic_load(cnt + 64 * u.pm, __ATOMIC_RELAXED, __HIP_MEMORY_SCOPE_AGENT)) >= want) break;
                if (__builtin_amdgcn_s_memrealtime() - t0 > 2000000ull) {
                    if (lane == 0) { unsigned expect = 0u; __hip_atomic_compare_exchange_strong(tmo + 1, &expect, code | (unsigned)(u.pm & 0xff), __ATOMIC_RELAXED, __ATOMIC_RELAXED, __HIP_MEMORY_SCOPE_AGENT);
                                     __hip_atomic_store(tmo, 1u, __ATOMIC_RELAXED, __HIP_MEMORY_SCOPE_AGENT); }
                    dead = true; break; }
                __builtin_amdgcn_s_sleep(2);
            }
            __builtin_amdgcn_fence(__ATOMIC_ACQUIRE, "agent");
            if (lane == 0) flag[0] = dead ? 1u : 0u;
        }
        asm volatile("s_waitcnt vmcnt(0) lgkmcnt(0)" ::: "memory"); __builtin_amdgcn_s_barrier(); asm volatile("" ::: "memory");
        const bool bad = flag[0] != 0u;
        if (lane < 32) {
            const unsigned long long* slot = (const unsigned long long*)xbuf + (size_t)(u.pm * BM + row) * 4; float mt[4], m2[4]; float ms = 0.f;
#pragma unroll
            for (int t = 0; t < 4; ++t) { if (t < ntn) { const unsigned long long w = __hip_atomic_load(slot + t, __ATOMIC_RELAXED, __HIP_MEMORY_SCOPE_AGENT); mt[t] = __uint_as_float((unsigned)w); m2[t] = __uint_as_float((unsigned)(w >> 32)); } else { mt[t] = 0.f; m2[t] = 0.f; } ms += mt[t]; }
            const float mean = ms / (float)ntn; float q = 0.f;
#pragma unroll
            for (int t = 0; t < 4; ++t) if (t < ntn) { const float dm = mt[t] - mean; q += m2[t] + 256.0f * dm * dm; }
            S[row] = (f32x2v){mean, 1.0f / sqrtf(q / (256.0f * (float)ntn) + eps)};
        }
        asm volatile("s_waitcnt lgkmcnt(0)" ::: "memory"); __builtin_amdgcn_s_barrier(); asm volatile("" ::: "memory");
        return bad;
    }
};
struct EpiLnRes {
    static constexpr bool PERM = false, AFTER_DRAIN = true;
    const float* base; float* out; int ldc; const float* bias; PanelStats st; unsigned poison;
    __device__ __forceinline__ void fused(f32x4 (&acc)[2][2][4][2], const Unit& u, int wr, int wc, int fr, int fq, PG8_LAS unsigned char* lds, int wid, int lane) const {
        typedef float f32x2v __attribute__((ext_vector_type(2)));
        const PG8_LAS f32x2v* S = (const PG8_LAS f32x2v*)(lds + 8192);
        const int col0 = u.pn * BM + wc * 32 + 4 * fq;
#pragma unroll
        for (int bj = 0; bj < 2; ++bj)
#pragma unroll
            for (int n = 0; n < 2; ++n) { const f32x4 bv = bias ? *(const f32x4*)(bias + col0 + bj * HALF + n * 16) : (f32x4){0.f, 0.f, 0.f, 0.f};
#pragma unroll
                for (int ai = 0; ai < 2; ++ai)
#pragma unroll
                    for (int m = 0; m < 4; ++m) acc[ai][bj][m][n] += bv; }
        f32x4 pre[4][2][2];
#pragma unroll
        for (int m = 0; m < 4; ++m) { const size_t off = (size_t)(u.pm * BM + wr * 64 + m * 16 + fr) * ldc + col0;
#pragma unroll
            for (int bj = 0; bj < 2; ++bj)
#pragma unroll
                for (int n = 0; n < 2; ++n) pre[m][bj][n] = *(const f32x4*)(base + off + bj * HALF + n * 16); }
        const bool bad = st.run(acc, u, wr, wc, fr, fq, lds, wid, lane) || poison != 0u;
        const float qnan = __builtin_nanf("");
#pragma unroll
        for (int ai = 0; ai < 2; ++ai)
#pragma unroll
            for (int m = 0; m < 4; ++m) { const int r = ai * HALF + wr * 64 + m * 16 + fr; const f32x2v sr = S[r]; const size_t off = (size_t)(u.pm * BM + r) * ldc + col0;
#pragma unroll
                for (int bj = 0; bj < 2; ++bj)
#pragma unroll
                    for (int n = 0; n < 2; ++n) { const f32x4 bs = ai == 0 ? pre[m][bj][n] : *(const f32x4*)(base + off + bj * HALF + n * 16); f32x4 o = bs + (acc[ai][bj][m][n] - sr.x) * sr.y;
                        if (bad) o = (f32x4){qnan, qnan, qnan, qnan}; *(f32x4*)(out + off + bj * HALF + n * 16) = o; }
                if (m & 1) asm volatile("" ::: "memory"); }
    }
};
struct EpiLnResLn {
    static constexpr bool PERM = false, AFTER_DRAIN = true;
    const float* base; float* out; bf16_t* xn; int ldc; const float* bias; PanelStats st1, st2; unsigned poison;
    __device__ __forceinline__ void fused(f32x4 (&acc)[2][2][4][2], const Unit& u, int wr, int wc, int fr, int fq, PG8_LAS unsigned char* lds, int wid, int lane) const {
        typedef float f32x2v __attribute__((ext_vector_type(2))); typedef unsigned u32x2v __attribute__((ext_vector_type(2)));
        const PG8_LAS f32x2v* S = (const PG8_LAS f32x2v*)(lds + 8192);
        const int col0 = u.pn * BM + wc * 32 + 4 * fq;
#pragma unroll
        for (int bj = 0; bj < 2; ++bj)
#pragma unroll
            for (int n = 0; n < 2; ++n) { const f32x4 bv = bias ? *(const f32x4*)(bias + col0 + bj * HALF + n * 16) : (f32x4){0.f, 0.f, 0.f, 0.f};
#pragma unroll
                for (int ai = 0; ai < 2; ++ai)
#pragma unroll
                    for (int m = 0; m < 4; ++m) acc[ai][bj][m][n] += bv; }
        bool bad = st1.run(acc, u, wr, wc, fr, fq, lds, wid, lane) || poison != 0u;
        const float qnan = __builtin_nanf("");
#pragma unroll
        for (int ai = 0; ai < 2; ++ai)
#pragma unroll
            for (int m = 0; m < 4; ++m) { const int r = ai * HALF + wr * 64 + m * 16 + fr; const f32x2v sr = S[r]; const size_t off = (size_t)(u.pm * BM + r) * ldc + col0;
#pragma unroll
                for (int bj = 0; bj < 2; ++bj)
#pragma unroll
                    for (int n = 0; n < 2; ++n) { const f32x4 bs = *(const f32x4*)(base + off + bj * HALF + n * 16); acc[ai][bj][m][n] = bs + (acc[ai][bj][m][n] - sr.x) * sr.y; }
                asm volatile("" : "+v"(acc[ai][0][m][0]), "+v"(acc[ai][0][m][1]), "+v"(acc[ai][1][m][0]), "+v"(acc[ai][1][m][1]));
                if (m & 1) asm volatile("" ::: "memory"); }
        const bool bad1 = bad;
        bad = st2.run(acc, u, wr, wc, fr, fq, lds, wid, lane) || bad;
#pragma unroll
        for (int ai = 0; ai < 2; ++ai)
#pragma unroll
            for (int m = 0; m < 4; ++m) { const int r = ai * HALF + wr * 64 + m * 16 + fr; const f32x2v sr = S[r]; const size_t off = (size_t)(u.pm * BM + r) * ldc + col0;
#pragma unroll
                for (int bj = 0; bj < 2; ++bj)
#pragma unroll
                    for (int n = 0; n < 2; ++n) { const f32x4 x1 = acc[ai][bj][m][n]; *(f32x4*)(out + off + bj * HALF + n * 16) = bad1 ? (f32x4){qnan, qnan, qnan, qnan} : x1;
                        const f32x4 o = (x1 - sr.x) * sr.y; u32x2v w; w.x = cvt_pk_bf16(o[0], o[1]); w.y = cvt_pk_bf16(o[2], o[3]);
                        if (bad) { w.x = 0x7fc07fc0u; w.y = 0x7fc07fc0u; } *(u32x2v*)(xn + off + bj * HALF + n * 16) = w; }
                asm volatile("" ::: "memory"); }
    }
};

template <class Epi, class Sched, bool ALIGN_EPI = false, bool SP2 = false>
__device__ __forceinline__ void gemm_phase(PG8_LAS unsigned char* lds, const Gemm g, const Sched& S, const Epi& E) {
    const int tid = threadIdx.x, wid = __builtin_amdgcn_readfirstlane(tid >> 6), lane = tid & 63, wr = wid >> 2, wc = wid & 3, fr = lane & 15, fq = lane >> 4;
    const int K = g.K, nt = K / BK;
    unsigned voffA[2], voffB[2];
#pragma unroll
    for (int i = 0; i < 2; ++i) { int R, C; stage_rc(tid * 16 + i * 8192, R, C); const int Rb = Epi::PERM ? ((R & ~31) + perm32(R & 31)) : R;
        voffA[i] = (unsigned)(R * K + C) * 2u; voffB[i] = (unsigned)(Rb * K + C) * 2u; }
    const size_t kstep = (size_t)(BK * 2);
    const size_t hstep = (size_t)HALF * K * 2;
    const size_t tstep = 2 * hstep;
    const unsigned ldsw = (unsigned)wid * 1024u;
    const int aoff = lds_byte(wr * 64 + fr, fq * 8), boff = lds_byte(wc * 32 + fr, fq * 8);
#define PG8_SA(b, h) (((b) * 2 + (h)) * HTB)
#define PG8_SB(b, h) ((4 + (b) * 2 + (h)) * HTB)
#define PG8_STAGE(bufoff, gbase, voff) do { _Pragma("unroll") for (int _i = 0; _i < 2; ++_i) \
        __builtin_amdgcn_global_load_lds((const unsigned*)((const char*)(gbase) + (voff)[_i]), (PG8_LAS unsigned*)(lds + (bufoff) + ldsw + _i * 8192), 16, 0, 0); } while (0)
#define PG8_LDA(dst, b, h) do { _Pragma("unroll") for (int m = 0; m < 4; ++m) _Pragma("unroll") for (int k = 0; k < 2; ++k) dst[m][k] = *(const PG8_LAS bf16x8*)(lds + PG8_SA(b, h) + aoff + m * 2048 + k * 1024); } while (0)
#define PG8_LDB(dst, b, h) do { _Pragma("unroll") for (int n = 0; n < 2; ++n) _Pragma("unroll") for (int k = 0; k < 2; ++k) dst[n][k] = *(const PG8_LAS bf16x8*)(lds + PG8_SB(b, h) + boff + n * 2048 + k * 1024); } while (0)
#define PG8_MMA(ai, bj, At, Bt) do { __builtin_amdgcn_s_setprio(1); _Pragma("unroll") for (int m = 0; m < 4; ++m) _Pragma("unroll") for (int n = 0; n < 2; ++n) _Pragma("unroll") for (int k = 0; k < 2; ++k) \
        acc[ai][bj][m][n] = __builtin_amdgcn_mfma_f32_16x16x32_bf16(Bt[n][k], At[m][k], acc[ai][bj][m][n], 0, 0, 0); __builtin_amdgcn_s_setprio(0); } while (0)
#define PG8_WAIT_V(n) asm volatile("s_waitcnt vmcnt(" #n ")" ::: "memory")
#define PG8_WAIT_L(n) asm volatile("s_waitcnt lgkmcnt(" #n ")" ::: "memory")
#define PG8_BAR __builtin_amdgcn_s_barrier()
#define PG8_SCHED __builtin_amdgcn_sched_barrier(0)
    Unit cur, nxt; int ui = 0;
    if (!S.next(0, cur)) return;
    f32x4 acc[2][2][4][2];
#pragma unroll
    for (int a = 0; a < 2; ++a)
#pragma unroll
        for (int b = 0; b < 2; ++b)
#pragma unroll
            for (int m = 0; m < 4; ++m)
#pragma unroll
                for (int n = 0; n < 2; ++n) acc[a][b][m][n] = (f32x4){0.f, 0.f, 0.f, 0.f};
    bf16x8 At[4][2], B0[2][2], B1[2][2];
    const char* cA = (const char*)g.A + (size_t)cur.pm * tstep; const char* cB = (const char*)g.Bt + (size_t)cur.pn * tstep;
    S.a_ready(cur);
    if constexpr (SP2) {
        PG8_STAGE(PG8_SB(0, 0), cB, voffB); PG8_STAGE(PG8_SB(0, 1), cB + hstep, voffB); PG8_STAGE(PG8_SA(0, 0), cA, voffA); PG8_STAGE(PG8_SA(0, 1), cA + hstep, voffA);
        if (wr == 1) PG8_BAR;
        PG8_WAIT_V(2); PG8_BAR;
        PG8_STAGE(PG8_SB(1, 0), cB + kstep, voffB); PG8_STAGE(PG8_SA(1, 0), cA + kstep, voffA); PG8_STAGE(PG8_SB(1, 1), cB + hstep + kstep, voffB);
        PG8_WAIT_V(6); PG8_BAR;
    } else {
        PG8_STAGE(PG8_SB(0, 0), cB, voffB); PG8_STAGE(PG8_SA(0, 0), cA, voffA); PG8_STAGE(PG8_SB(0, 1), cB + hstep, voffB); PG8_STAGE(PG8_SA(0, 1), cA + hstep, voffA);
        if (wr == 1) PG8_BAR;
        PG8_WAIT_V(4); PG8_BAR;
        PG8_STAGE(PG8_SB(1, 0), cB + kstep, voffB); PG8_STAGE(PG8_SA(1, 0), cA + kstep, voffA); PG8_STAGE(PG8_SB(1, 1), cB + hstep + kstep, voffB);
        PG8_WAIT_V(6); PG8_BAR;
    }
    for (;;) {
        const bool has_next = S.next(ui + 1, nxt);
        const char* nA = has_next ? (const char*)g.A + (size_t)nxt.pm * tstep : cA; const char* nB = has_next ? (const char*)g.Bt + (size_t)nxt.pn * tstep : cB;
        for (int t = 0; t < nt; t += 2) {
            const bool last = (t == nt - 2);
            const char* a1 = cA + (size_t)(t + 1) * kstep;
            const char* a2 = last ? nA : cA + (size_t)(t + 2) * kstep; const char* b2 = last ? nB : cB + (size_t)(t + 2) * kstep;
            const char* a3 = a2 + kstep; const char* b3 = b2 + kstep;
            if (last && has_next) S.a_ready(nxt);
            if constexpr (SP2) {
            PG8_LDB(B0, 0, 0); PG8_LDB(B1, 0, 1); PG8_SCHED; PG8_LDA(At, 0, 0); PG8_STAGE(PG8_SA(1, 1), a1 + hstep, voffA);
            PG8_WAIT_V(8); PG8_WAIT_L(0); PG8_BAR; PG8_MMA(0, 0, At, B0); PG8_MMA(0, 1, At, B1); PG8_BAR; PG8_SCHED;
            PG8_LDA(At, 0, 1); PG8_STAGE(PG8_SB(0, 0), b2, voffB); PG8_STAGE(PG8_SB(0, 1), b2 + hstep, voffB); PG8_STAGE(PG8_SA(0, 0), a2, voffA);
            PG8_WAIT_V(8); PG8_WAIT_L(0); PG8_BAR; PG8_MMA(1, 0, At, B0); PG8_MMA(1, 1, At, B1); PG8_BAR; PG8_SCHED;
            PG8_LDB(B0, 1, 0); PG8_LDB(B1, 1, 1); PG8_SCHED; PG8_LDA(At, 1, 0); PG8_STAGE(PG8_SA(0, 1), a2 + hstep, voffA);
            PG8_WAIT_V(8); PG8_WAIT_L(0); PG8_BAR; PG8_MMA(0, 0, At, B0); PG8_MMA(0, 1, At, B1); PG8_BAR; PG8_SCHED;
            PG8_LDA(At, 1, 1); PG8_STAGE(PG8_SB(1, 0), b3, voffB); PG8_STAGE(PG8_SB(1, 1), b3 + hstep, voffB); PG8_STAGE(PG8_SA(1, 0), a3, voffA);
            PG8_WAIT_V(8); PG8_WAIT_L(0); PG8_BAR; PG8_MMA(1, 0, At, B0); PG8_MMA(1, 1, At, B1); PG8_BAR; PG8_SCHED;
            } else {
            PG8_LDB(B0, 0, 0); PG8_SCHED; PG8_LDA(At, 0, 0); PG8_STAGE(PG8_SA(1, 1), a1 + hstep, voffA);
            PG8_WAIT_L(8); PG8_BAR; PG8_WAIT_L(0); PG8_MMA(0, 0, At, B0); PG8_BAR; PG8_SCHED;
            PG8_LDB(B1, 0, 1); PG8_STAGE(PG8_SB(0, 0), b2, voffB);
            PG8_BAR; PG8_WAIT_L(0); PG8_MMA(0, 1, At, B1); PG8_BAR;
            PG8_LDA(At, 0, 1); PG8_STAGE(PG8_SA(0, 0), a2, voffA);
            PG8_BAR; PG8_WAIT_L(0); PG8_MMA(1, 0, At, B0); PG8_BAR; PG8_SCHED;
            PG8_STAGE(PG8_SB(0, 1), b2 + hstep, voffB);
            PG8_WAIT_V(6); PG8_BAR; PG8_MMA(1, 1, At, B1); PG8_BAR;
            PG8_LDB(B0, 1, 0); PG8_SCHED; PG8_LDA(At, 1, 0); PG8_STAGE(PG8_SA(0, 1), a2 + hstep, voffA);
            PG8_WAIT_L(8); PG8_BAR; PG8_WAIT_L(0); PG8_MMA(0, 0, At, B0); PG8_BAR; PG8_SCHED;
            PG8_LDB(B1, 1, 1); PG8_STAGE(PG8_SB(1, 0), b3, voffB);
            PG8_BAR; PG8_WAIT_L(0); PG8_MMA(0, 1, At, B1); PG8_BAR;
            PG8_LDA(At, 1, 1); PG8_STAGE(PG8_SA(1, 0), a3, voffA);
            PG8_BAR; PG8_WAIT_L(0); PG8_MMA(1, 0, At, B0); PG8_BAR; PG8_SCHED;
            PG8_STAGE(PG8_SB(1, 1), b3 + hstep, voffB);
            PG8_WAIT_V(6); PG8_BAR; PG8_MMA(1, 1, At, B1); PG8_BAR;
            }
        }
        if constexpr (ALIGN_EPI) { if (wr == 0) PG8_BAR; }
        if constexpr (!Epi::AFTER_DRAIN) { E(acc, cur, wr, wc, fr, fq); S.done(cur); }
        if (!has_next) break;
#pragma unroll
        for (int a = 0; a < 2; ++a)
#pragma unroll
            for (int b = 0; b < 2; ++b)
#pragma unroll
                for (int m = 0; m < 4; ++m)
#pragma unroll
                    for (int n = 0; n < 2; ++n) acc[a][b][m][n] = (f32x4){0.f, 0.f, 0.f, 0.f};
        cur = nxt; cA = nA; cB = nB; ++ui;
        if constexpr (ALIGN_EPI) { if (wr == 1) PG8_BAR; }
    }
    PG8_WAIT_V(0);
    if constexpr (!ALIGN_EPI) { if (wr == 0) PG8_BAR; }
    PG8_BAR;
    if constexpr (Epi::AFTER_DRAIN) { E.fused(acc, cur, wr, wc, fr, fq, lds, wid, lane); S.done(cur); }
#undef PG8_SA
#undef PG8_SB
#undef PG8_STAGE
#undef PG8_LDA
#undef PG8_LDB
#undef PG8_MMA
#undef PG8_WAIT_V
#undef PG8_WAIT_L
#undef PG8_BAR
#undef PG8_SCHED
}
}
namespace pg8 {
__device__ __forceinline__ int erow(int ai, int m, int wr, int fr) { return ai * HALF + wr * 64 + m * 16 + fr; }
template <bool PERM> __device__ __forceinline__ int ecol(int bj, int n, int wc, int fq) { return PERM ? (bj * HALF + wc * 32 + 8 * fq + 4 * n) : (bj * HALF + wc * 32 + 16 * n + 4 * fq); }
typedef unsigned u32x2e __attribute__((ext_vector_type(2)));
__device__ __forceinline__ u32x2e pack4(f32x4 v) { u32x2e w; w.x = cvt_pk_bf16(v[0], v[1]); w.y = cvt_pk_bf16(v[2], v[3]); return w; }
__device__ __forceinline__ float sigm(float x) { return 1.0f - __builtin_amdgcn_rcpf(1.0f + __expf(x)); }
__device__ __forceinline__ float tanh_(float x) { return 1.0f - 2.0f * __builtin_amdgcn_rcpf(1.0f + __expf(2.0f * x)); }

struct RecInDst { bf16_t* QM; size_t off_km, off_vm, off_om; bf16_t *RAWb, *TWAD, *SGD; float* GATES; };
__device__ __forceinline__ void recin_store4(const RecInDst& d, size_t row, int pn, int c, f32x4 v) {
    if (pn < 8) {
        const size_t off = (pn < 2) ? 0 : (pn < 4 ? d.off_km : (pn < 6 ? d.off_vm : d.off_om));
        if (pn == 2 || pn == 3) v = v * 0.08838834764831845f;
        *(u32x2e*)(d.QM + off + row * 512 + (pn & 1) * 256 + c) = pack4(v);
    } else if (pn < 14) {
        *(u32x2e*)(d.RAWb + row * 1536 + (pn - 8) * 256 + c) = pack4(v);
    } else if (pn == 14) {
        if (c < 128) { v[0] = tanh_(v[0]); v[1] = tanh_(v[1]); v[2] = tanh_(v[2]); v[3] = tanh_(v[3]); }
        *(u32x2e*)(d.TWAD + row * 256 + c) = pack4(v);
    } else {
        if (c < 128) { v[0] = sigm(v[0]); v[1] = sigm(v[1]); v[2] = sigm(v[2]); v[3] = sigm(v[3]); *(u32x2e*)(d.SGD + row * 128 + c) = pack4(v); }
        else if (c < 144) { *(f32x4*)(d.GATES + row * 16 + (c - 128)) = v; }
    }
}
__device__ __forceinline__ void recin_store1(const RecInDst& d, size_t row, int col, float v) {
    const int pn = col >> 8, c = col & 255;
    if (pn < 8) {
        const size_t off = (pn < 2) ? 0 : (pn < 4 ? d.off_km : (pn < 6 ? d.off_vm : d.off_om));
        if (pn == 2 || pn == 3) v *= 0.08838834764831845f;
        d.QM[off + row * 512 + (pn & 1) * 256 + c] = (bf16_t)(cvt_pk_bf16(v, 0.f) & 0xffffu);
    } else if (pn < 14) d.RAWb[row * 1536 + (pn - 8) * 256 + c] = (bf16_t)(cvt_pk_bf16(v, 0.f) & 0xffffu);
    else if (pn == 14) d.TWAD[row * 256 + c] = (bf16_t)(cvt_pk_bf16(c < 128 ? tanh_(v) : v, 0.f) & 0xffffu);
    else if (c < 128) d.SGD[row * 128 + c] = (bf16_t)(cvt_pk_bf16(sigm(v), 0.f) & 0xffffu);
    else if (c < 144) d.GATES[row * 16 + (c - 128)] = v;
}
struct EpiRecIn {
    static constexpr bool PERM = false, AFTER_DRAIN = false;
    RecInDst d;
    __device__ __forceinline__ void operator()(const f32x4 (&acc)[2][2][4][2], const Unit& u, int wr, int wc, int fr, int fq) const {
        const int pn = u.pn;
#pragma unroll
        for (int ai = 0; ai < 2; ++ai)
#pragma unroll
            for (int m = 0; m < 4; ++m) {
                const size_t row = (size_t)u.pm * BM + erow(ai, m, wr, fr);
#pragma unroll
                for (int bj = 0; bj < 2; ++bj)
#pragma unroll
                    for (int n = 0; n < 2; ++n) recin_store4(d, row, pn, ecol<false>(bj, n, wc, fq), acc[ai][bj][m][n]);
            }
    }
};
template <int ldc> struct EpiStoreBf16 {
    static constexpr bool PERM = true, AFTER_DRAIN = false;
    bf16_t* O; int scale_pm; float scale;
    __device__ __forceinline__ void operator()(const f32x4 (&acc)[2][2][4][2], const Unit& u, int wr, int wc, int fr, int fq) const {
        const float sc = (u.pm < scale_pm) ? scale : 1.0f;
#pragma unroll
        for (int ai = 0; ai < 2; ++ai)
#pragma unroll
            for (int m = 0; m < 4; ++m) {
                bf16_t* rowp = O + ((size_t)u.pm * BM + erow(ai, m, wr, fr)) * ldc + (size_t)u.pn * BM;
#pragma unroll
                for (int bj = 0; bj < 2; ++bj) {
                    const f32x4 v0 = acc[ai][bj][m][0] * sc, v1 = acc[ai][bj][m][1] * sc;
                    u32x4 w; w.x = cvt_pk_bf16(v0[0], v0[1]); w.y = cvt_pk_bf16(v0[2], v0[3]); w.z = cvt_pk_bf16(v1[0], v1[1]); w.w = cvt_pk_bf16(v1[2], v1[3]);
                    *(u32x4*)(rowp + ecol<true>(bj, 0, wc, fq)) = w;
                }
            }
    }
};
template <int ldc> struct EpiSqRelu {
    static constexpr bool PERM = true, AFTER_DRAIN = false;
    bf16_t* O;
    __device__ __forceinline__ void operator()(const f32x4 (&acc)[2][2][4][2], const Unit& u, int wr, int wc, int fr, int fq) const {
#pragma unroll
        for (int ai = 0; ai < 2; ++ai)
#pragma unroll
            for (int m = 0; m < 4; ++m) {
                bf16_t* rowp = O + ((size_t)u.pm * BM + erow(ai, m, wr, fr)) * ldc + (size_t)u.pn * BM;
#pragma unroll
                for (int bj = 0; bj < 2; ++bj) {
                    f32x4 v0 = acc[ai][bj][m][0], v1 = acc[ai][bj][m][1];
#pragma unroll
                    for (int e = 0; e < 4; ++e) { const float a = fmaxf(v0[e], 0.f), b = fmaxf(v1[e], 0.f); v0[e] = a * a; v1[e] = b * b; }
                    u32x4 w; w.x = cvt_pk_bf16(v0[0], v0[1]); w.y = cvt_pk_bf16(v0[2], v0[3]); w.z = cvt_pk_bf16(v1[0], v1[1]); w.w = cvt_pk_bf16(v1[2], v1[3]);
                    *(u32x4*)(rowp + ecol<true>(bj, 0, wc, fq)) = w;
                }
            }
    }
};
struct EpiResid {
    static constexpr bool PERM = false, AFTER_DRAIN = false;
    const float* src_lat; const float* src_ctx; float* dst_lat; float* dst_ctx; const float* gate;
    __device__ __forceinline__ void operator()(const f32x4 (&acc)[2][2][4][2], const Unit& u, int wr, int wc, int fr, int fq) const {
        const int row0 = u.pm * BM; const bool isctx = row0 >= 16384;
        const float* s = isctx ? src_ctx + (size_t)(row0 - 16384) * 1024 : src_lat + (size_t)row0 * 1024;
        float* d = isctx ? dst_ctx + (size_t)(row0 - 16384) * 1024 : dst_lat + (size_t)row0 * 1024;
        const float* g = gate + (isctx ? 2 : (row0 >> 13)) * 6144 + u.pn * BM;
        f32x4 gv[2][2];
#pragma unroll
        for (int bj = 0; bj < 2; ++bj)
#pragma unroll
            for (int n = 0; n < 2; ++n) gv[bj][n] = *(const f32x4*)(g + ecol<false>(bj, n, wc, fq));
        constexpr int RB = 2;
#pragma unroll
        for (int ai = 0; ai < 2; ++ai)
#pragma unroll
            for (int m0 = 0; m0 < 4; m0 += RB) {
                f32x4 x[RB][2][2];
#pragma unroll
                for (int mm = 0; mm < RB; ++mm) { const size_t off = (size_t)erow(ai, m0 + mm, wr, fr) * 1024 + (size_t)u.pn * BM;
#pragma unroll
                    for (int bj = 0; bj < 2; ++bj)
#pragma unroll
                        for (int n = 0; n < 2; ++n) x[mm][bj][n] = *(const f32x4*)(s + off + ecol<false>(bj, n, wc, fq)); }
#pragma unroll
                for (int mm = 0; mm < RB; ++mm) { const size_t off = (size_t)erow(ai, m0 + mm, wr, fr) * 1024 + (size_t)u.pn * BM;
#pragma unroll
                    for (int bj = 0; bj < 2; ++bj)
#pragma unroll
                        for (int n = 0; n < 2; ++n) *(f32x4*)(d + off + ecol<false>(bj, n, wc, fq)) = x[mm][bj][n] + gv[bj][n] * acc[ai][bj][m0 + mm][n]; }
            }
    }
};
struct EpiResidN {
    static constexpr bool PERM = false, AFTER_DRAIN = false;
    const float* src; float* dst; const float* gate;
    const float* ng; const float* nsc;
    bf16_t* XN; float* SS;
    __device__ __forceinline__ void operator()(const f32x4 (&acc)[2][2][4][2], const Unit& u, int wr, int wc, int fr_, int fq_) const {
        int lz = 0; asm volatile("" : "+v"(lz));
        const int fr = fr_ + lz, fq = fq_ + lz;
        const int row0 = u.pm * BM, vec = row0 >> 13;
        const float* s = src + (size_t)row0 * 1024 + (size_t)u.pn * BM; float* d = dst + (size_t)row0 * 1024 + (size_t)u.pn * BM; bf16_t* xn = XN + (size_t)row0 * 1024 + (size_t)u.pn * BM;
        const float* g = gate + vec * 6144 + u.pn * BM; const float* gn = ng + u.pn * BM; const float* sn = nsc + vec * 6144 + u.pn * BM;
        f32x4 gv[2][2];
#pragma unroll
        for (int bj = 0; bj < 2; ++bj)
#pragma unroll
            for (int n = 0; n < 2; ++n) gv[bj][n] = *(const f32x4*)(g + ecol<false>(bj, n, wc, fq));
#pragma unroll
        for (int ai = 0; ai < 2; ++ai)
#pragma unroll
            for (int m = 0; m < 4; ++m) {
                const int r = erow(ai, m, wr, fr); const size_t off = (size_t)r * 1024; float q = 0.f;
#pragma unroll
                for (int bj = 0; bj < 2; ++bj)
#pragma unroll
                    for (int n = 0; n < 2; ++n) { const int c = ecol<false>(bj, n, wc, fq); const f32x4 x = *(const f32x4*)(s + off + c) + gv[bj][n] * acc[ai][bj][m][n];
                        *(f32x4*)(d + off + c) = x; const f32x4 gs = *(const f32x4*)(gn + c) * (*(const f32x4*)(sn + c) + 1.0f); *(u32x2e*)(xn + off + c) = pack4(x * gs); q += (x[0] * x[0] + x[1] * x[1]) + (x[2] * x[2] + x[3] * x[3]); }
                q += __shfl_xor(q, 16); q += __shfl_xor(q, 32);
                if (fq == 0) SS[(size_t)(row0 + r) * 16 + u.pn * 4 + wc] = q;
            }
    }
};
__device__ __forceinline__ float row_rs(const float* SS, size_t row, int fq) {
    const f32x4 p = *(const f32x4*)(SS + row * 16 + 4 * fq); float t = (p[0] + p[1]) + (p[2] + p[3]);
    t += __shfl_xor(t, 16); t += __shfl_xor(t, 32);
    return 1.0f / sqrtf(t * (1.0f / 1024.0f) + 1e-6f);
}
template <int ldc> struct EpiSqReluN {
    static constexpr bool PERM = true, AFTER_DRAIN = false;
    bf16_t* O; const float* SS; const float* bias;
    __device__ __forceinline__ void operator()(const f32x4 (&acc)[2][2][4][2], const Unit& u, int wr, int wc, int fr, int fq) const {
        const float* bp = bias + ((u.pm * BM) >> 13) * 4096 + u.pn * BM;
#pragma unroll
        for (int ai = 0; ai < 2; ++ai)
#pragma unroll
            for (int m = 0; m < 4; ++m) {
                const size_t row = (size_t)u.pm * BM + erow(ai, m, wr, fr); const float rs = row_rs(SS, row, fq);
                bf16_t* rowp = O + row * ldc + (size_t)u.pn * BM;
#pragma unroll
                for (int bj = 0; bj < 2; ++bj) { const int c = ecol<true>(bj, 0, wc, fq);
                    f32x4 v0 = acc[ai][bj][m][0] * rs + *(const f32x4*)(bp + c), v1 = acc[ai][bj][m][1] * rs + *(const f32x4*)(bp + c + 4);
#pragma unroll
                    for (int e_ = 0; e_ < 4; ++e_) { const float a = fmaxf(v0[e_], 0.f), b = fmaxf(v1[e_], 0.f); v0[e_] = a * a; v1[e_] = b * b; }
                    u32x4 w; w.x = cvt_pk_bf16(v0[0], v0[1]); w.y = cvt_pk_bf16(v0[2], v0[3]); w.z = cvt_pk_bf16(v1[0], v1[1]); w.w = cvt_pk_bf16(v1[2], v1[3]);
                    *(u32x4*)(rowp + c) = w; }
            }
    }
};
template <int ldc> struct EpiStoreF32N {
    static constexpr bool PERM = false, AFTER_DRAIN = false;
    float* O; const float* SS; const float* bias;
    __device__ __forceinline__ void operator()(const f32x4 (&acc)[2][2][4][2], const Unit& u, int wr, int wc, int fr, int fq) const {
        const float* bp = bias + ((u.pm * BM) >> 13) * 4096 + u.pn * BM;
#pragma unroll
        for (int ai = 0; ai < 2; ++ai)
#pragma unroll
            for (int m = 0; m < 4; ++m) {
                const size_t row = (size_t)u.pm * BM + erow(ai, m, wr, fr); const float rs = row_rs(SS, row, fq);
                float* rowp = O + row * ldc + (size_t)u.pn * BM;
#pragma unroll
                for (int bj = 0; bj < 2; ++bj)
#pragma unroll
                    for (int n = 0; n < 2; ++n) { const int c = ecol<false>(bj, n, wc, fq); *(f32x4*)(rowp + c) = acc[ai][bj][m][n] * rs + *(const f32x4*)(bp + c); }
            }
    }
};
template <int ldc> struct EpiStoreF32 {
    static constexpr bool PERM = false, AFTER_DRAIN = false;
    float* O;
    __device__ __forceinline__ void operator()(const f32x4 (&acc)[2][2][4][2], const Unit& u, int wr, int wc, int fr, int fq) const {
#pragma unroll
        for (int ai = 0; ai < 2; ++ai)
#pragma unroll
            for (int m = 0; m < 4; ++m) {
                float* rowp = O + ((size_t)u.pm * BM + erow(ai, m, wr, fr)) * ldc + (size_t)u.pn * BM;
#pragma unroll
                for (int bj = 0; bj < 2; ++bj)
#pragma unroll
                    for (int n = 0; n < 2; ++n) *(f32x4*)(rowp + ecol<false>(bj, n, wc, fq)) = acc[ai][bj][m][n];
            }
    }
};
}
#include <hip/hip_bf16.h>
#include <cmath>
namespace attn_body {
using bf16=__hip_bfloat16;
using bf16x8=__attribute__((ext_vector_type(8)))short;
using s16x4=__attribute__((ext_vector_type(4)))short;
using f32x16=__attribute__((ext_vector_type(16)))float;
using u32x4=__attribute__((ext_vector_type(4)))unsigned;
constexpr int BATCH=2,NHEAD=16,SEQ=8192,CTXL=256,KVP=64,D=64,DM=NHEAD*D;
constexpr int NW=8,QBLK=32,QB=QBLK*NW,KVBLK=64,NQB=SEQ/QB;
constexpr int ATTN_PITCH=DM, ATTN_UNIT_ROWS=QB;
__device__ __forceinline__ int crow(int r,int hi){return (r&3)+8*(r>>2)+4*hi;}
#define SBAR() __builtin_amdgcn_sched_barrier(0)
__device__ __forceinline__ void cmask(f32x16&p0,f32x16&p1,int jb,int qrel,int hi){
  const float NEG=-INFINITY; int kb=64*jb+4*hi;
  #pragma unroll
  for(int r=0;r<16;++r){int kv=kb+(r&3)+8*(r>>2); if(kv>qrel)p0[r]=NEG; if(kv+32>qrel)p1[r]=NEG;}
}

__device__ __forceinline__ void wmask(f32x16&p0,f32x16&p1,int dbase,int hi){
  const float NEG=-INFINITY; const int kb=dbase+4*hi;
  #pragma unroll
  for(int r=0;r<16;++r){int d=kb+(r&3)+8*(r>>2); if(d>128||d<-128)p0[r]=NEG; if(d+32>128||d+32<-128)p1[r]=NEG;}
}
constexpr int NSLOT=3, SLOTB=8192;
constexpr int LDS_K=0, LDS_V=NSLOT*SLOTB, LDS_WS=2*NSLOT*SLOTB, LDS_OST=LDS_WS+NW*64*4, LDS_BYTES=LDS_OST+NW*4096;
constexpr float C2=0.125f*1.4426950408889634f;
__device__ __forceinline__ void glds16(const void*gsrc,unsigned lds_dst){unsigned keep;
  asm volatile("s_mov_b32 %0, m0\n\ts_mov_b32 m0, %2\n\ts_nop 0\n\tglobal_load_lds_dwordx4 %1, off\n\ts_mov_b32 m0, %0":"=&s"(keep):"v"(gsrc),"s"(lds_dst):"memory");}
__device__ __forceinline__ float max3f(float a,float b,float c){float r;asm("v_max3_f32 %0, %1, %2, %3":"=v"(r):"v"(a),"v"(b),"v"(c));return r;}
__device__ __forceinline__ float max2f(float a,float b){float r;asm("v_max_f32_e32 %0, %1, %2":"=v"(r):"v"(a),"v"(b));return r;}
__device__ __forceinline__ float fadd_s(float a,float b){float r;asm("v_add_f32_e32 %0, %1, %2":"=v"(r):"v"(a),"v"(b));return r;}
__device__ __forceinline__ float fsub_s(float a,float b){float r;asm("v_sub_f32_e32 %0, %1, %2":"=v"(r):"v"(a),"v"(b));return r;}
typedef float f32x2_t __attribute__((ext_vector_type(2))); typedef __bf16 bf16x2_t __attribute__((ext_vector_type(2)));
__device__ __forceinline__ unsigned cvtpk_s(float lo,float hi){f32x2_t v={lo,hi};bf16x2_t b=__builtin_convertvector(v,bf16x2_t);return __builtin_bit_cast(unsigned,b);}
#define WAIT_BAR(N) asm volatile("s_waitcnt vmcnt(" #N ") lgkmcnt(0)\n\ts_barrier":::"memory")

__device__ __forceinline__ void qkt(f32x16&p0,f32x16&p1,const char*Kslot,const bf16x8*qr,const f32x16&negm,int r32,int hi){
  const char*kb=Kslot+hi*1024+r32*16;
  #pragma unroll
  for(int d0=0;d0<4;++d0){
    const bf16x8 b0=*reinterpret_cast<const bf16x8*>(kb+d0*2048);
    const bf16x8 b1=*reinterpret_cast<const bf16x8*>(kb+d0*2048+512);
    if(d0==0){p0=__builtin_amdgcn_mfma_f32_32x32x16_bf16(b0,qr[0],negm,0,0,0);p1=__builtin_amdgcn_mfma_f32_32x32x16_bf16(b1,qr[0],negm,0,0,0);}
    else{p0=__builtin_amdgcn_mfma_f32_32x32x16_bf16(b0,qr[d0],p0,0,0,0);p1=__builtin_amdgcn_mfma_f32_32x32x16_bf16(b1,qr[d0],p1,0,0,0);}}
}
typedef __attribute__((address_space(3))) const char* lds_cptr;
typedef short v4i16_t __attribute__((ext_vector_type(4)));
__device__ __forceinline__ void kload8(bf16x8*kf,lds_cptr kp){
  kf[0]=*(const __attribute__((address_space(3))) bf16x8*)(kp);      kf[1]=*(const __attribute__((address_space(3))) bf16x8*)(kp+512);
  kf[2]=*(const __attribute__((address_space(3))) bf16x8*)(kp+2048); kf[3]=*(const __attribute__((address_space(3))) bf16x8*)(kp+2560);
  kf[4]=*(const __attribute__((address_space(3))) bf16x8*)(kp+4096); kf[5]=*(const __attribute__((address_space(3))) bf16x8*)(kp+4608);
  kf[6]=*(const __attribute__((address_space(3))) bf16x8*)(kp+6144); kf[7]=*(const __attribute__((address_space(3))) bf16x8*)(kp+6656);
}
__device__ __forceinline__ void kload2(bf16x8*kf,lds_cptr kp,int j){ kf[2*j]=*(const __attribute__((address_space(3))) bf16x8*)(kp+j*2048); kf[2*j+1]=*(const __attribute__((address_space(3))) bf16x8*)(kp+j*2048+512); }
__device__ __forceinline__ s16x4 vtr(lds_cptr p){ return __builtin_bit_cast(s16x4,__builtin_amdgcn_ds_read_tr16_b64_v4i16((__attribute__((address_space(3))) v4i16_t*)p)); }
__device__ __forceinline__ float rowmax(const f32x16&p0,const f32x16&p1){
  float a=max3f(p0[0],p0[1],p1[0]),b=max3f(p0[2],p0[3],p1[1]);a=max3f(a,p1[2],p1[3]);
  #pragma unroll
  for(int r=4;r<16;r+=4){a=max3f(a,p0[r],p0[r+1]);b=max3f(b,p0[r+2],p0[r+3]);a=max3f(a,p1[r],p1[r+1]);b=max3f(b,p1[r+2],p1[r+3]);}
  const float m=max2f(a,b);
  auto rr=__builtin_amdgcn_permlane32_swap(__float_as_uint(m),__float_as_uint(m),false,false);
  return max2f(__uint_as_float(rr[0]),__uint_as_float(rr[1]));
}
__device__ __forceinline__ void pv(f32x16*o,int vb,bf16x8 pa0,bf16x8 pa1,bf16x8 pa2,bf16x8 pa3){
  #pragma unroll
  for(int d0=0;d0<2;++d0){s16x4 lo[4],hi[4];
    #pragma unroll
    for(int ks=0;ks<4;++ks){
      asm volatile("ds_read_b64_tr_b16 %0,%1 offset:%c2":"=&v"(lo[ks]):"v"(vb),"i"(d0*4096+ks*1024):"memory");
      asm volatile("ds_read_b64_tr_b16 %0,%1 offset:%c2":"=&v"(hi[ks]):"v"(vb),"i"(d0*4096+ks*1024+512):"memory");}
    asm volatile("s_waitcnt lgkmcnt(0)":::"memory");SBAR();
    #define PK(k) (bf16x8){lo[k][0],lo[k][1],lo[k][2],lo[k][3],hi[k][0],hi[k][1],hi[k][2],hi[k][3]}
    o[d0]=__builtin_amdgcn_mfma_f32_32x32x16_bf16(pa0,PK(0),o[d0],0,0,0);
    o[d0]=__builtin_amdgcn_mfma_f32_32x32x16_bf16(pa1,PK(1),o[d0],0,0,0);
    o[d0]=__builtin_amdgcn_mfma_f32_32x32x16_bf16(pa2,PK(2),o[d0],0,0,0);
    o[d0]=__builtin_amdgcn_mfma_f32_32x32x16_bf16(pa3,PK(3),o[d0],0,0,0);
    #undef PK
  }
}

#ifndef ATTN_STORE16
#define ATTN_STORE16(p,v) (*(u32x4*)(p)=(v))
#endif
template<int THRL,int MODE> __device__ __forceinline__ void attn_unit(int b,int h,int qb,const bf16*Q,const bf16*__restrict__ Kh,const bf16*__restrict__ Vh,bf16*O,char*shm,float sink_l2){
  const int tid=threadIdx.x,lane=tid&63,r32=lane&31,hi=lane>>5; const int wid=__builtin_amdgcn_readfirstlane(tid>>6);
  const long rowbase=(long)b*SEQ; const int q0=qb*QB;
  const bf16*Qw=Q+(rowbase+q0+wid*QBLK)*DM+h*D;
  const int wlo=(MODE==1)?(q0>=128?q0-128:0):0, whi=(MODE==1)?((q0+QB+128<=SEQ)?q0+QB+128:SEQ):0;
  #define TROW(t) ((MODE==1)?(((t)<4)?(SEQ+64*(t)):(wlo+64*((t)-4))):(64*(t)))
  const unsigned lds0=(unsigned)(uintptr_t)shm;
  float*wsf=(float*)(shm+LDS_WS)+wid*64;
  const bf16*ksrc=Kh+(long)lane*KVP+wid*8;
  const bf16*vsrc=Vh+(long)(16*(wid&3)+(lane>>2))*KVP+(wid>>2)*32+(lane&3)*8;
  const unsigned kdst=lds0+LDS_K+wid*1024, vdst=lds0+LDS_V+wid*1024;
  #define DMA_K(t,slot) glds16(ksrc+(long)TROW(t)*KVP,(unsigned)__builtin_amdgcn_readfirstlane(kdst+(slot)))
  #define DMA_V(t,slot) glds16(vsrc+(long)TROW(t)*KVP,(unsigned)__builtin_amdgcn_readfirstlane(vdst+(slot)))
  const int vb0=(int)(lds0+LDS_V)+((lane>>4)&1)*32+(lane&3)*8+(4*hi+((lane&15)>>2))*64;
  const char*Kbase=shm+LDS_K; bf16x8 kf[8];
  const lds_cptr shm3=(lds_cptr)shm; const lds_cptr kp0=shm3+LDS_K+hi*1024+r32*16; const lds_cptr vp0=shm3+LDS_V+((lane>>4)&1)*32+(lane&3)*8+(4*hi+((lane&15)>>2))*64;
  const int NT=(MODE==1)?(4+(whi-wlo)/KVBLK):((SEQ+CTXL)/KVBLK);
  DMA_K(0,0);DMA_V(0,0);DMA_K(1,SLOTB);
  bf16x8 qr[4];
  #pragma unroll
  for(int d0=0;d0<4;++d0)qr[d0]=*reinterpret_cast<const bf16x8*>(&Qw[(long)r32*DM+d0*16+hi*8]);
  float mhat=0.f,l_reg=0.f;f32x16 o[2];o[0]=f32x16{};o[1]=f32x16{};f32x16 negm=f32x16{};asm volatile("":"+v"(negm));
  const int qrel=wid*QBLK+r32;
  #define CMASK(P0,P1,t) do{ if(MODE==1&&(t)>=4) wmask(P0,P1,TROW(t)-(q0+qrel),hi); }while(0)
  bool resc=false;
  #define START(P0,P1) do{ const float rm=rowmax(P0,P1); resc=false; \
    { const float dl=rm; mhat=fadd_s(mhat,dl); \
      _Pragma("unroll") for(int r=0;r<16;++r){P0[r]=fsub_s(P0[r],dl);P1[r]=fsub_s(P1[r],dl);} \
      _Pragma("unroll") for(int r=0;r<16;++r)negm[r]=-mhat; asm volatile("":"+v"(negm)); } \
    _Pragma("unroll") for(int r=0;r<16;++r)P0[r]=__builtin_amdgcn_exp2f(P0[r]); }while(0)
  #define RESC() do{ if(resc){ asm volatile("s_waitcnt lgkmcnt(0)":::"memory"); \
      _Pragma("unroll") for(int d_=0;d_<2;++d_) _Pragma("unroll") for(int r=0;r<16;++r)o[d_][r]*=wsf[crow(r,hi)]; } }while(0)
  f32x16 pA0,pA1,pB0,pB1;
  int sl_prev=0,sl_cur=0,sl_next=SLOTB;
  #define ROT() do{sl_prev=sl_cur;sl_cur=sl_next;sl_next=(sl_next==(NSLOT-1)*SLOTB)?0:sl_next+SLOTB;}while(0)
  DMA_K(2,2*SLOTB);
  WAIT_BAR(3);
  qkt(pA0,pA1,Kbase,qr,negm,r32,hi);asm volatile("s_nop 15\n\ts_nop 7":"+v"(pA0),"+v"(pA1));CMASK(pA0,pA1,0);
  START(pA0,pA1);
  _Pragma("unroll") for(int r=0;r<16;++r)pA1[r]=__builtin_amdgcn_exp2f(pA1[r]);
  WAIT_BAR(0);
  DMA_K(3,0);DMA_V(1,SLOTB);
  ROT();
  kload8(kf,kp0+sl_cur);
  WAIT_BAR(2);
  s16x4 vlo[8],vhi[8]; u32x4 pw0,pw1,pw2,pw3;
  #define PKW(P,B) cvtpk_s(P[B],P[B+1])
  #define PAF(k) __builtin_bit_cast(bf16x8,pw##k)
  #define VFR(i) (bf16x8){vlo[i][0],vlo[i][1],vlo[i][2],vlo[i][3],vhi[i][0],vhi[i][1],vhi[i][2],vhi[i][3]}
  #define PIN(x) asm volatile("":"+v"(x))
  #define MX3(a,b,c) __builtin_fmaxf(__builtin_fmaxf((a),(b)),(c))
  #define GAPA(MF,A0,A1,A2,A3,W0,W1,PW) do{ MF; sacc+=A0; sacc+=A1; sacc+=A2; sacc+=A3; PIN(sacc); W0; W1; PIN(PW); SBAR(); }while(0)
  #define EX(v) __builtin_amdgcn_exp2f(v)
  #define GAPB(MF,X,B) do{ MF; X[B]=EX(X[B]); X[B+1]=EX(X[B+1]); X[B+2]=EX(X[B+2]); X[B+3]=EX(X[B+3]); PIN(X); SBAR(); }while(0)
  #define VRD(i) do{ vlo[i]=vtr(vp_+(((i)>>2)*4096+((i)&3)*1024)); vhi[i]=vtr(vp_+(((i)>>2)*4096+((i)&3)*1024+512)); }while(0)
  #define KRD(G,j) do{ if(G){ kload2(kf,kp0+sl_next,j); SBAR(); } }while(0)
  #define STEP(C0,C1,P0,P1,t,GK,GV,GL) do{ SBAR(); \
    const lds_cptr vp_=vp0+sl_prev; \
    VRD(0); SBAR(); float sacc=(P0[0]+P0[1]); \
    GAPA(C0=__builtin_amdgcn_mfma_f32_32x32x16_bf16(kf[0],qr[0],negm,0,0,0), P0[2],P0[3],P0[4],P0[5],     pw0[0]=PKW(P0,0), pw0[1]=PKW(P0,2), pw0); \
    VRD(4); SBAR(); GAPA(C1=__builtin_amdgcn_mfma_f32_32x32x16_bf16(kf[1],qr[0],negm,0,0,0), P0[6],P0[7],P0[8],P0[9],     pw0[2]=PKW(P0,4), pw0[3]=PKW(P0,6), pw0); \
    VRD(1); SBAR(); GAPA(C0=__builtin_amdgcn_mfma_f32_32x32x16_bf16(kf[2],qr[1],C0,0,0,0),   P0[10],P0[11],P0[12],P0[13], pw1[0]=PKW(P0,8), pw1[1]=PKW(P0,10), pw1); \
    VRD(5); SBAR(); GAPA(C1=__builtin_amdgcn_mfma_f32_32x32x16_bf16(kf[3],qr[1],C1,0,0,0),   P0[14],P0[15],P1[0],P1[1],   pw1[2]=PKW(P0,12),pw1[3]=PKW(P0,14), pw1); \
    VRD(2); SBAR(); GAPA(C0=__builtin_amdgcn_mfma_f32_32x32x16_bf16(kf[4],qr[2],C0,0,0,0),   P1[2],P1[3],P1[4],P1[5],     pw2[0]=PKW(P1,0), pw2[1]=PKW(P1,2), pw2); \
    VRD(6); SBAR(); GAPA(C1=__builtin_amdgcn_mfma_f32_32x32x16_bf16(kf[5],qr[2],C1,0,0,0),   P1[6],P1[7],P1[8],P1[9],     pw2[2]=PKW(P1,4), pw2[3]=PKW(P1,6), pw2); \
    VRD(3); SBAR(); GAPA(C0=__builtin_amdgcn_mfma_f32_32x32x16_bf16(kf[6],qr[3],C0,0,0,0),   P1[10],P1[11],P1[12],P1[13], pw3[0]=PKW(P1,8), pw3[1]=PKW(P1,10), pw3); \
    VRD(7); SBAR(); GAPA(C1=__builtin_amdgcn_mfma_f32_32x32x16_bf16(kf[7],qr[3],C1,0,0,0),   P1[14],P1[15],0.f,0.f,       pw3[2]=PKW(P1,12),pw3[3]=PKW(P1,14), pw3); \
    l_reg+=sacc; \
    if(GK){DMA_K((t)+3,sl_cur);} if(GV){DMA_V((t)+1,sl_next);} \
    CMASK(C0,C1,t); \
    { float a=MX3(C0[0],C0[1],C1[0]),b=MX3(C0[2],C0[3],C1[1]); a=MX3(a,C1[2],C1[3]); \
      _Pragma("unroll") for(int r=4;r<16;r+=4){a=MX3(a,C0[r],C0[r+1]);b=MX3(b,C0[r+2],C0[r+3]);a=MX3(a,C1[r],C1[r+1]);b=MX3(b,C1[r+2],C1[r+3]);} \
      float rm=__builtin_fmaxf(a,b); { auto rr=__builtin_amdgcn_permlane32_swap(__float_as_uint(rm),__float_as_uint(rm),false,false); rm=__builtin_fmaxf(__uint_as_float(rr[0]),__uint_as_float(rr[1])); } \
      resc=false; \
      if(__builtin_expect(__any(rm>(float)THRL),0)){ const float dl=__builtin_fmaxf(rm,0.f); mhat+=dl; \
        _Pragma("unroll") for(int r=0;r<16;++r){C0[r]-=dl;C1[r]-=dl;} \
        _Pragma("unroll") for(int r=0;r<16;++r)negm[r]=-mhat; asm volatile("":"+v"(negm)); \
        const float f=__builtin_amdgcn_exp2f(-dl); l_reg*=f; if(hi==0)wsf[r32]=f; resc=true; } } \
    SBAR(); \
    GAPB(o[0]=__builtin_amdgcn_mfma_f32_32x32x16_bf16(PAF(0),VFR(0),o[0],0,0,0), C0,0); \
    GAPB(o[1]=__builtin_amdgcn_mfma_f32_32x32x16_bf16(PAF(0),VFR(4),o[1],0,0,0), C0,4); \
    KRD(GL,0); GAPB(o[0]=__builtin_amdgcn_mfma_f32_32x32x16_bf16(PAF(1),VFR(1),o[0],0,0,0), C0,8); \
    KRD(GL,1); GAPB(o[1]=__builtin_amdgcn_mfma_f32_32x32x16_bf16(PAF(1),VFR(5),o[1],0,0,0), C0,12); \
    KRD(GL,2); GAPB(o[0]=__builtin_amdgcn_mfma_f32_32x32x16_bf16(PAF(2),VFR(2),o[0],0,0,0), C1,0); \
    KRD(GL,3); GAPB(o[1]=__builtin_amdgcn_mfma_f32_32x32x16_bf16(PAF(2),VFR(6),o[1],0,0,0), C1,4); \
    GAPB(o[0]=__builtin_amdgcn_mfma_f32_32x32x16_bf16(PAF(3),VFR(3),o[0],0,0,0), C1,8); \
    GAPB(o[1]=__builtin_amdgcn_mfma_f32_32x32x16_bf16(PAF(3),VFR(7),o[1],0,0,0), C1,12); \
    }while(0)
  int t=1;
  #undef CMASK
  #define CMASK(P0,P1,t) do{ if(MODE==1&&(t)>=4) wmask(P0,P1,TROW(t)-(q0+qrel),hi); }while(0)
  for(;t+5<NT;t+=2){
    STEP(pB0,pB1,pA0,pA1,t,true,true,true);     WAIT_BAR(2); RESC(); ROT();
    STEP(pA0,pA1,pB0,pB1,t+1,true,true,true);   WAIT_BAR(2); RESC(); ROT();
  }
  #undef CMASK
  #define CMASK(P0,P1,t) do{ if(MODE==1&&(t)>=4) wmask(P0,P1,TROW(t)-(q0+qrel),hi); }while(0)
  #define ENDW(tt) do{ if((tt)+3<NT){WAIT_BAR(2);} else if((tt)+2<NT){WAIT_BAR(1);} else {WAIT_BAR(0);} }while(0)
  for(;t+1<NT;t+=2){
    STEP(pB0,pB1,pA0,pA1,t,(t+3<NT),(t+1<NT),(t+1<NT));       ENDW(t);   RESC(); ROT();
    STEP(pA0,pA1,pB0,pB1,t+1,(t+4<NT),(t+2<NT),(t+2<NT));     ENDW(t+1); RESC(); ROT();
  }
  STEP(pB0,pB1,pA0,pA1,NT-1,false,false,false); RESC();
  { float sacc=pB0[0]+pB0[1]; _Pragma("unroll") for(int r=2;r<16;++r)sacc+=pB0[r]; _Pragma("unroll") for(int r=0;r<16;++r)sacc+=pB1[r]; l_reg+=sacc;
    pw0=(u32x4){PKW(pB0,0),PKW(pB0,2),PKW(pB0,4),PKW(pB0,6)};pw1=(u32x4){PKW(pB0,8),PKW(pB0,10),PKW(pB0,12),PKW(pB0,14)};pw2=(u32x4){PKW(pB1,0),PKW(pB1,2),PKW(pB1,4),PKW(pB1,6)};pw3=(u32x4){PKW(pB1,8),PKW(pB1,10),PKW(pB1,12),PKW(pB1,14)};
    SBAR(); pv(o,vb0+sl_cur,PAF(0),PAF(1),PAF(2),PAF(3)); }
  #undef PKW
  #undef PAF
  #undef VFR
  #undef PIN
  #undef MX3
  #undef GAPA
  #undef GAPB
  #undef EX
  #undef VRD
  #undef KRD
  #undef STEP
  #undef ENDW
  {auto rr=__builtin_amdgcn_permlane32_swap(__float_as_uint(l_reg),__float_as_uint(l_reg),false,false);l_reg=__uint_as_float(rr[0])+__uint_as_float(rr[1]);}
  if(MODE==1) l_reg+=__builtin_amdgcn_exp2f(sink_l2-mhat);
  if(hi==0)wsf[32+r32]=l_reg;asm volatile("s_waitcnt lgkmcnt(0)":::"memory");
  float rli[16];
  #pragma unroll
  for(int r=0;r<16;++r)rli[r]=__builtin_amdgcn_rcpf(wsf[32+crow(r,hi)]);
  bf16*Ow=O+(rowbase+q0+wid*QBLK)*DM+h*D;
  { bf16*stg=(bf16*)(shm+LDS_OST)+wid*2048;
    #pragma unroll
    for(int r=0;r<16;++r){const int orow=crow(r,hi);
      #pragma unroll
      for(int d0=0;d0<2;++d0)stg[orow*64+d0*32+r32]=__float2bfloat16(o[d0][r]*rli[r]);}
    asm volatile("s_waitcnt lgkmcnt(0)":::"memory");
    #pragma unroll
    for(int i=0;i<4;++i){const int row=i*8+(lane>>3),ch=lane&7; const u32x4 v=*(const u32x4*)(stg+row*64+ch*8); ATTN_STORE16(Ow+(long)row*DM+ch*8,v);} }
  asm volatile("s_waitcnt lgkmcnt(0)\n\ts_barrier":::"memory");
  #undef DMA_K
  #undef DMA_V
  #undef CMASK
  #undef START
  #undef RESC
  #undef ROT
  #undef TROW
}
constexpr int ATTN_LDS_BYTES=LDS_BYTES;
#undef SBAR
#undef WAIT_BAR
}
#define GAS __attribute__((address_space(1)))
#define LAS __attribute__((address_space(3)))
typedef unsigned short bf16;
typedef unsigned v4u __attribute__((ext_vector_type(4)));
typedef float f32x4 __attribute__((ext_vector_type(4)));
typedef short bf16x8 __attribute__((ext_vector_type(8)));
typedef GAS unsigned gu32;
typedef GAS unsigned long long gu64;
#define RLX_AGENT __ATOMIC_RELAXED, __HIP_MEMORY_SCOPE_AGENT
#define LDS_WAIT() asm volatile("s_waitcnt lgkmcnt(0)" ::: "memory")
#define VM_WAIT() asm volatile("s_waitcnt vmcnt(0)" ::: "memory")
__device__ __forceinline__ unsigned long long rt() { return __builtin_amdgcn_s_memrealtime(); }
typedef float f32x2c_t __attribute__((ext_vector_type(2))); typedef __bf16 bf16x2c_t __attribute__((ext_vector_type(2)));
__device__ __forceinline__ unsigned pk2(float lo, float hi) { f32x2c_t v = {lo, hi}; bf16x2c_t r = __builtin_convertvector(v, bf16x2c_t); return __builtin_bit_cast(unsigned, r); }
__device__ __forceinline__ unsigned f2bf(float f) { return pk2(f, 0.f) & 0xffffu; }

#define XB_TMO      128
#define XB_XCNT(j)  (256  + 64 * (j))
#define XB_XSUB(j)  (1280 + 64 * (j))
#define XB_XGEN(j)  (2304 + 64 * (j))
#define XB_TOP      3328
#define XB_TOPGEN   3392
#define XCD_BAR_WORDS 3456
#define XB_SPIN_CAP (1u << 18)

__device__ __forceinline__ unsigned xb_ld(unsigned* p)              { return __hip_atomic_load(p, __ATOMIC_RELAXED, __HIP_MEMORY_SCOPE_AGENT); }
__device__ __forceinline__ unsigned xb_add(unsigned* p, unsigned v) { return __hip_atomic_fetch_add(p, v, __ATOMIC_RELAXED, __HIP_MEMORY_SCOPE_AGENT); }
__device__ __forceinline__ unsigned xb_xcc_id() { return (unsigned)__builtin_amdgcn_s_getreg((3 << 11) | 20) & 0xFu; }
#define XB_SPIN(cond, bar) do { unsigned _sp = 0; while (cond) { __builtin_amdgcn_s_sleep(1); \
    if ((++_sp & 255u) == 0u) { if (xb_ld(&(bar)[XB_TMO])) break; if (_sp > XB_SPIN_CAP) { atomicAdd(&(bar)[XB_TMO], 1u); break; } } } } while (0)

struct XcdBarrier {
    unsigned* bar; unsigned x;
    volatile LAS unsigned* st;
};

__device__ __forceinline__ XcdBarrier xcd_barrier_post(unsigned* bar, volatile LAS unsigned* st) {
    XcdBarrier b; b.bar = bar; b.x = xb_xcc_id(); b.st = st;
    if (threadIdx.x == 0) (void)xb_add(&bar[XB_XCNT(b.x)], 1u);
    return b;
}
__device__ __forceinline__ void xcd_barrier_complete(unsigned* bar, unsigned x, unsigned& nloc, unsigned& nx) {
    const unsigned G = gridDim.x * gridDim.y * gridDim.z;
    unsigned sum, cnt, mine, sp = 0u;
    for (;;) {
        sum = 0u; cnt = 0u; mine = 0u;
#pragma unroll
        for (unsigned j = 0; j < 16; ++j) { const unsigned c = xb_ld(&bar[XB_XCNT(j)]); sum += c; cnt += (c > 0u) ? 1u : 0u; mine = (j == x) ? c : mine; }
        if (sum == G) break;
        __builtin_amdgcn_s_sleep(1);
        if ((++sp & 255u) == 0u) { if (xb_ld(&bar[XB_TMO])) break; if (sp > XB_SPIN_CAP) { atomicAdd(&bar[XB_TMO], 1u); break; } }
    }
    nloc = mine > 0u ? mine : 1u; nx = cnt > 0u ? cnt : 1u;
}

__device__ __forceinline__ void xcd_barrier(const XcdBarrier& b) {
    asm volatile("s_waitcnt vmcnt(0)" ::: "memory");
    __syncthreads();
    if (threadIdx.x == 0) {
        unsigned* bar = b.bar;
        __builtin_amdgcn_s_waitcnt(0);
        unsigned nloc = b.st[0], nx = b.st[1];
        if (nloc == 0u) { xcd_barrier_complete(bar, b.x, nloc, nx); b.st[0] = nloc; b.st[1] = nx; }
        const unsigned old = xb_add(&bar[XB_XSUB(b.x)], 1u);
        const unsigned gen = old / nloc;
        if (old + 1u == (gen + 1u) * nloc) {
            __builtin_amdgcn_fence(__ATOMIC_RELEASE, "agent");
            asm volatile("s_waitcnt vmcnt(0)" ::: "memory");
            const unsigned og = xb_add(&bar[XB_TOP], 1u);
            const unsigned tg = og / nx;
            if (og + 1u == (tg + 1u) * nx) xb_add(&bar[XB_TOPGEN], 1u);
            else XB_SPIN(xb_ld(&bar[XB_TOPGEN]) == tg, bar);
            __builtin_amdgcn_fence(__ATOMIC_ACQUIRE, "agent");
            xb_add(&bar[XB_XGEN(b.x)], 1u);
            asm volatile("s_waitcnt vmcnt(0)" ::: "memory");
        } else {
            XB_SPIN(xb_ld(&bar[XB_XGEN(b.x)]) == gen, bar);
            __builtin_amdgcn_fence(__ATOMIC_ACQUIRE, "agent");
            asm volatile("s_waitcnt vmcnt(0)" ::: "memory");
        }
    }
    __syncthreads();
}
constexpr int NWAVES = 8, NTHREADS = 512;
constexpr int BATCH = 2, T = 8192, D = 1024, CTXL = 256, FF = 4096;
constexpr int ML_ROWS = BATCH * T;
constexpr int MC_ROWS = BATCH * CTXL;
constexpr int MA_ROWS = ML_ROWS + MC_ROWS;
constexpr int REC_N = 4096;
constexpr int ATT_N = 1536;
constexpr int KV_LEN = T + CTXL;
constexpr int NCHUNK = KV_LEN / 128;
constexpr int NCHAIN_ML = 16;
constexpr int NITEM_ML = NCHAIN_ML * NCHUNK;
constexpr int NCHAIN_RW = 32;
constexpr float NORM_EPS = 1e-6f, GN_EPS = 64e-5f;

constexpr size_t MiB = 1u << 20;
constexpr size_t WS_CTL = 0, CTL_ZERO_BYTES = 1 * MiB;
constexpr size_t WS_MODP = 1 * MiB;
constexpr size_t WS_MOD = 4 * MiB;
constexpr size_t WS_ROPE = WS_MOD + 512 * 1024;
constexpr size_t WS_BIAS = WS_MOD + 640 * 1024;
constexpr size_t WS_SSC = WS_MOD + 800 * 1024;
constexpr size_t WS_SS = 7 * MiB;
constexpr size_t WS_MISC = 5 * MiB;
constexpr size_t WS_WREC = 8 * MiB;
constexpr size_t WS_WATT = 17 * MiB;
constexpr size_t WS_WOUT = 20 * MiB;
constexpr size_t WS_W1 = 24 * MiB;
constexpr size_t WS_W2 = 40 * MiB;
constexpr size_t WS_WG2 = 56 * MiB;
constexpr size_t WS_W2T = WS_WG2 + 128 * 1024;
constexpr size_t WS_XC = 57 * MiB;
constexpr size_t WS_XN = 59 * MiB;
constexpr size_t WS_R = 92 * MiB;
constexpr size_t WS_END = 256 * MiB;
constexpr size_t SZ_A = (size_t)MA_ROWS * 512 * 2;
constexpr size_t R_QM = WS_R, R_KM = R_QM + SZ_A, R_OM = R_KM + SZ_A;
constexpr size_t R_RAW = R_OM + SZ_A;
constexpr size_t R_TWAD = R_RAW + 3 * SZ_A;
constexpr size_t R_SGD = R_TWAD + SZ_A / 2;
constexpr size_t R_GATES = R_SGD + SZ_A / 4;
constexpr size_t R_YRW0 = R_GATES + (size_t)MA_ROWS * 16 * 4;
constexpr size_t R_VM = R_YRW0 + SZ_A;
static_assert(R_VM + 2 * SZ_A <= WS_END, "recurrent map: VM plus the free tail hold the 33 MiB RWKV N buffer");
constexpr size_t R_GATE = R_VM;
constexpr size_t R_MIX = R_QM;
constexpr size_t R_HML = WS_XN;
constexpr size_t DO_CST = 0, DO_YRW1 = 34 * MiB;
static_assert((size_t)NITEM_ML * 16384 * 2 <= DO_YRW1 && DO_YRW1 + SZ_A <= (size_t)ML_ROWS * D * 4, "d_out scratch map");
constexpr size_t R_ATT = WS_R;
constexpr size_t R_QB = R_ATT + (size_t)MA_ROWS * ATT_N * 4;
constexpr size_t SZ_KV = (size_t)BATCH * 2 * KV_LEN * 64 * 2;
constexpr size_t R_KW = R_QB + (size_t)ML_ROWS * D * 2, R_VW = R_KW + SZ_KV, R_KG = R_VW + SZ_KV, R_VG = R_KG + SZ_KV;
static_assert(R_VG + SZ_KV <= WS_END, "attention map");
constexpr size_t R_PART = WS_R + (size_t)MA_ROWS * FF * 2;
constexpr size_t R_H = WS_R;
static_assert(R_H + (size_t)MA_ROWS * FF * 2 + (size_t)4 * MC_ROWS * D * 4 <= WS_END, "ffn map");
constexpr size_t MI_BT = WS_MISC;
constexpr size_t MI_AT = MI_BT + (size_t)8 * MA_ROWS * 4;
constexpr size_t MI_CHS = MI_AT + (size_t)8 * MA_ROWS * 4;
constexpr size_t MI_MCH = MI_CHS + 16 * 66 * 2 * 4;
constexpr size_t MI_DN = MI_MCH + 16 * 66 * 4 + 256;
static_assert(MI_DN + (size_t)NITEM_ML * 128 * 4 <= WS_SS && WS_SS + (size_t)ML_ROWS * 16 * 4 <= WS_WREC && WS_SSC + 512 * 64 * 4 <= WS_MISC && WS_BIAS + 9 * 4096 * 4 <= WS_SSC, "misc map");
constexpr int LDSX_RSC = 153856;

constexpr int CW_TMO = 0, CW_CODE = 1;
constexpr int CW_BAR = 4096;
constexpr int CW_DBG = 65536;

constexpr int RING_OFF = 0, RING_BYTES = 131072;
constexpr int LDSCTL_OFF = RING_BYTES, MISC_OFF = LDSCTL_OFF + 320;
constexpr int LDS_BYTES = 163840;
constexpr int LDSX_OFF = 132096;
struct Frame {
    LAS unsigned char* lds;
    volatile LAS unsigned* MISC;
    gu32* ctl;
    int tid, lane, wave;
    int vcu, G;
    unsigned char* ws; float* out;
};
__device__ __forceinline__ float bf2f(bf16 b) { return __uint_as_float((unsigned)b << 16); }
__device__ __forceinline__ float wave_sum(float v);
__device__ __forceinline__ float wave_max(float v) {
#pragma unroll
    for (int o = 1; o < 64; o <<= 1) v = fmaxf(v, __shfl_xor(v, o));
    return v;
}
template <int CTRL> __device__ __forceinline__ float dpp_mov(float v) { return __builtin_bit_cast(float, __builtin_amdgcn_update_dpp(0, __builtin_bit_cast(int, v), CTRL, 0xF, 0xF, true)); }
__device__ __forceinline__ float sum8(float v) { v += dpp_mov<0xB1>(v); v += dpp_mov<0x4E>(v); v += dpp_mov<0x141>(v); return v; }
__device__ __forceinline__ float sum16(float v) { v = sum8(v); v += dpp_mov<0x140>(v); return v; }
__device__ __forceinline__ float wave_sum(float v) { v = sum16(v); v += __shfl_xor(v, 16); v += __shfl_xor(v, 32); return v; }
__device__ __forceinline__ float sigmoidf_(float x) { return __builtin_amdgcn_rcpf(1.0f + __expf(-x)); }
typedef float f32x2v __attribute__((ext_vector_type(2)));
typedef unsigned u32x2v __attribute__((ext_vector_type(2)));
#define MFMA16(a, b, c) __builtin_amdgcn_mfma_f32_16x16x32_bf16(a, b, c, 0, 0, 0)
template <int P = 72> __device__ __forceinline__ bf16x8 ldsfrag(const LAS bf16* t, int row, int col) { return *(const LAS bf16x8*)(t + row * P + col); }
typedef short v4i16_t __attribute__((ext_vector_type(4)));
template <int P = 72> __device__ __forceinline__ bf16x8 trfrag(const LAS bf16* t, int c0, int k0, int l15, int l4) {
    const LAS bf16* p = t + (k0 + 8 * l4 + (l15 >> 2)) * P + c0 + 4 * (l15 & 3);
    const v4i16_t lo = __builtin_amdgcn_ds_read_tr16_b64_v4i16((LAS v4i16_t*)p), hi = __builtin_amdgcn_ds_read_tr16_b64_v4i16((LAS v4i16_t*)(p + 4 * P));
    return (bf16x8){lo[0], lo[1], lo[2], lo[3], hi[0], hi[1], hi[2], hi[3]};
}
__device__ __forceinline__ bf16x8 gfrag(const bf16* p) { return __builtin_bit_cast(bf16x8, *(const GAS v4u*)p); }
__device__ __forceinline__ u32x2v pk4(f32x4 v) { u32x2v o; o.x = pk2(v[0], v[1]); o.y = pk2(v[2], v[3]); return o; }

enum { I_X = 0, I_C, I_CTX, I_CCTX, I_NORM_MIX, I_NORM_FFN, I_MOD_W, I_MOD_B, I_OUT_W, I_FFN_W1, I_FFN_W2, I_REC_IN_W, I_ML_GATE_B, I_ML_NORM_G, I_RW_CONV,
       I_RW_W0, I_RW_W2, I_RW_A0, I_RW_A2, I_RW_G2, I_RW_KK, I_RW_KA, I_RW_RK, I_RW_NORM_G, I_ATT_IN_W, I_WIN_Q_NORM, I_WIN_K_NORM, I_WIN_SINK, I_GLB_Q_NORM, I_GLB_K_NORM, N_IN };
struct Args { const float* in[N_IN]; float* out; unsigned char* ws; int ph_lo, ph_hi, li, pad; };

template <int MAP> __device__ __forceinline__ int src_col(int n) {
    if (MAP == 0) return n;
    if (n < 2048) return n;
    if (n < 3968) return n + 16;
    if (n < 3984) return n - 1920;
    return -1;
}
template <int MAP> __device__ __forceinline__ void p0_transpose_item(const float* W, int K, int srcN, int dstN, bf16* WT, LAS float* scr, int item, int lane) {
    const int nblk = dstN / 32, kb = item / nblk, nb = item % nblk, k0 = 64 * kb, n0 = 32 * nb;
    const int sc = src_col<MAP>(n0 + (lane & 31));
    float v[32];
#pragma unroll
    for (int i = 0; i < 32; ++i) { const int kk = 2 * i + (lane >> 5); v[i] = (sc >= 0) ? W[(size_t)(k0 + kk) * srcN + sc] : 0.f; }
#pragma unroll
    for (int i = 0; i < 32; ++i) { const int kk = 2 * i + (lane >> 5); scr[kk * 33 + (lane & 31)] = v[i]; }
    LDS_WAIT(); asm volatile("" ::: "memory");
    const int c = lane & 7;
#pragma unroll
    for (int j = 0; j < 4; ++j) { const int n = (lane >> 3) + 8 * j; const LAS float* s = scr + (8 * c) * 33 + n;
        v4u o; o.x = pk2(s[0 * 33], s[1 * 33]); o.y = pk2(s[2 * 33], s[3 * 33]); o.z = pk2(s[4 * 33], s[5 * 33]); o.w = pk2(s[6 * 33], s[7 * 33]);
        *(GAS v4u*)(WT + (size_t)(n0 + n) * K + k0 + 8 * c) = o; }
    LDS_WAIT(); asm volatile("" ::: "memory");
}
template <int PART> struct P0W {
    static constexpr int I_A = PART == 0 ? (D / 64) * (REC_N / 32) : (PART == 1 ? (D / 64) * (ATT_N / 32) : 0);
    static constexpr int I_OUT = (PART == 1 || PART == 4) ? (D / 64) * (D / 32) : 0, I_1 = (PART == 1 || PART == 3) ? (D / 64) * (FF / 32) : 0, I_2 = (PART == 2 || PART == 4) ? (FF / 64) * (D / 32) : 0, I_G2 = PART == 0 ? (128 / 64) * (512 / 32) : 0;
    static constexpr int NITEMS = I_A + I_OUT + I_1 + I_2 + I_G2;
};
template <int PART> __device__ __forceinline__ void p0_weight_item(Frame& F, const Args& A, int r) {
    typedef P0W<PART> P;
    LAS float* scr = (LAS float*)(F.lds + RING_OFF + F.wave * 16384);
    constexpr int l = (PART == 0 || PART >= 3) ? 0 : 1;
    unsigned char* ws = F.ws;
    if (r < P::I_A) { if (PART == 0) p0_transpose_item<1>(A.in[I_REC_IN_W], D, 3984, REC_N, (bf16*)(ws + WS_WREC), scr, r, F.lane); else p0_transpose_item<0>(A.in[I_ATT_IN_W], D, ATT_N, ATT_N, (bf16*)(ws + WS_WATT), scr, r, F.lane); return; } r -= P::I_A;
    if (r < P::I_OUT) { p0_transpose_item<0>(A.in[I_OUT_W] + (size_t)l * D * D, D, D, D, (bf16*)(ws + WS_WOUT) + (size_t)l * D * D, scr, r, F.lane); return; } r -= P::I_OUT;
    if (r < P::I_1) { p0_transpose_item<0>(A.in[I_FFN_W1] + (size_t)l * D * FF, D, FF, FF, (bf16*)(ws + WS_W1) + (size_t)l * D * FF, scr, r, F.lane); return; } r -= P::I_1;
    if (r < P::I_2) { p0_transpose_item<0>(A.in[I_FFN_W2] + (size_t)l * D * FF, FF, D, D, (bf16*)(ws + WS_W2) + (size_t)l * D * FF, scr, r, F.lane); return; } r -= P::I_2;
    if (PART == 0) p0_transpose_item<0>(A.in[I_RW_G2], 128, 512, 512, (bf16*)(ws + WS_WG2), scr, r, F.lane);
}
template <int PART> __device__ __forceinline__ void p0_weights_tail(Frame& F, const Args& A, int ntile, int bid) {
    const int nx = ntile % F.G; __syncthreads();
    int gw, NGW; if (nx == 0) { gw = bid * NWAVES + F.wave; NGW = F.G * NWAVES; } else if (bid >= nx) { gw = (bid - nx) * NWAVES + F.wave; NGW = (F.G - nx) * NWAVES; } else return;
    for (int it = gw; it < P0W<PART>::NITEMS; it += NGW) p0_weight_item<PART>(F, A, it);
}
__device__ __forceinline__ void p0_prologue(Frame& F, const Args& A) {
    const int gw = F.vcu * NWAVES + F.wave, NGW = F.G * NWAVES;
    unsigned char* ws = F.ws;
    constexpr int NGEMV = 2 * 48 * 16;
    float* MODP = (float*)(ws + WS_MODP);
    for (int it = gw; it < NGEMV + P0W<0>::NITEMS; it += NGW) {
        if (it >= NGEMV) { p0_weight_item<0>(F, A, it - NGEMV); continue; }
        const int l = it / (48 * 16), cc = (it / 16) % 48, kc = it % 16, hl = F.lane >> 5, l31 = F.lane & 31;
        float sv[3];
#pragma unroll
        for (int v = 0; v < 3; ++v) { const float cvv = (v < 2) ? A.in[I_C][v * D + kc * 64 + F.lane] : A.in[I_CCTX][kc * 64 + F.lane]; sv[v] = cvv * sigmoidf_(cvv); }
        const float* Wp = A.in[I_MOD_W] + ((size_t)l * D + kc * 64 + hl) * 6144 + cc * 128 + 4 * l31;
        f32x4 a0 = {0, 0, 0, 0}, a1 = a0, a2 = a0;
#pragma unroll 16
        for (int i = 0; i < 32; ++i) { const f32x4 w = *(const f32x4*)(Wp + (size_t)(2 * i) * 6144); const int k = 2 * i + hl; a0 += w * __shfl(sv[0], k); a1 += w * __shfl(sv[1], k); a2 += w * __shfl(sv[2], k); }
#pragma unroll
        for (int e = 0; e < 4; ++e) { a0[e] += __shfl_xor(a0[e], 32); a1[e] += __shfl_xor(a1[e], 32); a2[e] += __shfl_xor(a2[e], 32); }
        if (hl == 0) { float* o = MODP + ((size_t)(l * 16 + kc) * 3) * 6144 + cc * 128 + 4 * l31;
            *(f32x4*)(o) = a0; *(f32x4*)(o + 6144) = a1; *(f32x4*)(o + 2 * 6144) = a2; }
    }
    { bf16* W2T = (bf16*)(ws + WS_W2T);
      for (int e = F.vcu * NTHREADS + F.tid; e < 2 * 2 * 8 * 64 * 64; e += F.G * NTHREADS) {
          const int i = e & 63, ch = (e >> 6) & 63, h = (e >> 12) & 7, d = (e >> 15) & 1, which = e >> 16;
          const float* src = which == 0 ? A.in[I_RW_W2] : A.in[I_RW_A2];
          W2T[e] = (bf16)f2bf(src[(size_t)(d * 64 + i) * 512 + h * 64 + ch]); } }
    { float* ROPE = (float*)(ws + WS_ROPE);
      for (int e = F.vcu * NTHREADS + F.tid; e < 128 * 16; e += F.G * NTHREADS) { const float ang = (float)(e >> 4) * exp2f(-(float)(e & 15) * (13.287712379549449f / 16.0f)); float sn, cs; sincosf(ang, &sn, &cs); ROPE[2 * e] = cs; ROPE[2 * e + 1] = sn; } }
}
__device__ __forceinline__ void p1_mod_finalize(Frame& F, const Args& A) {
    const float* MODP = (const float*)(F.ws + WS_MODP); float* MOD = (float*)(F.ws + WS_MOD);
    for (int i = F.vcu * NTHREADS + F.tid; i < 2 * 3 * 6144; i += F.G * NTHREADS) {
        const int l = i / (3 * 6144), v = (i / 6144) % 3, n = i % 6144;
        float s = A.in[I_MOD_B][l * 6144 + n];
#pragma unroll
        for (int kc = 0; kc < 16; ++kc) s += MODP[((size_t)(l * 16 + kc) * 3 + v) * 6144 + n];
        MOD[i] = s;
    }
}
__device__ __forceinline__ void norm_rows(Frame& F, const Args& A, const float* lat, const float* ctx, int nrows, const float* g, const float* mod, int ch_shift, int ch_scale, bf16* XN, const float* cpart = nullptr, const float* cgate = nullptr) {
    const int gw = F.vcu * NWAVES + F.wave, NGW = F.G * NWAVES;
    constexpr int NR = 2;
    auto load_rows = [&](int r0, f32x4 (&vv)[NR][4]) {
#pragma unroll
        for (int q = 0; q < NR; ++q) { const int row = r0 + q; const float* src = (row < ML_ROWS) ? lat + (size_t)row * D : ctx + (size_t)(row - ML_ROWS) * D;
#pragma unroll
            for (int j = 0; j < 4; ++j) { vv[q][j] = *(const f32x4*)(src + 256 * j + 4 * F.lane);
                if (cpart && row >= ML_ROWS) { const float* pp = cpart + (size_t)(row - ML_ROWS) * D + 256 * j + 4 * F.lane; const f32x4 ps = (*(const f32x4*)pp + *(const f32x4*)(pp + (size_t)MC_ROWS * D)) + (*(const f32x4*)(pp + (size_t)2 * MC_ROWS * D) + *(const f32x4*)(pp + (size_t)3 * MC_ROWS * D)); vv[q][j] += ps * *(const f32x4*)(cgate + 256 * j + 4 * F.lane); } } }
    };
    f32x4 v[NR][4], vn[NR][4];
    if (NR * gw < nrows) load_rows(NR * gw, v);
    for (int row0 = NR * gw; row0 < nrows; row0 += NR * NGW) {
        const int rown = row0 + NR * NGW; const bool more = rown < nrows;
        if (more) load_rows(rown, vn);
        float ss[NR];
#pragma unroll
        for (int q = 0; q < NR; ++q) { ss[q] = 0.f;
#pragma unroll
            for (int j = 0; j < 4; ++j) ss[q] += (v[q][j].x * v[q][j].x + v[q][j].y * v[q][j].y) + (v[q][j].z * v[q][j].z + v[q][j].w * v[q][j].w); }
        f32x4 gsc[NR][4], sh[NR][4];
#pragma unroll
        for (int q = 0; q < NR; ++q) { const int row = row0 + q; const float* mv = mod + ((row < ML_ROWS) ? (row >> 13) : 2) * 6144;
#pragma unroll
            for (int j = 0; j < 4; ++j) { const int c = 256 * j + 4 * F.lane; gsc[q][j] = *(const f32x4*)(g + c) * (*(const f32x4*)(mv + ch_scale * 1024 + c) + 1.0f); sh[q][j] = *(const f32x4*)(mv + ch_shift * 1024 + c); } }
#pragma unroll
        for (int q = 0; q < NR; ++q) { const int row = row0 + q;
            const float rs = __builtin_amdgcn_rsqf(wave_sum(ss[q]) * (1.f / D) + NORM_EPS);
            unsigned long long* o8 = (unsigned long long*)(XN + (size_t)row * D);
#pragma unroll
            for (int j = 0; j < 4; ++j) {
                const f32x4 y = (v[q][j] * rs) * gsc[q][j] + sh[q][j];
                o8[64 * j + F.lane] = (unsigned long long)pk2(y.x, y.y) | ((unsigned long long)pk2(y.z, y.w) << 32);
            } }
        if (more) {
#pragma unroll
            for (int q = 0; q < NR; ++q)
#pragma unroll
                for (int j = 0; j < 4; ++j) v[q][j] = vn[q][j];
        }
    }
}

__device__ __forceinline__ int ml_chunk_base(int d, int b, int c) {
    if (c < 2) return ML_ROWS + b * CTXL + (d == 0 ? 128 * c : 128 * (1 - c));
    const int cc = c - 2; return b * T + (d == 0 ? 128 * cc : T - 128 * (cc + 1));
}
__device__ __forceinline__ void ml_pass_a(Frame& F, const Args& A) {
    constexpr int P = 136;
    unsigned char* ws = F.ws;
    const bf16* KM = (const bf16*)(ws + R_KM); const bf16* VM = (const bf16*)(ws + R_VM); const float* GATES = (const float*)(ws + R_GATES);
    float* BT = (float*)(ws + MI_BT); float* AT = (float*)(ws + MI_AT); float* CHS = (float*)(ws + MI_CHS); float* DN = (float*)(ws + MI_DN);
    bf16* CST = (bf16*)((unsigned char*)F.out + DO_CST);
    LAS bf16* Kt = (LAS bf16*)(F.lds); LAS bf16* Vt = Kt + 128 * P; LAS float* wl = (LAS float*)(F.lds + 2 * 128 * P * 2);
    const int w = F.wave;
    v4u kreg[4], vreg[4];
#define MLA_LOAD(it_) do { const int ch_ = (it_) / NCHUNK, c_ = (it_) % NCHUNK, d_ = ch_ >> 3, b_ = (ch_ >> 2) & 1, h_ = ch_ & 3; const int base_ = ml_chunk_base(d_, b_, c_); \
        _Pragma("unroll") for (int j = 0; j < 4; ++j) { const int idx = F.tid + 512 * j, row = idx >> 4, chk = idx & 15; \
            kreg[j] = *(const GAS v4u*)(KM + (size_t)(base_ + row) * 512 + h_ * 128 + 8 * chk); vreg[j] = *(const GAS v4u*)(VM + (size_t)(base_ + row) * 512 + h_ * 128 + 8 * chk); } } while (0)
    if (F.vcu < NITEM_ML) MLA_LOAD(F.vcu);
    for (int item = F.vcu; item < NITEM_ML; item += F.G) {
        const int chain = item / NCHUNK, c = item % NCHUNK, d = chain >> 3, b = (chain >> 2) & 1, h = chain & 3;
        const int base = ml_chunk_base(d, b, c);
        int lz = 0; asm volatile("" : "+s"(lz));
        const int tid = F.tid + lz, lane = tid & 63, l15 = lane & 15, l4 = lane >> 4;
        __syncthreads();
        if (w == 0) {
            const float bi = A.in[I_ML_GATE_B][(2 * d) * 4 + h], bfg = A.in[I_ML_GATE_B][(2 * d + 1) * 4 + h];
            float iv[2], lf[2];
#pragma unroll
            for (int e = 0; e < 2; ++e) { const int s = 2 * lane + e, o = d == 0 ? s : 127 - s; const float* gp = GATES + (size_t)(base + o) * 16 + 8 * d + h;
                iv[e] = gp[0] + bi; const float f = gp[4] + bfg; lf[e] = (f >= 0.f) ? -log1pf(__expf(-f)) : f - log1pf(__expf(f)); }
            const float pair = lf[0] + lf[1]; float incl = pair;
#pragma unroll
            for (int o = 1; o < 64; o <<= 1) { const float t_ = __shfl_up(incl, o); if (lane >= o) incl += t_; }
            const float excl = incl - pair; float bb[2] = {excl + lf[0], excl + pair}; float aa[2] = {iv[0] - bb[0], iv[1] - bb[1]};
            const float amax = wave_max(fmaxf(aa[0], aa[1])); const float bend = __shfl(bb[1], 63);
#pragma unroll
            for (int e = 0; e < 2; ++e) { const int s = 2 * lane + e, o = d == 0 ? s : 127 - s; const size_t gi = (size_t)(d * 4 + h) * MA_ROWS + base + o; BT[gi] = bb[e]; AT[gi] = aa[e]; wl[o] = __expf(aa[e] - amax); }
            if (lane == 0) { CHS[(chain * NCHUNK + c) * 2] = bend; CHS[(chain * NCHUNK + c) * 2 + 1] = amax; }
        }
#pragma unroll
        for (int j = 0; j < 4; ++j) { const int idx = tid + 512 * j, row = idx >> 4, ch = idx & 15; *(LAS v4u*)(Kt + row * P + 8 * ch) = kreg[j]; }
        __syncthreads();
#pragma unroll
        for (int j = 0; j < 4; ++j) { const int idx = tid + 512 * j, row = idx >> 4, ch = idx & 15; const float ws_ = wl[row]; const unsigned* pv_ = (const unsigned*)&vreg[j]; v4u o; unsigned* po = (unsigned*)&o;
#pragma unroll
            for (int q = 0; q < 4; ++q) po[q] = pk2(__uint_as_float(pv_[q] << 16) * ws_, __uint_as_float(pv_[q] & 0xffff0000u) * ws_);
            *(LAS v4u*)(Vt + row * P + 8 * ch) = o; }
        { const int dk = tid >> 2, q = tid & 3; float s = 0.f;
#pragma unroll 8
            for (int j = 0; j < 32; ++j) { const int so = 32 * q + j; s += bf2f(Kt[so * P + dk]) * wl[so]; }
            s += dpp_mov<0xB1>(s); s += dpp_mov<0x4E>(s);
            if (q == 0) DN[(size_t)item * 128 + dk] = s; }
        __syncthreads();
        { const int itn = item + F.G; if (itn < NITEM_ML) MLA_LOAD(itn); }
        f32x4 acc[8];
#pragma unroll
        for (int n8 = 0; n8 < 8; ++n8) acc[n8] = (f32x4){0.f, 0.f, 0.f, 0.f};
#pragma unroll
        for (int kk = 0; kk < 4; ++kk) {
            const bf16x8 vf = trfrag<P>(Vt, 16 * w, 32 * kk, l15, l4);
#pragma unroll
            for (int n8 = 0; n8 < 8; ++n8) acc[n8] = MFMA16(trfrag<P>(Kt, 16 * n8, 32 * kk, l15, l4), vf, acc[n8]);
        }
        bf16* cst = CST + (size_t)item * 16384 + (size_t)(16 * w + l15) * 128 + 4 * l4;
#pragma unroll
        for (int n8 = 0; n8 < 8; ++n8) *(u32x2v*)(cst + 16 * n8) = pk4(acc[n8]);
    }
#undef MLA_LOAD
    __syncthreads();
}
__device__ __forceinline__ void ml_pass_b(Frame& F, const Args& A) {
    unsigned char* ws = F.ws;
    const float* CHS = (const float*)(ws + MI_CHS); float* MCH = (float*)(ws + MI_MCH); float* DN = (float*)(ws + MI_DN);
    unsigned* CST = (unsigned*)((unsigned char*)F.out + DO_CST);
    constexpr int PER_CHAIN = 8192 + 128, NWORK = NCHAIN_ML * PER_CHAIN, NB = 11;
    static_assert(NCHUNK % NB == 0, "chunk batches");
    for (int wi = F.vcu * NTHREADS + F.tid; wi < NWORK; wi += F.G * NTHREADS) {
        const int chain = wi / PER_CHAIN, e = wi % PER_CHAIN;
        float m = 0.f, c0 = 0.f, c1 = 0.f;
        const float* chs = CHS + (size_t)chain * NCHUNK * 2;
        if (e < 8192) {
            unsigned* p = CST + (size_t)chain * NCHUNK * 8192 + e;
            for (int cb = 0; cb < NCHUNK; cb += NB) {
                unsigned dl[NB]; float be[NB], am[NB];
#pragma unroll
                for (int k = 0; k < NB; ++k) { dl[k] = p[(size_t)(cb + k) * 8192]; be[k] = chs[(cb + k) * 2]; am[k] = chs[(cb + k) * 2 + 1]; }
#pragma unroll
                for (int k = 0; k < NB; ++k) {
                    p[(size_t)(cb + k) * 8192] = pk2(c0, c1);
                    if (e == 0) MCH[chain * NCHUNK + cb + k] = m;
                    const float g = fmaxf(m, am[k]), so = __expf(m - g), sn = __expf(am[k] - g);
                    c0 = so * c0 + sn * __uint_as_float(dl[k] << 16); c1 = so * c1 + sn * __uint_as_float(dl[k] & 0xffff0000u);
                    m = be[k] + g;
                }
            }
        } else {
            float* p = DN + (size_t)chain * NCHUNK * 128 + (e - 8192);
            for (int cb = 0; cb < NCHUNK; cb += NB) {
                float dl[NB], be[NB], am[NB];
#pragma unroll
                for (int k = 0; k < NB; ++k) { dl[k] = p[(size_t)(cb + k) * 128]; be[k] = chs[(cb + k) * 2]; am[k] = chs[(cb + k) * 2 + 1]; }
#pragma unroll
                for (int k = 0; k < NB; ++k) {
                    p[(size_t)(cb + k) * 128] = c0;
                    const float g = fmaxf(m, am[k]), so = __expf(m - g), sn = __expf(am[k] - g);
                    c0 = so * c0 + sn * dl[k]; m = be[k] + g;
                }
            }
        }
    }
}
__device__ __forceinline__ void ml_pass_c(Frame& F, const Args& A) {
    constexpr int P = 136;
    unsigned char* ws = F.ws;
    const bf16* QM = (const bf16*)(ws + R_QM); const bf16* KM = (const bf16*)(ws + R_KM); const bf16* VM = (const bf16*)(ws + R_VM);
    const float* BT = (const float*)(ws + MI_BT); const float* AT = (const float*)(ws + MI_AT); const float* MCH = (const float*)(ws + MI_MCH); const float* NST = (const float*)(ws + MI_DN);
    const bf16* CST = (const bf16*)((unsigned char*)F.out + DO_CST);
    bf16* HML = (bf16*)(ws + R_HML);
    LAS bf16* Kt = (LAS bf16*)(F.lds); LAS bf16* Vt = Kt + 128 * P; LAS bf16* Ct = Vt + 128 * P;
    LAS bf16* Sl = F.wave < 6 ? (LAS bf16*)(F.lds + 3 * 128 * P * 2 + F.wave * (16 * P * 2)) : (LAS bf16*)(F.lds + LDSX_OFF + (F.wave - 6) * (16 * P * 2));
    LAS float* aw = (LAS float*)(F.lds + LDSX_OFF + 2 * (16 * P * 2)); LAS float* gq = aw + 128; LAS float* bq = gq + 128;
    static_assert(3 * 128 * P * 2 + 6 * 16 * P * 2 <= RING_BYTES && LDSX_OFF + 2 * 16 * P * 2 + 3 * 128 * 4 <= LDS_BYTES, "mLSTM pass C LDS map");
    const int w = F.wave;
    v4u kreg[4], vreg[4], creg[4];
#define MLC_LOAD(it_) do { const int ch_ = (it_) / NCHUNK, c_ = (it_) % NCHUNK, d_ = ch_ >> 3, b_ = (ch_ >> 2) & 1, h_ = ch_ & 3; const int base_ = ml_chunk_base(d_, b_, c_); \
        _Pragma("unroll") for (int j = 0; j < 4; ++j) { const int idx = F.tid + 512 * j, row = idx >> 4, chk = idx & 15; \
            kreg[j] = *(const GAS v4u*)(KM + (size_t)(base_ + row) * 512 + h_ * 128 + 8 * chk); vreg[j] = *(const GAS v4u*)(VM + (size_t)(base_ + row) * 512 + h_ * 128 + 8 * chk); \
            creg[j] = *(const GAS v4u*)(CST + (size_t)(it_) * 16384 + (size_t)row * 128 + 8 * chk); } } while (0)
    if (F.vcu < NITEM_ML) MLC_LOAD(F.vcu);
    for (int item = F.vcu; item < NITEM_ML; item += F.G) {
        const int chain = item / NCHUNK, c = item % NCHUNK, d = chain >> 3, b = (chain >> 2) & 1, h = chain & 3;
        const int base = ml_chunk_base(d, b, c);
        int lz = 0; asm volatile("" : "+s"(lz));
        const int tid = F.tid + lz, lane = tid & 63, l15 = lane & 15, l4 = lane >> 4;
        const float m = MCH[chain * NCHUNK + c];
        const int to = 16 * w + l15;
        bf16x8 qf[4];
        { const bf16* qp = QM + (size_t)(base + to) * 512 + h * 128 + 8 * l4;
#pragma unroll
            for (int kk = 0; kk < 4; ++kk) qf[kk] = gfrag(qp + 32 * kk); }
        __syncthreads();
        if (w == 0) {
            float aa[2], bb[2];
#pragma unroll
            for (int e = 0; e < 2; ++e) { const int s = 2 * lane + e, o = d == 0 ? s : 127 - s; const size_t gi = (size_t)(d * 4 + h) * MA_ROWS + base + o; aa[e] = AT[gi]; bb[e] = BT[gi]; }
            const float pm = fmaxf(aa[0], aa[1]); float incl = pm;
#pragma unroll
            for (int o = 1; o < 64; o <<= 1) { const float t_ = __shfl_up(incl, o); if (lane >= o) incl = fmaxf(incl, t_); }
            float excl = __shfl_up(incl, 1); if (lane == 0) excl = -INFINITY;
            const float g0 = fmaxf(m, fmaxf(excl, aa[0])), g1 = fmaxf(m, incl);
#pragma unroll
            for (int e = 0; e < 2; ++e) { const int s = 2 * lane + e, o = d == 0 ? s : 127 - s; aw[o] = aa[e]; gq[o] = e == 0 ? g0 : g1; bq[o] = bb[e]; }
        }
#pragma unroll
        for (int j = 0; j < 4; ++j) { const int idx = tid + 512 * j, row = idx >> 4, chk = idx & 15; *(LAS v4u*)(Kt + row * P + 8 * chk) = kreg[j]; *(LAS v4u*)(Vt + row * P + 8 * chk) = vreg[j]; *(LAS v4u*)(Ct + row * P + 8 * chk) = creg[j]; }
        __syncthreads();
        { const int itn = item + F.G; if (itn < NITEM_ML) MLC_LOAD(itn); }
        const float gt = gq[to], bt = bq[to];
        float den = 0.f;
#pragma unroll
        for (int m8 = 0; m8 < 8; ++m8) {
            f32x4 st = {0.f, 0.f, 0.f, 0.f};
#pragma unroll
            for (int kk = 0; kk < 4; ++kk) st = MFMA16(ldsfrag<P>(Kt, 16 * m8 + l15, 32 * kk + 8 * l4), qf[kk], st);
            f32x4 vv;
#pragma unroll
            for (int r = 0; r < 4; ++r) { const int so = 16 * m8 + 4 * l4 + r; const bool valid = d == 0 ? (so <= to) : (so >= to); const float wgt = valid ? __expf(aw[so] - gt) : 0.f; vv[r] = st[r] * wgt; den += vv[r]; }
            *(LAS u32x2v*)(Sl + l15 * P + 16 * m8 + 4 * l4) = pk4(vv);
        }
        den += __shfl_xor(den, 16); den += __shfl_xor(den, 32);
        float qn = 0.f;
        { const float* np = NST + (size_t)item * 128 + 8 * l4;
#pragma unroll
            for (int kk = 0; kk < 4; ++kk) { const unsigned* pq = (const unsigned*)&qf[kk];
#pragma unroll
                for (int e = 0; e < 4; ++e) qn += __uint_as_float(pq[e] << 16) * np[32 * kk + 2 * e] + __uint_as_float(pq[e] & 0xffff0000u) * np[32 * kk + 2 * e + 1]; }
            qn += __shfl_xor(qn, 16); qn += __shfl_xor(qn, 32); }
        asm volatile("s_waitcnt lgkmcnt(0)" ::: "memory"); __builtin_amdgcn_wave_barrier();
        bf16x8 sf[4];
#pragma unroll
        for (int kk = 0; kk < 4; ++kk) sf[kk] = ldsfrag<P>(Sl, l15, 32 * kk + 8 * l4);
        const float wprev = __expf(m - gt);
        const float dent = den + wprev * qn;
        const float rdn = __builtin_amdgcn_rcpf(fmaxf(fabsf(dent), __expf(-(bt + gt))));
        bf16* hp = HML + ((size_t)d * MA_ROWS + base + to) * 512 + h * 128 + 4 * l4;
#pragma unroll
        for (int v8 = 0; v8 < 8; ++v8) {
            f32x4 an = {0.f, 0.f, 0.f, 0.f}, ai = {0.f, 0.f, 0.f, 0.f};
#pragma unroll
            for (int kk = 0; kk < 4; ++kk) {
                an = MFMA16(trfrag<P>(Vt, 16 * v8, 32 * kk, l15, l4), sf[kk], an);
                ai = MFMA16(ldsfrag<P>(Ct, 16 * v8 + l15, 32 * kk + 8 * l4), qf[kk], ai);
            }
            f32x4 o; o[0] = (an[0] + wprev * ai[0]) * rdn; o[1] = (an[1] + wprev * ai[1]) * rdn; o[2] = (an[2] + wprev * ai[2]) * rdn; o[3] = (an[3] + wprev * ai[3]) * rdn;
            *(u32x2v*)(hp + 16 * v8) = pk4(o);
        }
    }
#undef MLC_LOAD
    __syncthreads();
}
template <class EPI> __device__ __forceinline__ void ctx_gemm(Frame& F, const bf16* Am, int lda, const bf16* Bt, int ldb, int M, int N, int K, const EPI& epi) {
    LAS f32x4* red = (LAS f32x4*)(F.lds);
    const int lane = F.lane, w = F.wave, l15 = lane & 15, l4 = lane >> 4;
    const int ntn = N / 64, ntiles = (M / 32) * ntn, ks = K / 8;
    for (int tile = F.vcu; tile < ntiles; tile += F.G) {
        const int tm = tile / ntn, tn = tile % ntn;
        f32x4 acc[2][4];
#pragma unroll
        for (int mi = 0; mi < 2; ++mi)
#pragma unroll
            for (int ni = 0; ni < 4; ++ni) acc[mi][ni] = (f32x4){0.f, 0.f, 0.f, 0.f};
        const bf16* ap = Am + (size_t)(32 * tm + l15) * lda + w * ks + 8 * l4;
        const bf16* bp = Bt + (size_t)(64 * tn + l15) * ldb + w * ks + 8 * l4;
#pragma unroll 2
        for (int k0 = 0; k0 < ks; k0 += 32) {
            bf16x8 a[2], b[4];
#pragma unroll
            for (int mi = 0; mi < 2; ++mi) a[mi] = __builtin_bit_cast(bf16x8, *(const GAS v4u*)(ap + (size_t)(16 * mi) * lda + k0));
#pragma unroll
            for (int ni = 0; ni < 4; ++ni) b[ni] = __builtin_bit_cast(bf16x8, *(const GAS v4u*)(bp + (size_t)(16 * ni) * ldb + k0));
#pragma unroll
            for (int mi = 0; mi < 2; ++mi)
#pragma unroll
                for (int ni = 0; ni < 4; ++ni) acc[mi][ni] = MFMA16(a[mi], b[ni], acc[mi][ni]);
        }
        __syncthreads();
#pragma unroll
        for (int mi = 0; mi < 2; ++mi)
#pragma unroll
            for (int ni = 0; ni < 4; ++ni) red[(w * 8 + mi * 4 + ni) * 64 + lane] = acc[mi][ni];
        __syncthreads();
        {
            f32x4 s = red[(0 * 8 + w) * 64 + lane];
#pragma unroll
            for (int ww = 1; ww < 8; ++ww) s += red[(ww * 8 + w) * 64 + lane];
            const int row0 = 32 * tm + 16 * (w >> 2) + 4 * l4, col = 64 * tn + 16 * (w & 3) + l15;
#pragma unroll
            for (int r = 0; r < 4; ++r) epi(row0 + r, col, s[r]);
        }
    }
    __syncthreads();
}
template <int KSPLIT = 1, class EPI> __device__ __forceinline__ void ctx_gemm2(Frame& F, const bf16* Am, int lda, const bf16* Bt, int ldb, int M, int N, int K, const EPI& epi) {
    constexpr int TP = 72, ABYTES = 64 * TP * 2, BBYTES = 128 * TP * 2, STAGE = ABYTES + BBYTES;
    const int tid = F.tid, lane = F.lane, w = F.wave, l15 = lane & 15, l4 = lane >> 4, wm = w >> 2, wn = w & 3;
    const int ntn = N / 128, ntiles = (M / 64) * ntn * KSPLIT, nk = K / 64 / KSPLIT;
    const int arow = tid >> 3, apc = tid & 7;
    for (int tile = F.vcu; tile < ntiles; tile += F.G) {
        const int ksl = tile % KSPLIT, tl = tile / KSPLIT, tm = tl / ntn, tn = tl % ntn;
        const bf16* ap = Am + (size_t)(64 * tm + arow) * lda + 8 * apc + (size_t)ksl * nk * 64;
        const bf16* bp0 = Bt + (size_t)(128 * tn + arow) * ldb + 8 * apc + (size_t)ksl * nk * 64; const bf16* bp1 = bp0 + (size_t)64 * ldb;
        f32x4 acc[2][2];
#pragma unroll
        for (int mi = 0; mi < 2; ++mi)
#pragma unroll
            for (int ni = 0; ni < 2; ++ni) acc[mi][ni] = (f32x4){0.f, 0.f, 0.f, 0.f};
        v4u xa = *(const GAS v4u*)ap, xb0 = *(const GAS v4u*)bp0, xb1 = *(const GAS v4u*)bp1;
        v4u ya = *(const GAS v4u*)(ap + 64), yb0 = *(const GAS v4u*)(bp0 + 64), yb1 = *(const GAS v4u*)(bp1 + 64);
        __syncthreads();
#define CG2_STEP(RA, RB0, RB1, ks_) do { LAS bf16* As = (LAS bf16*)(F.lds + ((ks_) & 1) * STAGE); LAS bf16* Bs = (LAS bf16*)(F.lds + ((ks_) & 1) * STAGE + ABYTES); \
            *(LAS v4u*)(As + arow * TP + 8 * apc) = RA; *(LAS v4u*)(Bs + arow * TP + 8 * apc) = RB0; *(LAS v4u*)(Bs + (arow + 64) * TP + 8 * apc) = RB1; \
            if ((ks_) + 2 < nk) { RA = *(const GAS v4u*)(ap + 64 * ((ks_) + 2)); RB0 = *(const GAS v4u*)(bp0 + 64 * ((ks_) + 2)); RB1 = *(const GAS v4u*)(bp1 + 64 * ((ks_) + 2)); } \
            asm volatile("s_waitcnt lgkmcnt(0)\n\ts_barrier" ::: "memory"); \
            _Pragma("unroll") for (int kk = 0; kk < 2; ++kk) { bf16x8 a[2], b[2]; \
                _Pragma("unroll") for (int mi = 0; mi < 2; ++mi) a[mi] = ldsfrag<TP>(As, 32 * wm + 16 * mi + l15, 32 * kk + 8 * l4); \
                _Pragma("unroll") for (int ni = 0; ni < 2; ++ni) b[ni] = ldsfrag<TP>(Bs, 32 * wn + 16 * ni + l15, 32 * kk + 8 * l4); \
                _Pragma("unroll") for (int mi = 0; mi < 2; ++mi) _Pragma("unroll") for (int ni = 0; ni < 2; ++ni) acc[mi][ni] = MFMA16(a[mi], b[ni], acc[mi][ni]); } } while (0)
        for (int ks = 0; ks < nk; ks += 2) { CG2_STEP(xa, xb0, xb1, ks); CG2_STEP(ya, yb0, yb1, ks + 1); }
#undef CG2_STEP
#pragma unroll
        for (int mi = 0; mi < 2; ++mi)
#pragma unroll
            for (int ni = 0; ni < 2; ++ni) { const int row0 = 64 * tm + 32 * wm + 16 * mi + 4 * l4, col = 128 * tn + 32 * wn + 16 * ni + l15;
#pragma unroll
                for (int r = 0; r < 4; ++r) { if constexpr (KSPLIT == 1) epi(row0 + r, col, acc[mi][ni][r]); else epi(row0 + r, col, acc[mi][ni][r], ksl); } }
    }
    __syncthreads();
}
__device__ __forceinline__ void rw_seq_rows(int d, int b, int p, int& R, int& idx, int& len, int& sbase) {
    if (p < CTXL) { idx = d == 0 ? p : CTXL - 1 - p; len = CTXL; sbase = ML_ROWS + b * CTXL; }
    else { const int q = p - CTXL; idx = d == 0 ? q : T - 1 - q; len = T; sbase = b * T; }
    R = sbase + idx;
}
__device__ __forceinline__ void rw_scan(Frame& F, const Args& A) {
    unsigned char* ws = F.ws;
    const bf16* RAWb = (const bf16*)(ws + R_RAW); const bf16* TWAD = (const bf16*)(ws + R_TWAD);
    LAS float* w2h = (LAS float*)(F.lds); LAS float* a2h = w2h + 4096; LAS float* vecs = a2h + 4096;
    LAS float* ybuf = vecs + 32 * 384; LAS float* twl = ybuf + 2048; LAS float* adl = twl + 2048;
    const int tid = F.tid, lane = F.lane, wv = F.wave;
    for (int chain = F.vcu; chain < NCHAIN_RW; chain += F.G) {
        const int d = chain >> 4, b = (chain >> 3) & 1, h = chain & 7;
        bf16* YRW = d == 0 ? (bf16*)(ws + R_YRW0) : (bf16*)((unsigned char*)F.out + DO_YRW1);
        __syncthreads();
        for (int i = tid; i < 4096; i += NTHREADS) { const int ii = i >> 6, ch = i & 63; w2h[i] = A.in[I_RW_W2][((size_t)d * 64 + ii) * 512 + h * 64 + ch]; a2h[i] = A.in[I_RW_A2][((size_t)d * 64 + ii) * 512 + h * 64 + ch]; }
        const int ppos = tid >> 4, chq = tid & 15, ch0 = 4 * chq, hc = h * 64 + ch0;
        float cw[3][3][4], kkw[4], kaw[4], w0v[4], a0v[4];
#pragma unroll
        for (int k = 0; k < 3; ++k)
#pragma unroll
            for (int g = 0; g < 3; ++g)
#pragma unroll
                for (int e = 0; e < 4; ++e) cw[k][g][e] = A.in[I_RW_CONV][k * 1536 + g * 512 + hc + e];
#pragma unroll
        for (int e = 0; e < 4; ++e) { kkw[e] = A.in[I_RW_KK][hc + e]; kaw[e] = A.in[I_RW_KA][hc + e]; w0v[e] = A.in[I_RW_W0][d * 512 + hc + e]; a0v[e] = A.in[I_RW_A0][d * 512 + hc + e]; }
        float S[8];
#pragma unroll
        for (int j = 0; j < 8; ++j) S[j] = 0.f;
        const int row_i = 8 * wv + (lane >> 3), j0 = 8 * (lane & 7);
        for (int blk = 0; blk < KV_LEN / 32; ++blk) {
            int R, idx, len, sbase; rw_seq_rows(d, b, 32 * blk + ppos, R, idx, len, sbase);
            __syncthreads();
            { const u32x2v tw = *(const GAS u32x2v*)(TWAD + (size_t)R * 256 + d * 64 + ch0), ad = *(const GAS u32x2v*)(TWAD + (size_t)R * 256 + 128 + d * 64 + ch0);
              LAS float* t_ = twl + ppos * 64 + ch0; LAS float* a_ = adl + ppos * 64 + ch0;
              t_[0] = __uint_as_float(tw.x << 16); t_[1] = __uint_as_float(tw.x & 0xffff0000u); t_[2] = __uint_as_float(tw.y << 16); t_[3] = __uint_as_float(tw.y & 0xffff0000u);
              a_[0] = __uint_as_float(ad.x << 16); a_[1] = __uint_as_float(ad.x & 0xffff0000u); a_[2] = __uint_as_float(ad.y << 16); a_[3] = __uint_as_float(ad.y & 0xffff0000u); }
            float cv[3][4];
#pragma unroll
            for (int g = 0; g < 3; ++g)
#pragma unroll
                for (int e = 0; e < 4; ++e) cv[g][e] = 0.f;
#pragma unroll
            for (int k = 0; k < 3; ++k) { const int ii = idx + k - 1; if (ii >= 0 && ii < len) {
#pragma unroll
                for (int g = 0; g < 3; ++g) { const u32x2v x = *(const GAS u32x2v*)(RAWb + (size_t)(sbase + ii) * 1536 + g * 512 + hc);
                    cv[g][0] += cw[k][g][0] * __uint_as_float(x.x << 16); cv[g][1] += cw[k][g][1] * __uint_as_float(x.x & 0xffff0000u); cv[g][2] += cw[k][g][2] * __uint_as_float(x.y << 16); cv[g][3] += cw[k][g][3] * __uint_as_float(x.y & 0xffff0000u); } } }
            float kkv[4], ss = 0.f;
#pragma unroll
            for (int e = 0; e < 4; ++e) { kkv[e] = cv[1][e] * kkw[e]; ss += kkv[e] * kkv[e]; }
            ss += __shfl_xor(ss, 1); ss += __shfl_xor(ss, 2); ss += __shfl_xor(ss, 4); ss += __shfl_xor(ss, 8);
            const float rn = __builtin_amdgcn_rsqf(ss + NORM_EPS);
            __syncthreads();
            float wl_[4], al_[4];
#pragma unroll
            for (int e = 0; e < 4; ++e) { wl_[e] = w0v[e]; al_[e] = a0v[e]; }
            for (int i = 0; i < 64; ++i) { const float tv = twl[ppos * 64 + i], av = adl[ppos * 64 + i]; const f32x4 w2 = *(const LAS f32x4*)(w2h + i * 64 + ch0), a2 = *(const LAS f32x4*)(a2h + i * 64 + ch0);
#pragma unroll
                for (int e = 0; e < 4; ++e) { wl_[e] += tv * w2[e]; al_[e] += av * a2[e]; } }
            LAS float* vb = vecs + ppos * 384 + ch0;
#pragma unroll
            for (int e = 0; e < 4; ++e) {
                const float wdec = __expf(-0.6065306597126334f * sigmoidf_(wl_[e])), a = sigmoidf_(al_[e]), kk = kkv[e] * rn;
                vb[e] = wdec; vb[64 + e] = kk * a; vb[128 + e] = cv[1][e] * (1.0f + (a - 1.0f) * kaw[e]); vb[192 + e] = kk; vb[256 + e] = cv[0][e]; vb[320 + e] = cv[2][e];
            }
            __syncthreads();
            for (int pp = 0; pp < 32; ++pp) {
                const LAS float* v_ = vecs + pp * 384;
                const f32x4 k0 = *(const LAS f32x4*)(v_ + 192 + j0), k1 = *(const LAS f32x4*)(v_ + 192 + j0 + 4);
                float skk = S[0] * k0[0] + S[1] * k0[1] + S[2] * k0[2] + S[3] * k0[3] + S[4] * k1[0] + S[5] * k1[1] + S[6] * k1[2] + S[7] * k1[3];
                skk += __shfl_xor(skk, 1); skk += __shfl_xor(skk, 2); skk += __shfl_xor(skk, 4);
                const f32x4 w0_ = *(const LAS f32x4*)(v_ + j0), w1_ = *(const LAS f32x4*)(v_ + j0 + 4), b0 = *(const LAS f32x4*)(v_ + 64 + j0), b1 = *(const LAS f32x4*)(v_ + 64 + j0 + 4);
                const f32x4 e0 = *(const LAS f32x4*)(v_ + 128 + j0), e1 = *(const LAS f32x4*)(v_ + 128 + j0 + 4), r0 = *(const LAS f32x4*)(v_ + 256 + j0), r1 = *(const LAS f32x4*)(v_ + 256 + j0 + 4);
                const float vi = v_[320 + row_i];
                float y = 0.f;
#pragma unroll
                for (int j = 0; j < 4; ++j) { S[j] = S[j] * w0_[j] - skk * b0[j] + vi * e0[j]; S[4 + j] = S[4 + j] * w1_[j] - skk * b1[j] + vi * e1[j]; y += S[j] * r0[j] + S[4 + j] * r1[j]; }
                y += __shfl_xor(y, 1); y += __shfl_xor(y, 2); y += __shfl_xor(y, 4);
                if ((lane & 7) == 0) ybuf[pp * 64 + row_i] = y;
            }
            __syncthreads();
            { const LAS float* yb = ybuf + ppos * 64 + ch0; u32x2v o; o.x = pk2(yb[0], yb[1]); o.y = pk2(yb[2], yb[3]); *(u32x2v*)(YRW + (size_t)R * 512 + hc) = o; }
        }
    }
    __syncthreads();
}

__device__ __forceinline__ void merge_rows(Frame& F, const Args& A) {
    unsigned char* ws = F.ws;
    const bf16* HML = (const bf16*)(ws + R_HML); const bf16* OM = (const bf16*)(ws + R_OM); const bf16* RAWb = (const bf16*)(ws + R_RAW);
    const bf16* YRW0 = (const bf16*)(ws + R_YRW0); const bf16* YRW1 = (const bf16*)((unsigned char*)F.out + DO_YRW1);
    bf16* MIX = (bf16*)(ws + R_MIX);
    const int gw = F.vcu * NWAVES + F.wave, NGW = F.G * NWAVES, lane = F.lane, c8 = 8 * lane;
    struct RowIn { v4u h0, h1, og, y0, y1, gg, x[3]; float bs; };
    auto load_row = [&](int row, RowIn& r) {
        r.h0 = *(const GAS v4u*)(HML + (size_t)row * 512 + c8); r.h1 = *(const GAS v4u*)(HML + ((size_t)MA_ROWS + row) * 512 + c8);
        r.og = *(const GAS v4u*)(OM + (size_t)row * 512 + c8);
        r.y0 = *(const GAS v4u*)(YRW0 + (size_t)row * 512 + c8); r.y1 = *(const GAS v4u*)(YRW1 + (size_t)row * 512 + c8);
        r.gg = *(const GAS v4u*)(RAWb + (size_t)row * 1536 + c8);
        r.bs = ((const float*)(ws + WS_SS))[(size_t)row * 8 + (lane >> 3)];
        int idx, len, sbase; if (row < ML_ROWS) { idx = row & (T - 1); len = T; sbase = row - idx; } else { idx = (row - ML_ROWS) & (CTXL - 1); len = CTXL; sbase = row - idx; }
#pragma unroll
        for (int k = 0; k < 3; ++k) { const int ii = idx + k - 1; const bool ok = ii >= 0 && ii < len; const v4u x = *(const GAS v4u*)(RAWb + (size_t)(sbase + (ok ? ii : idx)) * 1536 + 2 * 512 + c8);
            const v4u z0 = {0u, 0u, 0u, 0u}; r.x[k] = ok ? x : z0; }
    };
    RowIn cur, nxt;
    if (gw < MA_ROWS) load_row(gw, cur);
    for (int row = gw; row < MA_ROWS; row += NGW) {
        const bool more = row + NGW < MA_ROWS;
        if (more) load_row(row + NGW, nxt);
        const v4u in_og = cur.og, in_y0 = cur.y0, in_y1 = cur.y1, in_gg = cur.gg; const float bs = cur.bs;
        v4u in_x[3]; in_x[0] = cur.x[0]; in_x[1] = cur.x[1]; in_x[2] = cur.x[2];
        float y[8];
        { const unsigned* pa = (const unsigned*)&cur.h0; const unsigned* pb = (const unsigned*)&cur.h1;
#pragma unroll
            for (int q = 0; q < 4; ++q) { y[2 * q] = __uint_as_float(pa[q] << 16) + __uint_as_float(pb[q] << 16); y[2 * q + 1] = __uint_as_float(pa[q] & 0xffff0000u) + __uint_as_float(pb[q] & 0xffff0000u); } }
        float s = 0.f;
#pragma unroll
        for (int e = 0; e < 8; ++e) s += y[e];
        s += __shfl_xor(s, 1); s += __shfl_xor(s, 2); s += __shfl_xor(s, 4); s += __shfl_xor(s, 8);
        const float mean = s * (1.f / 128.f); float q2 = 0.f;
#pragma unroll
        for (int e = 0; e < 8; ++e) { y[e] -= mean; q2 += y[e] * y[e]; }
        q2 += __shfl_xor(q2, 1); q2 += __shfl_xor(q2, 2); q2 += __shfl_xor(q2, 4); q2 += __shfl_xor(q2, 8);
        const float rstd = __builtin_amdgcn_rsqf(q2 * (1.f / 128.f) + GN_EPS);
        { const unsigned* po = (const unsigned*)&in_og; float o[8];
#pragma unroll
            for (int q = 0; q < 4; ++q) { o[2 * q] = __uint_as_float(po[q] << 16); o[2 * q + 1] = __uint_as_float(po[q] & 0xffff0000u); }
            v4u w; unsigned* pw = (unsigned*)&w;
#pragma unroll
            for (int q = 0; q < 4; ++q) { const float g0 = A.in[I_ML_NORM_G][c8 + 2 * q], g1 = A.in[I_ML_NORM_G][c8 + 2 * q + 1];
                pw[q] = pk2(y[2 * q] * rstd * g0 * sigmoidf_(o[2 * q]), y[2 * q + 1] * rstd * g1 * sigmoidf_(o[2 * q + 1])); }
            *(GAS v4u*)(MIX + (size_t)row * D + c8) = w; }
        float z[8];
        { const unsigned* pa = (const unsigned*)&in_y0; const unsigned* pb = (const unsigned*)&in_y1;
#pragma unroll
            for (int q = 0; q < 4; ++q) { z[2 * q] = __uint_as_float(pa[q] << 16) + __uint_as_float(pb[q] << 16); z[2 * q + 1] = __uint_as_float(pa[q] & 0xffff0000u) + __uint_as_float(pb[q] & 0xffff0000u); } }
        s = 0.f;
#pragma unroll
        for (int e = 0; e < 8; ++e) s += z[e];
        s += __shfl_xor(s, 1); s += __shfl_xor(s, 2); s += __shfl_xor(s, 4);
        const float mean2 = s * (1.f / 64.f); q2 = 0.f;
#pragma unroll
        for (int e = 0; e < 8; ++e) { z[e] -= mean2; q2 += z[e] * z[e]; }
        q2 += __shfl_xor(q2, 1); q2 += __shfl_xor(q2, 2); q2 += __shfl_xor(q2, 4);
        const float rstd2 = __builtin_amdgcn_rsqf(q2 * (1.f / 64.f) + GN_EPS);
        float cv[3][8];
#pragma unroll
        for (int e = 0; e < 8; ++e) cv[2][e] = 0.f;
#pragma unroll
        for (int k = 0; k < 3; ++k) { const unsigned* px = (const unsigned*)&in_x[k]; const float* cwp = A.in[I_RW_CONV] + k * 1536 + 2 * 512 + c8;
#pragma unroll
            for (int q = 0; q < 4; ++q) { cv[2][2 * q] += cwp[2 * q] * __uint_as_float(px[q] << 16); cv[2][2 * q + 1] += cwp[2 * q + 1] * __uint_as_float(px[q] & 0xffff0000u); } }
        { const unsigned* pg = (const unsigned*)&in_gg; v4u w; unsigned* pw = (unsigned*)&w;
#pragma unroll
            for (int q = 0; q < 4; ++q) { const float g0 = __uint_as_float(pg[q] << 16), g1 = __uint_as_float(pg[q] & 0xffff0000u);
                const float o0 = (z[2 * q] * rstd2 * A.in[I_RW_NORM_G][c8 + 2 * q] + bs * cv[2][2 * q]) * g0, o1 = (z[2 * q + 1] * rstd2 * A.in[I_RW_NORM_G][c8 + 2 * q + 1] + bs * cv[2][2 * q + 1]) * g1;
                pw[q] = pk2(o0, o1); }
            *(GAS v4u*)(MIX + (size_t)row * D + 512 + c8) = w; }
        if (more) cur = nxt;
    }
}

__device__ __forceinline__ void qk_prep(Frame& F, const Args& A) {
    unsigned char* ws = F.ws;
    const bf16* ATT = (const bf16*)(ws + R_ATT); const float* ROPE = (const float*)(ws + WS_ROPE);
    bf16* QB = (bf16*)(ws + R_QB); bf16* KW = (bf16*)(ws + R_KW); bf16* VW = (bf16*)(ws + R_VW); bf16* KG = (bf16*)(ws + R_KG); bf16* VG = (bf16*)(ws + R_VG);
    const int gw = F.vcu * NWAVES + F.wave, NGW = F.G * NWAVES, lane = F.lane, l15 = lane & 15, hg = lane >> 4;
    const f32x4 gwq = *(const f32x4*)(A.in[I_WIN_Q_NORM] + 4 * l15), gwk = *(const f32x4*)(A.in[I_WIN_K_NORM] + 4 * l15), ggq = *(const f32x4*)(A.in[I_GLB_Q_NORM] + 4 * l15), ggk = *(const f32x4*)(A.in[I_GLB_K_NORM] + 4 * l15);
    for (int row0 = 2 * gw; row0 < MA_ROWS; row0 += 2 * NGW) {
        u32x2v xin[2][6];
#pragma unroll
        for (int q = 0; q < 2; ++q)
#pragma unroll
            for (int grp = 0; grp < 6; ++grp) xin[q][grp] = *(const GAS u32x2v*)(ATT + (size_t)(row0 + q) * ATT_N + 4 * lane + 256 * grp);
        f32x4 cs2[2];
#pragma unroll
        for (int q = 0; q < 2; ++q) { const int row = row0 + q; const bool lat = row < ML_ROWS; const int t = lat ? (row & (T - 1)) : 0;
            cs2[q] = (f32x4){1.f, 0.f, 1.f, 0.f}; if (lat) cs2[q] = *(const f32x4*)(ROPE + ((size_t)((l15 < 8) ? (t >> 6) : (t & 63)) * 16 + ((2 * l15) & 15)) * 2); }
#pragma unroll
        for (int q = 0; q < 2; ++q) {
        const int row = row0 + q;
        const bool lat = row < ML_ROWS; const int b = lat ? (row >> 13) : ((row - ML_ROWS) >> 8); const int t = lat ? (row & (T - 1)) : 0;
        const int pos = lat ? t : T + ((row - ML_ROWS) & (CTXL - 1));
        const f32x4 cssn = cs2[q];
#pragma unroll
        for (int grp = 0; grp < 6; ++grp) {
            const bool qgrp = (grp != 2) && (grp != 5);
            if (qgrp && !lat) continue;
            f32x4 x; { const u32x2v xb = xin[q][grp]; x[0] = __uint_as_float(xb.x << 16); x[1] = __uint_as_float(xb.x & 0xffff0000u); x[2] = __uint_as_float(xb.y << 16); x[3] = __uint_as_float(xb.y & 0xffff0000u); }
            const bool isv = !qgrp && hg >= 2;
            const f32x4 g = grp < 2 ? gwq : grp == 2 ? gwk : grp < 5 ? ggq : ggk;
            const float ss = sum16((x[0] * x[0] + x[1] * x[1]) + (x[2] * x[2] + x[3] * x[3]));
            if (!isv) {
                const float rs = __builtin_amdgcn_rsqf(ss * (1.f / 64.f) + NORM_EPS);
                x = x * rs * g;
                const f32x4 y = {x[0] * cssn[0] - x[1] * cssn[1], x[0] * cssn[1] + x[1] * cssn[0], x[2] * cssn[2] - x[3] * cssn[3], x[2] * cssn[3] + x[3] * cssn[2]};
                x = qgrp ? y * attn_body::C2 : y;
            }
            u32x2v o; o.x = pk2(x[0], x[1]); o.y = pk2(x[2], x[3]);
            if (qgrp) *(u32x2v*)(QB + (size_t)row * D + (grp < 2 ? 256 * grp : 512 + 256 * (grp - 3)) + 4 * lane) = o;
            else { bf16* dst = (grp == 2) ? (hg < 2 ? KW : VW) : (hg < 2 ? KG : VG); *(u32x2v*)(dst + ((size_t)(b * 2 + (hg & 1)) * KV_LEN + pos) * 64 + 4 * l15) = o; }
        }
        }
    }
}

__device__ __forceinline__ void attn_phase(Frame& F, const Args& A, char* lds_generic) {
    unsigned char* ws = F.ws;
    const attn_body::bf16* QB = (const attn_body::bf16*)(ws + R_QB);
    for (int k = 0; k < 4; ++k) {
        const int uid = k * F.G + F.vcu; if (uid >= 1024) break;
        const int grp = uid >> 9, gi = uid & 511;
        int bh, qb;
        if (F.G == 256) { bh = (gi & 255) >> 4; qb = 2 * ((gi & 255) & 15) + (gi >> 8); } else { bh = gi >> 5; qb = gi & 31; }
        const int b = bh >> 3, hq = bh & 7, kvh = hq >> 2;
        if (grp == 0) {
            const attn_body::bf16* Kh = (const attn_body::bf16*)(ws + R_KG) + (size_t)(b * 2 + kvh) * KV_LEN * 64; const attn_body::bf16* Vh = (const attn_body::bf16*)(ws + R_VG) + (size_t)(b * 2 + kvh) * KV_LEN * 64;
            attn_body::attn_unit<8, 0>(b, 8 + hq, qb, QB, Kh, Vh, (attn_body::bf16*)QB, lds_generic, 0.f);
        } else {
            const attn_body::bf16* Kh = (const attn_body::bf16*)(ws + R_KW) + (size_t)(b * 2 + kvh) * KV_LEN * 64; const attn_body::bf16* Vh = (const attn_body::bf16*)(ws + R_VW) + (size_t)(b * 2 + kvh) * KV_LEN * 64;
            attn_body::attn_unit<8, 1>(b, hq, qb, QB, Kh, Vh, (attn_body::bf16*)QB, lds_generic, A.in[I_WIN_SINK][hq] * 1.4426950408889634f);
        }
    }
}
constexpr int RW_NCH = 132;
constexpr int RW_NITEM = NCHAIN_RW * RW_NCH;
constexpr size_t RW_LCT = R_QM, RW_NC = R_VM, RW_PL = R_GATES;
static_assert((size_t)RW_NITEM * 4096 * 2 <= 2 * SZ_A && (size_t)RW_NITEM * 64 * 4 <= (size_t)MA_ROWS * 16 * 4 && WS_W2T + 2 * 2 * 8 * 64 * 64 * 2 <= WS_XC, "rwkv chunk scratch map");

template <int MODE> __device__ __forceinline__ void rw_chunk_pass(Frame& F, const Args& A) {
    constexpr int TP = 72;
    unsigned char* ws = F.ws;
    const bf16* RAWb = (const bf16*)(ws + R_RAW); const bf16* TWAD = (const bf16*)(ws + R_TWAD); const bf16* W2T = (const bf16*)(ws + WS_W2T);
    bf16* LCT = (bf16*)(ws + RW_LCT); bf16* NCG = (bf16*)(ws + RW_NC); float* PLG = (float*)(ws + RW_PL);
    const bf16* SCG = (const bf16*)((unsigned char*)F.out + DO_CST);
    LAS unsigned char* Lb = F.lds;
    LAS bf16* tKT = (LAS bf16*)(Lb + 0); LAS bf16* tRT = (LAS bf16*)(Lb + 9216); LAS bf16* tKH = (LAS bf16*)(Lb + 18432); LAS bf16* tBH = (LAS bf16*)(Lb + 27648);
    LAS bf16* tKTT = (LAS bf16*)(Lb + 36864); LAS bf16* tKBT = (LAS bf16*)(Lb + 46080); LAS bf16* tBBT = (LAS bf16*)(Lb + 55296); LAS bf16* tVT = (LAS bf16*)(Lb + 64512);
    LAS float* WA = (LAS float*)(Lb + 73728);
    LAS float* ABK = (LAS float*)(Lb + 73728);
    LAS bf16* tAKK = (LAS bf16*)(Lb + 91136); LAS bf16* tAKRT = (LAS bf16*)(Lb + 100352); LAS bf16* tABRT = (LAS bf16*)(Lb + 109568); LAS bf16* tW = (LAS bf16*)(Lb + 118784);
    LAS float* CLL = (LAS float*)(Lb + 128000);
    LAS bf16* tTT = tKH; LAS bf16* tX = tBH; LAS bf16* tUL = tKT;
    LAS bf16* tE1 = MODE == 0 ? (LAS bf16*)(Lb + 154112) : tKBT; LAS bf16* tE2 = MODE == 0 ? (LAS bf16*)(Lb + 73728) : tBBT;
    const int tid = F.tid, lane = F.lane, w = F.wave, l15 = lane & 15, l4 = lane >> 4;
#ifdef TS_RWC
    unsigned long long tst[12] = {0,0,0,0,0,0,0,0,0,0,0,0}, tprev = __builtin_amdgcn_s_memtime();
#define STG(k) do { const unsigned long long tn_ = __builtin_amdgcn_s_memtime(); tst[k] += tn_ - tprev; tprev = tn_; } while (0)
#else
#define STG(k) do {} while (0)
#endif
    LAS float* cst = (LAS float*)(Lb + LDSX_OFF); LAS bf16* W2L = (LAS bf16*)(Lb + LDSX_OFF + 3584);
    const int pos = tid >> 3, part = tid & 7, ch0 = 8 * part;
    constexpr int IPW = 17;
    const int item_lo = F.vcu * IPW, item_hi = (item_lo + IPW < RW_NITEM) ? item_lo + IPW : RW_NITEM;
    v4u pf_a0, pf_a1, pf_raw[3][3]; int pf_valid = 0;
    v4u pf_s[6];
#define RWC_PREFETCH(itn) do { const int ch_ = (itn) / RW_NCH, c_ = (itn) % RW_NCH, d_ = ch_ >> 4, b_ = (ch_ >> 3) & 1; \
        int R, idx, len, sbase; rw_seq_rows(d_, b_, 64 * c_ + 16 * (w & 3) + l15, R, idx, len, sbase); const bf16* ap = TWAD + (size_t)R * 256 + (w >> 2) * 128 + d_ * 64 + 8 * l4; \
        pf_a0 = *(const GAS v4u*)ap; pf_a1 = *(const GAS v4u*)(ap + 32); } while (0)
#define RWC_LOADRAW(itn) do { const int ch_ = (itn) / RW_NCH, c_ = (itn) % RW_NCH, d_ = ch_ >> 4, b_ = (ch_ >> 3) & 1, h_ = ch_ & 7; \
        int R, idx, len, sbase; rw_seq_rows(d_, b_, 64 * c_ + pos, R, idx, len, sbase); pf_valid = 0; \
        _Pragma("unroll") for (int k = 0; k < 3; ++k) { const int ii = idx + k - 1; const bool ok = ii >= 0 && ii < len; pf_valid |= ok ? (1 << k) : 0; const int iic = ok ? ii : idx; \
            _Pragma("unroll") for (int g = 0; g < 3; ++g) pf_raw[k][g] = *(const GAS v4u*)(RAWb + (size_t)(sbase + iic) * 1536 + g * 512 + h_ * 64 + ch0); } } while (0)
#define RWC_BAR() asm volatile("s_waitcnt lgkmcnt(0)\n\ts_barrier" ::: "memory")
    int cur_chain = -1;
    if (item_lo < item_hi) RWC_PREFETCH(item_lo);
    for (int item = item_lo; item < item_hi; ++item) {
        const int chain = item / RW_NCH, c = item % RW_NCH, d = chain >> 4, b = (chain >> 3) & 1, h = chain & 7;
        int lz = 0; asm volatile("" : "+s"(lz));
        const int tid = F.tid + lz, lane = tid & 63, l15 = lane & 15, l4 = lane >> 4, pos = tid >> 3, part = tid & 7, ch0 = 8 * part;
        RWC_LOADRAW(item);
        RWC_BAR();
        if (chain != cur_chain) {
            cur_chain = chain;
            for (int i = tid; i < 896; i += NTHREADS) {
                float v;
                if (i < 576) v = A.in[I_RW_CONV][((i >> 6) / 3) * 1536 + ((i >> 6) % 3) * 512 + h * 64 + (i & 63)];
                else if (i < 640) v = A.in[I_RW_KK][h * 64 + (i & 63)];
                else if (i < 704) v = A.in[I_RW_KA][h * 64 + (i & 63)];
                else if (i < 768) v = A.in[I_RW_W0][d * 512 + h * 64 + (i & 63)];
                else if (i < 832) v = A.in[I_RW_A0][d * 512 + h * 64 + (i & 63)];
                else v = A.in[I_RW_RK][h * 64 + (i & 63)];
                cst[i] = v;
            }
            for (int i = tid; i < 2 * 64 * 8; i += NTHREADS) {
                const int which = i >> 9, ch = (i >> 3) & 63, pc = i & 7;
                *(LAS v4u*)(W2L + which * (64 * TP) + ch * TP + 8 * pc) = *(const GAS v4u*)(W2T + ((size_t)((which * 2 + d) * 8 + h) * 64 + ch) * 64 + 8 * pc);
            }
            RWC_BAR();
        }
        STG(0);
        {
            const int which = w >> 2, mt = w & 3;
            const bf16x8 a0 = __builtin_bit_cast(bf16x8, pf_a0), a1 = __builtin_bit_cast(bf16x8, pf_a1);
            const LAS bf16* bt = W2L + which * (64 * TP);
#pragma unroll
            for (int nt = 0; nt < 4; ++nt) {
                f32x4 acc = {0.f, 0.f, 0.f, 0.f};
                acc = MFMA16(a0, ldsfrag(bt, 16 * nt + l15, 8 * l4), acc); acc = MFMA16(a1, ldsfrag(bt, 16 * nt + l15, 32 + 8 * l4), acc);
                const float bv = cst[704 + which * 64 + 16 * nt + l15];
#pragma unroll
                for (int r = 0; r < 4; ++r) WA[which * (64 * 65) + (16 * mt + 4 * l4 + r) * 65 + 16 * nt + l15] = acc[r] + bv;
            }
        }
        RWC_BAR();
        STG(1);
        float kkv[8], keyv[8], betv[8], rv[8], vv[8], lamv[8];
        {
            float cv[3][8];
            {
                f32x2v c2[3][4];
#pragma unroll
                for (int g = 0; g < 3; ++g)
#pragma unroll
                    for (int q = 0; q < 4; ++q) c2[g][q] = (f32x2v){0.f, 0.f};
#pragma unroll
                for (int k = 0; k < 3; ++k) { const bool okk = (pf_valid >> k) & 1;
#pragma unroll
                    for (int g = 0; g < 3; ++g) { const unsigned* px = (const unsigned*)&pf_raw[k][g];
                        const LAS f32x2v* cp = (const LAS f32x2v*)(cst + (k * 3 + g) * 64 + ch0);
#pragma unroll
                        for (int q = 0; q < 4; ++q) { const unsigned xw = (k == 1 || okk) ? px[q] : 0u;
                            const f32x2v x2 = {__uint_as_float(xw << 16), __uint_as_float(xw & 0xffff0000u)};
                            c2[g][q] += cp[q] * x2; } } }
#pragma unroll
                for (int g = 0; g < 3; ++g)
#pragma unroll
                    for (int q = 0; q < 4; ++q) { cv[g][2 * q] = c2[g][q].x; cv[g][2 * q + 1] = c2[g][q].y; }
            }
            if (d == 0) {
                float bs = 0.f;
#pragma unroll
                for (int e = 0; e < 8; ++e) bs += cv[0][e] * cv[1][e] * cst[832 + ch0 + e];
                bs = sum8(bs);
                if (part == 0) { int R, idx, len, sbase; rw_seq_rows(d, b, 64 * c + pos, R, idx, len, sbase); ((float*)(ws + WS_SS))[(size_t)R * 8 + h] = bs; }
            }
            float ss = 0.f;
#pragma unroll
            for (int e = 0; e < 8; ++e) { kkv[e] = cv[1][e] * cst[576 + ch0 + e]; ss += kkv[e] * kkv[e]; }
            ss = sum8(ss);
            const float rn = __builtin_amdgcn_rsqf(ss + NORM_EPS);
#pragma unroll
            for (int e = 0; e < 8; ++e) {
                const float wl_ = WA[pos * 65 + ch0 + e], al_ = WA[64 * 65 + pos * 65 + ch0 + e];
                const float a = sigmoidf_(al_); lamv[e] = (0.6065306597126334f * 1.4426950408889634f) * sigmoidf_(wl_);
                kkv[e] *= rn; betv[e] = kkv[e] * a; keyv[e] = cv[1][e] * (1.0f + (a - 1.0f) * cst[640 + ch0 + e]); rv[e] = cv[0][e]; vv[e] = cv[2][e];
                WA[pos * 65 + ch0 + e] = lamv[e];
            }
        }
        RWC_BAR();
        STG(2);
        {
            const int ch = tid >> 3; float x[8]; float run = 0.f;
#pragma unroll
            for (int q = 0; q < 8; ++q) { run += WA[(8 * part + q) * 65 + ch]; x[q] = run; }
            float inc = run;
            { float t_ = dpp_mov<0x111>(inc); if (part >= 1) inc += t_; t_ = dpp_mov<0x112>(inc); if (part >= 2) inc += t_; t_ = dpp_mov<0x114>(inc); if (part >= 4) inc += t_; }
            const float excl = inc - run;
#pragma unroll
            for (int q = 0; q < 8; ++q) WA[(8 * part + q) * 65 + ch] = x[q] + excl;
            if (part == 7) { CLL[ch] = inc; CLL[64 + ch] = __builtin_amdgcn_exp2f(-inc); }
        }
        RWC_BAR();
        STG(3);
        {
            float kt[8], rt[8], kh[8], bh[8], kb[8], bbn[8];
#pragma unroll
            for (int e = 0; e < 8; ++e) {
                const float cl = WA[pos * 65 + ch0 + e];
                const float eI = __builtin_amdgcn_exp2f(cl), eB = eI * CLL[64 + ch0 + e];
                kt[e] = kkv[e] * __builtin_amdgcn_exp2f(lamv[e] - cl); rt[e] = rv[e] * __builtin_amdgcn_exp2f(-cl); kh[e] = keyv[e] * eI; bh[e] = betv[e] * eI; kb[e] = keyv[e] * eB; bbn[e] = -betv[e] * eB;
            }
            v4u o;
            o.x = pk2(kt[0], kt[1]); o.y = pk2(kt[2], kt[3]); o.z = pk2(kt[4], kt[5]); o.w = pk2(kt[6], kt[7]); *(LAS v4u*)(tKT + pos * TP + ch0) = o; *(LAS v4u*)(tKTT + pos * TP + ch0) = o;
            o.x = pk2(rt[0], rt[1]); o.y = pk2(rt[2], rt[3]); o.z = pk2(rt[4], rt[5]); o.w = pk2(rt[6], rt[7]); *(LAS v4u*)(tRT + pos * TP + ch0) = o;
            o.x = pk2(kh[0], kh[1]); o.y = pk2(kh[2], kh[3]); o.z = pk2(kh[4], kh[5]); o.w = pk2(kh[6], kh[7]); *(LAS v4u*)(tKH + pos * TP + ch0) = o;
            o.x = pk2(bh[0], bh[1]); o.y = pk2(bh[2], bh[3]); o.z = pk2(bh[4], bh[5]); o.w = pk2(bh[6], bh[7]); *(LAS v4u*)(tBH + pos * TP + ch0) = o;
            o.x = pk2(vv[0], vv[1]); o.y = pk2(vv[2], vv[3]); o.z = pk2(vv[4], vv[5]); o.w = pk2(vv[6], vv[7]); *(LAS v4u*)(tVT + pos * TP + ch0) = o;
            if (MODE == 0) {
                o.x = pk2(kb[0], kb[1]); o.y = pk2(kb[2], kb[3]); o.z = pk2(kb[4], kb[5]); o.w = pk2(kb[6], kb[7]); *(LAS v4u*)(tKBT + pos * TP + ch0) = o;
                o.x = pk2(bbn[0], bbn[1]); o.y = pk2(bbn[2], bbn[3]); o.z = pk2(bbn[4], bbn[5]); o.w = pk2(bbn[6], bbn[7]); *(LAS v4u*)(tBBT + pos * TP + ch0) = o;
            }
        }
        RWC_BAR();
        STG(4);
        {
            const int st = w & 3;
            if (w < 4) {
                const bf16x8 a0 = ldsfrag(tBH, 16 * st + l15, 8 * l4), a1 = ldsfrag(tBH, 16 * st + l15, 32 + 8 * l4);
#pragma unroll
                for (int tt = 0; tt < 4; ++tt) {
                    f32x4 acc = {0.f, 0.f, 0.f, 0.f};
                    acc = MFMA16(a0, ldsfrag(tKT, 16 * tt + l15, 8 * l4), acc); acc = MFMA16(a1, ldsfrag(tKT, 16 * tt + l15, 32 + 8 * l4), acc);
                    const int t = 16 * tt + l15, s0 = 16 * st + 4 * l4;
#pragma unroll
                    for (int r = 0; r < 4; ++r) if (s0 + r >= t) acc[r] = 0.f;
                    *(LAS f32x4*)(ABK + t * 68 + s0) = acc; *(LAS u32x2v*)(tE1 + t * TP + s0) = pk4(acc);
                    {
                        f32x4 ac2 = {0.f, 0.f, 0.f, 0.f};
                        ac2 = MFMA16(a0, ldsfrag(tRT, 16 * tt + l15, 8 * l4), ac2); ac2 = MFMA16(a1, ldsfrag(tRT, 16 * tt + l15, 32 + 8 * l4), ac2);
#pragma unroll
                        for (int r = 0; r < 4; ++r) ac2[r] = (s0 + r > t) ? 0.f : -ac2[r];
                        *(LAS u32x2v*)(tABRT + t * TP + s0) = pk4(ac2);
                    }
                }
            } else {
                const bf16x8 b0 = ldsfrag(tKH, 16 * st + l15, 8 * l4), b1 = ldsfrag(tKH, 16 * st + l15, 32 + 8 * l4);
#pragma unroll
                for (int tt = 0; tt < 4; ++tt) {
                    f32x4 acc = {0.f, 0.f, 0.f, 0.f};
                    acc = MFMA16(ldsfrag(tKT, 16 * tt + l15, 8 * l4), b0, acc); acc = MFMA16(ldsfrag(tKT, 16 * tt + l15, 32 + 8 * l4), b1, acc);
                    const int s = 16 * st + l15, t0 = 16 * tt + 4 * l4;
#pragma unroll
                    for (int r = 0; r < 4; ++r) if (s >= t0 + r) acc[r] = 0.f;
                    *(LAS u32x2v*)(tAKK + s * TP + t0) = pk4(acc);
                    {
                        f32x4 ac2 = {0.f, 0.f, 0.f, 0.f};
                        ac2 = MFMA16(b0, ldsfrag(tRT, 16 * tt + l15, 8 * l4), ac2); ac2 = MFMA16(b1, ldsfrag(tRT, 16 * tt + l15, 32 + 8 * l4), ac2);
                        const int t = 16 * tt + l15, s0 = 16 * st + 4 * l4;
#pragma unroll
                        for (int r = 0; r < 4; ++r) if (s0 + r > t) ac2[r] = 0.f;
                        *(LAS u32x2v*)(tAKRT + t * TP + s0) = pk4(ac2);
                    }
                }
            }
        }
        RWC_BAR();
        STG(5);
        { const int itn = (item + 1 < item_hi) ? item + 1 : item; RWC_PREFETCH(itn); }
        if (MODE == 1) { const bf16* Sg_ = SCG + (size_t)item * 4096; const int mt_ = w & 3, n0_ = 2 * (w >> 2);
#pragma unroll
            for (int q = 0; q < 2; ++q) { pf_s[2 * q] = *(const GAS v4u*)(Sg_ + (size_t)(16 * (n0_ + q) + l15) * 64 + 8 * l4); pf_s[2 * q + 1] = *(const GAS v4u*)(Sg_ + (size_t)(16 * (n0_ + q) + l15) * 64 + 32 + 8 * l4); }
            pf_s[4] = *(const GAS v4u*)(Sg_ + (size_t)(16 * mt_ + l15) * 64 + 8 * l4); pf_s[5] = *(const GAS v4u*)(Sg_ + (size_t)(16 * mt_ + l15) * 64 + 32 + 8 * l4); }
        if (tid < 128) {
            const int kind = tid >> 6, bb_ = (tid >> 4) & 3, x = tid & 15; float u[16];
            if (kind == 0) {
#pragma unroll
                for (int y = 0; y < 16; ++y) { float s = (y == x) ? 1.f : 0.f; const LAS float* ar = ABK + (16 * bb_ + y) * 68 + 16 * bb_;
#pragma unroll
                    for (int z = 0; z < y; ++z) s -= u[z] * ar[z];
                    u[y] = s; }
            } else {
#pragma unroll
                for (int z = 15; z >= 0; --z) { float s = (z == x) ? 1.f : 0.f;
#pragma unroll
                    for (int z2 = z + 1; z2 < 16; ++z2) s -= ABK[(16 * bb_ + z2) * 68 + 16 * bb_ + z] * u[z2];
                    u[z] = s; }
            }
            LAS bf16* dst = (kind == 0 ? tKT : tKH) + (16 * bb_ + x) * TP;
            const v4u zz = {0u, 0u, 0u, 0u};
#pragma unroll
            for (int q = 0; q < 8; ++q) *(LAS v4u*)(dst + 8 * q) = zz;
            v4u o0, o1; o0.x = pk2(u[0], u[1]); o0.y = pk2(u[2], u[3]); o0.z = pk2(u[4], u[5]); o0.w = pk2(u[6], u[7]); o1.x = pk2(u[8], u[9]); o1.y = pk2(u[10], u[11]); o1.z = pk2(u[12], u[13]); o1.w = pk2(u[14], u[15]);
            asm volatile("" ::: "memory");
            *(LAS v4u*)(dst + 16 * bb_) = o0; *(LAS v4u*)(dst + 16 * bb_ + 8) = o1;
        } else {
            for (int tl = w - 2; tl < 16; tl += 6) { const int it_ = tl >> 2, stl = tl & 3;
                f32x4 acc = {0.f, 0.f, 0.f, 0.f};
                acc = MFMA16(trfrag(tAKK, 16 * stl, 0, l15, l4), trfrag(tVT, 16 * it_, 0, l15, l4), acc); acc = MFMA16(trfrag(tAKK, 16 * stl, 32, l15, l4), trfrag(tVT, 16 * it_, 32, l15, l4), acc);
                *(LAS u32x2v*)(tX + (16 * it_ + l15) * TP + 16 * stl + 4 * l4) = pk4(acc); }
        }
        RWC_BAR();
        STG(10);
        {
            const int mt5 = w & 3, n50 = 2 * (w >> 2);
            const bf16x8 zf = {0, 0, 0, 0, 0, 0, 0, 0};
            {
                bf16x8 a0 = ldsfrag(tE1, 16 * mt5 + l15, 8 * l4), a1 = ldsfrag(tE1, 16 * mt5 + l15, 32 + 8 * l4);
                if (!((mt5 & 1) && (mt5 >> 1) == 0 && l4 < 2)) a0 = zf;
                if (!((mt5 & 1) && (mt5 >> 1) == 1 && l4 < 2)) a1 = zf;
#pragma unroll
                for (int q = 0; q < 2; ++q) { const int nt = n50 + q; f32x4 acc = {0.f, 0.f, 0.f, 0.f};
                    acc = MFMA16(a0, ldsfrag(tKT, 16 * nt + l15, 8 * l4), acc); acc = MFMA16(a1, ldsfrag(tKT, 16 * nt + l15, 32 + 8 * l4), acc);
                    *(LAS u32x2v*)(tE2 + (16 * nt + l15) * TP + 16 * mt5 + 4 * l4) = pk4(acc); }
            }
            RWC_BAR();
            {
                const bf16x8 g0 = ldsfrag(tKH, 16 * mt5 + l15, 8 * l4), g1 = ldsfrag(tKH, 16 * mt5 + l15, 32 + 8 * l4);
                const bf16x8 p0 = ldsfrag(tE2, 16 * mt5 + l15, 8 * l4), p1 = ldsfrag(tE2, 16 * mt5 + l15, 32 + 8 * l4);
                f32x4 accA[2], accB[2];
#pragma unroll
                for (int q = 0; q < 2; ++q) { const int nt = n50 + q;
                    accA[q] = (f32x4){0.f, 0.f, 0.f, 0.f}; accA[q] = MFMA16(g0, ldsfrag(tE2, 16 * nt + l15, 8 * l4), accA[q]); accA[q] = MFMA16(g1, ldsfrag(tE2, 16 * nt + l15, 32 + 8 * l4), accA[q]);
                    accB[q] = (f32x4){0.f, 0.f, 0.f, 0.f}; accB[q] = MFMA16(p0, ldsfrag(tKH, 16 * nt + l15, 8 * l4), accB[q]); accB[q] = MFMA16(p1, ldsfrag(tKH, 16 * nt + l15, 32 + 8 * l4), accB[q]); }
#pragma unroll
                for (int q = 0; q < 2; ++q) { const int nt = n50 + q;
                    { LAS u32x2v* tp = (LAS u32x2v*)(tKT + (16 * nt + l15) * TP + 16 * mt5 + 4 * l4); const u32x2v old = *tp; f32x4 v;
                      v[0] = __uint_as_float(old.x << 16) - accA[q][0]; v[1] = __uint_as_float(old.x & 0xffff0000u) - accA[q][1]; v[2] = __uint_as_float(old.y << 16) - accA[q][2]; v[3] = __uint_as_float(old.y & 0xffff0000u) - accA[q][3]; *tp = pk4(v); }
                    { const u32x2v old = *(const LAS u32x2v*)(tKH + (16 * nt + l15) * TP + 16 * mt5 + 4 * l4); f32x4 v;
                      v[0] = __uint_as_float(old.x << 16) - accB[q][0]; v[1] = __uint_as_float(old.x & 0xffff0000u) - accB[q][1]; v[2] = __uint_as_float(old.y << 16) - accB[q][2]; v[3] = __uint_as_float(old.y & 0xffff0000u) - accB[q][3];
                      *(LAS u32x2v*)(tW + (16 * nt + l15) * TP + 16 * mt5 + 4 * l4) = pk4(v); } }
            }
            RWC_BAR();
            {
                bf16x8 a0 = ldsfrag(tE1, 16 * mt5 + l15, 8 * l4);
                if (mt5 < 2) a0 = zf;
#pragma unroll
                for (int q = 0; q < 2; ++q) { const int nt = n50 + q; f32x4 acc = {0.f, 0.f, 0.f, 0.f};
                    acc = MFMA16(a0, ldsfrag(tKT, 16 * nt + l15, 8 * l4), acc);
                    *(LAS u32x2v*)(tE2 + (16 * nt + l15) * TP + 16 * mt5 + 4 * l4) = pk4(acc); }
            }
            RWC_BAR();
            {
                const bf16x8 p0 = ldsfrag(tE2, 16 * mt5 + l15, 8 * l4), p1 = ldsfrag(tE2, 16 * mt5 + l15, 32 + 8 * l4);
#pragma unroll
                for (int q = 0; q < 2; ++q) { const int nt = n50 + q; f32x4 acc = {0.f, 0.f, 0.f, 0.f};
                    acc = MFMA16(p0, ldsfrag(tW, 16 * nt + l15, 8 * l4), acc); acc = MFMA16(p1, ldsfrag(tW, 16 * nt + l15, 32 + 8 * l4), acc);
                    const u32x2v old = *(const LAS u32x2v*)(tW + (16 * nt + l15) * TP + 16 * mt5 + 4 * l4); f32x4 v;
                    v[0] = __uint_as_float(old.x << 16) - acc[0]; v[1] = __uint_as_float(old.x & 0xffff0000u) - acc[1]; v[2] = __uint_as_float(old.y << 16) - acc[2]; v[3] = __uint_as_float(old.y & 0xffff0000u) - acc[3];
                    *(LAS u32x2v*)(tTT + (16 * nt + l15) * TP + 16 * mt5 + 4 * l4) = pk4(v); }
            }
        }
        RWC_BAR();
        STG(6);
        if (w < 4) {
            const bf16x8 a0 = MODE == 0 ? ldsfrag(tTT, 16 * w + l15, 8 * l4) : trfrag(tKTT, 16 * w, 0, l15, l4), a1 = MODE == 0 ? ldsfrag(tTT, 16 * w + l15, 32 + 8 * l4) : trfrag(tKTT, 16 * w, 32, l15, l4);
#pragma unroll
            for (int nt = 0; nt < 4; ++nt) {
                f32x4 acc = {0.f, 0.f, 0.f, 0.f};
                const bf16x8 b0 = MODE == 0 ? trfrag(tKTT, 16 * nt, 0, l15, l4) : ldsfrag(tTT, 16 * nt + l15, 8 * l4), b1 = MODE == 0 ? trfrag(tKTT, 16 * nt, 32, l15, l4) : ldsfrag(tTT, 16 * nt + l15, 32 + 8 * l4);
                acc = MFMA16(a0, b0, acc); acc = MFMA16(a1, b1, acc);
                *(LAS u32x2v*)(tW + (16 * nt + l15) * TP + 16 * w + 4 * l4) = pk4(acc);
            }
        } else {
            const int mtu = w - 4;
            const bf16x8 a0 = ldsfrag(tTT, 16 * mtu + l15, 8 * l4), a1 = ldsfrag(tTT, 16 * mtu + l15, 32 + 8 * l4);
#pragma unroll
            for (int nt = 0; nt < 4; ++nt) {
                f32x4 acc = {0.f, 0.f, 0.f, 0.f};
                acc = MFMA16(a0, ldsfrag(tX, 16 * nt + l15, 8 * l4), acc); acc = MFMA16(a1, ldsfrag(tX, 16 * nt + l15, 32 + 8 * l4), acc);
                *(LAS u32x2v*)(tUL + (16 * nt + l15) * TP + 16 * mtu + 4 * l4) = pk4(acc);
            }
        }
        STG(7);
        const int mt = w & 3, nt0 = 2 * (w >> 2);
        RWC_BAR();
        STG(8);
        if (MODE == 0) {
            const bf16x8 k0 = trfrag(tKBT, 16 * mt, 0, l15, l4), k1 = trfrag(tKBT, 16 * mt, 32, l15, l4), bb0 = trfrag(tBBT, 16 * mt, 0, l15, l4), bb1 = trfrag(tBBT, 16 * mt, 32, l15, l4);
            const bf16x8 w0 = ldsfrag(tW, 16 * mt + l15, 8 * l4), w1 = ldsfrag(tW, 16 * mt + l15, 32 + 8 * l4);
            const bf16x8 v0 = trfrag(tVT, 16 * mt, 0, l15, l4), v1 = trfrag(tVT, 16 * mt, 32, l15, l4), u0 = ldsfrag(tUL, 16 * mt + l15, 8 * l4), u1 = ldsfrag(tUL, 16 * mt + l15, 32 + 8 * l4);
            bf16* YRW = d == 0 ? (bf16*)(ws + R_YRW0) : (bf16*)((unsigned char*)F.out + DO_YRW1);
            bf16* RWTG = (bf16*)((unsigned char*)F.out + DO_CST);
#pragma unroll
            for (int q = 0; q < 2; ++q) { const int nt = nt0 + q;
                f32x4 acc = {0.f, 0.f, 0.f, 0.f};
                acc = MFMA16(k0, trfrag(tVT, 16 * nt, 0, l15, l4), acc); acc = MFMA16(k1, trfrag(tVT, 16 * nt, 32, l15, l4), acc);
                acc = MFMA16(bb0, ldsfrag(tUL, 16 * nt + l15, 8 * l4), acc); acc = MFMA16(bb1, ldsfrag(tUL, 16 * nt + l15, 32 + 8 * l4), acc);
                *(u32x2v*)(NCG + ((size_t)item * 64 + 16 * nt + l15) * 64 + 16 * mt + 4 * l4) = pk4(acc);
                f32x4 ac2 = {0.f, 0.f, 0.f, 0.f};
                ac2 = MFMA16(w0, trfrag(tBBT, 16 * nt, 0, l15, l4), ac2); ac2 = MFMA16(w1, trfrag(tBBT, 16 * nt, 32, l15, l4), ac2);
                *(u32x2v*)(LCT + ((size_t)item * 64 + 16 * nt + l15) * 64 + 32 * (mt >> 1) + 8 * l4 + 4 * (mt & 1)) = pk4(ac2);
                const bf16x8 ab0 = ldsfrag(tABRT, 16 * nt + l15, 8 * l4), ab1 = ldsfrag(tABRT, 16 * nt + l15, 32 + 8 * l4);
                { const u32x2v rr = *(const LAS u32x2v*)(tRT + (16 * nt + l15) * TP + 16 * mt + 4 * l4);
                  f32x4 a3 = {__uint_as_float(rr.x << 16), __uint_as_float(rr.x & 0xffff0000u), __uint_as_float(rr.y << 16), __uint_as_float(rr.y & 0xffff0000u)};
                  a3 = MFMA16(w0, ab0, a3); a3 = MFMA16(w1, ab1, a3);
                  *(u32x2v*)(RWTG + ((size_t)item * 64 + 16 * nt + l15) * 64 + 16 * mt + 4 * l4) = pk4(a3); }
                { f32x4 a4 = {0.f, 0.f, 0.f, 0.f};
                  a4 = MFMA16(v0, ldsfrag(tAKRT, 16 * nt + l15, 8 * l4), a4); a4 = MFMA16(v1, ldsfrag(tAKRT, 16 * nt + l15, 32 + 8 * l4), a4);
                  a4 = MFMA16(u0, ab0, a4); a4 = MFMA16(u1, ab1, a4);
                  int R, idx, len, sbase; rw_seq_rows(d, b, 64 * c + 16 * nt + l15, R, idx, len, sbase);
                  *(u32x2v*)(YRW + (size_t)R * 512 + h * 64 + 16 * mt + 4 * l4) = pk4(a4); }
            }
            if (tid < 64) PLG[(size_t)item * 64 + tid] = CLL[64 + tid];
        } else {
            {
                const bf16x8 a0 = ldsfrag(tW, 16 * mt + l15, 8 * l4), a1 = ldsfrag(tW, 16 * mt + l15, 32 + 8 * l4);
#pragma unroll
                for (int q = 0; q < 2; ++q) { const int nt = nt0 + q;
                    f32x4 acc = {0.f, 0.f, 0.f, 0.f};
                    acc = MFMA16(a0, __builtin_bit_cast(bf16x8, pf_s[2 * q]), acc); acc = MFMA16(a1, __builtin_bit_cast(bf16x8, pf_s[2 * q + 1]), acc);
                    LAS u32x2v* up = (LAS u32x2v*)(tUL + (16 * nt + l15) * TP + 16 * mt + 4 * l4); const u32x2v ul = *up;
                    acc[0] += __uint_as_float(ul.x << 16); acc[1] += __uint_as_float(ul.x & 0xffff0000u); acc[2] += __uint_as_float(ul.y << 16); acc[3] += __uint_as_float(ul.y & 0xffff0000u);
                    *up = pk4(acc);
                }
            }
            RWC_BAR();
            {
                bf16* YRW = d == 0 ? (bf16*)(ws + R_YRW0) : (bf16*)((unsigned char*)F.out + DO_YRW1);
                const bf16x8 s0 = __builtin_bit_cast(bf16x8, pf_s[4]), s1 = __builtin_bit_cast(bf16x8, pf_s[5]);
                const bf16x8 v0 = trfrag(tVT, 16 * mt, 0, l15, l4), v1 = trfrag(tVT, 16 * mt, 32, l15, l4), u0 = ldsfrag(tUL, 16 * mt + l15, 8 * l4), u1 = ldsfrag(tUL, 16 * mt + l15, 32 + 8 * l4);
#pragma unroll
                for (int q = 0; q < 2; ++q) { const int nt = nt0 + q;
                    f32x4 acc = {0.f, 0.f, 0.f, 0.f};
                    acc = MFMA16(s0, ldsfrag(tRT, 16 * nt + l15, 8 * l4), acc); acc = MFMA16(s1, ldsfrag(tRT, 16 * nt + l15, 32 + 8 * l4), acc);
                    acc = MFMA16(v0, ldsfrag(tAKRT, 16 * nt + l15, 8 * l4), acc); acc = MFMA16(v1, ldsfrag(tAKRT, 16 * nt + l15, 32 + 8 * l4), acc);
                    acc = MFMA16(u0, ldsfrag(tABRT, 16 * nt + l15, 8 * l4), acc); acc = MFMA16(u1, ldsfrag(tABRT, 16 * nt + l15, 32 + 8 * l4), acc);
                    int R, idx, len, sbase; rw_seq_rows(d, b, 64 * c + 16 * nt + l15, R, idx, len, sbase);
                    *(u32x2v*)(YRW + (size_t)R * 512 + h * 64 + 16 * mt + 4 * l4) = pk4(acc);
                }
            }
        }
        STG(9);
    }
#ifdef TS_RWC
    if (MODE == TS_RWC - 1 && blockIdx.x == 0 && F.tid == 0) { unsigned long long* ts = (unsigned long long*)(ws + WS_CTL + 512 * 1024); for (int k = 0; k < 11; ++k) ts[40 + k] = tst[k] / 10; }
#endif
#undef STG
#undef RWC_PREFETCH
#undef RWC_LOADRAW
#undef RWC_BAR
    __syncthreads();
}

#ifdef TS_PASSB
#define TSB(...) __VA_ARGS__
#else
#define TSB(...)
#endif
__device__ __forceinline__ void rw_pass_b(Frame& F, const Args& A) {
    constexpr int TP = 72, SLOT = 2 * 64 * TP * 2 + 256;
    unsigned char* ws = F.ws;
    const bf16* LCT = (const bf16*)(ws + RW_LCT); const bf16* NCG = (const bf16*)(ws + RW_NC); const float* PLG = (const float*)(ws + RW_PL);
    const int lane = F.lane, w = F.wave, l15 = lane & 15, l4 = lane >> 4;
    const bool spread = (F.G >= 256) && (F.G % 2 == 0);
    const int pair0 = spread ? ((F.vcu & 1) ? 4 * NCHAIN_RW : (F.vcu >> 1)) : F.vcu, pstep = spread ? (F.G >> 1) : F.G;
#define RWB_BAR() asm volatile("s_waitcnt lgkmcnt(0)\n\ts_barrier" ::: "memory")
    for (int pair = pair0; pair < 4 * NCHAIN_RW; pair += pstep) {
        const int chain = pair >> 2, nt = pair & 3;
        const size_t it0 = (size_t)chain * RW_NCH;
        __syncthreads();
        if (w == 0) {
            f32x4 acc[4];
#pragma unroll
            for (int m = 0; m < 4; ++m) acc[m] = (f32x4){0.f, 0.f, 0.f, 0.f};
            bf16* sg = (bf16*)(ws + RW_NC) + it0 * 4096 + (size_t)(16 * nt + l15) * 64 + 4 * l4; const size_t sdummy = ((size_t)RW_NITEM - it0) * 4096;
            struct OpRegs { bf16x8 a[4][2]; f32x4 pl[4]; u32x2v nc[4]; };
            OpRegs RA, RB;
#define RWB_FETCH(R, slot) do { const LAS bf16* Ls = (const LAS bf16*)(F.lds + (slot) * SLOT); const LAS bf16* Ns = Ls + 64 * TP; const LAS float* Ps = (const LAS float*)(F.lds + (slot) * SLOT + 2 * 64 * TP * 2); \
            _Pragma("unroll") for (int m = 0; m < 4; ++m) { R.a[m][0] = ldsfrag(Ls, 16 * m + l15, 8 * l4); R.a[m][1] = ldsfrag(Ls, 16 * m + l15, 32 + 8 * l4); \
                R.pl[m] = *(const LAS f32x4*)(Ps + 16 * m + 4 * l4); R.nc[m] = *(const LAS u32x2v*)(Ns + l15 * TP + 16 * m + 4 * l4); } } while (0)
#define RWB_STEP(CUR, NXT, cc, nslot) do { u32x2v sb[4]; TSB(tq0 = __builtin_amdgcn_s_memtime(); tacc2 += tq0 - tq2;) \
            _Pragma("unroll") for (int m = 0; m < 4; ++m) { sb[m] = pk4(acc[m]); *(u32x2v*)(sg + ((cc) > 0 ? (size_t)((cc) - 1) * 4096 : sdummy) + 16 * m) = sb[m]; } \
            const v4u q0 = {sb[0].x, sb[0].y, sb[1].x, sb[1].y}, q1 = {sb[2].x, sb[2].y, sb[3].x, sb[3].y}; \
            const bf16x8 b0 = __builtin_bit_cast(bf16x8, q0), b1 = __builtin_bit_cast(bf16x8, q1); \
            f32x4 dl[4]; \
            _Pragma("unroll") for (int m = 0; m < 4; ++m) { dl[m] = (f32x4){0.f, 0.f, 0.f, 0.f}; dl[m] = MFMA16(CUR.a[m][0], b0, dl[m]); dl[m] = MFMA16(CUR.a[m][1], b1, dl[m]); } \
            TSB(asm volatile("" :: "v"(dl[0]), "v"(dl[1]), "v"(dl[2]), "v"(dl[3])); tq1 = __builtin_amdgcn_s_memtime(); tacc0 += tq1 - tq0;) RWB_BAR(); TSB(tq2 = __builtin_amdgcn_s_memtime(); tacc1 += tq2 - tq1;) RWB_FETCH(NXT, nslot); \
            _Pragma("unroll") for (int m = 0; m < 4; ++m) { \
                acc[m][0] = acc[m][0] * CUR.pl[m][0] + dl[m][0] + __uint_as_float(CUR.nc[m].x << 16); acc[m][1] = acc[m][1] * CUR.pl[m][1] + dl[m][1] + __uint_as_float(CUR.nc[m].x & 0xffff0000u); \
                acc[m][2] = acc[m][2] * CUR.pl[m][2] + dl[m][2] + __uint_as_float(CUR.nc[m].y << 16); acc[m][3] = acc[m][3] * CUR.pl[m][3] + dl[m][3] + __uint_as_float(CUR.nc[m].y & 0xffff0000u); } } while (0)
            RWB_BAR();
            TSB(unsigned long long tq0 = 0, tq1 = 0, tq2 = __builtin_amdgcn_s_memtime(), tacc0 = 0, tacc1 = 0, tacc2 = 0;)
            RWB_FETCH(RA, 0);
            for (int c6 = 0; c6 < RW_NCH; c6 += 6) {
                RWB_STEP(RA, RB, c6 + 0, 1); RWB_STEP(RB, RA, c6 + 1, 2); RWB_STEP(RA, RB, c6 + 2, 0);
                RWB_STEP(RB, RA, c6 + 3, 1); RWB_STEP(RA, RB, c6 + 4, 2); RWB_STEP(RB, RA, c6 + 5, 0);
            }
            TSB(if (blockIdx.x == 0 && F.tid == 0) { unsigned long long* ts = (unsigned long long*)(ws + WS_CTL + 512 * 1024); ts[40] = tacc0 / 10; ts[41] = tacc1 / 10; ts[42] = tacc2 / 10; })
#undef RWB_FETCH
#undef RWB_STEP
        } else if (w < 4) {
            RWB_BAR();
            for (int c = 0; c < RW_NCH; ++c) RWB_BAR();
        } else {
            const int t = F.tid - 256, row = t >> 2, cp = (t & 3) * 16;
            v4u L0[6], L1[6], N0[6], P0[6];
#define RWB_LOADG(k, cc) do { const size_t it_ = it0 + ((cc) < RW_NCH ? (cc) : RW_NCH - 1); \
            L0[k] = *(const GAS v4u*)(LCT + it_ * 4096 + t * 16); L1[k] = *(const GAS v4u*)(LCT + it_ * 4096 + t * 16 + 8); \
            if (t < 128) N0[k] = *(const GAS v4u*)(NCG + (it_ * 64 + 16 * nt + (t >> 3)) * 64 + 8 * (t & 7)); \
            if (t < 16) P0[k] = *(const GAS v4u*)(PLG + it_ * 64 + 4 * t); } while (0)
#define RWB_WRITEL(k, slot) do { LAS bf16* Ls = (LAS bf16*)(F.lds + (slot) * SLOT); LAS bf16* Ns = Ls + 64 * TP; \
            *(LAS v4u*)(Ls + row * TP + cp) = L0[k]; *(LAS v4u*)(Ls + row * TP + cp + 8) = L1[k]; if (t < 128) *(LAS v4u*)(Ns + (t >> 3) * TP + 8 * (t & 7)) = N0[k]; \
            if (t < 16) *(LAS v4u*)(F.lds + (slot) * SLOT + 2 * 64 * TP * 2 + 16 * t) = P0[k]; } while (0)
#pragma unroll
            for (int k = 0; k < 6; ++k) RWB_LOADG(k, k);
            RWB_WRITEL(0, 0); RWB_LOADG(0, 6); RWB_WRITEL(1, 1); RWB_LOADG(1, 7);
            RWB_BAR();
            TSB(unsigned long long lq0 = 0, lq1 = 0, lq2 = __builtin_amdgcn_s_memtime(), lacc0 = 0, lacc1 = 0, lacc2 = 0;)
            for (int c6 = 0; c6 < RW_NCH; c6 += 6) {
#pragma unroll
                for (int k = 0; k < 6; ++k) {
                    TSB(lq0 = __builtin_amdgcn_s_memtime(); lacc2 += lq0 - lq2;) RWB_BAR(); TSB(lq1 = __builtin_amdgcn_s_memtime(); lacc0 += lq1 - lq0;)
                    RWB_WRITEL((k + 2) % 6, (k + 2) % 3); TSB(asm volatile("s_waitcnt lgkmcnt(0)" ::: "memory"); lq2 = __builtin_amdgcn_s_memtime(); lacc1 += lq2 - lq1;) RWB_LOADG((k + 2) % 6, c6 + k + 8);
                }
            }
            TSB(if (blockIdx.x == 0 && t == 0) { unsigned long long* ts = (unsigned long long*)(ws + WS_CTL + 512 * 1024); ts[44] = lacc0 / 10; ts[45] = lacc1 / 10; ts[46] = lacc2 / 10; })
#undef RWB_LOADG
#undef RWB_WRITEL
        }
    }
#undef RWB_BAR
    __syncthreads();
}

__device__ __forceinline__ void rw_pass_c2(Frame& F, const Args& A) {
    unsigned char* ws = F.ws;
    const bf16* NCG = (const bf16*)(ws + RW_NC); const bf16* RWTG = (const bf16*)((unsigned char*)F.out + DO_CST);
    const int lane = F.lane, l15 = lane & 15, l4 = lane >> 4;
    const int gw = F.vcu * NWAVES + F.wave, nw = F.G * NWAVES;
    for (int u = gw; u < RW_NITEM * 4; u += nw) {
        const int item = u >> 2, nt = u & 3;
        const int chain = item / RW_NCH, c = item % RW_NCH, d = chain >> 4, b = (chain >> 3) & 1, h = chain & 7;
        if (c == 0) continue;
        bf16* YRW = d == 0 ? (bf16*)(ws + R_YRW0) : (bf16*)((unsigned char*)F.out + DO_YRW1);
        int R, idx, len, sbase; rw_seq_rows(d, b, 64 * c + 16 * nt + l15, R, idx, len, sbase);
        bf16* yp = YRW + (size_t)R * 512 + h * 64 + 4 * l4;
        const bf16* rp = RWTG + ((size_t)item * 64 + 16 * nt + l15) * 64 + 8 * l4;
        const bf16* sp = NCG + (size_t)(item - 1) * 4096 + l15 * 64 + 8 * l4;
        const v4u b0 = *(const GAS v4u*)rp, b1 = *(const GAS v4u*)(rp + 32);
        v4u a0[4], a1[4]; u32x2v ci[4];
#pragma unroll
        for (int mt = 0; mt < 4; ++mt) { a0[mt] = *(const GAS v4u*)(sp + mt * 1024); a1[mt] = *(const GAS v4u*)(sp + mt * 1024 + 32); ci[mt] = *(const GAS u32x2v*)(yp + 16 * mt); }
#pragma unroll
        for (int mt = 0; mt < 4; ++mt) {
            f32x4 acc = {__uint_as_float(ci[mt].x << 16), __uint_as_float(ci[mt].x & 0xffff0000u), __uint_as_float(ci[mt].y << 16), __uint_as_float(ci[mt].y & 0xffff0000u)};
            acc = MFMA16(__builtin_bit_cast(bf16x8, a0[mt]), __builtin_bit_cast(bf16x8, b0), acc); acc = MFMA16(__builtin_bit_cast(bf16x8, a1[mt]), __builtin_bit_cast(bf16x8, b1), acc);
            *(u32x2v*)(yp + 16 * mt) = pk4(acc);
        }
    }
    __syncthreads();
}
#ifndef MK_N_LAUNCHES
#define MK_N_LAUNCHES 1
#endif
constexpr int NPHASE = 23;
#ifndef PHMASK
#define PHMASK 0xffffffffu
#endif
#define PH_ON(k) (((PHMASK) >> (k)) & 1u)
__global__ void __launch_bounds__(NTHREADS, 2) mk_fwd(Args args) {
    extern __shared__ __attribute__((aligned(16))) unsigned char lds[];
    Frame F;
    F.lds = (LAS unsigned char*)lds;
    F.MISC = (volatile LAS unsigned*)(F.lds + MISC_OFF);
    F.tid = threadIdx.x; F.lane = F.tid & 63; F.wave = __builtin_amdgcn_readfirstlane(F.tid >> 6);
    F.G = gridDim.x; { const int bx = blockIdx.x; F.vcu = (F.G % 8 == 0) ? (bx % 8) * (F.G / 8) + bx / 8 : bx; }
    F.ws = args.ws; F.out = args.out; const Args& A = args;
    unsigned char* ws = args.ws;
    F.ctl = (gu32*)(ws + WS_CTL);
    for (int u = F.tid; u < (LDS_BYTES - LDSCTL_OFF) / 4; u += NTHREADS) ((LAS unsigned*)(F.lds + LDSCTL_OFF))[u] = 0u;
    __syncthreads();
    const bool use_bar = (args.ph_hi - args.ph_lo) > 1;
    XcdBarrier bar; bar.bar = (unsigned*)(F.ctl + CW_BAR) + args.li * XCD_BAR_WORDS; bar.x = 0; bar.st = nullptr;
    if (use_bar) bar = xcd_barrier_post((unsigned*)(F.ctl + CW_BAR) + args.li * XCD_BAR_WORDS, F.MISC + 8);
    const float* MOD = (const float*)(ws + WS_MOD);
    bf16* XN = (bf16*)(ws + WS_XN);
    float* XC = (float*)(ws + WS_XC);
    const int bid = (int)blockIdx.x;
    const int lo = args.ph_lo, hi = args.ph_hi;
#define IN(k) (PH_ON(k) && lo <= (k) && (k) < hi)
#ifdef TS_A
#define TSTAMP(i) do { if (blockIdx.x == TS_BLK && F.tid == 0) ((unsigned long long*)(ws + WS_CTL + 512 * 1024))[i] = __builtin_amdgcn_s_memrealtime(); } while (0)
#else
#define TSTAMP(i) do {} while (0)
#endif
#ifndef TS_OFF
#define TS_OFF 0
#endif
#ifndef TS_BLK
#define TS_BLK 0
#endif
#define SEAM(k) do { if ((k) + 1 < hi) xcd_barrier(bar); TSTAMP((k) + 1); } while (0)
    TSTAMP(0);
    if (IN(0)) { p0_prologue(F, A); SEAM(0); }
    if (IN(1)) { p1_mod_finalize(F, A); SEAM(1); }
    if (IN(2)) { norm_rows(F, A, A.in[I_X], A.in[I_CTX], MA_ROWS, A.in[I_NORM_MIX], MOD, 0, 1, XN); SEAM(2); }
    if (IN(3)) { { const pg8::RecInDst rd{(bf16*)(ws + R_QM), (R_KM - R_QM) / 2, (R_VM - R_QM) / 2, (R_OM - R_QM) / 2, (bf16*)(ws + R_RAW), (bf16*)(ws + R_TWAD), (bf16*)(ws + R_SGD), (float*)(ws + R_GATES)};
            { pg8::Gemm g{XN, (const bf16*)(ws + WS_WREC), ML_ROWS, REC_N, D}; pg8::StaticOrder S; S.init(ML_ROWS, REC_N, F.G, bid);
              pg8::EpiRecIn E{rd};
              pg8::gemm_phase<pg8::EpiRecIn, pg8::StaticOrder, true, true>(F.lds + RING_OFF, g, S, E); }
            ctx_gemm2(F, XN + (size_t)ML_ROWS * D, D, (const bf16*)(ws + WS_WREC), D, MC_ROWS, REC_N, D, [=](int row, int col, float v) { pg8::recin_store1(rd, (size_t)(ML_ROWS + row), col, v); });
        } SEAM(3); }
    if (IN(4)) { ml_pass_a(F, A); p0_weights_tail<3>(F, A, NITEM_ML, F.vcu); SEAM(4); }
    if (IN(5)) { ml_pass_b(F, A); SEAM(5); }
    if (IN(6)) { ml_pass_c(F, A); p0_weights_tail<4>(F, A, NITEM_ML, F.vcu); SEAM(6); }
    if (IN(7)) { rw_chunk_pass<0>(F, A); SEAM(7); }
    if (IN(8)) { rw_pass_b(F, A);
            { const bool spread = (F.G >= 256) && (F.G % 2 == 0);
              if (!spread || (F.vcu & 1)) {
                int kg = 128; asm volatile("" : "+s"(kg)); pg8::Gemm g{(const bf16*)(ws + R_SGD), (const bf16*)(ws + WS_WG2), MA_ROWS, 512, kg}; pg8::StaticOrder S; S.init(MA_ROWS, 512, spread ? F.G / 2 : F.G, spread ? (F.vcu >> 1) : F.vcu);
                pg8::EpiStoreBf16<1536> E{(bf16*)(ws + R_RAW), 0, 1.f};
                pg8::gemm_phase<pg8::EpiStoreBf16<1536>, pg8::StaticOrder, true, true>(F.lds + RING_OFF, g, S, E); } }
        SEAM(8); }
    if (IN(9)) { rw_pass_c2(F, A); SEAM(9); }
    if (IN(10)) { merge_rows(F, A); SEAM(10); }
    if (IN(11)) { { pg8::Gemm g{(const bf16*)(ws + R_MIX), (const bf16*)(ws + WS_WOUT), ML_ROWS, D, D}; pg8::StaticOrder S; S.init(ML_ROWS, D, F.G, bid);
            pg8::EpiResid E{A.in[I_X], A.in[I_CTX], F.out, XC, MOD + 2 * 1024};
            pg8::gemm_phase<pg8::EpiResid, pg8::StaticOrder, true, true>(F.lds + RING_OFF, g, S, E);
            { const float* src = A.in[I_CTX]; const float* gate = MOD + 2 * 6144 + 2 * 1024;
              ctx_gemm2(F, (const bf16*)(ws + R_MIX) + (size_t)ML_ROWS * D, D, (const bf16*)(ws + WS_WOUT), D, MC_ROWS, D, D, [=](int row, int col, float v) { XC[(size_t)row * D + col] = src[(size_t)row * D + col] + gate[col] * v; }); } } SEAM(11); }
    if (IN(12)) { norm_rows(F, A, F.out, XC, MA_ROWS, A.in[I_NORM_FFN], MOD, 3, 4, XN); SEAM(12); }
    if (IN(13)) { { pg8::Gemm g{XN, (const bf16*)(ws + WS_W1), MA_ROWS, FF, D}; pg8::StaticOrder S; S.init(MA_ROWS, FF, F.G, bid);
            pg8::EpiSqRelu<FF> E{(bf16*)(ws + R_H)};
            pg8::gemm_phase<pg8::EpiSqRelu<FF>, pg8::StaticOrder, true, true>(F.lds + RING_OFF, g, S, E);
            p0_weights_tail<1>(F, A, (MA_ROWS / 256) * (FF / 256), bid); } SEAM(13); }
    if (IN(14)) { { pg8::Gemm g{(const bf16*)(ws + R_H), (const bf16*)(ws + WS_W2), ML_ROWS, D, FF}; pg8::StaticOrder S; S.init(ML_ROWS, D, F.G, bid);
            pg8::EpiResid E{F.out, XC, F.out, XC, MOD + 5 * 1024};
            pg8::gemm_phase<pg8::EpiResid, pg8::StaticOrder, true, true>(F.lds + RING_OFF, g, S, E);
            { const float* gate = MOD + 2 * 6144 + 5 * 1024; TSTAMP(40);
              ctx_gemm(F, (const bf16*)(ws + R_H) + (size_t)ML_ROWS * FF, FF, (const bf16*)(ws + WS_W2), FF, MC_ROWS, D, FF, [=](int row, int col, float v) { XC[(size_t)row * D + col] += gate[col] * v; }); TSTAMP(41); } } SEAM(14); }
    if (IN(15)) { norm_rows(F, A, F.out, XC, MA_ROWS, A.in[I_NORM_MIX] + D, MOD + 3 * 6144, 0, 1, XN); SEAM(15); }
    if (IN(16)) { { pg8::Gemm g{XN, (const bf16*)(ws + WS_WATT), MA_ROWS, ATT_N, D}; pg8::StaticOrder S; S.init(MA_ROWS, ATT_N, F.G, bid);
            pg8::EpiStoreBf16<ATT_N> E{(bf16*)(ws + R_ATT), 0, 1.f};
            pg8::gemm_phase<pg8::EpiStoreBf16<ATT_N>, pg8::StaticOrder, true, true>(F.lds + RING_OFF, g, S, E);
            p0_weights_tail<2>(F, A, (MA_ROWS / 256) * (ATT_N / 256), bid); } SEAM(16); }
    if (IN(17)) { qk_prep(F, A); SEAM(17); }
    if (IN(18)) { attn_phase(F, A, (char*)lds + RING_OFF); SEAM(18); }
    if (IN(19)) { { pg8::Gemm g{(const bf16*)(ws + R_QB), (const bf16*)(ws + WS_WOUT) + (size_t)D * D, ML_ROWS, D, D}; pg8::StaticOrder S; S.init(ML_ROWS, D, F.G, bid);
            pg8::EpiResid E{F.out, XC, F.out, XC, MOD + 3 * 6144 + 2 * 1024};
            pg8::gemm_phase<pg8::EpiResid, pg8::StaticOrder, true, true>(F.lds + RING_OFF, g, S, E); } SEAM(19); }
    if (IN(20)) { norm_rows(F, A, F.out, XC, ML_ROWS, A.in[I_NORM_FFN] + D, MOD + 3 * 6144, 3, 4, XN); SEAM(20); }
    if (IN(21)) { { pg8::Gemm g{XN, (const bf16*)(ws + WS_W1) + (size_t)D * FF, ML_ROWS, FF, D}; pg8::StaticOrder S; S.init(ML_ROWS, FF, F.G, bid);
            pg8::EpiSqRelu<FF> E{(bf16*)(ws + R_H)};
            pg8::gemm_phase<pg8::EpiSqRelu<FF>, pg8::StaticOrder, true, true>(F.lds + RING_OFF, g, S, E); } SEAM(21); }
    if (IN(22)) { { pg8::Gemm g{(const bf16*)(ws + R_H), (const bf16*)(ws + WS_W2) + (size_t)D * FF, ML_ROWS, D, FF}; pg8::StaticOrder S; S.init(ML_ROWS, D, F.G, bid);
            pg8::EpiResid E{F.out, XC, F.out, XC, MOD + 3 * 6144 + 5 * 1024};
            pg8::gemm_phase<pg8::EpiResid, pg8::StaticOrder, true, true>(F.lds + RING_OFF, g, S, E); } SEAM(22); }
#ifdef TS_A
    if (blockIdx.x == TS_BLK && F.tid == 0) { const unsigned long long* ts = (const unsigned long long*)(ws + WS_CTL + 512 * 1024);
        __builtin_amdgcn_s_waitcnt(0); F.out[0] += ((float)(ts[TS_B] - ts[TS_A]) - (float)(TS_OFF)) * 0.001f; }
#endif
#undef IN
#undef SEAM
}

extern "C" void kernel_launch(void* const* d_in, const int* in_sizes, int n_in, void* d_out, int out_size, void* d_ws, size_t ws_size, hipStream_t stream) {
    static int grid = 0;
    if (grid == 0) {
        if (n_in != N_IN || out_size != ML_ROWS * D || ws_size < WS_END) { fprintf(stderr, "kernel_launch: unexpected shapes (n_in %d, out %d, ws %zu); nothing launched\n", n_in, out_size, ws_size); grid = -1; return; }
        int dev = 0, cus = 0, per_cu = 0;
        if (hipGetDevice(&dev) != hipSuccess || hipDeviceGetAttribute(&cus, hipDeviceAttributeMultiprocessorCount, dev) != hipSuccess) { grid = -1; return; }
        if (hipFuncSetAttribute((const void*)mk_fwd, hipFuncAttributeMaxDynamicSharedMemorySize, LDS_BYTES) != hipSuccess) { fprintf(stderr, "kernel_launch: hipFuncSetAttribute failed\n"); grid = -1; return; }
        if (hipOccupancyMaxActiveBlocksPerMultiprocessor(&per_cu, (const void*)mk_fwd, NTHREADS, LDS_BYTES) != hipSuccess || per_cu < 1) { fprintf(stderr, "kernel_launch: occupancy query says %d blocks per CU\n", per_cu); per_cu = 1; }
        (void)hipGetLastError();
        grid = cus;
    }
    if (grid < 0) return;
    (void)hipMemsetAsync((char*)d_ws + WS_CTL, 0, CTL_ZERO_BYTES, stream);
    Args a{};
    for (int i = 0; i < N_IN; ++i) a.in[i] = (const float*)d_in[i];
    a.out = (float*)d_out; a.ws = (unsigned char*)d_ws;
#if MK_N_LAUNCHES == 1
    a.ph_lo = 0; a.ph_hi = NPHASE; a.li = 0;
    { void* kargs[] = {&a}; hipError_t e = hipLaunchCooperativeKernel((const void*)mk_fwd, dim3(grid), dim3(NTHREADS), kargs, LDS_BYTES, stream);
      if (e != hipSuccess) fprintf(stderr, "kernel_launch: cooperative launch failed: %s\n", hipGetErrorString(e)); }
#else
    for (int p = 0; p < NPHASE; ++p) { a.ph_lo = p; a.ph_hi = p + 1; a.li = 0; hipLaunchKernelGGL(mk_fwd, dim3(grid), dim3(NTHREADS), LDS_BYTES, stream, a); }
#endif
}
```

```cpp
#include <hip/hip_runtime.h>
#include <hip/hip_bf16.h>
#include <cstdio>
#include <cstdint>
#include <cmath>
namespace pg8 {
#define PG8_LAS __attribute__((address_space(3)))
typedef unsigned short bf16_t;
typedef short bf16x8 __attribute__((ext_vector_type(8)));
typedef float f32x4 __attribute__((ext_vector_type(4)));
typedef unsigned u32x4 __attribute__((ext_vector_type(4)));
constexpr int BM = 256, BK = 64, HALF = 128, HTB = HALF * BK * 2  , STAGE_BYTES = 8 * HTB, NXCD = 8, WGM = 8;

__host__ __device__ __forceinline__ int lds_byte(int r, int c) { const int st = (r >> 4) * 2 + (c >> 5), rr = r & 15, cc = c & 31, ob = rr * 64 + cc * 2; return st * 1024 + (ob ^ (((ob >> 9) & 1) << 5)); }
__host__ __device__ __forceinline__ void stage_rc(int b, int& R, int& C) { const int st = b / 1024, sb = b % 1024, swz = sb ^ (((sb >> 9) & 1) << 5); R = (st >> 1) * 16 + swz / 64; C = (st & 1) * 32 + (swz % 64) / 2; }
__host__ __device__ __forceinline__ int perm32(int rho) { const int n = rho >> 4, i = rho & 15; return 8 * (i >> 2) + 4 * n + (i & 3); }

struct Unit { int pm, pn; };
struct Gemm { const bf16_t* A; const bf16_t* Bt; int M, N, K; };

struct StaticOrder {
    int nM, nN, nwg, G, c;
    __host__ __device__ void init(int M, int N, int G_, int c_) { nM = M / BM; nN = N / BM; nwg = nM * nN; G = G_; c = c_; }
    __host__ __device__ bool next(int i, Unit& u) const {
        const long L = (long)i * G + c; if (L >= nwg) return false;
        int wgid = (int)L; { const int q = nwg / NXCD, r = nwg % NXCD, xcd = wgid % NXCD, off = wgid / NXCD; wgid = (xcd < r ? xcd * (q + 1) : r * (q + 1) + (xcd - r) * q) + off; }
        const int nig = WGM * nN, gid = wgid / nig, fm = gid * WGM, gsz = (nM - fm) < WGM ? (nM - fm) : WGM;
        u.pm = fm + ((wgid % nig) % gsz); u.pn = (wgid % nig) / gsz; return true;
    }
    __device__ __forceinline__ void a_ready(const Unit&) const {}
    __device__ __forceinline__ void done(const Unit&) const {}
};

__device__ __forceinline__ unsigned cvt_pk_bf16(float lo, float hi) { unsigned r; asm volatile("v_cvt_pk_bf16_f32 %0, %1, %2" : "=v"(r) : "v"(lo), "v"(hi)); return r; }
typedef float f32x2 __attribute__((ext_vector_type(2)));
__device__ __forceinline__ f32x2 gelu_pk(f32x2 v) {
    const f32x2 av = __builtin_elementwise_abs(v), d = av * 0.2316418882f + 1.0f;
    f32x2 t; t.x = __builtin_amdgcn_rcpf(d.x); t.y = __builtin_amdgcn_rcpf(d.y);
    f32x2 q = t * 0.5307027145f + (-0.7265760135f); q = q * t + 0.7107068705f; q = q * t + (-0.142248368f); q = q * t + 0.127414796f; q = q * t;
    const f32x2 s = (v * v) * (-0.72134752044f);
    f32x2 e; e.x = __builtin_amdgcn_exp2f(s.x); e.y = __builtin_amdgcn_exp2f(s.y);
    const f32x2 m = v * (q * e), r = v - m;
    f32x2 o; o.x = v.x < 0.f ? m.x : r.x; o.y = v.y < 0.f ? m.y : r.y; return o;
}

template <int ACT  > struct EpiBf16 {
    static constexpr bool PERM = true, AFTER_DRAIN = false; static_assert(ACT == 0 || ACT == 1, "EpiBf16: ACT is 0 (none) or 1 (gelu_pk)");
    bf16_t* O; int ldc; const float* bias; int split_cols; size_t split_stride; float scale0;
    __device__ __forceinline__ void operator()(const f32x4 (&acc)[2][2][4][2], const Unit& u, int wr, int wc, int fr, int fq) const {
        const int row0 = u.pm * BM + wr * 64 + fr; int colt = u.pn * BM; bf16_t* base = O;
        float sc = 1.f; if (split_cols) { const int t = colt / split_cols; base += (size_t)t * split_stride; colt -= t * split_cols; if (t == 0) sc = scale0; }
        const int col0 = colt + wc * 32 + 8 * fq, bcol0 = u.pn * BM + wc * 32 + 8 * fq;
        f32x4 bv[2][2];
#pragma unroll
        for (int bj = 0; bj < 2; ++bj)
#pragma unroll
            for (int n = 0; n < 2; ++n) bv[bj][n] = bias ? *(const f32x4*)(bias + bcol0 + bj * HALF + 4 * n) : (f32x4){0.f, 0.f, 0.f, 0.f};
#pragma unroll
        for (int ai = 0; ai < 2; ++ai)
#pragma unroll
            for (int m = 0; m < 4; ++m) { bf16_t* rowp = base + (size_t)(row0 + ai * HALF + m * 16) * ldc + col0;
#pragma unroll
                for (int bj = 0; bj < 2; ++bj) { f32x4 v0 = acc[ai][bj][m][0] + bv[bj][0], v1 = acc[ai][bj][m][1] + bv[bj][1];
                    if (ACT == 1) { f32x2 a = gelu_pk((f32x2){v0[0], v0[1]}), b = gelu_pk((f32x2){v0[2], v0[3]}), c = gelu_pk((f32x2){v1[0], v1[1]}), d = gelu_pk((f32x2){v1[2], v1[3]});
                        v0 = (f32x4){a.x, a.y, b.x, b.y}; v1 = (f32x4){c.x, c.y, d.x, d.y}; }
                    v0 = v0 * sc; v1 = v1 * sc; u32x4 w; w.x = cvt_pk_bf16(v0[0], v0[1]); w.y = cvt_pk_bf16(v0[2], v0[3]); w.z = cvt_pk_bf16(v1[0], v1[1]); w.w = cvt_pk_bf16(v1[2], v1[3]);
                    *(u32x4*)(rowp + bj * HALF) = w; } }
    }
};

struct PanelStats {
    unsigned* xbuf;
    unsigned* cnt;
    unsigned* tmo;
    int ntn; float eps;
    unsigned code;
    __device__ __forceinline__ bool run(const f32x4 (&v)[2][2][4][2], const Unit& u, int wr, int wc, int fr, int fq, PG8_LAS unsigned char* lds, int wid, int lane) const {
        typedef float f32x2v __attribute__((ext_vector_type(2)));
        PG8_LAS f32x2v* P = (PG8_LAS f32x2v*)lds;
        PG8_LAS f32x2v* S = (PG8_LAS f32x2v*)(lds + 8192);
        PG8_LAS unsigned* flag = (PG8_LAS unsigned*)(lds + 8192 + 2048);
#pragma unroll
        for (int ai = 0; ai < 2; ++ai)
#pragma unroll
            for (int m = 0; m < 4; ++m) {
                float s = 0.f;
#pragma unroll
                for (int bj = 0; bj < 2; ++bj)
#pragma unroll
                    for (int n = 0; n < 2; ++n) { const f32x4 x = v[ai][bj][m][n]; s += (x[0] + x[1]) + (x[2] + x[3]); }
                s += __shfl_xor(s, 16); s += __shfl_xor(s, 32);
                const float mw = s * (1.0f / 64.0f); float q = 0.f;
#pragma unroll
                for (int bj = 0; bj < 2; ++bj)
#pragma unroll
                    for (int n = 0; n < 2; ++n) { const f32x4 d = v[ai][bj][m][n] - mw; q += (d[0] * d[0] + d[1] * d[1]) + (d[2] * d[2] + d[3] * d[3]); }
                q += __shfl_xor(q, 16); q += __shfl_xor(q, 32);
                if (fq == 0) P[(ai * HALF + wr * 64 + m * 16 + fr) * 4 + wc] = (f32x2v){mw, q};
            }
        asm volatile("s_waitcnt lgkmcnt(0)" ::: "memory"); __builtin_amdgcn_s_barrier(); asm volatile("" ::: "memory");
#if defined(BROKEN_EXCHANGE_NO_WAIT)
#warning BROKEN CONTROL BUILD: the row-statistics exchange does not wait; results are wrong by design
        if (blockIdx.x >= 64) { const long long t0_ = clock64(); while (clock64() - t0_ < 60000) __builtin_amdgcn_s_sleep(8); }
#endif
        const int row = wid * 32 + (lane & 31);
        if (lane < 32) {
            const f32x2v a = P[row * 4 + 0], b = P[row * 4 + 1], c = P[row * 4 + 2], d = P[row * 4 + 3];
            const float mt = (a.x + b.x + c.x + d.x) * 0.25f;
            const float da = a.x - mt, db = b.x - mt, dc = c.x - mt, dd = d.x - mt;
            const float m2 = (a.y + b.y) + (c.y + d.y) + 64.0f * ((da * da + db * db) + (dc * dc + dd * dd));
            unsigned long long* slot = (unsigned long long*)xbuf + ((size_t)(u.pm * BM + row) * 4 + u.pn);
            __hip_atomic_store(slot, ((unsigned long long)__float_as_uint(m2) << 32) | __float_as_uint(mt), __ATOMIC_RELAXED, __HIP_MEMORY_SCOPE_AGENT);
        }
        asm volatile("s_waitcnt vmcnt(0)" ::: "memory");
        if (lane == 0) __hip_atomic_fetch_add(cnt + 64 * u.pm, 1u, __ATOMIC_RELAXED, __HIP_MEMORY_SCOPE_AGENT);
        if (wid == 0) {
            bool dead = false; const unsigned long long t0 = __builtin_amdgcn_s_memrealtime(); const unsigned want = 8u * (unsigned)ntn;
            for (;;) {
#if defined(BROKEN_EXCHANGE_NO_WAIT)
                break;
#endif
                if ((unsigned)__builtin_amdgcn_readfirstlane(__hip_atomic_load(cnt + 64 * u.pm, __ATOMIC_RELAXED, __HIP_MEMORY_SCOPE_AGENT)) >= want) break;
                if (__builtin_amdgcn_s_memrealtime() - t0 > 2000000ull) {
                    if (lane == 0) { unsigned expect = 0u; __hip_atomic_compare_exchange_strong(tmo + 1, &expect, code | (unsigned)(u.pm & 0xff), __ATOMIC_RELAXED, __ATOMIC_RELAXED, __HIP_MEMORY_SCOPE_AGENT);
                                     __hip_atomic_store(tmo, 1u, __ATOMIC_RELAXED, __HIP_MEMORY_SCOPE_AGENT); }
                    dead = true; break; }
                __builtin_amdgcn_s_sleep(2);
            }
            __builtin_amdgcn_fence(__ATOMIC_ACQUIRE, "agent");
            if (lane == 0) flag[0] = dead ? 1u : 0u;
        }
        asm volatile("s_waitcnt vmcnt(0) lgkmcnt(0)" ::: "memory"); __builtin_amdgcn_s_barrier(); asm volatile("" ::: "memory");
        const bool bad = flag[0] != 0u;
        if (lane < 32) {
            const unsigned long long* slot = (const unsigned long long*)xbuf + (size_t)(u.pm * BM + row) * 4; float mt[4], m2[4]; float ms = 0.f;
#pragma unroll
            for (int t = 0; t < 4; ++t) { if (t < ntn) { const unsigned long long w = __hip_atomic_load(slot + t, __ATOMIC_RELAXED, __HIP_MEMORY_SCOPE_AGENT); mt[t] = __uint_as_float((unsigned)w); m2[t] = __uint_as_float((unsigned)(w >> 32)); } else { mt[t] = 0.f; m2[t] = 0.f; } ms += mt[t]; }
            const float mean = ms / (float)ntn; float q = 0.f;
#pragma unroll
            for (int t = 0; t < 4; ++t) if (t < ntn) { const float dm = mt[t] - mean; q += m2[t] + 256.0f * dm * dm; }
            S[row] = (f32x2v){mean, 1.0f / sqrtf(q / (256.0f * (float)ntn) + eps)};
        }
        asm volatile("s_waitcnt lgkmcnt(0)" ::: "memory"); __builtin_amdgcn_s_barrier(); asm volatile("" ::: "memory");
        return bad;
    }
};
struct EpiLnRes {
    static constexpr bool PERM = false, AFTER_DRAIN = true;
    const float* base; float* out; int ldc; const float* bias; PanelStats st; unsigned poison;
    __device__ __forceinline__ void fused(f32x4 (&acc)[2][2][4][2], const Unit& u, int wr, int wc, int fr, int fq, PG8_LAS unsigned char* lds, int wid, int lane) const {
        typedef float f32x2v __attribute__((ext_vector_type(2)));
        const PG8_LAS f32x2v* S = (const PG8_LAS f32x2v*)(lds + 8192);
        const int col0 = u.pn * BM + wc * 32 + 4 * fq;
#pragma unroll
        for (int bj = 0; bj < 2; ++bj)
#pragma unroll
            for (int n = 0; n < 2; ++n) { const f32x4 bv = bias ? *(const f32x4*)(bias + col0 + bj * HALF + n * 16) : (f32x4){0.f, 0.f, 0.f, 0.f};
#pragma unroll
                for (int ai = 0; ai < 2; ++ai)
#pragma unroll
                    for (int m = 0; m < 4; ++m) acc[ai][bj][m][n] += bv; }
        f32x4 pre[4][2][2];
#pragma unroll
        for (int m = 0; m < 4; ++m) { const size_t off = (size_t)(u.pm * BM + wr * 64 + m * 16 + fr) * ldc + col0;
#pragma unroll
            for (int bj = 0; bj < 2; ++bj)
#pragma unroll
                for (int n = 0; n < 2; ++n) pre[m][bj][n] = *(const f32x4*)(base + off + bj * HALF + n * 16); }
        const bool bad = st.run(acc, u, wr, wc, fr, fq, lds, wid, lane) || poison != 0u;
        const float qnan = __builtin_nanf("");
#pragma unroll
        for (int ai = 0; ai < 2; ++ai)
#pragma unroll
            for (int m = 0; m < 4; ++m) { const int r = ai * HALF + wr * 64 + m * 16 + fr; const f32x2v sr = S[r]; const size_t off = (size_t)(u.pm * BM + r) * ldc + col0;
#pragma unroll
                for (int bj = 0; bj < 2; ++bj)
#pragma unroll
                    for (int n = 0; n < 2; ++n) { const f32x4 bs = ai == 0 ? pre[m][bj][n] : *(const f32x4*)(base + off + bj * HALF + n * 16); f32x4 o = bs + (acc[ai][bj][m][n] - sr.x) * sr.y;
                        if (bad) o = (f32x4){qnan, qnan, qnan, qnan}; *(f32x4*)(out + off + bj * HALF + n * 16) = o; }
                if (m & 1) asm volatile("" ::: "memory"); }
    }
};
struct EpiLnResLn {
    static constexpr bool PERM = false, AFTER_DRAIN = true;
    const float* base; float* out; bf16_t* xn; int ldc; const float* bias; PanelStats st1, st2; unsigned poison;
    __device__ __forceinline__ void fused(f32x4 (&acc)[2][2][4][2], const Unit& u, int wr, int wc, int fr, int fq, PG8_LAS unsigned char* lds, int wid, int lane) const {
        typedef float f32x2v __attribute__((ext_vector_type(2))); typedef unsigned u32x2v __attribute__((ext_vector_type(2)));
        const PG8_LAS f32x2v* S = (const PG8_LAS f32x2v*)(lds + 8192);
        const int col0 = u.pn * BM + wc * 32 + 4 * fq;
#pragma unroll
        for (int bj = 0; bj < 2; ++bj)
#pragma unroll
            for (int n = 0; n < 2; ++n) { const f32x4 bv = bias ? *(const f32x4*)(bias + col0 + bj * HALF + n * 16) : (f32x4){0.f, 0.f, 0.f, 0.f};
#pragma unroll
                for (int ai = 0; ai < 2; ++ai)
#pragma unroll
                    for (int m = 0; m < 4; ++m) acc[ai][bj][m][n] += bv; }
        bool bad = st1.run(acc, u, wr, wc, fr, fq, lds, wid, lane) || poison != 0u;
        const float qnan = __builtin_nanf("");
#pragma unroll
        for (int ai = 0; ai < 2; ++ai)
#pragma unroll
            for (int m = 0; m < 4; ++m) { const int r = ai * HALF + wr * 64 + m * 16 + fr; const f32x2v sr = S[r]; const size_t off = (size_t)(u.pm * BM + r) * ldc + col0;
#pragma unroll
                for (int bj = 0; bj < 2; ++bj)
#pragma unroll
                    for (int n = 0; n < 2; ++n) { const f32x4 bs = *(const f32x4*)(base + off + bj * HALF + n * 16); acc[ai][bj][m][n] = bs + (acc[ai][bj][m][n] - sr.x) * sr.y; }
                asm volatile("" : "+v"(acc[ai][0][m][0]), "+v"(acc[ai][0][m][1]), "+v"(acc[ai][1][m][0]), "+v"(acc[ai][1][m][1]));
                if (m & 1) asm volatile("" ::: "memory"); }
        const bool bad1 = bad;
        bad = st2.run(acc, u, wr, wc, fr, fq, lds, wid, lane) || bad;
#pragma unroll
        for (int ai = 0; ai < 2; ++ai)
#pragma unroll
            for (int m = 0; m < 4; ++m) { const int r = ai * HALF + wr * 64 + m * 16 + fr; const f32x2v sr = S[r]; const size_t off = (size_t)(u.pm * BM + r) * ldc + col0;
#pragma unroll
                for (int bj = 0; bj < 2; ++bj)
#pragma unroll
                    for (int n = 0; n < 2; ++n) { const f32x4 x1 = acc[ai][bj][m][n]; *(f32x4*)(out + off + bj * HALF + n * 16) = bad1 ? (f32x4){qnan, qnan, qnan, qnan} : x1;
                        const f32x4 o = (x1 - sr.x) * sr.y; u32x2v w; w.x = cvt_pk_bf16(o[0], o[1]); w.y = cvt_pk_bf16(o[2], o[3]);
                        if (bad) { w.x = 0x7fc07fc0u; w.y = 0x7fc07fc0u; } *(u32x2v*)(xn + off + bj * HALF + n * 16) = w; }
                asm volatile("" ::: "memory"); }
    }
};

template <class Epi, class Sched, bool ALIGN_EPI = false, bool SP2 = false>
__device__ __forceinline__ void gemm_phase(PG8_LAS unsigned char* lds, const Gemm g, const Sched& S, const Epi& E) {
    const int tid = threadIdx.x, wid = __builtin_amdgcn_readfirstlane(tid >> 6), lane = tid & 63, wr = wid >> 2, wc = wid & 3, fr = lane & 15, fq = lane >> 4;
    const int K = g.K, nt = K / BK;
    unsigned voffA[2], voffB[2];
#pragma unroll
    for (int i = 0; i < 2; ++i) { int R, C; stage_rc(tid * 16 + i * 8192, R, C); const int Rb = Epi::PERM ? ((R & ~31) + perm32(R & 31)) : R;
        voffA[i] = (unsigned)(R * K + C) * 2u; voffB[i] = (unsigned)(Rb * K + C) * 2u; }
    const size_t kstep = (size_t)(BK * 2);
    const size_t hstep = (size_t)HALF * K * 2;
    const size_t tstep = 2 * hstep;
    const unsigned ldsw = (unsigned)wid * 1024u;
    const int aoff = lds_byte(wr * 64 + fr, fq * 8), boff = lds_byte(wc * 32 + fr, fq * 8);
#define PG8_SA(b, h) (((b) * 2 + (h)) * HTB)
#define PG8_SB(b, h) ((4 + (b) * 2 + (h)) * HTB)
#define PG8_STAGE(bufoff, gbase, voff) do { _Pragma("unroll") for (int _i = 0; _i < 2; ++_i) \
        __builtin_amdgcn_global_load_lds((const unsigned*)((const char*)(gbase) + (voff)[_i]), (PG8_LAS unsigned*)(lds + (bufoff) + ldsw + _i * 8192), 16, 0, 0); } while (0)
#define PG8_LDA(dst, b, h) do { _Pragma("unroll") for (int m = 0; m < 4; ++m) _Pragma("unroll") for (int k = 0; k < 2; ++k) dst[m][k] = *(const PG8_LAS bf16x8*)(lds + PG8_SA(b, h) + aoff + m * 2048 + k * 1024); } while (0)
#define PG8_LDB(dst, b, h) do { _Pragma("unroll") for (int n = 0; n < 2; ++n) _Pragma("unroll") for (int k = 0; k < 2; ++k) dst[n][k] = *(const PG8_LAS bf16x8*)(lds + PG8_SB(b, h) + boff + n * 2048 + k * 1024); } while (0)
#define PG8_MMA(ai, bj, At, Bt) do { __builtin_amdgcn_s_setprio(1); _Pragma("unroll") for (int m = 0; m < 4; ++m) _Pragma("unroll") for (int n = 0; n < 2; ++n) _Pragma("unroll") for (int k = 0; k < 2; ++k) \
        acc[ai][bj][m][n] = __builtin_amdgcn_mfma_f32_16x16x32_bf16(Bt[n][k], At[m][k], acc[ai][bj][m][n], 0, 0, 0); __builtin_amdgcn_s_setprio(0); } while (0)
#define PG8_WAIT_V(n) asm volatile("s_waitcnt vmcnt(" #n ")" ::: "memory")
#define PG8_WAIT_L(n) asm volatile("s_waitcnt lgkmcnt(" #n ")" ::: "memory")
#define PG8_BAR __builtin_amdgcn_s_barrier()
#define PG8_SCHED __builtin_amdgcn_sched_barrier(0)
    Unit cur, nxt; int ui = 0;
    if (!S.next(0, cur)) return;
    f32x4 acc[2][2][4][2];
#pragma unroll
    for (int a = 0; a < 2; ++a)
#pragma unroll
        for (int b = 0; b < 2; ++b)
#pragma unroll
            for (int m = 0; m < 4; ++m)
#pragma unroll
                for (int n = 0; n < 2; ++n) acc[a][b][m][n] = (f32x4){0.f, 0.f, 0.f, 0.f};
    bf16x8 At[4][2], B0[2][2], B1[2][2];
    const char* cA = (const char*)g.A + (size_t)cur.pm * tstep; const char* cB = (const char*)g.Bt + (size_t)cur.pn * tstep;
    S.a_ready(cur);
    if constexpr (SP2) {
        PG8_STAGE(PG8_SB(0, 0), cB, voffB); PG8_STAGE(PG8_SB(0, 1), cB + hstep, voffB); PG8_STAGE(PG8_SA(0, 0), cA, voffA); PG8_STAGE(PG8_SA(0, 1), cA + hstep, voffA);
        if (wr == 1) PG8_BAR;
        PG8_WAIT_V(2); PG8_BAR;
        PG8_STAGE(PG8_SB(1, 0), cB + kstep, voffB); PG8_STAGE(PG8_SA(1, 0), cA + kstep, voffA); PG8_STAGE(PG8_SB(1, 1), cB + hstep + kstep, voffB);
        PG8_WAIT_V(6); PG8_BAR;
    } else {
        PG8_STAGE(PG8_SB(0, 0), cB, voffB); PG8_STAGE(PG8_SA(0, 0), cA, voffA); PG8_STAGE(PG8_SB(0, 1), cB + hstep, voffB); PG8_STAGE(PG8_SA(0, 1), cA + hstep, voffA);
        if (wr == 1) PG8_BAR;
        PG8_WAIT_V(4); PG8_BAR;
        PG8_STAGE(PG8_SB(1, 0), cB + kstep, voffB); PG8_STAGE(PG8_SA(1, 0), cA + kstep, voffA); PG8_STAGE(PG8_SB(1, 1), cB + hstep + kstep, voffB);
        PG8_WAIT_V(6); PG8_BAR;
    }
    for (;;) {
        const bool has_next = S.next(ui + 1, nxt);
        const char* nA = has_next ? (const char*)g.A + (size_t)nxt.pm * tstep : cA; const char* nB = has_next ? (const char*)g.Bt + (size_t)nxt.pn * tstep : cB;
        for (int t = 0; t < nt; t += 2) {
            const bool last = (t == nt - 2);
            const char* a1 = cA + (size_t)(t + 1) * kstep;
            const char* a2 = last ? nA : cA + (size_t)(t + 2) * kstep; const char* b2 = last ? nB : cB + (size_t)(t + 2) * kstep;
            const char* a3 = a2 + kstep; const char* b3 = b2 + kstep;
            if (last && has_next) S.a_ready(nxt);
            if constexpr (SP2) {
            PG8_LDB(B0, 0, 0); PG8_LDB(B1, 0, 1); PG8_SCHED; PG8_LDA(At, 0, 0); PG8_STAGE(PG8_SA(1, 1), a1 + hstep, voffA);
            PG8_WAIT_V(8); PG8_WAIT_L(0); PG8_BAR; PG8_MMA(0, 0, At, B0); PG8_MMA(0, 1, At, B1); PG8_BAR; PG8_SCHED;
            PG8_LDA(At, 0, 1); PG8_STAGE(PG8_SB(0, 0), b2, voffB); PG8_STAGE(PG8_SB(0, 1), b2 + hstep, voffB); PG8_STAGE(PG8_SA(0, 0), a2, voffA);
            PG8_WAIT_V(8); PG8_WAIT_L(0); PG8_BAR; PG8_MMA(1, 0, At, B0); PG8_MMA(1, 1, At, B1); PG8_BAR; PG8_SCHED;
            PG8_LDB(B0, 1, 0); PG8_LDB(B1, 1, 1); PG8_SCHED; PG8_LDA(At, 1, 0); PG8_STAGE(PG8_SA(0, 1), a2 + hstep, voffA);
            PG8_WAIT_V(8); PG8_WAIT_L(0); PG8_BAR; PG8_MMA(0, 0, At, B0); PG8_MMA(0, 1, At, B1); PG8_BAR; PG8_SCHED;
            PG8_LDA(At, 1, 1); PG8_STAGE(PG8_SB(1, 0), b3, voffB); PG8_STAGE(PG8_SB(1, 1), b3 + hstep, voffB); PG8_STAGE(PG8_SA(1, 0), a3, voffA);
            PG8_WAIT_V(8); PG8_WAIT_L(0); PG8_BAR; PG8_MMA(1, 0, At, B0); PG8_MMA(1, 1, At, B1); PG8_BAR; PG8_SCHED;
            } else {
            PG8_LDB(B0, 0, 0); PG8_SCHED; PG8_LDA(At, 0, 0); PG8_STAGE(PG8_SA(1, 1), a1 + hstep, voffA);
            PG8_WAIT_L(8); PG8_BAR; PG8_WAIT_L(0); PG8_MMA(0, 0, At, B0); PG8_BAR; PG8_SCHED;
            PG8_LDB(B1, 0, 1); PG8_STAGE(PG8_SB(0, 0), b2, voffB);
            PG8_BAR; PG8_WAIT_L(0); PG8_MMA(0, 1, At, B1); PG8_BAR;
            PG8_LDA(At, 0, 1); PG8_STAGE(PG8_SA(0, 0), a2, voffA);
            PG8_BAR; PG8_WAIT_L(0); PG8_MMA(1, 0, At, B0); PG8_BAR; PG8_SCHED;
            PG8_STAGE(PG8_SB(0, 1), b2 + hstep, voffB);
            PG8_WAIT_V(6); PG8_BAR; PG8_MMA(1, 1, At, B1); PG8_BAR;
            PG8_LDB(B0, 1, 0); PG8_SCHED; PG8_LDA(At, 1, 0); PG8_STAGE(PG8_SA(0, 1), a2 + hstep, voffA);
            PG8_WAIT_L(8); PG8_BAR; PG8_WAIT_L(0); PG8_MMA(0, 0, At, B0); PG8_BAR; PG8_SCHED;
            PG8_LDB(B1, 1, 1); PG8_STAGE(PG8_SB(1, 0), b3, voffB);
            PG8_BAR; PG8_WAIT_L(0); PG8_MMA(0, 1, At, B1); PG8_BAR;
            PG8_LDA(At, 1, 1); PG8_STAGE(PG8_SA(1, 0), a3, voffA);
            PG8_BAR; PG8_WAIT_L(0); PG8_MMA(1, 0, At, B0); PG8_BAR; PG8_SCHED;
            PG8_STAGE(PG8_SB(1, 1), b3 + hstep, voffB);
            PG8_WAIT_V(6); PG8_BAR; PG8_MMA(1, 1, At, B1); PG8_BAR;
            }
        }
        if constexpr (ALIGN_EPI) { if (wr == 0) PG8_BAR; }
        if constexpr (!Epi::AFTER_DRAIN) { E(acc, cur, wr, wc, fr, fq); S.done(cur); }
        if (!has_next) break;
#pragma unroll
        for (int a = 0; a < 2; ++a)
#pragma unroll
            for (int b = 0; b < 2; ++b)
#pragma unroll
                for (int m = 0; m < 4; ++m)
#pragma unroll
                    for (int n = 0; n < 2; ++n) acc[a][b][m][n] = (f32x4){0.f, 0.f, 0.f, 0.f};
        cur = nxt; cA = nA; cB = nB; ++ui;
        if constexpr (ALIGN_EPI) { if (wr == 1) PG8_BAR; }
    }
    PG8_WAIT_V(0);
    if constexpr (!ALIGN_EPI) { if (wr == 0) PG8_BAR; }
    PG8_BAR;
    if constexpr (Epi::AFTER_DRAIN) { E.fused(acc, cur, wr, wc, fr, fq, lds, wid, lane); S.done(cur); }
#undef PG8_SA
#undef PG8_SB
#undef PG8_STAGE
#undef PG8_LDA
#undef PG8_LDB
#undef PG8_MMA
#undef PG8_WAIT_V
#undef PG8_WAIT_L
#undef PG8_BAR
#undef PG8_SCHED
}
}
namespace pg8 {
__device__ __forceinline__ int erow(int ai, int m, int wr, int fr) { return ai * HALF + wr * 64 + m * 16 + fr; }
template <bool PERM> __device__ __forceinline__ int ecol(int bj, int n, int wc, int fq) { return PERM ? (bj * HALF + wc * 32 + 8 * fq + 4 * n) : (bj * HALF + wc * 32 + 16 * n + 4 * fq); }
typedef unsigned u32x2e __attribute__((ext_vector_type(2)));
__device__ __forceinline__ u32x2e pack4(f32x4 v) { u32x2e w; w.x = cvt_pk_bf16(v[0], v[1]); w.y = cvt_pk_bf16(v[2], v[3]); return w; }
__device__ __forceinline__ float sigm(float x) { return 1.0f - __builtin_amdgcn_rcpf(1.0f + __expf(x)); }
__device__ __forceinline__ float tanh_(float x) { return 1.0f - 2.0f * __builtin_amdgcn_rcpf(1.0f + __expf(2.0f * x)); }

struct RecInDst { bf16_t* QM; size_t off_km, off_vm, off_om; bf16_t *RAWb, *TWAD, *SGD; float* GATES; };
__device__ __forceinline__ void recin_store4(const RecInDst& d, size_t row, int pn, int c, f32x4 v) {
    if (pn < 8) {
        const size_t off = (pn < 2) ? 0 : (pn < 4 ? d.off_km : (pn < 6 ? d.off_vm : d.off_om));
        if (pn == 2 || pn == 3) v = v * 0.08838834764831845f;
        *(u32x2e*)(d.QM + off + row * 512 + (pn & 1) * 256 + c) = pack4(v);
    } else if (pn < 14) {
        *(u32x2e*)(d.RAWb + row * 1536 + (pn - 8) * 256 + c) = pack4(v);
    } else if (pn == 14) {
        if (c < 128) { v[0] = tanh_(v[0]); v[1] = tanh_(v[1]); v[2] = tanh_(v[2]); v[3] = tanh_(v[3]); }
        *(u32x2e*)(d.TWAD + row * 256 + c) = pack4(v);
    } else {
        if (c < 128) { v[0] = sigm(v[0]); v[1] = sigm(v[1]); v[2] = sigm(v[2]); v[3] = sigm(v[3]); *(u32x2e*)(d.SGD + row * 128 + c) = pack4(v); }
        else if (c < 144) { *(f32x4*)(d.GATES + row * 16 + (c - 128)) = v; }
    }
}
__device__ __forceinline__ void recin_store1(const RecInDst& d, size_t row, int col, float v) {
    const int pn = col >> 8, c = col & 255;
    if (pn < 8) {
        const size_t off = (pn < 2) ? 0 : (pn < 4 ? d.off_km : (pn < 6 ? d.off_vm : d.off_om));
        if (pn == 2 || pn == 3) v *= 0.08838834764831845f;
        d.QM[off + row * 512 + (pn & 1) * 256 + c] = (bf16_t)(cvt_pk_bf16(v, 0.f) & 0xffffu);
    } else if (pn < 14) d.RAWb[row * 1536 + (pn - 8) * 256 + c] = (bf16_t)(cvt_pk_bf16(v, 0.f) & 0xffffu);
    else if (pn == 14) d.TWAD[row * 256 + c] = (bf16_t)(cvt_pk_bf16(c < 128 ? tanh_(v) : v, 0.f) & 0xffffu);
    else if (c < 128) d.SGD[row * 128 + c] = (bf16_t)(cvt_pk_bf16(sigm(v), 0.f) & 0xffffu);
    else if (c < 144) d.GATES[row * 16 + (c - 128)] = v;
}
struct EpiRecIn {
    static constexpr bool PERM = false, AFTER_DRAIN = false;
    RecInDst d;
    __device__ __forceinline__ void operator()(const f32x4 (&acc)[2][2][4][2], const Unit& u, int wr, int wc, int fr, int fq) const {
        const int pn = u.pn;
#pragma unroll
        for (int ai = 0; ai < 2; ++ai)
#pragma unroll
            for (int m = 0; m < 4; ++m) {
                const size_t row = (size_t)u.pm * BM + erow(ai, m, wr, fr);
#pragma unroll
                for (int bj = 0; bj < 2; ++bj)
#pragma unroll
                    for (int n = 0; n < 2; ++n) recin_store4(d, row, pn, ecol<false>(bj, n, wc, fq), acc[ai][bj][m][n]);
            }
    }
};
template <int ldc> struct EpiStoreBf16 {
    static constexpr bool PERM = true, AFTER_DRAIN = false;
    bf16_t* O; int scale_pm; float scale;
    __device__ __forceinline__ void operator()(const f32x4 (&acc)[2][2][4][2], const Unit& u, int wr, int wc, int fr, int fq) const {
        const float sc = (u.pm < scale_pm) ? scale : 1.0f;
#pragma unroll
        for (int ai = 0; ai < 2; ++ai)
#pragma unroll
            for (int m = 0; m < 4; ++m) {
                bf16_t* rowp = O + ((size_t)u.pm * BM + erow(ai, m, wr, fr)) * ldc + (size_t)u.pn * BM;
#pragma unroll
                for (int bj = 0; bj < 2; ++bj) {
                    const f32x4 v0 = acc[ai][bj][m][0] * sc, v1 = acc[ai][bj][m][1] * sc;
                    u32x4 w; w.x = cvt_pk_bf16(v0[0], v0[1]); w.y = cvt_pk_bf16(v0[2], v0[3]); w.z = cvt_pk_bf16(v1[0], v1[1]); w.w = cvt_pk_bf16(v1[2], v1[3]);
                    *(u32x4*)(rowp + ecol<true>(bj, 0, wc, fq)) = w;
                }
            }
    }
};
template <int ldc> struct EpiSqRelu {
    static constexpr bool PERM = true, AFTER_DRAIN = false;
    bf16_t* O;
    __device__ __forceinline__ void operator()(const f32x4 (&acc)[2][2][4][2], const Unit& u, int wr, int wc, int fr, int fq) const {
#pragma unroll
        for (int ai = 0; ai < 2; ++ai)
#pragma unroll
            for (int m = 0; m < 4; ++m) {
                bf16_t* rowp = O + ((size_t)u.pm * BM + erow(ai, m, wr, fr)) * ldc + (size_t)u.pn * BM;
#pragma unroll
                for (int bj = 0; bj < 2; ++bj) {
                    f32x4 v0 = acc[ai][bj][m][0], v1 = acc[ai][bj][m][1];
#pragma unroll
                    for (int e = 0; e < 4; ++e) { const float a = fmaxf(v0[e], 0.f), b = fmaxf(v1[e], 0.f); v0[e] = a * a; v1[e] = b * b; }
                    u32x4 w; w.x = cvt_pk_bf16(v0[0], v0[1]); w.y = cvt_pk_bf16(v0[2], v0[3]); w.z = cvt_pk_bf16(v1[0], v1[1]); w.w = cvt_pk_bf16(v1[2], v1[3]);
                    *(u32x4*)(rowp + ecol<true>(bj, 0, wc, fq)) = w;
                }
            }
    }
};
struct EpiResid {
    static constexpr bool PERM = false, AFTER_DRAIN = false;
    const float* src_lat; const float* src_ctx; float* dst_lat; float* dst_ctx; const float* gate;
    __device__ __forceinline__ void operator()(const f32x4 (&acc)[2][2][4][2], const Unit& u, int wr, int wc, int fr, int fq) const {
        const int row0 = u.pm * BM; const bool isctx = row0 >= 16384;
        const float* s = isctx ? src_ctx + (size_t)(row0 - 16384) * 1024 : src_lat + (size_t)row0 * 1024;
        float* d = isctx ? dst_ctx + (size_t)(row0 - 16384) * 1024 : dst_lat + (size_t)row0 * 1024;
        const float* g = gate + (isctx ? 2 : (row0 >> 13)) * 6144 + u.pn * BM;
        f32x4 gv[2][2];
#pragma unroll
        for (int bj = 0; bj < 2; ++bj)
#pragma unroll
            for (int n = 0; n < 2; ++n) gv[bj][n] = *(const f32x4*)(g + ecol<false>(bj, n, wc, fq));
        constexpr int RB = 2;
#pragma unroll
        for (int ai = 0; ai < 2; ++ai)
#pragma unroll
            for (int m0 = 0; m0 < 4; m0 += RB) {
                f32x4 x[RB][2][2];
#pragma unroll
                for (int mm = 0; mm < RB; ++mm) { const size_t off = (size_t)erow(ai, m0 + mm, wr, fr) * 1024 + (size_t)u.pn * BM;
#pragma unroll
                    for (int bj = 0; bj < 2; ++bj)
#pragma unroll
                        for (int n = 0; n < 2; ++n) x[mm][bj][n] = *(const f32x4*)(s + off + ecol<false>(bj, n, wc, fq)); }
#pragma unroll
                for (int mm = 0; mm < RB; ++mm) { const size_t off = (size_t)erow(ai, m0 + mm, wr, fr) * 1024 + (size_t)u.pn * BM;
#pragma unroll
                    for (int bj = 0; bj < 2; ++bj)
#pragma unroll
                        for (int n = 0; n < 2; ++n) *(f32x4*)(d + off + ecol<false>(bj, n, wc, fq)) = x[mm][bj][n] + gv[bj][n] * acc[ai][bj][m0 + mm][n]; }
            }
    }
};
struct EpiResidN {
    static constexpr bool PERM = false, AFTER_DRAIN = false;
    const float* src; float* dst; const float* gate;
    const float* ng; const float* nsc;
    bf16_t* XN; float* SS;
    __device__ __forceinline__ void operator()(const f32x4 (&acc)[2][2][4][2], const Unit& u, int wr, int wc, int fr_, int fq_) const {
        int lz = 0; asm volatile("" : "+v"(lz));
        const int fr = fr_ + lz, fq = fq_ + lz;
        const int row0 = u.pm * BM, vec = row0 >> 13;
        const float* s = src + (size_t)row0 * 1024 + (size_t)u.pn * BM; float* d = dst + (size_t)row0 * 1024 + (size_t)u.pn * BM; bf16_t* xn = XN + (size_t)row0 * 1024 + (size_t)u.pn * BM;
        const float* g = gate + vec * 6144 + u.pn * BM; const float* gn = ng + u.pn * BM; const float* sn = nsc + vec * 6144 + u.pn * BM;
        f32x4 gv[2][2];
#pragma unroll
        for (int bj = 0; bj < 2; ++bj)
#pragma unroll
            for (int n = 0; n < 2; ++n) gv[bj][n] = *(const f32x4*)(g + ecol<false>(bj, n, wc, fq));
#pragma unroll
        for (int ai = 0; ai < 2; ++ai)
#pragma unroll
            for (int m = 0; m < 4; ++m) {
                const int r = erow(ai, m, wr, fr); const size_t off = (size_t)r * 1024; float q = 0.f;
#pragma unroll
                for (int bj = 0; bj < 2; ++bj)
#pragma unroll
                    for (int n = 0; n < 2; ++n) { const int c = ecol<false>(bj, n, wc, fq); const f32x4 x = *(const f32x4*)(s + off + c) + gv[bj][n] * acc[ai][bj][m][n];
                        *(f32x4*)(d + off + c) = x; const f32x4 gs = *(const f32x4*)(gn + c) * (*(const f32x4*)(sn + c) + 1.0f); *(u32x2e*)(xn + off + c) = pack4(x * gs); q += (x[0] * x[0] + x[1] * x[1]) + (x[2] * x[2] + x[3] * x[3]); }
                q += __shfl_xor(q, 16); q += __shfl_xor(q, 32);
                if (fq == 0) SS[(size_t)(row0 + r) * 16 + u.pn * 4 + wc] = q;
            }
    }
};
__device__ __forceinline__ float row_rs(const float* SS, size_t row, int fq) {
    const f32x4 p = *(const f32x4*)(SS + row * 16 + 4 * fq); float t = (p[0] + p[1]) + (p[2] + p[3]);
    t += __shfl_xor(t, 16); t += __shfl_xor(t, 32);
    return 1.0f / sqrtf(t * (1.0f / 1024.0f) + 1e-6f);
}
template <int ldc> struct EpiSqReluN {
    static constexpr bool PERM = true, AFTER_DRAIN = false;
    bf16_t* O; const float* SS; const float* bias;
    __device__ __forceinline__ void operator()(const f32x4 (&acc)[2][2][4][2], const Unit& u, int wr, int wc, int fr, int fq) const {
        const float* bp = bias + ((u.pm * BM) >> 13) * 4096 + u.pn * BM;
#pragma unroll
        for (int ai = 0; ai < 2; ++ai)
#pragma unroll
            for (int m = 0; m < 4; ++m) {
                const size_t row = (size_t)u.pm * BM + erow(ai, m, wr, fr); const float rs = row_rs(SS, row, fq);
                bf16_t* rowp = O + row * ldc + (size_t)u.pn * BM;
#pragma unroll
                for (int bj = 0; bj < 2; ++bj) { const int c = ecol<true>(bj, 0, wc, fq);
                    f32x4 v0 = acc[ai][bj][m][0] * rs + *(const f32x4*)(bp + c), v1 = acc[ai][bj][m][1] * rs + *(const f32x4*)(bp + c + 4);
#pragma unroll
                    for (int e_ = 0; e_ < 4; ++e_) { const float a = fmaxf(v0[e_], 0.f), b = fmaxf(v1[e_], 0.f); v0[e_] = a * a; v1[e_] = b * b; }
                    u32x4 w; w.x = cvt_pk_bf16(v0[0], v0[1]); w.y = cvt_pk_bf16(v0[2], v0[3]); w.z = cvt_pk_bf16(v1[0], v1[1]); w.w = cvt_pk_bf16(v1[2], v1[3]);
                    *(u32x4*)(rowp + c) = w; }
            }
    }
};
template <int ldc> struct EpiStoreF32N {
    static constexpr bool PERM = false, AFTER_DRAIN = false;
    float* O; const float* SS; const float* bias;
    __device__ __forceinline__ void operator()(const f32x4 (&acc)[2][2][4][2], const Unit& u, int wr, int wc, int fr, int fq) const {
        const float* bp = bias + ((u.pm * BM) >> 13) * 4096 + u.pn * BM;
#pragma unroll
        for (int ai = 0; ai < 2; ++ai)
#pragma unroll
            for (int m = 0; m < 4; ++m) {
                const size_t row = (size_t)u.pm * BM + erow(ai, m, wr, fr); const float rs = row_rs(SS, row, fq);
                float* rowp = O + row * ldc + (size_t)u.pn * BM;
#pragma unroll
                for (int bj = 0; bj < 2; ++bj)
#pragma unroll
                    for (int n = 0; n < 2; ++n) { const int c = ecol<false>(bj, n, wc, fq); *(f32x4*)(rowp + c) = acc[ai][bj][m][n] * rs + *(const f32x4*)(bp + c); }
            }
    }
};
template <int ldc> struct EpiStoreF32 {
    static constexpr bool PERM = false, AFTER_DRAIN = false;
    float* O;
    __device__ __forceinline__ void operator()(const f32x4 (&acc)[2][2][4][2], const Unit& u, int wr, int wc, int fr, int fq) const {
#pragma unroll
        for (int ai = 0; ai < 2; ++ai)
#pragma unroll
            for (int m = 0; m < 4; ++m) {
                float* rowp = O + ((size_t)u.pm * BM + erow(ai, m, wr, fr)) * ldc + (size_t)u.pn * BM;
#pragma unroll
                for (int bj = 0; bj < 2; ++bj)
#pragma unroll
                    for (int n = 0; n < 2; ++n) *(f32x4*)(rowp + ecol<false>(bj, n, wc, fq)) = acc[ai][bj][m][n];
            }
    }
};
}
#include <hip/hip_bf16.h>
#include <cmath>
namespace attn_body {
using bf16=__hip_bfloat16;
using bf16x8=__attribute__((ext_vector_type(8)))short;
using s16x4=__attribute__((ext_vector_type(4)))short;
using f32x16=__attribute__((ext_vector_type(16)))float;
using u32x4=__attribute__((ext_vector_type(4)))unsigned;
constexpr int BATCH=2,NHEAD=16,SEQ=8192,CTXL=256,KVP=64,D=64,DM=NHEAD*D;
constexpr int NW=8,QBLK=32,QB=QBLK*NW,KVBLK=64,NQB=SEQ/QB;
constexpr int ATTN_PITCH=DM, ATTN_UNIT_ROWS=QB;
__device__ __forceinline__ int crow(int r,int hi){return (r&3)+8*(r>>2)+4*hi;}
#define SBAR() __builtin_amdgcn_sched_barrier(0)
__device__ __forceinline__ void cmask(f32x16&p0,f32x16&p1,int jb,int qrel,int hi){
  const float NEG=-INFINITY; int kb=64*jb+4*hi;
  #pragma unroll
  for(int r=0;r<16;++r){int kv=kb+(r&3)+8*(r>>2); if(kv>qrel)p0[r]=NEG; if(kv+32>qrel)p1[r]=NEG;}
}

__device__ __forceinline__ void wmask(f32x16&p0,f32x16&p1,int dbase,int hi){
  const float NEG=-INFINITY; const int kb=dbase+4*hi;
  #pragma unroll
  for(int r=0;r<16;++r){int d=kb+(r&3)+8*(r>>2); if(d>128||d<-128)p0[r]=NEG; if(d+32>128||d+32<-128)p1[r]=NEG;}
}
constexpr int NSLOT=3, SLOTB=8192;
constexpr int LDS_K=0, LDS_V=NSLOT*SLOTB, LDS_WS=2*NSLOT*SLOTB, LDS_OST=LDS_WS+NW*64*4, LDS_BYTES=LDS_OST+NW*4096;
constexpr float C2=0.125f*1.4426950408889634f;
__device__ __forceinline__ void glds16(const void*gsrc,unsigned lds_dst){unsigned keep;
  asm volatile("s_mov_b32 %0, m0\n\ts_mov_b32 m0, %2\n\ts_nop 0\n\tglobal_load_lds_dwordx4 %1, off\n\ts_mov_b32 m0, %0":"=&s"(keep):"v"(gsrc),"s"(lds_dst):"memory");}
__device__ __forceinline__ float max3f(float a,float b,float c){float r;asm("v_max3_f32 %0, %1, %2, %3":"=v"(r):"v"(a),"v"(b),"v"(c));return r;}
__device__ __forceinline__ float max2f(float a,float b){float r;asm("v_max_f32_e32 %0, %1, %2":"=v"(r):"v"(a),"v"(b));return r;}
__device__ __forceinline__ float fadd_s(float a,float b){float r;asm("v_add_f32_e32 %0, %1, %2":"=v"(r):"v"(a),"v"(b));return r;}
__device__ __forceinline__ float fsub_s(float a,float b){float r;asm("v_sub_f32_e32 %0, %1, %2":"=v"(r):"v"(a),"v"(b));return r;}
typedef float f32x2_t __attribute__((ext_vector_type(2))); typedef __bf16 bf16x2_t __attribute__((ext_vector_type(2)));
__device__ __forceinline__ unsigned cvtpk_s(float lo,float hi){f32x2_t v={lo,hi};bf16x2_t b=__builtin_convertvector(v,bf16x2_t);return __builtin_bit_cast(unsigned,b);}
#define WAIT_BAR(N) asm volatile("s_waitcnt vmcnt(" #N ") lgkmcnt(0)\n\ts_barrier":::"memory")

__device__ __forceinline__ void qkt(f32x16&p0,f32x16&p1,const char*Kslot,const bf16x8*qr,const f32x16&negm,int r32,int hi){
  const char*kb=Kslot+hi*1024+r32*16;
  #pragma unroll
  for(int d0=0;d0<4;++d0){
    const bf16x8 b0=*reinterpret_cast<const bf16x8*>(kb+d0*2048);
    const bf16x8 b1=*reinterpret_cast<const bf16x8*>(kb+d0*2048+512);
    if(d0==0){p0=__builtin_amdgcn_mfma_f32_32x32x16_bf16(b0,qr[0],negm,0,0,0);p1=__builtin_amdgcn_mfma_f32_32x32x16_bf16(b1,qr[0],negm,0,0,0);}
    else{p0=__builtin_amdgcn_mfma_f32_32x32x16_bf16(b0,qr[d0],p0,0,0,0);p1=__builtin_amdgcn_mfma_f32_32x32x16_bf16(b1,qr[d0],p1,0,0,0);}}
}
typedef __attribute__((address_space(3))) const char* lds_cptr;
typedef short v4i16_t __attribute__((ext_vector_type(4)));
__device__ __forceinline__ void kload8(bf16x8*kf,lds_cptr kp){
  kf[0]=*(const __attribute__((address_space(3))) bf16x8*)(kp);      kf[1]=*(const __attribute__((address_space(3))) bf16x8*)(kp+512);
  kf[2]=*(const __attribute__((address_space(3))) bf16x8*)(kp+2048); kf[3]=*(const __attribute__((address_space(3))) bf16x8*)(kp+2560);
  kf[4]=*(const __attribute__((address_space(3))) bf16x8*)(kp+4096); kf[5]=*(const __attribute__((address_space(3))) bf16x8*)(kp+4608);
  kf[6]=*(const __attribute__((address_space(3))) bf16x8*)(kp+6144); kf[7]=*(const __attribute__((address_space(3))) bf16x8*)(kp+6656);
}
__device__ __forceinline__ void kload2(bf16x8*kf,lds_cptr kp,int j){ kf[2*j]=*(const __attribute__((address_space(3))) bf16x8*)(kp+j*2048); kf[2*j+1]=*(const __attribute__((address_space(3))) bf16x8*)(kp+j*2048+512); }
__device__ __forceinline__ s16x4 vtr(lds_cptr p){ return __builtin_bit_cast(s16x4,__builtin_amdgcn_ds_read_tr16_b64_v4i16((__attribute__((address_space(3))) v4i16_t*)p)); }
__device__ __forceinline__ float rowmax(const f32x16&p0,const f32x16&p1){
  float a=max3f(p0[0],p0[1],p1[0]),b=max3f(p0[2],p0[3],p1[1]);a=max3f(a,p1[2],p1[3]);
  #pragma unroll
  for(int r=4;r<16;r+=4){a=max3f(a,p0[r],p0[r+1]);b=max3f(b,p0[r+2],p0[r+3]);a=max3f(a,p1[r],p1[r+1]);b=max3f(b,p1[r+2],p1[r+3]);}
  const float m=max2f(a,b);
  auto rr=__builtin_amdgcn_permlane32_swap(__float_as_uint(m),__float_as_uint(m),false,false);
  return max2f(__uint_as_float(rr[0]),__uint_as_float(rr[1]));
}
__device__ __forceinline__ void pv(f32x16*o,int vb,bf16x8 pa0,bf16x8 pa1,bf16x8 pa2,bf16x8 pa3){
  #pragma unroll
  for(int d0=0;d0<2;++d0){s16x4 lo[4],hi[4];
    #pragma unroll
    for(int ks=0;ks<4;++ks){
      asm volatile("ds_read_b64_tr_b16 %0,%1 offset:%c2":"=&v"(lo[ks]):"v"(vb),"i"(d0*4096+ks*1024):"memory");
      asm volatile("ds_read_b64_tr_b16 %0,%1 offset:%c2":"=&v"(hi[ks]):"v"(vb),"i"(d0*4096+ks*1024+512):"memory");}
    asm volatile("s_waitcnt lgkmcnt(0)":::"memory");SBAR();
    #define PK(k) (bf16x8){lo[k][0],lo[k][1],lo[k][2],lo[k][3],hi[k][0],hi[k][1],hi[k][2],hi[k][3]}
    o[d0]=__builtin_amdgcn_mfma_f32_32x32x16_bf16(pa0,PK(0),o[d0],0,0,0);
    o[d0]=__builtin_amdgcn_mfma_f32_32x32x16_bf16(pa1,PK(1),o[d0],0,0,0);
    o[d0]=__builtin_amdgcn_mfma_f32_32x32x16_bf16(pa2,PK(2),o[d0],0,0,0);
    o[d0]=__builtin_amdgcn_mfma_f32_32x32x16_bf16(pa3,PK(3),o[d0],0,0,0);
    #undef PK
  }
}

#ifndef ATTN_STORE16
#define ATTN_STORE16(p,v) (*(u32x4*)(p)=(v))
#endif
template<int THRL,int MODE> __device__ __forceinline__ void attn_unit(int b,int h,int qb,const bf16*Q,const bf16*__restrict__ Kh,const bf16*__restrict__ Vh,bf16*O,char*shm,float sink_l2){
  const int tid=threadIdx.x,lane=tid&63,r32=lane&31,hi=lane>>5; const int wid=__builtin_amdgcn_readfirstlane(tid>>6);
  const long rowbase=(long)b*SEQ; const int q0=qb*QB;
  const bf16*Qw=Q+(rowbase+q0+wid*QBLK)*DM+h*D;
  const int wlo=(MODE==1)?(q0>=128?q0-128:0):0, whi=(MODE==1)?((q0+QB+128<=SEQ)?q0+QB+128:SEQ):0;
  #define TROW(t) ((MODE==1)?(((t)<4)?(SEQ+64*(t)):(wlo+64*((t)-4))):(64*(t)))
  const unsigned lds0=(unsigned)(uintptr_t)shm;
  float*wsf=(float*)(shm+LDS_WS)+wid*64;
  const bf16*ksrc=Kh+(long)lane*KVP+wid*8;
  const bf16*vsrc=Vh+(long)(16*(wid&3)+(lane>>2))*KVP+(wid>>2)*32+(lane&3)*8;
  const unsigned kdst=lds0+LDS_K+wid*1024, vdst=lds0+LDS_V+wid*1024;
  #define DMA_K(t,slot) glds16(ksrc+(long)TROW(t)*KVP,(unsigned)__builtin_amdgcn_readfirstlane(kdst+(slot)))
  #define DMA_V(t,slot) glds16(vsrc+(long)TROW(t)*KVP,(unsigned)__builtin_amdgcn_readfirstlane(vdst+(slot)))
  const int vb0=(int)(lds0+LDS_V)+((lane>>4)&1)*32+(lane&3)*8+(4*hi+((lane&15)>>2))*64;
  const char*Kbase=shm+LDS_K; bf16x8 kf[8];
  const lds_cptr shm3=(lds_cptr)shm; const lds_cptr kp0=shm3+LDS_K+hi*1024+r32*16; const lds_cptr vp0=shm3+LDS_V+((lane>>4)&1)*32+(lane&3)*8+(4*hi+((lane&15)>>2))*64;
  const int NT=(MODE==1)?(4+(whi-wlo)/KVBLK):((SEQ+CTXL)/KVBLK);
  DMA_K(0,0);DMA_V(0,0);DMA_K(1,SLOTB);
  bf16x8 qr[4];
  #pragma unroll
  for(int d0=0;d0<4;++d0)qr[d0]=*reinterpret_cast<const bf16x8*>(&Qw[(long)r32*DM+d0*16+hi*8]);
  float mhat=0.f,l_reg=0.f;f32x16 o[2];o[0]=f32x16{};o[1]=f32x16{};f32x16 negm=f32x16{};asm volatile("":"+v"(negm));
  const int qrel=wid*QBLK+r32;
  #define CMASK(P0,P1,t) do{ if(MODE==1&&(t)>=4) wmask(P0,P1,TROW(t)-(q0+qrel),hi); }while(0)
  bool resc=false;
  #define START(P0,P1) do{ const float rm=rowmax(P0,P1); resc=false; \
    { const float dl=rm; mhat=fadd_s(mhat,dl); \
      _Pragma("unroll") for(int r=0;r<16;++r){P0[r]=fsub_s(P0[r],dl);P1[r]=fsub_s(P1[r],dl);} \
      _Pragma("unroll") for(int r=0;r<16;++r)negm[r]=-mhat; asm volatile("":"+v"(negm)); } \
    _Pragma("unroll") for(int r=0;r<16;++r)P0[r]=__builtin_amdgcn_exp2f(P0[r]); }while(0)
  #define RESC() do{ if(resc){ asm volatile("s_waitcnt lgkmcnt(0)":::"memory"); \
      _Pragma("unroll") for(int d_=0;d_<2;++d_) _Pragma("unroll") for(int r=0;r<16;++r)o[d_][r]*=wsf[crow(r,hi)]; } }while(0)
  f32x16 pA0,pA1,pB0,pB1;
  int sl_prev=0,sl_cur=0,sl_next=SLOTB;
  #define ROT() do{sl_prev=sl_cur;sl_cur=sl_next;sl_next=(sl_next==(NSLOT-1)*SLOTB)?0:sl_next+SLOTB;}while(0)
  DMA_K(2,2*SLOTB);
  WAIT_BAR(3);
  qkt(pA0,pA1,Kbase,qr,negm,r32,hi);asm volatile("s_nop 15\n\ts_nop 7":"+v"(pA0),"+v"(pA1));CMASK(pA0,pA1,0);
  START(pA0,pA1);
  _Pragma("unroll") for(int r=0;r<16;++r)pA1[r]=__builtin_amdgcn_exp2f(pA1[r]);
  WAIT_BAR(0);
  DMA_K(3,0);DMA_V(1,SLOTB);
  ROT();
  kload8(kf,kp0+sl_cur);
  WAIT_BAR(2);
  s16x4 vlo[8],vhi[8]; u32x4 pw0,pw1,pw2,pw3;
  #define PKW(P,B) cvtpk_s(P[B],P[B+1])
  #define PAF(k) __builtin_bit_cast(bf16x8,pw##k)
  #define VFR(i) (bf16x8){vlo[i][0],vlo[i][1],vlo[i][2],vlo[i][3],vhi[i][0],vhi[i][1],vhi[i][2],vhi[i][3]}
  #define PIN(x) asm volatile("":"+v"(x))
  #define MX3(a,b,c) __builtin_fmaxf(__builtin_fmaxf((a),(b)),(c))
  #define GAPA(MF,A0,A1,A2,A3,W0,W1,PW) do{ MF; sacc+=A0; sacc+=A1; sacc+=A2; sacc+=A3; PIN(sacc); W0; W1; PIN(PW); SBAR(); }while(0)
  #define EX(v) __builtin_amdgcn_exp2f(v)
  #define GAPB(MF,X,B) do{ MF; X[B]=EX(X[B]); X[B+1]=EX(X[B+1]); X[B+2]=EX(X[B+2]); X[B+3]=EX(X[B+3]); PIN(X); SBAR(); }while(0)
  #define VRD(i) do{ vlo[i]=vtr(vp_+(((i)>>2)*4096+((i)&3)*1024)); vhi[i]=vtr(vp_+(((i)>>2)*4096+((i)&3)*1024+512)); }while(0)
  #define KRD(G,j) do{ if(G){ kload2(kf,kp0+sl_next,j); SBAR(); } }while(0)
  #define STEP(C0,C1,P0,P1,t,GK,GV,GL) do{ SBAR(); \
    const lds_cptr vp_=vp0+sl_prev; \
    VRD(0); SBAR(); float sacc=(P0[0]+P0[1]); \
    GAPA(C0=__builtin_amdgcn_mfma_f32_32x32x16_bf16(kf[0],qr[0],negm,0,0,0), P0[2],P0[3],P0[4],P0[5],     pw0[0]=PKW(P0,0), pw0[1]=PKW(P0,2), pw0); \
    VRD(4); SBAR(); GAPA(C1=__builtin_amdgcn_mfma_f32_32x32x16_bf16(kf[1],qr[0],negm,0,0,0), P0[6],P0[7],P0[8],P0[9],     pw0[2]=PKW(P0,4), pw0[3]=PKW(P0,6), pw0); \
    VRD(1); SBAR(); GAPA(C0=__builtin_amdgcn_mfma_f32_32x32x16_bf16(kf[2],qr[1],C0,0,0,0),   P0[10],P0[11],P0[12],P0[13], pw1[0]=PKW(P0,8), pw1[1]=PKW(P0,10), pw1); \
    VRD(5); SBAR(); GAPA(C1=__builtin_amdgcn_mfma_f32_32x32x16_bf16(kf[3],qr[1],C1,0,0,0),   P0[14],P0[15],P1[0],P1[1],   pw1[2]=PKW(P0,12),pw1[3]=PKW(P0,14), pw1); \
    VRD(2); SBAR(); GAPA(C0=__builtin_amdgcn_mfma_f32_32x32x16_bf16(kf[4],qr[2],C0,0,0,0),   P1[2],P1[3],P1[4],P1[5],     pw2[0]=PKW(P1,0), pw2[1]=PKW(P1,2), pw2); \
    VRD(6); SBAR(); GAPA(C1=__builtin_amdgcn_mfma_f32_32x32x16_bf16(kf[5],qr[2],C1,0,0,0),   P1[6],P1[7],P1[8],P1[9],     pw2[2]=PKW(P1,4), pw2[3]=PKW(P1,6), pw2); \
    VRD(3); SBAR(); GAPA(C0=__builtin_amdgcn_mfma_f32_32x32x16_bf16(kf[6],qr[3],C0,0,0,0),   P1[10],P1[11],P1[12],P1[13], pw3[0]=PKW(P1,8), pw3[1]=PKW(P1,10), pw3); \
    VRD(7); SBAR(); GAPA(C1=__builtin_amdgcn_mfma_f32_32x32x16_bf16(kf[7],qr[3],C1,0,0,0),   P1[14],P1[15],0.f,0.f,       pw3[2]=PKW(P1,12),pw3[3]=PKW(P1,14), pw3); \
    l_reg+=sacc; \
    if(GK){DMA_K((t)+3,sl_cur);} if(GV){DMA_V((t)+1,sl_next);} \
    CMASK(C0,C1,t); \
    { float a=MX3(C0[0],C0[1],C1[0]),b=MX3(C0[2],C0[3],C1[1]); a=MX3(a,C1[2],C1[3]); \
      _Pragma("unroll") for(int r=4;r<16;r+=4){a=MX3(a,C0[r],C0[r+1]);b=MX3(b,C0[r+2],C0[r+3]);a=MX3(a,C1[r],C1[r+1]);b=MX3(b,C1[r+2],C1[r+3]);} \
      float rm=__builtin_fmaxf(a,b); { auto rr=__builtin_amdgcn_permlane32_swap(__float_as_uint(rm),__float_as_uint(rm),false,false); rm=__builtin_fmaxf(__uint_as_float(rr[0]),__uint_as_float(rr[1])); } \
      resc=false; \
      if(__builtin_expect(__any(rm>(float)THRL),0)){ const float dl=__builtin_fmaxf(rm,0.f); mhat+=dl; \
        _Pragma("unroll") for(int r=0;r<16;++r){C0[r]-=dl;C1[r]-=dl;} \
        _Pragma("unroll") for(int r=0;r<16;++r)negm[r]=-mhat; asm volatile("":"+v"(negm)); \
        const float f=__builtin_amdgcn_exp2f(-dl); l_reg*=f; if(hi==0)wsf[r32]=f; resc=true; } } \
    SBAR(); \
    GAPB(o[0]=__builtin_amdgcn_mfma_f32_32x32x16_bf16(PAF(0),VFR(0),o[0],0,0,0), C0,0); \
    GAPB(o[1]=__builtin_amdgcn_mfma_f32_32x32x16_bf16(PAF(0),VFR(4),o[1],0,0,0), C0,4); \
    KRD(GL,0); GAPB(o[0]=__builtin_amdgcn_mfma_f32_32x32x16_bf16(PAF(1),VFR(1),o[0],0,0,0), C0,8); \
    KRD(GL,1); GAPB(o[1]=__builtin_amdgcn_mfma_f32_32x32x16_bf16(PAF(1),VFR(5),o[1],0,0,0), C0,12); \
    KRD(GL,2); GAPB(o[0]=__builtin_amdgcn_mfma_f32_32x32x16_bf16(PAF(2),VFR(2),o[0],0,0,0), C1,0); \
    KRD(GL,3); GAPB(o[1]=__builtin_amdgcn_mfma_f32_32x32x16_bf16(PAF(2),VFR(6),o[1],0,0,0), C1,4); \
    GAPB(o[0]=__builtin_amdgcn_mfma_f32_32x32x16_bf16(PAF(3),VFR(3),o[0],0,0,0), C1,8); \
    GAPB(o[1]=__builtin_amdgcn_mfma_f32_32x32x16_bf16(PAF(3),VFR(7),o[1],0,0,0), C1,12); \
    }while(0)
  int t=1;
  #undef CMASK
  #define CMASK(P0,P1,t) do{ if(MODE==1&&(t)>=4) wmask(P0,P1,TROW(t)-(q0+qrel),hi); }while(0)
  for(;t+5<NT;t+=2){
    STEP(pB0,pB1,pA0,pA1,t,true,true,true);     WAIT_BAR(2); RESC(); ROT();
    STEP(pA0,pA1,pB0,pB1,t+1,true,true,true);   WAIT_BAR(2); RESC(); ROT();
  }
  #undef CMASK
  #define CMASK(P0,P1,t) do{ if(MODE==1&&(t)>=4) wmask(P0,P1,TROW(t)-(q0+qrel),hi); }while(0)
  #define ENDW(tt) do{ if((tt)+3<NT){WAIT_BAR(2);} else if((tt)+2<NT){WAIT_BAR(1);} else {WAIT_BAR(0);} }while(0)
  for(;t+1<NT;t+=2){
    STEP(pB0,pB1,pA0,pA1,t,(t+3<NT),(t+1<NT),(t+1<NT));       ENDW(t);   RESC(); ROT();
    STEP(pA0,pA1,pB0,pB1,t+1,(t+4<NT),(t+2<NT),(t+2<NT));     ENDW(t+1); RESC(); ROT();
  }
  STEP(pB0,pB1,pA0,pA1,NT-1,false,false,false); RESC();
  { float sacc=pB0[0]+pB0[1]; _Pragma("unroll") for(int r=2;r<16;++r)sacc+=pB0[r]; _Pragma("unroll") for(int r=0;r<16;++r)sacc+=pB1[r]; l_reg+=sacc;
    pw0=(u32x4){PKW(pB0,0),PKW(pB0,2),PKW(pB0,4),PKW(pB0,6)};pw1=(u32x4){PKW(pB0,8),PKW(pB0,10),PKW(pB0,12),PKW(pB0,14)};pw2=(u32x4){PKW(pB1,0),PKW(pB1,2),PKW(pB1,4),PKW(pB1,6)};pw3=(u32x4){PKW(pB1,8),PKW(pB1,10),PKW(pB1,12),PKW(pB1,14)};
    SBAR(); pv(o,vb0+sl_cur,PAF(0),PAF(1),PAF(2),PAF(3)); }
  #undef PKW
  #undef PAF
  #undef VFR
  #undef PIN
  #undef MX3
  #undef GAPA
  #undef GAPB
  #undef EX
  #undef VRD
  #undef KRD
  #undef STEP
  #undef ENDW
  {auto rr=__builtin_amdgcn_permlane32_swap(__float_as_uint(l_reg),__float_as_uint(l_reg),false,false);l_reg=__uint_as_float(rr[0])+__uint_as_float(rr[1]);}
  if(MODE==1) l_reg+=__builtin_amdgcn_exp2f(sink_l2-mhat);
  if(hi==0)wsf[32+r32]=l_reg;asm volatile("s_waitcnt lgkmcnt(0)":::"memory");
  float rli[16];
  #pragma unroll
  for(int r=0;r<16;++r)rli[r]=__builtin_amdgcn_rcpf(wsf[32+crow(r,hi)]);
  bf16*Ow=O+(rowbase+q0+wid*QBLK)*DM+h*D;
  { bf16*stg=(bf16*)(shm+LDS_OST)+wid*2048;
    #pragma unroll
    for(int r=0;r<16;++r){const int orow=crow(r,hi);
      #pragma unroll
      for(int d0=0;d0<2;++d0)stg[orow*64+d0*32+r32]=__float2bfloat16(o[d0][r]*rli[r]);}
    asm volatile("s_waitcnt lgkmcnt(0)":::"memory");
    #pragma unroll
    for(int i=0;i<4;++i){const int row=i*8+(lane>>3),ch=lane&7; const u32x4 v=*(const u32x4*)(stg+row*64+ch*8); ATTN_STORE16(Ow+(long)row*DM+ch*8,v);} }
  asm volatile("s_waitcnt lgkmcnt(0)\n\ts_barrier":::"memory");
  #undef DMA_K
  #undef DMA_V
  #undef CMASK
  #undef START
  #undef RESC
  #undef ROT
  #undef TROW
}
constexpr int ATTN_LDS_BYTES=LDS_BYTES;
#undef SBAR
#undef WAIT_BAR
}
#define GAS __attribute__((address_space(1)))
#define LAS __attribute__((address_space(3)))
typedef unsigned short bf16;
typedef unsigned v4u __attribute__((ext_vector_type(4)));
typedef float f32x4 __attribute__((ext_vector_type(4)));
typedef short bf16x8 __attribute__((ext_vector_type(8)));
typedef GAS unsigned gu32;
typedef GAS unsigned long long gu64;
#define RLX_AGENT __ATOMIC_RELAXED, __HIP_MEMORY_SCOPE_AGENT
#define LDS_WAIT() asm volatile("s_waitcnt lgkmcnt(0)" ::: "memory")
#define VM_WAIT() asm volatile("s_waitcnt vmcnt(0)" ::: "memory")
__device__ __forceinline__ unsigned long long rt() { return __builtin_amdgcn_s_memrealtime(); }
typedef float f32x2c_t __attribute__((ext_vector_type(2))); typedef __bf16 bf16x2c_t __attribute__((ext_vector_type(2)));
__device__ __forceinline__ unsigned pk2(float lo, float hi) { f32x2c_t v = {lo, hi}; bf16x2c_t r = __builtin_convertvector(v, bf16x2c_t); return __builtin_bit_cast(unsigned, r); }
__device__ __forceinline__ unsigned f2bf(float f) { return pk2(f, 0.f) & 0xffffu; }

#define XB_TMO      128
#define XB_XCNT(j)  (256  + 64 * (j))
#define XB_XSUB(j)  (1280 + 64 * (j))
#define XB_XGEN(j)  (2304 + 64 * (j))
#define XB_TOP      3328
#define XB_TOPGEN   3392
#define XCD_BAR_WORDS 3456
#define XB_SPIN_CAP (1u << 18)

__device__ __forceinline__ unsigned xb_ld(unsigned* p)              { return __hip_atomic_load(p, __ATOMIC_RELAXED, __HIP_MEMORY_SCOPE_AGENT); }
__device__ __forceinline__ unsigned xb_add(unsigned* p, unsigned v) { return __hip_atomic_fetch_add(p, v, __ATOMIC_RELAXED, __HIP_MEMORY_SCOPE_AGENT); }
__device__ __forceinline__ unsigned xb_xcc_id() { return (unsigned)__builtin_amdgcn_s_getreg((3 << 11) | 20) & 0xFu; }
#define XB_SPIN(cond, bar) do { unsigned _sp = 0; while (cond) { __builtin_amdgcn_s_sleep(1); \
    if ((++_sp & 255u) == 0u) { if (xb_ld(&(bar)[XB_TMO])) break; if (_sp > XB_SPIN_CAP) { atomicAdd(&(bar)[XB_TMO], 1u); break; } } } } while (0)

struct XcdBarrier {
    unsigned* bar; unsigned x;
    volatile LAS unsigned* st;
};

__device__ __forceinline__ XcdBarrier xcd_barrier_post(unsigned* bar, volatile LAS unsigned* st) {
    XcdBarrier b; b.bar = bar; b.x = xb_xcc_id(); b.st = st;
    if (threadIdx.x == 0) (void)xb_add(&bar[XB_XCNT(b.x)], 1u);
    return b;
}
__device__ __forceinline__ void xcd_barrier_complete(unsigned* bar, unsigned x, unsigned& nloc, unsigned& nx) {
    const unsigned G = gridDim.x * gridDim.y * gridDim.z;
    unsigned sum, cnt, mine, sp = 0u;
    for (;;) {
        sum = 0u; cnt = 0u; mine = 0u;
#pragma unroll
        for (unsigned j = 0; j < 16; ++j) { const unsigned c = xb_ld(&bar[XB_XCNT(j)]); sum += c; cnt += (c > 0u) ? 1u : 0u; mine = (j == x) ? c : mine; }
        if (sum == G) break;
        __builtin_amdgcn_s_sleep(1);
        if ((++sp & 255u) == 0u) { if (xb_ld(&bar[XB_TMO])) break; if (sp > XB_SPIN_CAP) { atomicAdd(&bar[XB_TMO], 1u); break; } }
    }
    nloc = mine > 0u ? mine : 1u; nx = cnt > 0u ? cnt : 1u;
}

__device__ __forceinline__ void xcd_barrier(const XcdBarrier& b) {
    asm volatile("s_waitcnt vmcnt(0)" ::: "memory");
    __syncthreads();
    if (threadIdx.x == 0) {
        unsigned* bar = b.bar;
        __builtin_amdgcn_s_waitcnt(0);
        unsigned nloc = b.st[0], nx = b.st[1];
        if (nloc == 0u) { xcd_barrier_complete(bar, b.x, nloc, nx); b.st[0] = nloc; b.st[1] = nx; }
        const unsigned old = xb_add(&bar[XB_XSUB(b.x)], 1u);
        const unsigned gen = old / nloc;
        if (old + 1u == (gen + 1u) * nloc) {
            __builtin_amdgcn_fence(__ATOMIC_RELEASE, "agent");
            asm volatile("s_waitcnt vmcnt(0)" ::: "memory");
            const unsigned og = xb_add(&bar[XB_TOP], 1u);
            const unsigned tg = og / nx;
            if (og + 1u == (tg + 1u) * nx) xb_add(&bar[XB_TOPGEN], 1u);
            else XB_SPIN(xb_ld(&bar[XB_TOPGEN]) == tg, bar);
            __builtin_amdgcn_fence(__ATOMIC_ACQUIRE, "agent");
            xb_add(&bar[XB_XGEN(b.x)], 1u);
            asm volatile("s_waitcnt vmcnt(0)" ::: "memory");
        } else {
            XB_SPIN(xb_ld(&bar[XB_XGEN(b.x)]) == gen, bar);
            __builtin_amdgcn_fence(__ATOMIC_ACQUIRE, "agent");
            asm volatile("s_waitcnt vmcnt(0)" ::: "memory");
        }
    }
    __syncthreads();
}
constexpr int NWAVES = 8, NTHREADS = 512;
constexpr int BATCH = 2, T = 8192, D = 1024, CTXL = 256, FF = 4096;
constexpr int ML_ROWS = BATCH * T;
constexpr int MC_ROWS = BATCH * CTXL;
constexpr int MA_ROWS = ML_ROWS + MC_ROWS;
constexpr int REC_N = 4096;
constexpr int ATT_N = 1536;
constexpr int KV_LEN = T + CTXL;
constexpr int NCHUNK = KV_LEN / 128;
constexpr int NCHAIN_ML = 16;
constexpr int NITEM_ML = NCHAIN_ML * NCHUNK;
constexpr int NCHAIN_RW = 32;
constexpr float NORM_EPS = 1e-6f, GN_EPS = 64e-5f;

constexpr size_t MiB = 1u << 20;
constexpr size_t WS_CTL = 0, CTL_ZERO_BYTES = 1 * MiB;
constexpr size_t WS_MODP = 1 * MiB;
constexpr size_t WS_MOD = 4 * MiB;
constexpr size_t WS_ROPE = WS_MOD + 512 * 1024;
constexpr size_t WS_BIAS = WS_MOD + 640 * 1024;
constexpr size_t WS_SSC = WS_MOD + 800 * 1024;
constexpr size_t WS_SS = 7 * MiB;
constexpr size_t WS_MISC = 5 * MiB;
constexpr size_t WS_WREC = 8 * MiB;
constexpr size_t WS_WATT = 17 * MiB;
constexpr size_t WS_WOUT = 20 * MiB;
constexpr size_t WS_W1 = 24 * MiB;
constexpr size_t WS_W2 = 40 * MiB;
constexpr size_t WS_WG2 = 56 * MiB;
constexpr size_t WS_W2T = WS_WG2 + 128 * 1024;
constexpr size_t WS_XC = 57 * MiB;
constexpr size_t WS_XN = 59 * MiB;
constexpr size_t WS_R = 92 * MiB;
constexpr size_t WS_END = 256 * MiB;
constexpr size_t SZ_A = (size_t)MA_ROWS * 512 * 2;
constexpr size_t R_QM = WS_R, R_KM = R_QM + SZ_A, R_OM = R_KM + SZ_A;
constexpr size_t R_RAW = R_OM + SZ_A;
constexpr size_t R_TWAD = R_RAW + 3 * SZ_A;
constexpr size_t R_SGD = R_TWAD + SZ_A / 2;
constexpr size_t R_GATES = R_SGD + SZ_A / 4;
constexpr size_t R_YRW0 = R_GATES + (size_t)MA_ROWS * 16 * 4;
constexpr size_t R_VM = R_YRW0 + SZ_A;
static_assert(R_VM + 2 * SZ_A <= WS_END, "recurrent map: VM plus the free tail hold the 33 MiB RWKV N buffer");
constexpr size_t R_GATE = R_VM;
constexpr size_t R_MIX = R_QM;
constexpr size_t R_HML = WS_XN;
constexpr size_t DO_CST = 0, DO_YRW1 = 34 * MiB;
static_assert((size_t)NITEM_ML * 16384 * 2 <= DO_YRW1 && DO_YRW1 + SZ_A <= (size_t)ML_ROWS * D * 4, "d_out scratch map");
constexpr size_t R_ATT = WS_R;
constexpr size_t R_QB = R_ATT + (size_t)MA_ROWS * ATT_N * 4;
constexpr size_t SZ_KV = (size_t)BATCH * 2 * KV_LEN * 64 * 2;
constexpr size_t R_KW = R_QB + (size_t)ML_ROWS * D * 2, R_VW = R_KW + SZ_KV, R_KG = R_VW + SZ_KV, R_VG = R_KG + SZ_KV;
static_assert(R_VG + SZ_KV <= WS_END, "attention map");
constexpr size_t R_PART = WS_R + (size_t)MA_ROWS * FF * 2;
constexpr size_t R_H = WS_R;
static_assert(R_H + (size_t)MA_ROWS * FF * 2 + (size_t)4 * MC_ROWS * D * 4 <= WS_END, "ffn map");
constexpr size_t MI_BT = WS_MISC;
constexpr size_t MI_AT = MI_BT + (size_t)8 * MA_ROWS * 4;
constexpr size_t MI_CHS = MI_AT + (size_t)8 * MA_ROWS * 4;
constexpr size_t MI_MCH = MI_CHS + 16 * 66 * 2 * 4;
constexpr size_t MI_DN = MI_MCH + 16 * 66 * 4 + 256;
static_assert(MI_DN + (size_t)NITEM_ML * 128 * 4 <= WS_SS && WS_SS + (size_t)ML_ROWS * 16 * 4 <= WS_WREC && WS_SSC + 512 * 64 * 4 <= WS_MISC && WS_BIAS + 9 * 4096 * 4 <= WS_SSC, "misc map");
constexpr int LDSX_RSC = 153856;

constexpr int CW_TMO = 0, CW_CODE = 1;
constexpr int CW_BAR = 4096;
constexpr int CW_DBG = 65536;

constexpr int RING_OFF = 0, RING_BYTES = 131072;
constexpr int LDSCTL_OFF = RING_BYTES, MISC_OFF = LDSCTL_OFF + 320;
constexpr int LDS_BYTES = 163840;
constexpr int LDSX_OFF = 132096;
struct Frame {
    LAS unsigned char* lds;
    volatile LAS unsigned* MISC;
    gu32* ctl;
    int tid, lane, wave;
    int vcu, G;
    unsigned char* ws; float* out;
};
__device__ __forceinline__ float bf2f(bf16 b) { return __uint_as_float((unsigned)b << 16); }
__device__ __forceinline__ float wave_sum(float v);
__device__ __forceinline__ float wave_max(float v) {
#pragma unroll
    for (int o = 1; o < 64; o <<= 1) v = fmaxf(v, __shfl_xor(v, o));
    return v;
}
template <int CTRL> __device__ __forceinline__ float dpp_mov(float v) { return __builtin_bit_cast(float, __builtin_amdgcn_update_dpp(0, __builtin_bit_cast(int, v), CTRL, 0xF, 0xF, true)); }
__device__ __forceinline__ float sum8(float v) { v += dpp_mov<0xB1>(v); v += dpp_mov<0x4E>(v); v += dpp_mov<0x141>(v); return v; }
__device__ __forceinline__ float sum16(float v) { v = sum8(v); v += dpp_mov<0x140>(v); return v; }
__device__ __forceinline__ float wave_sum(float v) { v = sum16(v); v += __shfl_xor(v, 16); v += __shfl_xor(v, 32); return v; }
__device__ __forceinline__ float sigmoidf_(float x) { return __builtin_amdgcn_rcpf(1.0f + __expf(-x)); }
typedef float f32x2v __attribute__((ext_vector_type(2)));
typedef unsigned u32x2v __attribute__((ext_vector_type(2)));
#define MFMA16(a, b, c) __builtin_amdgcn_mfma_f32_16x16x32_bf16(a, b, c, 0, 0, 0)
template <int P = 72> __device__ __forceinline__ bf16x8 ldsfrag(const LAS bf16* t, int row, int col) { return *(const LAS bf16x8*)(t + row * P + col); }
typedef short v4i16_t __attribute__((ext_vector_type(4)));
template <int P = 72> __device__ __forceinline__ bf16x8 trfrag(const LAS bf16* t, int c0, int k0, int l15, int l4) {
    const LAS bf16* p = t + (k0 + 8 * l4 + (l15 >> 2)) * P + c0 + 4 * (l15 & 3);
    const v4i16_t lo = __builtin_amdgcn_ds_read_tr16_b64_v4i16((LAS v4i16_t*)p), hi = __builtin_amdgcn_ds_read_tr16_b64_v4i16((LAS v4i16_t*)(p + 4 * P));
    return (bf16x8){lo[0], lo[1], lo[2], lo[3], hi[0], hi[1], hi[2], hi[3]};
}
__device__ __forceinline__ bf16x8 gfrag(const bf16* p) { return __builtin_bit_cast(bf16x8, *(const GAS v4u*)p); }
__device__ __forceinline__ u32x2v pk4(f32x4 v) { u32x2v o; o.x = pk2(v[0], v[1]); o.y = pk2(v[2], v[3]); return o; }

enum { I_X = 0, I_C, I_CTX, I_CCTX, I_NORM_MIX, I_NORM_FFN, I_MOD_W, I_MOD_B, I_OUT_W, I_FFN_W1, I_FFN_W2, I_REC_IN_W, I_ML_GATE_B, I_ML_NORM_G, I_RW_CONV,
       I_RW_W0, I_RW_W2, I_RW_A0, I_RW_A2, I_RW_G2, I_RW_KK, I_RW_KA, I_RW_RK, I_RW_NORM_G, I_ATT_IN_W, I_WIN_Q_NORM, I_WIN_K_NORM, I_WIN_SINK, I_GLB_Q_NORM, I_GLB_K_NORM, N_IN };
struct Args { const float* in[N_IN]; float* out; unsigned char* ws; int ph_lo, ph_hi, li, pad; };

template <int MAP> __device__ __forceinline__ int src_col(int n) {
    if (MAP == 0) return n;
    if (n < 2048) return n;
    if (n < 3968) return n + 16;
    if (n < 3984) return n - 1920;
    return -1;
}
template <int MAP> __device__ __forceinline__ void p0_transpose_item(const float* W, int K, int srcN, int dstN, bf16* WT, LAS float* scr, int item, int lane) {
    const int nblk = dstN / 32, kb = item / nblk, nb = item % nblk, k0 = 64 * kb, n0 = 32 * nb;
    const int sc = src_col<MAP>(n0 + (lane & 31));
    float v[32];
#pragma unroll
    for (int i = 0; i < 32; ++i) { const int kk = 2 * i + (lane >> 5); v[i] = (sc >= 0) ? W[(size_t)(k0 + kk) * srcN + sc] : 0.f; }
#pragma unroll
    for (int i = 0; i < 32; ++i) { const int kk = 2 * i + (lane >> 5); scr[kk * 33 + (lane & 31)] = v[i]; }
    LDS_WAIT(); asm volatile("" ::: "memory");
    const int c = lane & 7;
#pragma unroll
    for (int j = 0; j < 4; ++j) { const int n = (lane >> 3) + 8 * j; const LAS float* s = scr + (8 * c) * 33 + n;
        v4u o; o.x = pk2(s[0 * 33], s[1 * 33]); o.y = pk2(s[2 * 33], s[3 * 33]); o.z = pk2(s[4 * 33], s[5 * 33]); o.w = pk2(s[6 * 33], s[7 * 33]);
        *(GAS v4u*)(WT + (size_t)(n0 + n) * K + k0 + 8 * c) = o; }
    LDS_WAIT(); asm volatile("" ::: "memory");
}
template <int PART> struct P0W {
    static constexpr int I_A = PART == 0 ? (D / 64) * (REC_N / 32) : (PART == 1 ? (D / 64) * (ATT_N / 32) : 0);
    static constexpr int I_OUT = (PART == 1 || PART == 4) ? (D / 64) * (D / 32) : 0, I_1 = (PART == 1 || PART == 3) ? (D / 64) * (FF / 32) : 0, I_2 = (PART == 2 || PART == 4) ? (FF / 64) * (D / 32) : 0, I_G2 = PART == 0 ? (128 / 64) * (512 / 32) : 0;
    static constexpr int NITEMS = I_A + I_OUT + I_1 + I_2 + I_G2;
};
template <int PART> __device__ __forceinline__ void p0_weight_item(Frame& F, const Args& A, int r) {
    typedef P0W<PART> P;
    LAS float* scr = (LAS float*)(F.lds + RING_OFF + F.wave * 16384);
    constexpr int l = (PART == 0 || PART >= 3) ? 0 : 1;
    unsigned char* ws = F.ws;
    if (r < P::I_A) { if (PART == 0) p0_transpose_item<1>(A.in[I_REC_IN_W], D, 3984, REC_N, (bf16*)(ws + WS_WREC), scr, r, F.lane); else p0_transpose_item<0>(A.in[I_ATT_IN_W], D, ATT_N, ATT_N, (bf16*)(ws + WS_WATT), scr, r, F.lane); return; } r -= P::I_A;
    if (r < P::I_OUT) { p0_transpose_item<0>(A.in[I_OUT_W] + (size_t)l * D * D, D, D, D, (bf16*)(ws + WS_WOUT) + (size_t)l * D * D, scr, r, F.lane); return; } r -= P::I_OUT;
    if (r < P::I_1) { p0_transpose_item<0>(A.in[I_FFN_W1] + (size_t)l * D * FF, D, FF, FF, (bf16*)(ws + WS_W1) + (size_t)l * D * FF, scr, r, F.lane); return; } r -= P::I_1;
    if (r < P::I_2) { p0_transpose_item<0>(A.in[I_FFN_W2] + (size_t)l * D * FF, FF, D, D, (bf16*)(ws + WS_W2) + (size_t)l * D * FF, scr, r, F.lane); return; } r -= P::I_2;
    if (PART == 0) p0_transpose_item<0>(A.in[I_RW_G2], 128, 512, 512, (bf16*)(ws + WS_WG2), scr, r, F.lane);
}
template <int PART> __device__ __forceinline__ void p0_weights_tail(Frame& F, const Args& A, int ntile, int bid) {
    const int nx = ntile % F.G; __syncthreads();
    int gw, NGW; if (nx == 0) { gw = bid * NWAVES + F.wave; NGW = F.G * NWAVES; } else if (bid >= nx) { gw = (bid - nx) * NWAVES + F.wave; NGW = (F.G - nx) * NWAVES; } else return;
    for (int it = gw; it < P0W<PART>::NITEMS; it += NGW) p0_weight_item<PART>(F, A, it);
}
__device__ __forceinline__ void p0_prologue(Frame& F, const Args& A) {
    const int gw = F.vcu * NWAVES + F.wave, NGW = F.G * NWAVES;
    unsigned char* ws = F.ws;
    constexpr int NGEMV = 2 * 48 * 16;
    float* MODP = (float*)(ws + WS_MODP);
    for (int it = gw; it < NGEMV + P0W<0>::NITEMS; it += NGW) {
        if (it >= NGEMV) { p0_weight_item<0>(F, A, it - NGEMV); continue; }
        const int l = it / (48 * 16), cc = (it / 16) % 48, kc = it % 16, hl = F.lane >> 5, l31 = F.lane & 31;
        float sv[3];
#pragma unroll
        for (int v = 0; v < 3; ++v) { const float cvv = (v < 2) ? A.in[I_C][v * D + kc * 64 + F.lane] : A.in[I_CCTX][kc * 64 + F.lane]; sv[v] = cvv * sigmoidf_(cvv); }
        const float* Wp = A.in[I_MOD_W] + ((size_t)l * D + kc * 64 + hl) * 6144 + cc * 128 + 4 * l31;
        f32x4 a0 = {0, 0, 0, 0}, a1 = a0, a2 = a0;
#pragma unroll 16
        for (int i = 0; i < 32; ++i) { const f32x4 w = *(const f32x4*)(Wp + (size_t)(2 * i) * 6144); const int k = 2 * i + hl; a0 += w * __shfl(sv[0], k); a1 += w * __shfl(sv[1], k); a2 += w * __shfl(sv[2], k); }
#pragma unroll
        for (int e = 0; e < 4; ++e) { a0[e] += __shfl_xor(a0[e], 32); a1[e] += __shfl_xor(a1[e], 32); a2[e] += __shfl_xor(a2[e], 32); }
        if (hl == 0) { float* o = MODP + ((size_t)(l * 16 + kc) * 3) * 6144 + cc * 128 + 4 * l31;
            *(f32x4*)(o) = a0; *(f32x4*)(o + 6144) = a1; *(f32x4*)(o + 2 * 6144) = a2; }
    }
    { bf16* W2T = (bf16*)(ws + WS_W2T);
      for (int e = F.vcu * NTHREADS + F.tid; e < 2 * 2 * 8 * 64 * 64; e += F.G * NTHREADS) {
          const int i = e & 63, ch = (e >> 6) & 63, h = (e >> 12) & 7, d = (e >> 15) & 1, which = e >> 16;
          const float* src = which == 0 ? A.in[I_RW_W2] : A.in[I_RW_A2];
          W2T[e] = (bf16)f2bf(src[(size_t)(d * 64 + i) * 512 + h * 64 + ch]); } }
    { float* ROPE = (float*)(ws + WS_ROPE);
      for (int e = F.vcu * NTHREADS + F.tid; e < 128 * 16; e += F.G * NTHREADS) { const float ang = (float)(e >> 4) * exp2f(-(float)(e & 15) * (13.287712379549449f / 16.0f)); float sn, cs; sincosf(ang, &sn, &cs); ROPE[2 * e] = cs; ROPE[2 * e + 1] = sn; } }
}
__device__ __forceinline__ void p1_mod_finalize(Frame& F, const Args& A) {
    const float* MODP = (const float*)(F.ws + WS_MODP); float* MOD = (float*)(F.ws + WS_MOD);
    for (int i = F.vcu * NTHREADS + F.tid; i < 2 * 3 * 6144; i += F.G * NTHREADS) {
        const int l = i / (3 * 6144), v = (i / 6144) % 3, n = i % 6144;
        float s = A.in[I_MOD_B][l * 6144 + n];
#pragma unroll
        for (int kc = 0; kc < 16; ++kc) s += MODP[((size_t)(l * 16 + kc) * 3 + v) * 6144 + n];
        MOD[i] = s;
    }
}
__device__ __forceinline__ void norm_rows(Frame& F, const Args& A, const float* lat, const float* ctx, int nrows, const float* g, const float* mod, int ch_shift, int ch_scale, bf16* XN, const float* cpart = nullptr, const float* cgate = nullptr) {
    const int gw = F.vcu * NWAVES + F.wave, NGW = F.G * NWAVES;
    constexpr int NR = 2;
    for (int row0 = NR * gw; row0 < nrows; row0 += NR * NGW) {
        f32x4 v[NR][4]; float ss[NR];
#pragma unroll
        for (int q = 0; q < NR; ++q) { const int row = row0 + q; const float* src = (row < ML_ROWS) ? lat + (size_t)row * D : ctx + (size_t)(row - ML_ROWS) * D; ss[q] = 0.f;
#pragma unroll
            for (int j = 0; j < 4; ++j) { v[q][j] = *(const f32x4*)(src + 256 * j + 4 * F.lane);
                if (cpart && row >= ML_ROWS) { const float* pp = cpart + (size_t)(row - ML_ROWS) * D + 256 * j + 4 * F.lane; const f32x4 ps = (*(const f32x4*)pp + *(const f32x4*)(pp + (size_t)MC_ROWS * D)) + (*(const f32x4*)(pp + (size_t)2 * MC_ROWS * D) + *(const f32x4*)(pp + (size_t)3 * MC_ROWS * D)); v[q][j] += ps * *(const f32x4*)(cgate + 256 * j + 4 * F.lane); }
                ss[q] += (v[q][j].x * v[q][j].x + v[q][j].y * v[q][j].y) + (v[q][j].z * v[q][j].z + v[q][j].w * v[q][j].w); } }
        f32x4 gsc[NR][4], sh[NR][4];
#pragma unroll
        for (int q = 0; q < NR; ++q) { const int row = row0 + q; const float* mv = mod + ((row < ML_ROWS) ? (row >> 13) : 2) * 6144;
#pragma unroll
            for (int j = 0; j < 4; ++j) { const int c = 256 * j + 4 * F.lane; gsc[q][j] = *(const f32x4*)(g + c) * (*(const f32x4*)(mv + ch_scale * 1024 + c) + 1.0f); sh[q][j] = *(const f32x4*)(mv + ch_shift * 1024 + c); } }
#pragma unroll
        for (int q = 0; q < NR; ++q) { const int row = row0 + q;
            const float rs = __builtin_amdgcn_rsqf(wave_sum(ss[q]) * (1.f / D) + NORM_EPS);
            unsigned long long* o8 = (unsigned long long*)(XN + (size_t)row * D);
#pragma unroll
            for (int j = 0; j < 4; ++j) {
                const f32x4 y = (v[q][j] * rs) * gsc[q][j] + sh[q][j];
                o8[64 * j + F.lane] = (unsigned long long)pk2(y.x, y.y) | ((unsigned long long)pk2(y.z, y.w) << 32);
            } }
    }
}

__device__ __forceinline__ int ml_chunk_base(int d, int b, int c) {
    if (c < 2) return ML_ROWS + b * CTXL + (d == 0 ? 128 * c : 128 * (1 - c));
    const int cc = c - 2; return b * T + (d == 0 ? 128 * cc : T - 128 * (cc + 1));
}
__device__ __forceinline__ void ml_pass_a(Frame& F, const Args& A) {
    constexpr int P = 136;
    unsigned char* ws = F.ws;
    const bf16* KM = (const bf16*)(ws + R_KM); const bf16* VM = (const bf16*)(ws + R_VM); const float* GATES = (const float*)(ws + R_GATES);
    float* BT = (float*)(ws + MI_BT); float* AT = (float*)(ws + MI_AT); float* CHS = (float*)(ws + MI_CHS); float* DN = (float*)(ws + MI_DN);
    bf16* CST = (bf16*)((unsigned char*)F.out + DO_CST);
    LAS bf16* Kt = (LAS bf16*)(F.lds); LAS bf16* Vt = Kt + 128 * P; LAS float* wl = (LAS float*)(F.lds + 2 * 128 * P * 2);
    const int w = F.wave;
    v4u kreg[4], vreg[4];
#define MLA_LOAD(it_) do { const int ch_ = (it_) / NCHUNK, c_ = (it_) % NCHUNK, d_ = ch_ >> 3, b_ = (ch_ >> 2) & 1, h_ = ch_ & 3; const int base_ = ml_chunk_base(d_, b_, c_); \
        _Pragma("unroll") for (int j = 0; j < 4; ++j) { const int idx = F.tid + 512 * j, row = idx >> 4, chk = idx & 15; \
            kreg[j] = *(const GAS v4u*)(KM + (size_t)(base_ + row) * 512 + h_ * 128 + 8 * chk); vreg[j] = *(const GAS v4u*)(VM + (size_t)(base_ + row) * 512 + h_ * 128 + 8 * chk); } } while (0)
    if (F.vcu < NITEM_ML) MLA_LOAD(F.vcu);
    for (int item = F.vcu; item < NITEM_ML; item += F.G) {
        const int chain = item / NCHUNK, c = item % NCHUNK, d = chain >> 3, b = (chain >> 2) & 1, h = chain & 3;
        const int base = ml_chunk_base(d, b, c);
        int lz = 0; asm volatile("" : "+s"(lz));
        const int tid = F.tid + lz, lane = tid & 63, l15 = lane & 15, l4 = lane >> 4;
        __syncthreads();
        if (w == 0) {
            const float bi = A.in[I_ML_GATE_B][(2 * d) * 4 + h], bfg = A.in[I_ML_GATE_B][(2 * d + 1) * 4 + h];
            float iv[2], lf[2];
#pragma unroll
            for (int e = 0; e < 2; ++e) { const int s = 2 * lane + e, o = d == 0 ? s : 127 - s; const float* gp = GATES + (size_t)(base + o) * 16 + 8 * d + h;
                iv[e] = gp[0] + bi; const float f = gp[4] + bfg; lf[e] = (f >= 0.f) ? -log1pf(__expf(-f)) : f - log1pf(__expf(f)); }
            const float pair = lf[0] + lf[1]; float incl = pair;
#pragma unroll
            for (int o = 1; o < 64; o <<= 1) { const float t_ = __shfl_up(incl, o); if (lane >= o) incl += t_; }
            const float excl = incl - pair; float bb[2] = {excl + lf[0], excl + pair}; float aa[2] = {iv[0] - bb[0], iv[1] - bb[1]};
            const float amax = wave_max(fmaxf(aa[0], aa[1])); const float bend = __shfl(bb[1], 63);
#pragma unroll
            for (int e = 0; e < 2; ++e) { const int s = 2 * lane + e, o = d == 0 ? s : 127 - s; const size_t gi = (size_t)(d * 4 + h) * MA_ROWS + base + o; BT[gi] = bb[e]; AT[gi] = aa[e]; wl[o] = __expf(aa[e] - amax); }
            if (lane == 0) { CHS[(chain * NCHUNK + c) * 2] = bend; CHS[(chain * NCHUNK + c) * 2 + 1] = amax; }
        }
#pragma unroll
        for (int j = 0; j < 4; ++j) { const int idx = tid + 512 * j, row = idx >> 4, ch = idx & 15; *(LAS v4u*)(Kt + row * P + 8 * ch) = kreg[j]; }
        __syncthreads();
#pragma unroll
        for (int j = 0; j < 4; ++j) { const int idx = tid + 512 * j, row = idx >> 4, ch = idx & 15; const float ws_ = wl[row]; const unsigned* pv_ = (const unsigned*)&vreg[j]; v4u o; unsigned* po = (unsigned*)&o;
#pragma unroll
            for (int q = 0; q < 4; ++q) po[q] = pk2(__uint_as_float(pv_[q] << 16) * ws_, __uint_as_float(pv_[q] & 0xffff0000u) * ws_);
            *(LAS v4u*)(Vt + row * P + 8 * ch) = o; }
        { const int dk = tid >> 2, q = tid & 3; float s = 0.f;
#pragma unroll 8
            for (int j = 0; j < 32; ++j) { const int so = 32 * q + j; s += bf2f(Kt[so * P + dk]) * wl[so]; }
            s += dpp_mov<0xB1>(s); s += dpp_mov<0x4E>(s);
            if (q == 0) DN[(size_t)item * 128 + dk] = s; }
        __syncthreads();
        { const int itn = item + F.G; if (itn < NITEM_ML) MLA_LOAD(itn); }
        f32x4 acc[8];
#pragma unroll
        for (int n8 = 0; n8 < 8; ++n8) acc[n8] = (f32x4){0.f, 0.f, 0.f, 0.f};
#pragma unroll
        for (int kk = 0; kk < 4; ++kk) {
            const bf16x8 vf = trfrag<P>(Vt, 16 * w, 32 * kk, l15, l4);
#pragma unroll
            for (int n8 = 0; n8 < 8; ++n8) acc[n8] = MFMA16(trfrag<P>(Kt, 16 * n8, 32 * kk, l15, l4), vf, acc[n8]);
        }
        bf16* cst = CST + (size_t)item * 16384 + (size_t)(16 * w + l15) * 128 + 4 * l4;
#pragma unroll
        for (int n8 = 0; n8 < 8; ++n8) *(u32x2v*)(cst + 16 * n8) = pk4(acc[n8]);
    }
#undef MLA_LOAD
    __syncthreads();
}
__device__ __forceinline__ void ml_pass_b(Frame& F, const Args& A) {
    unsigned char* ws = F.ws;
    const float* CHS = (const float*)(ws + MI_CHS); float* MCH = (float*)(ws + MI_MCH); float* DN = (float*)(ws + MI_DN);
    unsigned* CST = (unsigned*)((unsigned char*)F.out + DO_CST);
    constexpr int PER_CHAIN = 8192 + 128, NWORK = NCHAIN_ML * PER_CHAIN, NB = 11;
    static_assert(NCHUNK % NB == 0, "chunk batches");
    for (int wi = F.vcu * NTHREADS + F.tid; wi < NWORK; wi += F.G * NTHREADS) {
        const int chain = wi / PER_CHAIN, e = wi % PER_CHAIN;
        float m = 0.f, c0 = 0.f, c1 = 0.f;
        const float* chs = CHS + (size_t)chain * NCHUNK * 2;
        if (e < 8192) {
            unsigned* p = CST + (size_t)chain * NCHUNK * 8192 + e;
            for (int cb = 0; cb < NCHUNK; cb += NB) {
                unsigned dl[NB]; float be[NB], am[NB];
#pragma unroll
                for (int k = 0; k < NB; ++k) { dl[k] = p[(size_t)(cb + k) * 8192]; be[k] = chs[(cb + k) * 2]; am[k] = chs[(cb + k) * 2 + 1]; }
#pragma unroll
                for (int k = 0; k < NB; ++k) {
                    p[(size_t)(cb + k) * 8192] = pk2(c0, c1);
                    if (e == 0) MCH[chain * NCHUNK + cb + k] = m;
                    const float g = fmaxf(m, am[k]), so = __expf(m - g), sn = __expf(am[k] - g);
                    c0 = so * c0 + sn * __uint_as_float(dl[k] << 16); c1 = so * c1 + sn * __uint_as_float(dl[k] & 0xffff0000u);
                    m = be[k] + g;
                }
            }
        } else {
            float* p = DN + (size_t)chain * NCHUNK * 128 + (e - 8192);
            for (int cb = 0; cb < NCHUNK; cb += NB) {
                float dl[NB], be[NB], am[NB];
#pragma unroll
                for (int k = 0; k < NB; ++k) { dl[k] = p[(size_t)(cb + k) * 128]; be[k] = chs[(cb + k) * 2]; am[k] = chs[(cb + k) * 2 + 1]; }
#pragma unroll
                for (int k = 0; k < NB; ++k) {
                    p[(size_t)(cb + k) * 128] = c0;
                    const float g = fmaxf(m, am[k]), so = __expf(m - g), sn = __expf(am[k] - g);
                    c0 = so * c0 + sn * dl[k]; m = be[k] + g;
                }
            }
        }
    }
}
__device__ __forceinline__ void ml_pass_c(Frame& F, const Args& A) {
    constexpr int P = 136;
    unsigned char* ws = F.ws;
    const bf16* QM = (const bf16*)(ws + R_QM); const bf16* KM = (const bf16*)(ws + R_KM); const bf16* VM = (const bf16*)(ws + R_VM);
    const float* BT = (const float*)(ws + MI_BT); const float* AT = (const float*)(ws + MI_AT); const float* MCH = (const float*)(ws + MI_MCH); const float* NST = (const float*)(ws + MI_DN);
    const bf16* CST = (const bf16*)((unsigned char*)F.out + DO_CST);
    bf16* HML = (bf16*)(ws + R_HML);
    LAS bf16* Kt = (LAS bf16*)(F.lds); LAS bf16* Vt = Kt + 128 * P; LAS bf16* Ct = Vt + 128 * P;
    LAS bf16* Sl = F.wave < 6 ? (LAS bf16*)(F.lds + 3 * 128 * P * 2 + F.wave * (16 * P * 2)) : (LAS bf16*)(F.lds + LDSX_OFF + (F.wave - 6) * (16 * P * 2));
    LAS float* aw = (LAS float*)(F.lds + LDSX_OFF + 2 * (16 * P * 2)); LAS float* gq = aw + 128; LAS float* bq = gq + 128;
    static_assert(3 * 128 * P * 2 + 6 * 16 * P * 2 <= RING_BYTES && LDSX_OFF + 2 * 16 * P * 2 + 3 * 128 * 4 <= LDS_BYTES, "mLSTM pass C LDS map");
    const int w = F.wave;
    v4u kreg[4], vreg[4], creg[4];
    bf16x8 qn[4]; float m_n = 0.f, aan[2] = {0.f, 0.f}, bbn[2] = {0.f, 0.f};
#define MLC_LOAD(it_) do { const int ch_ = (it_) / NCHUNK, c_ = (it_) % NCHUNK, d_ = ch_ >> 3, b_ = (ch_ >> 2) & 1, h_ = ch_ & 3; const int base_ = ml_chunk_base(d_, b_, c_); \
        _Pragma("unroll") for (int j = 0; j < 4; ++j) { const int idx = F.tid + 512 * j, row = idx >> 4, chk = idx & 15; \
            kreg[j] = *(const GAS v4u*)(KM + (size_t)(base_ + row) * 512 + h_ * 128 + 8 * chk); vreg[j] = *(const GAS v4u*)(VM + (size_t)(base_ + row) * 512 + h_ * 128 + 8 * chk); \
            creg[j] = *(const GAS v4u*)(CST + (size_t)(it_) * 16384 + (size_t)row * 128 + 8 * chk); } \
        m_n = MCH[ch_ * NCHUNK + c_]; \
        { const bf16* qp_ = QM + (size_t)(base_ + 16 * F.wave + (F.lane & 15)) * 512 + h_ * 128 + 8 * (F.lane >> 4); _Pragma("unroll") for (int kk = 0; kk < 4; ++kk) qn[kk] = gfrag(qp_ + 32 * kk); } \
        if (F.wave == 0) { _Pragma("unroll") for (int e = 0; e < 2; ++e) { const int s_ = 2 * F.lane + e, o_ = d_ == 0 ? s_ : 127 - s_; const size_t gi_ = (size_t)(d_ * 4 + h_) * MA_ROWS + base_ + o_; aan[e] = AT[gi_]; bbn[e] = BT[gi_]; } } } while (0)
    if (F.vcu < NITEM_ML) MLC_LOAD(F.vcu);
    for (int item = F.vcu; item < NITEM_ML; item += F.G) {
        const int chain = item / NCHUNK, c = item % NCHUNK, d = chain >> 3, b = (chain >> 2) & 1, h = chain & 3;
        const int base = ml_chunk_base(d, b, c);
        int lz = 0; asm volatile("" : "+s"(lz));
        const int tid = F.tid + lz, lane = tid & 63, l15 = lane & 15, l4 = lane >> 4;
        const float m = m_n;
        const int to = 16 * w + l15;
        bf16x8 qf[4];
#pragma unroll
        for (int kk = 0; kk < 4; ++kk) qf[kk] = qn[kk];
        __syncthreads();
        if (w == 0) {
            float aa[2], bb[2];
#pragma unroll
            for (int e = 0; e < 2; ++e) { aa[e] = aan[e]; bb[e] = bbn[e]; }
            const float pm = fmaxf(aa[0], aa[1]); float incl = pm;
#pragma unroll
            for (int o = 1; o < 64; o <<= 1) { const float t_ = __shfl_up(incl, o); if (lane >= o) incl = fmaxf(incl, t_); }
            float excl = __shfl_up(incl, 1); if (lane == 0) excl = -INFINITY;
            const float g0 = fmaxf(m, fmaxf(excl, aa[0])), g1 = fmaxf(m, incl);
#pragma unroll
            for (int e = 0; e < 2; ++e) { const int s = 2 * lane + e, o = d == 0 ? s : 127 - s; aw[o] = aa[e]; gq[o] = e == 0 ? g0 : g1; bq[o] = bb[e]; }
        }
#pragma unroll
        for (int j = 0; j < 4; ++j) { const int idx = tid + 512 * j, row = idx >> 4, chk = idx & 15; *(LAS v4u*)(Kt + row * P + 8 * chk) = kreg[j]; *(LAS v4u*)(Vt + row * P + 8 * chk) = vreg[j]; *(LAS v4u*)(Ct + row * P + 8 * chk) = creg[j]; }
        __syncthreads();
        { const int itn = item + F.G; if (itn < NITEM_ML) MLC_LOAD(itn); }
        const float gt = gq[to], bt = bq[to];
        float den = 0.f;
#pragma unroll
        for (int m8 = 0; m8 < 8; ++m8) {
            f32x4 st = {0.f, 0.f, 0.f, 0.f};
#pragma unroll
            for (int kk = 0; kk < 4; ++kk) st = MFMA16(ldsfrag<P>(Kt, 16 * m8 + l15, 32 * kk + 8 * l4), qf[kk], st);
            f32x4 vv;
#pragma unroll
            for (int r = 0; r < 4; ++r) { const int so = 16 * m8 + 4 * l4 + r; const bool valid = d == 0 ? (so <= to) : (so >= to); const float wgt = valid ? __expf(aw[so] - gt) : 0.f; vv[r] = st[r] * wgt; den += vv[r]; }
            *(LAS u32x2v*)(Sl + l15 * P + 16 * m8 + 4 * l4) = pk4(vv);
        }
        den += __shfl_xor(den, 16); den += __shfl_xor(den, 32);
        float qn = 0.f;
        { const float* np = NST + (size_t)item * 128 + 8 * l4;
#pragma unroll
            for (int kk = 0; kk < 4; ++kk) { const unsigned* pq = (const unsigned*)&qf[kk];
#pragma unroll
                for (int e = 0; e < 4; ++e) qn += __uint_as_float(pq[e] << 16) * np[32 * kk + 2 * e] + __uint_as_float(pq[e] & 0xffff0000u) * np[32 * kk + 2 * e + 1]; }
            qn += __shfl_xor(qn, 16); qn += __shfl_xor(qn, 32); }
        asm volatile("s_waitcnt lgkmcnt(0)" ::: "memory"); __builtin_amdgcn_wave_barrier();
        bf16x8 sf[4];
#pragma unroll
        for (int kk = 0; kk < 4; ++kk) sf[kk] = ldsfrag<P>(Sl, l15, 32 * kk + 8 * l4);
        const float wprev = __expf(m - gt);
        const float dent = den + wprev * qn;
        const float rdn = __builtin_amdgcn_rcpf(fmaxf(fabsf(dent), __expf(-(bt + gt))));
        bf16* hp = HML + ((size_t)d * MA_ROWS + base + to) * 512 + h * 128 + 4 * l4;
#pragma unroll
        for (int v8 = 0; v8 < 8; ++v8) {
            f32x4 an = {0.f, 0.f, 0.f, 0.f}, ai = {0.f, 0.f, 0.f, 0.f};
#pragma unroll
            for (int kk = 0; kk < 4; ++kk) {
                an = MFMA16(trfrag<P>(Vt, 16 * v8, 32 * kk, l15, l4), sf[kk], an);
                ai = MFMA16(ldsfrag<P>(Ct, 16 * v8 + l15, 32 * kk + 8 * l4), qf[kk], ai);
            }
            f32x4 o; o[0] = (an[0] + wprev * ai[0]) * rdn; o[1] = (an[1] + wprev * ai[1]) * rdn; o[2] = (an[2] + wprev * ai[2]) * rdn; o[3] = (an[3] + wprev * ai[3]) * rdn;
            *(u32x2v*)(hp + 16 * v8) = pk4(o);
        }
    }
#undef MLC_LOAD
    __syncthreads();
}
template <class EPI> __device__ __forceinline__ void ctx_gemm(Frame& F, const bf16* Am, int lda, const bf16* Bt, int ldb, int M, int N, int K, const EPI& epi) {
    LAS f32x4* red = (LAS f32x4*)(F.lds);
    const int lane = F.lane, w = F.wave, l15 = lane & 15, l4 = lane >> 4;
    const int ntn = N / 64, ntiles = (M / 32) * ntn, ks = K / 8;
    for (int tile = F.vcu; tile < ntiles; tile += F.G) {
        const int tm = tile / ntn, tn = tile % ntn;
        f32x4 acc[2][4];
#pragma unroll
        for (int mi = 0; mi < 2; ++mi)
#pragma unroll
            for (int ni = 0; ni < 4; ++ni) acc[mi][ni] = (f32x4){0.f, 0.f, 0.f, 0.f};
        const bf16* ap = Am + (size_t)(32 * tm + l15) * lda + w * ks + 8 * l4;
        const bf16* bp = Bt + (size_t)(64 * tn + l15) * ldb + w * ks + 8 * l4;
#pragma unroll 2
        for (int k0 = 0; k0 < ks; k0 += 32) {
            bf16x8 a[2], b[4];
#pragma unroll
            for (int mi = 0; mi < 2; ++mi) a[mi] = __builtin_bit_cast(bf16x8, *(const GAS v4u*)(ap + (size_t)(16 * mi) * lda + k0));
#pragma unroll
            for (int ni = 0; ni < 4; ++ni) b[ni] = __builtin_bit_cast(bf16x8, *(const GAS v4u*)(bp + (size_t)(16 * ni) * ldb + k0));
#pragma unroll
            for (int mi = 0; mi < 2; ++mi)
#pragma unroll
                for (int ni = 0; ni < 4; ++ni) acc[mi][ni] = MFMA16(a[mi], b[ni], acc[mi][ni]);
        }
        __syncthreads();
#pragma unroll
        for (int mi = 0; mi < 2; ++mi)
#pragma unroll
            for (int ni = 0; ni < 4; ++ni) red[(w * 8 + mi * 4 + ni) * 64 + lane] = acc[mi][ni];
        __syncthreads();
        {
            f32x4 s = red[(0 * 8 + w) * 64 + lane];
#pragma unroll
            for (int ww = 1; ww < 8; ++ww) s += red[(ww * 8 + w) * 64 + lane];
            const int row0 = 32 * tm + 16 * (w >> 2) + 4 * l4, col = 64 * tn + 16 * (w & 3) + l15;
#pragma unroll
            for (int r = 0; r < 4; ++r) epi(row0 + r, col, s[r]);
        }
    }
    __syncthreads();
}
template <int KSPLIT = 1, class EPI> __device__ __forceinline__ void ctx_gemm2(Frame& F, const bf16* Am, int lda, const bf16* Bt, int ldb, int M, int N, int K, const EPI& epi) {
    constexpr int TP = 72, ABYTES = 64 * TP * 2, BBYTES = 128 * TP * 2, STAGE = ABYTES + BBYTES;
    const int tid = F.tid, lane = F.lane, w = F.wave, l15 = lane & 15, l4 = lane >> 4, wm = w >> 2, wn = w & 3;
    const int ntn = N / 128, ntiles = (M / 64) * ntn * KSPLIT, nk = K / 64 / KSPLIT;
    const int arow = tid >> 3, apc = tid & 7;
    for (int tile = F.vcu; tile < ntiles; tile += F.G) {
        const int ksl = tile % KSPLIT, tl = tile / KSPLIT, tm = tl / ntn, tn = tl % ntn;
        const bf16* ap = Am + (size_t)(64 * tm + arow) * lda + 8 * apc + (size_t)ksl * nk * 64;
        const bf16* bp0 = Bt + (size_t)(128 * tn + arow) * ldb + 8 * apc + (size_t)ksl * nk * 64; const bf16* bp1 = bp0 + (size_t)64 * ldb;
        f32x4 acc[2][2];
#pragma unroll
        for (int mi = 0; mi < 2; ++mi)
#pragma unroll
            for (int ni = 0; ni < 2; ++ni) acc[mi][ni] = (f32x4){0.f, 0.f, 0.f, 0.f};
        v4u xa = *(const GAS v4u*)ap, xb0 = *(const GAS v4u*)bp0, xb1 = *(const GAS v4u*)bp1;
        v4u ya = *(const GAS v4u*)(ap + 64), yb0 = *(const GAS v4u*)(bp0 + 64), yb1 = *(const GAS v4u*)(bp1 + 64);
        __syncthreads();
#define CG2_STEP(RA, RB0, RB1, ks_) do { LAS bf16* As = (LAS bf16*)(F.lds + ((ks_) & 1) * STAGE); LAS bf16* Bs = (LAS bf16*)(F.lds + ((ks_) & 1) * STAGE + ABYTES); \
            *(LAS v4u*)(As + arow * TP + 8 * apc) = RA; *(LAS v4u*)(Bs + arow * TP + 8 * apc) = RB0; *(LAS v4u*)(Bs + (arow + 64) * TP + 8 * apc) = RB1; \
            if ((ks_) + 2 < nk) { RA = *(const GAS v4u*)(ap + 64 * ((ks_) + 2)); RB0 = *(const GAS v4u*)(bp0 + 64 * ((ks_) + 2)); RB1 = *(const GAS v4u*)(bp1 + 64 * ((ks_) + 2)); } \
            asm volatile("s_waitcnt lgkmcnt(0)\n\ts_barrier" ::: "memory"); \
            _Pragma("unroll") for (int kk = 0; kk < 2; ++kk) { bf16x8 a[2], b[2]; \
                _Pragma("unroll") for (int mi = 0; mi < 2; ++mi) a[mi] = ldsfrag<TP>(As, 32 * wm + 16 * mi + l15, 32 * kk + 8 * l4); \
                _Pragma("unroll") for (int ni = 0; ni < 2; ++ni) b[ni] = ldsfrag<TP>(Bs, 32 * wn + 16 * ni + l15, 32 * kk + 8 * l4); \
                _Pragma("unroll") for (int mi = 0; mi < 2; ++mi) _Pragma("unroll") for (int ni = 0; ni < 2; ++ni) acc[mi][ni] = MFMA16(a[mi], b[ni], acc[mi][ni]); } } while (0)
        for (int ks = 0; ks < nk; ks += 2) { CG2_STEP(xa, xb0, xb1, ks); CG2_STEP(ya, yb0, yb1, ks + 1); }
#undef CG2_STEP
#pragma unroll
        for (int mi = 0; mi < 2; ++mi)
#pragma unroll
            for (int ni = 0; ni < 2; ++ni) { const int row0 = 64 * tm + 32 * wm + 16 * mi + 4 * l4, col = 128 * tn + 32 * wn + 16 * ni + l15;
#pragma unroll
                for (int r = 0; r < 4; ++r) { if constexpr (KSPLIT == 1) epi(row0 + r, col, acc[mi][ni][r]); else epi(row0 + r, col, acc[mi][ni][r], ksl); } }
    }
    __syncthreads();
}
__device__ __forceinline__ void rw_seq_rows(int d, int b, int p, int& R, int& idx, int& len, int& sbase) {
    if (p < CTXL) { idx = d == 0 ? p : CTXL - 1 - p; len = CTXL; sbase = ML_ROWS + b * CTXL; }
    else { const int q = p - CTXL; idx = d == 0 ? q : T - 1 - q; len = T; sbase = b * T; }
    R = sbase + idx;
}
__device__ __forceinline__ void rw_scan(Frame& F, const Args& A) {
    unsigned char* ws = F.ws;
    const bf16* RAWb = (const bf16*)(ws + R_RAW); const bf16* TWAD = (const bf16*)(ws + R_TWAD);
    LAS float* w2h = (LAS float*)(F.lds); LAS float* a2h = w2h + 4096; LAS float* vecs = a2h + 4096;
    LAS float* ybuf = vecs + 32 * 384; LAS float* twl = ybuf + 2048; LAS float* adl = twl + 2048;
    const int tid = F.tid, lane = F.lane, wv = F.wave;
    for (int chain = F.vcu; chain < NCHAIN_RW; chain += F.G) {
        const int d = chain >> 4, b = (chain >> 3) & 1, h = chain & 7;
        bf16* YRW = d == 0 ? (bf16*)(ws + R_YRW0) : (bf16*)((unsigned char*)F.out + DO_YRW1);
        __syncthreads();
        for (int i = tid; i < 4096; i += NTHREADS) { const int ii = i >> 6, ch = i & 63; w2h[i] = A.in[I_RW_W2][((size_t)d * 64 + ii) * 512 + h * 64 + ch]; a2h[i] = A.in[I_RW_A2][((size_t)d * 64 + ii) * 512 + h * 64 + ch]; }
        const int ppos = tid >> 4, chq = tid & 15, ch0 = 4 * chq, hc = h * 64 + ch0;
        float cw[3][3][4], kkw[4], kaw[4], w0v[4], a0v[4];
#pragma unroll
        for (int k = 0; k < 3; ++k)
#pragma unroll
            for (int g = 0; g < 3; ++g)
#pragma unroll
                for (int e = 0; e < 4; ++e) cw[k][g][e] = A.in[I_RW_CONV][k * 1536 + g * 512 + hc + e];
#pragma unroll
        for (int e = 0; e < 4; ++e) { kkw[e] = A.in[I_RW_KK][hc + e]; kaw[e] = A.in[I_RW_KA][hc + e]; w0v[e] = A.in[I_RW_W0][d * 512 + hc + e]; a0v[e] = A.in[I_RW_A0][d * 512 + hc + e]; }
        float S[8];
#pragma unroll
        for (int j = 0; j < 8; ++j) S[j] = 0.f;
        const int row_i = 8 * wv + (lane >> 3), j0 = 8 * (lane & 7);
        for (int blk = 0; blk < KV_LEN / 32; ++blk) {
            int R, idx, len, sbase; rw_seq_rows(d, b, 32 * blk + ppos, R, idx, len, sbase);
            __syncthreads();
            { const u32x2v tw = *(const GAS u32x2v*)(TWAD + (size_t)R * 256 + d * 64 + ch0), ad = *(const GAS u32x2v*)(TWAD + (size_t)R * 256 + 128 + d * 64 + ch0);
              LAS float* t_ = twl + ppos * 64 + ch0; LAS float* a_ = adl + ppos * 64 + ch0;
              t_[0] = __uint_as_float(tw.x << 16); t_[1] = __uint_as_float(tw.x & 0xffff0000u); t_[2] = __uint_as_float(tw.y << 16); t_[3] = __uint_as_float(tw.y & 0xffff0000u);
              a_[0] = __uint_as_float(ad.x << 16); a_[1] = __uint_as_float(ad.x & 0xffff0000u); a_[2] = __uint_as_float(ad.y << 16); a_[3] = __uint_as_float(ad.y & 0xffff0000u); }
            float cv[3][4];
#pragma unroll
            for (int g = 0; g < 3; ++g)
#pragma unroll
                for (int e = 0; e < 4; ++e) cv[g][e] = 0.f;
#pragma unroll
            for (int k = 0; k < 3; ++k) { const int ii = idx + k - 1; if (ii >= 0 && ii < len) {
#pragma unroll
                for (int g = 0; g < 3; ++g) { const u32x2v x = *(const GAS u32x2v*)(RAWb + (size_t)(sbase + ii) * 1536 + g * 512 + hc);
                    cv[g][0] += cw[k][g][0] * __uint_as_float(x.x << 16); cv[g][1] += cw[k][g][1] * __uint_as_float(x.x & 0xffff0000u); cv[g][2] += cw[k][g][2] * __uint_as_float(x.y << 16); cv[g][3] += cw[k][g][3] * __uint_as_float(x.y & 0xffff0000u); } } }
            float kkv[4], ss = 0.f;
#pragma unroll
            for (int e = 0; e < 4; ++e) { kkv[e] = cv[1][e] * kkw[e]; ss += kkv[e] * kkv[e]; }
            ss += __shfl_xor(ss, 1); ss += __shfl_xor(ss, 2); ss += __shfl_xor(ss, 4); ss += __shfl_xor(ss, 8);
            const float rn = __builtin_amdgcn_rsqf(ss + NORM_EPS);
            __syncthreads();
            float wl_[4], al_[4];
#pragma unroll
            for (int e = 0; e < 4; ++e) { wl_[e] = w0v[e]; al_[e] = a0v[e]; }
            for (int i = 0; i < 64; ++i) { const float tv = twl[ppos * 64 + i], av = adl[ppos * 64 + i]; const f32x4 w2 = *(const LAS f32x4*)(w2h + i * 64 + ch0), a2 = *(const LAS f32x4*)(a2h + i * 64 + ch0);
#pragma unroll
                for (int e = 0; e < 4; ++e) { wl_[e] += tv * w2[e]; al_[e] += av * a2[e]; } }
            LAS float* vb = vecs + ppos * 384 + ch0;
#pragma unroll
            for (int e = 0; e < 4; ++e) {
                const float wdec = __expf(-0.6065306597126334f * sigmoidf_(wl_[e])), a = sigmoidf_(al_[e]), kk = kkv[e] * rn;
                vb[e] = wdec; vb[64 + e] = kk * a; vb[128 + e] = cv[1][e] * (1.0f + (a - 1.0f) * kaw[e]); vb[192 + e] = kk; vb[256 + e] = cv[0][e]; vb[320 + e] = cv[2][e];
            }
            __syncthreads();
            for (int pp = 0; pp < 32; ++pp) {
                const LAS float* v_ = vecs + pp * 384;
                const f32x4 k0 = *(const LAS f32x4*)(v_ + 192 + j0), k1 = *(const LAS f32x4*)(v_ + 192 + j0 + 4);
                float skk = S[0] * k0[0] + S[1] * k0[1] + S[2] * k0[2] + S[3] * k0[3] + S[4] * k1[0] + S[5] * k1[1] + S[6] * k1[2] + S[7] * k1[3];
                skk += __shfl_xor(skk, 1); skk += __shfl_xor(skk, 2); skk += __shfl_xor(skk, 4);
                const f32x4 w0_ = *(const LAS f32x4*)(v_ + j0), w1_ = *(const LAS f32x4*)(v_ + j0 + 4), b0 = *(const LAS f32x4*)(v_ + 64 + j0), b1 = *(const LAS f32x4*)(v_ + 64 + j0 + 4);
                const f32x4 e0 = *(const LAS f32x4*)(v_ + 128 + j0), e1 = *(const LAS f32x4*)(v_ + 128 + j0 + 4), r0 = *(const LAS f32x4*)(v_ + 256 + j0), r1 = *(const LAS f32x4*)(v_ + 256 + j0 + 4);
                const float vi = v_[320 + row_i];
                float y = 0.f;
#pragma unroll
                for (int j = 0; j < 4; ++j) { S[j] = S[j] * w0_[j] - skk * b0[j] + vi * e0[j]; S[4 + j] = S[4 + j] * w1_[j] - skk * b1[j] + vi * e1[j]; y += S[j] * r0[j] + S[4 + j] * r1[j]; }
                y += __shfl_xor(y, 1); y += __shfl_xor(y, 2); y += __shfl_xor(y, 4);
                if ((lane & 7) == 0) ybuf[pp * 64 + row_i] = y;
            }
            __syncthreads();
            { const LAS float* yb = ybuf + ppos * 64 + ch0; u32x2v o; o.x = pk2(yb[0], yb[1]); o.y = pk2(yb[2], yb[3]); *(u32x2v*)(YRW + (size_t)R * 512 + hc) = o; }
        }
    }
    __syncthreads();
}

__device__ __forceinline__ void merge_rows(Frame& F, const Args& A) {
    unsigned char* ws = F.ws;
    const bf16* HML = (const bf16*)(ws + R_HML); const bf16* OM = (const bf16*)(ws + R_OM); const bf16* RAWb = (const bf16*)(ws + R_RAW);
    const bf16* YRW0 = (const bf16*)(ws + R_YRW0); const bf16* YRW1 = (const bf16*)((unsigned char*)F.out + DO_YRW1);
    bf16* MIX = (bf16*)(ws + R_MIX);
    const int gw = F.vcu * NWAVES + F.wave, NGW = F.G * NWAVES, lane = F.lane, c8 = 8 * lane;
    for (int row = gw; row < MA_ROWS; row += NGW) {
        float y[8];
        const v4u in_og = *(const GAS v4u*)(OM + (size_t)row * 512 + c8);
        const v4u in_y0 = *(const GAS v4u*)(YRW0 + (size_t)row * 512 + c8), in_y1 = *(const GAS v4u*)(YRW1 + (size_t)row * 512 + c8);
        const v4u in_gg = *(const GAS v4u*)(RAWb + (size_t)row * 1536 + c8);
        const float bs = ((const float*)(ws + WS_SS))[(size_t)row * 8 + (lane >> 3)];
        int idx, len, sbase; if (row < ML_ROWS) { idx = row & (T - 1); len = T; sbase = row - idx; } else { idx = (row - ML_ROWS) & (CTXL - 1); len = CTXL; sbase = row - idx; }
        v4u in_x[3];
#pragma unroll
        for (int k = 0; k < 3; ++k) { const int ii = idx + k - 1; const bool ok = ii >= 0 && ii < len; const v4u x = *(const GAS v4u*)(RAWb + (size_t)(sbase + (ok ? ii : idx)) * 1536 + 2 * 512 + c8);
            const v4u z0 = {0u, 0u, 0u, 0u}; in_x[k] = ok ? x : z0; }
        { const v4u a = *(const GAS v4u*)(HML + (size_t)row * 512 + c8), b_ = *(const GAS v4u*)(HML + ((size_t)MA_ROWS + row) * 512 + c8); const unsigned* pa = (const unsigned*)&a; const unsigned* pb = (const unsigned*)&b_;
#pragma unroll
            for (int q = 0; q < 4; ++q) { y[2 * q] = __uint_as_float(pa[q] << 16) + __uint_as_float(pb[q] << 16); y[2 * q + 1] = __uint_as_float(pa[q] & 0xffff0000u) + __uint_as_float(pb[q] & 0xffff0000u); } }
        float s = 0.f;
#pragma unroll
        for (int e = 0; e < 8; ++e) s += y[e];
        s += __shfl_xor(s, 1); s += __shfl_xor(s, 2); s += __shfl_xor(s, 4); s += __shfl_xor(s, 8);
        const float mean = s * (1.f / 128.f); float q2 = 0.f;
#pragma unroll
        for (int e = 0; e < 8; ++e) { y[e] -= mean; q2 += y[e] * y[e]; }
        q2 += __shfl_xor(q2, 1); q2 += __shfl_xor(q2, 2); q2 += __shfl_xor(q2, 4); q2 += __shfl_xor(q2, 8);
        const float rstd = __builtin_amdgcn_rsqf(q2 * (1.f / 128.f) + GN_EPS);
        { const unsigned* po = (const unsigned*)&in_og; float o[8];
#pragma unroll
            for (int q = 0; q < 4; ++q) { o[2 * q] = __uint_as_float(po[q] << 16); o[2 * q + 1] = __uint_as_float(po[q] & 0xffff0000u); }
            v4u w; unsigned* pw = (unsigned*)&w;
#pragma unroll
            for (int q = 0; q < 4; ++q) { const float g0 = A.in[I_ML_NORM_G][c8 + 2 * q], g1 = A.in[I_ML_NORM_G][c8 + 2 * q + 1];
                pw[q] = pk2(y[2 * q] * rstd * g0 * sigmoidf_(o[2 * q]), y[2 * q + 1] * rstd * g1 * sigmoidf_(o[2 * q + 1])); }
            *(GAS v4u*)(MIX + (size_t)row * D + c8) = w; }
        float z[8];
        { const unsigned* pa = (const unsigned*)&in_y0; const unsigned* pb = (const unsigned*)&in_y1;
#pragma unroll
            for (int q = 0; q < 4; ++q) { z[2 * q] = __uint_as_float(pa[q] << 16) + __uint_as_float(pb[q] << 16); z[2 * q + 1] = __uint_as_float(pa[q] & 0xffff0000u) + __uint_as_float(pb[q] & 0xffff0000u); } }
        s = 0.f;
#pragma unroll
        for (int e = 0; e < 8; ++e) s += z[e];
        s += __shfl_xor(s, 1); s += __shfl_xor(s, 2); s += __shfl_xor(s, 4);
        const float mean2 = s * (1.f / 64.f); q2 = 0.f;
#pragma unroll
        for (int e = 0; e < 8; ++e) { z[e] -= mean2; q2 += z[e] * z[e]; }
        q2 += __shfl_xor(q2, 1); q2 += __shfl_xor(q2, 2); q2 += __shfl_xor(q2, 4);
        const float rstd2 = __builtin_amdgcn_rsqf(q2 * (1.f / 64.f) + GN_EPS);
        float cv[3][8];
#pragma unroll
        for (int e = 0; e < 8; ++e) cv[2][e] = 0.f;
#pragma unroll
        for (int k = 0; k < 3; ++k) { const unsigned* px = (const unsigned*)&in_x[k]; const float* cwp = A.in[I_RW_CONV] + k * 1536 + 2 * 512 + c8;
#pragma unroll
            for (int q = 0; q < 4; ++q) { cv[2][2 * q] += cwp[2 * q] * __uint_as_float(px[q] << 16); cv[2][2 * q + 1] += cwp[2 * q + 1] * __uint_as_float(px[q] & 0xffff0000u); } }
        { const unsigned* pg = (const unsigned*)&in_gg; v4u w; unsigned* pw = (unsigned*)&w;
#pragma unroll
            for (int q = 0; q < 4; ++q) { const float g0 = __uint_as_float(pg[q] << 16), g1 = __uint_as_float(pg[q] & 0xffff0000u);
                const float o0 = (z[2 * q] * rstd2 * A.in[I_RW_NORM_G][c8 + 2 * q] + bs * cv[2][2 * q]) * g0, o1 = (z[2 * q + 1] * rstd2 * A.in[I_RW_NORM_G][c8 + 2 * q + 1] + bs * cv[2][2 * q + 1]) * g1;
                pw[q] = pk2(o0, o1); }
            *(GAS v4u*)(MIX + (size_t)row * D + 512 + c8) = w; }
    }
}

__device__ __forceinline__ void qk_prep(Frame& F, const Args& A) {
    unsigned char* ws = F.ws;
    const bf16* ATT = (const bf16*)(ws + R_ATT); const float* ROPE = (const float*)(ws + WS_ROPE);
    bf16* QB = (bf16*)(ws + R_QB); bf16* KW = (bf16*)(ws + R_KW); bf16* VW = (bf16*)(ws + R_VW); bf16* KG = (bf16*)(ws + R_KG); bf16* VG = (bf16*)(ws + R_VG);
    const int gw = F.vcu * NWAVES + F.wave, NGW = F.G * NWAVES, lane = F.lane, l15 = lane & 15, hg = lane >> 4;
    const f32x4 gwq = *(const f32x4*)(A.in[I_WIN_Q_NORM] + 4 * l15), gwk = *(const f32x4*)(A.in[I_WIN_K_NORM] + 4 * l15), ggq = *(const f32x4*)(A.in[I_GLB_Q_NORM] + 4 * l15), ggk = *(const f32x4*)(A.in[I_GLB_K_NORM] + 4 * l15);
    for (int row0 = 2 * gw; row0 < MA_ROWS; row0 += 2 * NGW) {
        u32x2v xin[2][6];
#pragma unroll
        for (int q = 0; q < 2; ++q)
#pragma unroll
            for (int grp = 0; grp < 6; ++grp) xin[q][grp] = *(const GAS u32x2v*)(ATT + (size_t)(row0 + q) * ATT_N + 4 * lane + 256 * grp);
        f32x4 cs2[2];
#pragma unroll
        for (int q = 0; q < 2; ++q) { const int row = row0 + q; const bool lat = row < ML_ROWS; const int t = lat ? (row & (T - 1)) : 0;
            cs2[q] = (f32x4){1.f, 0.f, 1.f, 0.f}; if (lat) cs2[q] = *(const f32x4*)(ROPE + ((size_t)((l15 < 8) ? (t >> 6) : (t & 63)) * 16 + ((2 * l15) & 15)) * 2); }
#pragma unroll
        for (int q = 0; q < 2; ++q) {
        const int row = row0 + q;
        const bool lat = row < ML_ROWS; const int b = lat ? (row >> 13) : ((row - ML_ROWS) >> 8); const int t = lat ? (row & (T - 1)) : 0;
        const int pos = lat ? t : T + ((row - ML_ROWS) & (CTXL - 1));
        const f32x4 cssn = cs2[q];
#pragma unroll
        for (int grp = 0; grp < 6; ++grp) {
            const bool qgrp = (grp != 2) && (grp != 5);
            if (qgrp && !lat) continue;
            f32x4 x; { const u32x2v xb = xin[q][grp]; x[0] = __uint_as_float(xb.x << 16); x[1] = __uint_as_float(xb.x & 0xffff0000u); x[2] = __uint_as_float(xb.y << 16); x[3] = __uint_as_float(xb.y & 0xffff0000u); }
            const bool isv = !qgrp && hg >= 2;
            const f32x4 g = grp < 2 ? gwq : grp == 2 ? gwk : grp < 5 ? ggq : ggk;
            const float ss = sum16((x[0] * x[0] + x[1] * x[1]) + (x[2] * x[2] + x[3] * x[3]));
            if (!isv) {
                const float rs = __builtin_amdgcn_rsqf(ss * (1.f / 64.f) + NORM_EPS);
                x = x * rs * g;
                const f32x4 y = {x[0] * cssn[0] - x[1] * cssn[1], x[0] * cssn[1] + x[1] * cssn[0], x[2] * cssn[2] - x[3] * cssn[3], x[2] * cssn[3] + x[3] * cssn[2]};
                x = qgrp ? y * attn_body::C2 : y;
            }
            u32x2v o; o.x = pk2(x[0], x[1]); o.y = pk2(x[2], x[3]);
            if (qgrp) *(u32x2v*)(QB + (size_t)row * D + (grp < 2 ? 256 * grp : 512 + 256 * (grp - 3)) + 4 * lane) = o;
            else { bf16* dst = (grp == 2) ? (hg < 2 ? KW : VW) : (hg < 2 ? KG : VG); *(u32x2v*)(dst + ((size_t)(b * 2 + (hg & 1)) * KV_LEN + pos) * 64 + 4 * l15) = o; }
        }
        }
    }
}

__device__ __forceinline__ void attn_phase(Frame& F, const Args& A, char* lds_generic) {
    unsigned char* ws = F.ws;
    const attn_body::bf16* QB = (const attn_body::bf16*)(ws + R_QB);
    for (int k = 0; k < 4; ++k) {
        const int uid = k * F.G + F.vcu; if (uid >= 1024) break;
        const int grp = uid >> 9, gi = uid & 511;
        int bh, qb;
        if (F.G == 256) { bh = (gi & 255) >> 4; qb = 2 * ((gi & 255) & 15) + (gi >> 8); } else { bh = gi >> 5; qb = gi & 31; }
        const int b = bh >> 3, hq = bh & 7, kvh = hq >> 2;
        if (grp == 0) {
            const attn_body::bf16* Kh = (const attn_body::bf16*)(ws + R_KG) + (size_t)(b * 2 + kvh) * KV_LEN * 64; const attn_body::bf16* Vh = (const attn_body::bf16*)(ws + R_VG) + (size_t)(b * 2 + kvh) * KV_LEN * 64;
            attn_body::attn_unit<8, 0>(b, 8 + hq, qb, QB, Kh, Vh, (attn_body::bf16*)QB, lds_generic, 0.f);
        } else {
            const attn_body::bf16* Kh = (const attn_body::bf16*)(ws + R_KW) + (size_t)(b * 2 + kvh) * KV_LEN * 64; const attn_body::bf16* Vh = (const attn_body::bf16*)(ws + R_VW) + (size_t)(b * 2 + kvh) * KV_LEN * 64;
            attn_body::attn_unit<8, 1>(b, hq, qb, QB, Kh, Vh, (attn_body::bf16*)QB, lds_generic, A.in[I_WIN_SINK][hq] * 1.4426950408889634f);
        }
    }
}
constexpr int RW_NCH = 132;
constexpr int RW_NITEM = NCHAIN_RW * RW_NCH;
constexpr size_t RW_LCT = R_QM, RW_NC = R_VM, RW_PL = R_GATES;
static_assert((size_t)RW_NITEM * 4096 * 2 <= 2 * SZ_A && (size_t)RW_NITEM * 64 * 4 <= (size_t)MA_ROWS * 16 * 4 && WS_W2T + 2 * 2 * 8 * 64 * 64 * 2 <= WS_XC, "rwkv chunk scratch map");

template <int MODE> __device__ __forceinline__ void rw_chunk_pass(Frame& F, const Args& A) {
    constexpr int TP = 72;
    unsigned char* ws = F.ws;
    const bf16* RAWb = (const bf16*)(ws + R_RAW); const bf16* TWAD = (const bf16*)(ws + R_TWAD); const bf16* W2T = (const bf16*)(ws + WS_W2T);
    bf16* LCT = (bf16*)(ws + RW_LCT); bf16* NCG = (bf16*)(ws + RW_NC); float* PLG = (float*)(ws + RW_PL);
    const bf16* SCG = (const bf16*)((unsigned char*)F.out + DO_CST);
    LAS unsigned char* Lb = F.lds;
    LAS bf16* tKT = (LAS bf16*)(Lb + 0); LAS bf16* tRT = (LAS bf16*)(Lb + 9216); LAS bf16* tKH = (LAS bf16*)(Lb + 18432); LAS bf16* tBH = (LAS bf16*)(Lb + 27648);
    LAS bf16* tKTT = (LAS bf16*)(Lb + 36864); LAS bf16* tKBT = (LAS bf16*)(Lb + 46080); LAS bf16* tBBT = (LAS bf16*)(Lb + 55296); LAS bf16* tVT = (LAS bf16*)(Lb + 64512);
    LAS float* WA = (LAS float*)(Lb + 73728);
    LAS float* ABK = (LAS float*)(Lb + 73728);
    LAS bf16* tAKK = (LAS bf16*)(Lb + 91136); LAS bf16* tAKRT = (LAS bf16*)(Lb + 100352); LAS bf16* tABRT = (LAS bf16*)(Lb + 109568); LAS bf16* tW = (LAS bf16*)(Lb + 118784);
    LAS float* CLL = (LAS float*)(Lb + 128000);
    LAS bf16* tTT = tKH; LAS bf16* tX = tBH; LAS bf16* tUL = tKT;
    LAS bf16* tE1 = MODE == 0 ? (LAS bf16*)(Lb + 154112) : tKBT; LAS bf16* tE2 = MODE == 0 ? (LAS bf16*)(Lb + 73728) : tBBT;
    const int tid = F.tid, lane = F.lane, w = F.wave, l15 = lane & 15, l4 = lane >> 4;
#ifdef TS_RWC
    unsigned long long tst[12] = {0,0,0,0,0,0,0,0,0,0,0,0}, tprev = __builtin_amdgcn_s_memtime();
#define STG(k) do { const unsigned long long tn_ = __builtin_amdgcn_s_memtime(); tst[k] += tn_ - tprev; tprev = tn_; } while (0)
#else
#define STG(k) do {} while (0)
#endif
    LAS float* cst = (LAS float*)(Lb + LDSX_OFF); LAS bf16* W2L = (LAS bf16*)(Lb + LDSX_OFF + 3584);
    const int pos = tid >> 3, part = tid & 7, ch0 = 8 * part;
    constexpr int IPW = 17;
    const int item_lo = F.vcu * IPW, item_hi = (item_lo + IPW < RW_NITEM) ? item_lo + IPW : RW_NITEM;
    v4u pf_a0, pf_a1, pf_raw[3][3]; int pf_valid = 0;
    v4u pf_s[6];
#define RWC_PREFETCH(itn) do { const int ch_ = (itn) / RW_NCH, c_ = (itn) % RW_NCH, d_ = ch_ >> 4, b_ = (ch_ >> 3) & 1; \
        int R, idx, len, sbase; rw_seq_rows(d_, b_, 64 * c_ + 16 * (w & 3) + l15, R, idx, len, sbase); const bf16* ap = TWAD + (size_t)R * 256 + (w >> 2) * 128 + d_ * 64 + 8 * l4; \
        pf_a0 = *(const GAS v4u*)ap; pf_a1 = *(const GAS v4u*)(ap + 32); } while (0)
#define RWC_LOADRAW(itn) do { const int ch_ = (itn) / RW_NCH, c_ = (itn) % RW_NCH, d_ = ch_ >> 4, b_ = (ch_ >> 3) & 1, h_ = ch_ & 7; \
        int R, idx, len, sbase; rw_seq_rows(d_, b_, 64 * c_ + pos, R, idx, len, sbase); pf_valid = 0; \
        _Pragma("unroll") for (int k = 0; k < 3; ++k) { const int ii = idx + k - 1; const bool ok = ii >= 0 && ii < len; pf_valid |= ok ? (1 << k) : 0; const int iic = ok ? ii : idx; \
            _Pragma("unroll") for (int g = 0; g < 3; ++g) pf_raw[k][g] = *(const GAS v4u*)(RAWb + (size_t)(sbase + iic) * 1536 + g * 512 + h_ * 64 + ch0); } } while (0)
#define RWC_BAR() asm volatile("s_waitcnt lgkmcnt(0)\n\ts_barrier" ::: "memory")
    int cur_chain = -1;
    if (item_lo < item_hi) RWC_PREFETCH(item_lo);
    for (int item = item_lo; item < item_hi; ++item) {
        const int chain = item / RW_NCH, c = item % RW_NCH, d = chain >> 4, b = (chain >> 3) & 1, h = chain & 7;
        int lz = 0; asm volatile("" : "+s"(lz));
        const int tid = F.tid + lz, lane = tid & 63, l15 = lane & 15, l4 = lane >> 4, pos = tid >> 3, part = tid & 7, ch0 = 8 * part;
        RWC_LOADRAW(item);
        RWC_BAR();
        if (chain != cur_chain) {
            cur_chain = chain;
            for (int i = tid; i < 896; i += NTHREADS) {
                float v;
                if (i < 576) v = A.in[I_RW_CONV][((i >> 6) / 3) * 1536 + ((i >> 6) % 3) * 512 + h * 64 + (i & 63)];
                else if (i < 640) v = A.in[I_RW_KK][h * 64 + (i & 63)];
                else if (i < 704) v = A.in[I_RW_KA][h * 64 + (i & 63)];
                else if (i < 768) v = A.in[I_RW_W0][d * 512 + h * 64 + (i & 63)];
                else if (i < 832) v = A.in[I_RW_A0][d * 512 + h * 64 + (i & 63)];
                else v = A.in[I_RW_RK][h * 64 + (i & 63)];
                cst[i] = v;
            }
            for (int i = tid; i < 2 * 64 * 8; i += NTHREADS) {
                const int which = i >> 9, ch = (i >> 3) & 63, pc = i & 7;
                *(LAS v4u*)(W2L + which * (64 * TP) + ch * TP + 8 * pc) = *(const GAS v4u*)(W2T + ((size_t)((which * 2 + d) * 8 + h) * 64 + ch) * 64 + 8 * pc);
            }
            RWC_BAR();
        }
        STG(0);
        {
            const int which = w >> 2, mt = w & 3;
            const bf16x8 a0 = __builtin_bit_cast(bf16x8, pf_a0), a1 = __builtin_bit_cast(bf16x8, pf_a1);
            const LAS bf16* bt = W2L + which * (64 * TP);
#pragma unroll
            for (int nt = 0; nt < 4; ++nt) {
                f32x4 acc = {0.f, 0.f, 0.f, 0.f};
                acc = MFMA16(a0, ldsfrag(bt, 16 * nt + l15, 8 * l4), acc); acc = MFMA16(a1, ldsfrag(bt, 16 * nt + l15, 32 + 8 * l4), acc);
                const float bv = cst[704 + which * 64 + 16 * nt + l15];
#pragma unroll
                for (int r = 0; r < 4; ++r) WA[which * (64 * 65) + (16 * mt + 4 * l4 + r) * 65 + 16 * nt + l15] = acc[r] + bv;
            }
        }
        RWC_BAR();
        STG(1);
        float kkv[8], keyv[8], betv[8], rv[8], vv[8], lamv[8];
        {
            float cv[3][8];
            {
                f32x2v c2[3][4];
#pragma unroll
                for (int g = 0; g < 3; ++g)
#pragma unroll
                    for (int q = 0; q < 4; ++q) c2[g][q] = (f32x2v){0.f, 0.f};
#pragma unroll
                for (int k = 0; k < 3; ++k) { const bool okk = (pf_valid >> k) & 1;
#pragma unroll
                    for (int g = 0; g < 3; ++g) { const unsigned* px = (const unsigned*)&pf_raw[k][g];
                        const LAS f32x2v* cp = (const LAS f32x2v*)(cst + (k * 3 + g) * 64 + ch0);
#pragma unroll
                        for (int q = 0; q < 4; ++q) { const unsigned xw = (k == 1 || okk) ? px[q] : 0u;
                            const f32x2v x2 = {__uint_as_float(xw << 16), __uint_as_float(xw & 0xffff0000u)};
                            c2[g][q] += cp[q] * x2; } } }
#pragma unroll
                for (int g = 0; g < 3; ++g)
#pragma unroll
                    for (int q = 0; q < 4; ++q) { cv[g][2 * q] = c2[g][q].x; cv[g][2 * q + 1] = c2[g][q].y; }
            }
            if (d == 0) {
                float bs = 0.f;
#pragma unroll
                for (int e = 0; e < 8; ++e) bs += cv[0][e] * cv[1][e] * cst[832 + ch0 + e];
                bs = sum8(bs);
                if (part == 0) { int R, idx, len, sbase; rw_seq_rows(d, b, 64 * c + pos, R, idx, len, sbase); ((float*)(ws + WS_SS))[(size_t)R * 8 + h] = bs; }
            }
            float ss = 0.f;
#pragma unroll
            for (int e = 0; e < 8; ++e) { kkv[e] = cv[1][e] * cst[576 + ch0 + e]; ss += kkv[e] * kkv[e]; }
            ss = sum8(ss);
            const float rn = __builtin_amdgcn_rsqf(ss + NORM_EPS);
#pragma unroll
            for (int e = 0; e < 8; ++e) {
                const float wl_ = WA[pos * 65 + ch0 + e], al_ = WA[64 * 65 + pos * 65 + ch0 + e];
                const float a = sigmoidf_(al_); lamv[e] = (0.6065306597126334f * 1.4426950408889634f) * sigmoidf_(wl_);
                kkv[e] *= rn; betv[e] = kkv[e] * a; keyv[e] = cv[1][e] * (1.0f + (a - 1.0f) * cst[640 + ch0 + e]); rv[e] = cv[0][e]; vv[e] = cv[2][e];
                WA[pos * 65 + ch0 + e] = lamv[e];
            }
        }
        RWC_BAR();
        STG(2);
        {
            const int ch = tid >> 3; float x[8]; float run = 0.f;
#pragma unroll
            for (int q = 0; q < 8; ++q) { run += WA[(8 * part + q) * 65 + ch]; x[q] = run; }
            float inc = run;
            { float t_ = dpp_mov<0x111>(inc); if (part >= 1) inc += t_; t_ = dpp_mov<0x112>(inc); if (part >= 2) inc += t_; t_ = dpp_mov<0x114>(inc); if (part >= 4) inc += t_; }
            const float excl = inc - run;
#pragma unroll
            for (int q = 0; q < 8; ++q) WA[(8 * part + q) * 65 + ch] = x[q] + excl;
            if (part == 7) { CLL[ch] = inc; CLL[64 + ch] = __builtin_amdgcn_exp2f(-inc); }
        }
        RWC_BAR();
        STG(3);
        {
            float kt[8], rt[8], kh[8], bh[8], kb[8], bbn[8];
#pragma unroll
            for (int e = 0; e < 8; ++e) {
                const float cl = WA[pos * 65 + ch0 + e];
                const float eI = __builtin_amdgcn_exp2f(cl), eB = eI * CLL[64 + ch0 + e];
                kt[e] = kkv[e] * __builtin_amdgcn_exp2f(lamv[e] - cl); rt[e] = rv[e] * __builtin_amdgcn_exp2f(-cl); kh[e] = keyv[e] * eI; bh[e] = betv[e] * eI; kb[e] = keyv[e] * eB; bbn[e] = -betv[e] * eB;
            }
            v4u o;
            o.x = pk2(kt[0], kt[1]); o.y = pk2(kt[2], kt[3]); o.z = pk2(kt[4], kt[5]); o.w = pk2(kt[6], kt[7]); *(LAS v4u*)(tKT + pos * TP + ch0) = o; *(LAS v4u*)(tKTT + pos * TP + ch0) = o;
            o.x = pk2(rt[0], rt[1]); o.y = pk2(rt[2], rt[3]); o.z = pk2(rt[4], rt[5]); o.w = pk2(rt[6], rt[7]); *(LAS v4u*)(tRT + pos * TP + ch0) = o;
            o.x = pk2(kh[0], kh[1]); o.y = pk2(kh[2], kh[3]); o.z = pk2(kh[4], kh[5]); o.w = pk2(kh[6], kh[7]); *(LAS v4u*)(tKH + pos * TP + ch0) = o;
            o.x = pk2(bh[0], bh[1]); o.y = pk2(bh[2], bh[3]); o.z = pk2(bh[4], bh[5]); o.w = pk2(bh[6], bh[7]); *(LAS v4u*)(tBH + pos * TP + ch0) = o;
            o.x = pk2(vv[0], vv[1]); o.y = pk2(vv[2], vv[3]); o.z = pk2(vv[4], vv[5]); o.w = pk2(vv[6], vv[7]); *(LAS v4u*)(tVT + pos * TP + ch0) = o;
            if (MODE == 0) {
                o.x = pk2(kb[0], kb[1]); o.y = pk2(kb[2], kb[3]); o.z = pk2(kb[4], kb[5]); o.w = pk2(kb[6], kb[7]); *(LAS v4u*)(tKBT + pos * TP + ch0) = o;
                o.x = pk2(bbn[0], bbn[1]); o.y = pk2(bbn[2], bbn[3]); o.z = pk2(bbn[4], bbn[5]); o.w = pk2(bbn[6], bbn[7]); *(LAS v4u*)(tBBT + pos * TP + ch0) = o;
            }
        }
        RWC_BAR();
        STG(4);
        {
            const int st = w & 3;
            if (w < 4) {
                const bf16x8 a0 = ldsfrag(tBH, 16 * st + l15, 8 * l4), a1 = ldsfrag(tBH, 16 * st + l15, 32 + 8 * l4);
#pragma unroll
                for (int tt = 0; tt < 4; ++tt) {
                    f32x4 acc = {0.f, 0.f, 0.f, 0.f};
                    acc = MFMA16(a0, ldsfrag(tKT, 16 * tt + l15, 8 * l4), acc); acc = MFMA16(a1, ldsfrag(tKT, 16 * tt + l15, 32 + 8 * l4), acc);
                    const int t = 16 * tt + l15, s0 = 16 * st + 4 * l4;
#pragma unroll
                    for (int r = 0; r < 4; ++r) if (s0 + r >= t) acc[r] = 0.f;
                    *(LAS f32x4*)(ABK + t * 68 + s0) = acc; *(LAS u32x2v*)(tE1 + t * TP + s0) = pk4(acc);
                    {
                        f32x4 ac2 = {0.f, 0.f, 0.f, 0.f};
                        ac2 = MFMA16(a0, ldsfrag(tRT, 16 * tt + l15, 8 * l4), ac2); ac2 = MFMA16(a1, ldsfrag(tRT, 16 * tt + l15, 32 + 8 * l4), ac2);
#pragma unroll
                        for (int r = 0; r < 4; ++r) ac2[r] = (s0 + r > t) ? 0.f : -ac2[r];
                        *(LAS u32x2v*)(tABRT + t * TP + s0) = pk4(ac2);
                    }
                }
            } else {
                const bf16x8 b0 = ldsfrag(tKH, 16 * st + l15, 8 * l4), b1 = ldsfrag(tKH, 16 * st + l15, 32 + 8 * l4);
#pragma unroll
                for (int tt = 0; tt < 4; ++tt) {
                    f32x4 acc = {0.f, 0.f, 0.f, 0.f};
                    acc = MFMA16(ldsfrag(tKT, 16 * tt + l15, 8 * l4), b0, acc); acc = MFMA16(ldsfrag(tKT, 16 * tt + l15, 32 + 8 * l4), b1, acc);
                    const int s = 16 * st + l15, t0 = 16 * tt + 4 * l4;
#pragma unroll
                    for (int r = 0; r < 4; ++r) if (s >= t0 + r) acc[r] = 0.f;
                    *(LAS u32x2v*)(tAKK + s * TP + t0) = pk4(acc);
                    {
                        f32x4 ac2 = {0.f, 0.f, 0.f, 0.f};
                        ac2 = MFMA16(b0, ldsfrag(tRT, 16 * tt + l15, 8 * l4), ac2); ac2 = MFMA16(b1, ldsfrag(tRT, 16 * tt + l15, 32 + 8 * l4), ac2);
                        const int t = 16 * tt + l15, s0 = 16 * st + 4 * l4;
#pragma unroll
                        for (int r = 0; r < 4; ++r) if (s0 + r > t) ac2[r] = 0.f;
                        *(LAS u32x2v*)(tAKRT + t * TP + s0) = pk4(ac2);
                    }
                }
            }
        }
        RWC_BAR();
        STG(5);
        { const int itn = (item + 1 < item_hi) ? item + 1 : item; RWC_PREFETCH(itn); }
        if (MODE == 1) { const bf16* Sg_ = SCG + (size_t)item * 4096; const int mt_ = w & 3, n0_ = 2 * (w >> 2);
#pragma unroll
            for (int q = 0; q < 2; ++q) { pf_s[2 * q] = *(const GAS v4u*)(Sg_ + (size_t)(16 * (n0_ + q) + l15) * 64 + 8 * l4); pf_s[2 * q + 1] = *(const GAS v4u*)(Sg_ + (size_t)(16 * (n0_ + q) + l15) * 64 + 32 + 8 * l4); }
            pf_s[4] = *(const GAS v4u*)(Sg_ + (size_t)(16 * mt_ + l15) * 64 + 8 * l4); pf_s[5] = *(const GAS v4u*)(Sg_ + (size_t)(16 * mt_ + l15) * 64 + 32 + 8 * l4); }
        if (tid < 128) {
            const int kind = tid >> 6, bb_ = (tid >> 4) & 3, x = tid & 15; float u[16];
            if (kind == 0) {
#pragma unroll
                for (int y = 0; y < 16; ++y) { float s = (y == x) ? 1.f : 0.f; const LAS float* ar = ABK + (16 * bb_ + y) * 68 + 16 * bb_;
#pragma unroll
                    for (int z = 0; z < y; ++z) s -= u[z] * ar[z];
                    u[y] = s; }
            } else {
#pragma unroll
                for (int z = 15; z >= 0; --z) { float s = (z == x) ? 1.f : 0.f;
#pragma unroll
                    for (int z2 = z + 1; z2 < 16; ++z2) s -= ABK[(16 * bb_ + z2) * 68 + 16 * bb_ + z] * u[z2];
                    u[z] = s; }
            }
            LAS bf16* dst = (kind == 0 ? tKT : tKH) + (16 * bb_ + x) * TP;
            const v4u zz = {0u, 0u, 0u, 0u};
#pragma unroll
            for (int q = 0; q < 8; ++q) *(LAS v4u*)(dst + 8 * q) = zz;
            v4u o0, o1; o0.x = pk2(u[0], u[1]); o0.y = pk2(u[2], u[3]); o0.z = pk2(u[4], u[5]); o0.w = pk2(u[6], u[7]); o1.x = pk2(u[8], u[9]); o1.y = pk2(u[10], u[11]); o1.z = pk2(u[12], u[13]); o1.w = pk2(u[14], u[15]);
            asm volatile("" ::: "memory");
            *(LAS v4u*)(dst + 16 * bb_) = o0; *(LAS v4u*)(dst + 16 * bb_ + 8) = o1;
        } else {
            for (int tl = w - 2; tl < 16; tl += 6) { const int it_ = tl >> 2, stl = tl & 3;
                f32x4 acc = {0.f, 0.f, 0.f, 0.f};
                acc = MFMA16(trfrag(tAKK, 16 * stl, 0, l15, l4), trfrag(tVT, 16 * it_, 0, l15, l4), acc); acc = MFMA16(trfrag(tAKK, 16 * stl, 32, l15, l4), trfrag(tVT, 16 * it_, 32, l15, l4), acc);
                *(LAS u32x2v*)(tX + (16 * it_ + l15) * TP + 16 * stl + 4 * l4) = pk4(acc); }
        }
        RWC_BAR();
        STG(10);
        {
            const int mt5 = w & 3, n50 = 2 * (w >> 2);
            const bf16x8 zf = {0, 0, 0, 0, 0, 0, 0, 0};
            {
                bf16x8 a0 = ldsfrag(tE1, 16 * mt5 + l15, 8 * l4), a1 = ldsfrag(tE1, 16 * mt5 + l15, 32 + 8 * l4);
                if (!((mt5 & 1) && (mt5 >> 1) == 0 && l4 < 2)) a0 = zf;
                if (!((mt5 & 1) && (mt5 >> 1) == 1 && l4 < 2)) a1 = zf;
#pragma unroll
                for (int q = 0; q < 2; ++q) { const int nt = n50 + q; f32x4 acc = {0.f, 0.f, 0.f, 0.f};
                    acc = MFMA16(a0, ldsfrag(tKT, 16 * nt + l15, 8 * l4), acc); acc = MFMA16(a1, ldsfrag(tKT, 16 * nt + l15, 32 + 8 * l4), acc);
                    *(LAS u32x2v*)(tE2 + (16 * nt + l15) * TP + 16 * mt5 + 4 * l4) = pk4(acc); }
            }
            RWC_BAR();
            {
                const bf16x8 g0 = ldsfrag(tKH, 16 * mt5 + l15, 8 * l4), g1 = ldsfrag(tKH, 16 * mt5 + l15, 32 + 8 * l4);
                const bf16x8 p0 = ldsfrag(tE2, 16 * mt5 + l15, 8 * l4), p1 = ldsfrag(tE2, 16 * mt5 + l15, 32 + 8 * l4);
                f32x4 accA[2], accB[2];
#pragma unroll
                for (int q = 0; q < 2; ++q) { const int nt = n50 + q;
                    accA[q] = (f32x4){0.f, 0.f, 0.f, 0.f}; accA[q] = MFMA16(g0, ldsfrag(tE2, 16 * nt + l15, 8 * l4), accA[q]); accA[q] = MFMA16(g1, ldsfrag(tE2, 16 * nt + l15, 32 + 8 * l4), accA[q]);
                    accB[q] = (f32x4){0.f, 0.f, 0.f, 0.f}; accB[q] = MFMA16(p0, ldsfrag(tKH, 16 * nt + l15, 8 * l4), accB[q]); accB[q] = MFMA16(p1, ldsfrag(tKH, 16 * nt + l15, 32 + 8 * l4), accB[q]); }
#pragma unroll
                for (int q = 0; q < 2; ++q) { const int nt = n50 + q;
                    { LAS u32x2v* tp = (LAS u32x2v*)(tKT + (16 * nt + l15) * TP + 16 * mt5 + 4 * l4); const u32x2v old = *tp; f32x4 v;
                      v[0] = __uint_as_float(old.x << 16) - accA[q][0]; v[1] = __uint_as_float(old.x & 0xffff0000u) - accA[q][1]; v[2] = __uint_as_float(old.y << 16) - accA[q][2]; v[3] = __uint_as_float(old.y & 0xffff0000u) - accA[q][3]; *tp = pk4(v); }
                    { const u32x2v old = *(const LAS u32x2v*)(tKH + (16 * nt + l15) * TP + 16 * mt5 + 4 * l4); f32x4 v;
                      v[0] = __uint_as_float(old.x << 16) - accB[q][0]; v[1] = __uint_as_float(old.x & 0xffff0000u) - accB[q][1]; v[2] = __uint_as_float(old.y << 16) - accB[q][2]; v[3] = __uint_as_float(old.y & 0xffff0000u) - accB[q][3];
                      *(LAS u32x2v*)(tW + (16 * nt + l15) * TP + 16 * mt5 + 4 * l4) = pk4(v); } }
            }
            RWC_BAR();
            {
                bf16x8 a0 = ldsfrag(tE1, 16 * mt5 + l15, 8 * l4);
                if (mt5 < 2) a0 = zf;
#pragma unroll
                for (int q = 0; q < 2; ++q) { const int nt = n50 + q; f32x4 acc = {0.f, 0.f, 0.f, 0.f};
                    acc = MFMA16(a0, ldsfrag(tKT, 16 * nt + l15, 8 * l4), acc);
                    *(LAS u32x2v*)(tE2 + (16 * nt + l15) * TP + 16 * mt5 + 4 * l4) = pk4(acc); }
            }
            RWC_BAR();
            {
                const bf16x8 p0 = ldsfrag(tE2, 16 * mt5 + l15, 8 * l4), p1 = ldsfrag(tE2, 16 * mt5 + l15, 32 + 8 * l4);
#pragma unroll
                for (int q = 0; q < 2; ++q) { const int nt = n50 + q; f32x4 acc = {0.f, 0.f, 0.f, 0.f};
                    acc = MFMA16(p0, ldsfrag(tW, 16 * nt + l15, 8 * l4), acc); acc = MFMA16(p1, ldsfrag(tW, 16 * nt + l15, 32 + 8 * l4), acc);
                    const u32x2v old = *(const LAS u32x2v*)(tW + (16 * nt + l15) * TP + 16 * mt5 + 4 * l4); f32x4 v;
                    v[0] = __uint_as_float(old.x << 16) - acc[0]; v[1] = __uint_as_float(old.x & 0xffff0000u) - acc[1]; v[2] = __uint_as_float(old.y << 16) - acc[2]; v[3] = __uint_as_float(old.y & 0xffff0000u) - acc[3];
                    *(LAS u32x2v*)(tTT + (16 * nt + l15) * TP + 16 * mt5 + 4 * l4) = pk4(v); }
            }
        }
        RWC_BAR();
        STG(6);
        if (w < 4) {
            const bf16x8 a0 = MODE == 0 ? ldsfrag(tTT, 16 * w + l15, 8 * l4) : trfrag(tKTT, 16 * w, 0, l15, l4), a1 = MODE == 0 ? ldsfrag(tTT, 16 * w + l15, 32 + 8 * l4) : trfrag(tKTT, 16 * w, 32, l15, l4);
#pragma unroll
            for (int nt = 0; nt < 4; ++nt) {
                f32x4 acc = {0.f, 0.f, 0.f, 0.f};
                const bf16x8 b0 = MODE == 0 ? trfrag(tKTT, 16 * nt, 0, l15, l4) : ldsfrag(tTT, 16 * nt + l15, 8 * l4), b1 = MODE == 0 ? trfrag(tKTT, 16 * nt, 32, l15, l4) : ldsfrag(tTT, 16 * nt + l15, 32 + 8 * l4);
                acc = MFMA16(a0, b0, acc); acc = MFMA16(a1, b1, acc);
                *(LAS u32x2v*)(tW + (16 * nt + l15) * TP + 16 * w + 4 * l4) = pk4(acc);
            }
        } else {
            const int mtu = w - 4;
            const bf16x8 a0 = ldsfrag(tTT, 16 * mtu + l15, 8 * l4), a1 = ldsfrag(tTT, 16 * mtu + l15, 32 + 8 * l4);
#pragma unroll
            for (int nt = 0; nt < 4; ++nt) {
                f32x4 acc = {0.f, 0.f, 0.f, 0.f};
                acc = MFMA16(a0, ldsfrag(tX, 16 * nt + l15, 8 * l4), acc); acc = MFMA16(a1, ldsfrag(tX, 16 * nt + l15, 32 + 8 * l4), acc);
                *(LAS u32x2v*)(tUL + (16 * nt + l15) * TP + 16 * mtu + 4 * l4) = pk4(acc);
            }
        }
        STG(7);
        const int mt = w & 3, nt0 = 2 * (w >> 2);
        RWC_BAR();
        STG(8);
        if (MODE == 0) {
            const bf16x8 k0 = trfrag(tKBT, 16 * mt, 0, l15, l4), k1 = trfrag(tKBT, 16 * mt, 32, l15, l4), bb0 = trfrag(tBBT, 16 * mt, 0, l15, l4), bb1 = trfrag(tBBT, 16 * mt, 32, l15, l4);
            const bf16x8 w0 = ldsfrag(tW, 16 * mt + l15, 8 * l4), w1 = ldsfrag(tW, 16 * mt + l15, 32 + 8 * l4);
            const bf16x8 v0 = trfrag(tVT, 16 * mt, 0, l15, l4), v1 = trfrag(tVT, 16 * mt, 32, l15, l4), u0 = ldsfrag(tUL, 16 * mt + l15, 8 * l4), u1 = ldsfrag(tUL, 16 * mt + l15, 32 + 8 * l4);
            bf16* YRW = d == 0 ? (bf16*)(ws + R_YRW0) : (bf16*)((unsigned char*)F.out + DO_YRW1);
            bf16* RWTG = (bf16*)((unsigned char*)F.out + DO_CST);
#pragma unroll
            for (int q = 0; q < 2; ++q) { const int nt = nt0 + q;
                f32x4 acc = {0.f, 0.f, 0.f, 0.f};
                acc = MFMA16(k0, trfrag(tVT, 16 * nt, 0, l15, l4), acc); acc = MFMA16(k1, trfrag(tVT, 16 * nt, 32, l15, l4), acc);
                acc = MFMA16(bb0, ldsfrag(tUL, 16 * nt + l15, 8 * l4), acc); acc = MFMA16(bb1, ldsfrag(tUL, 16 * nt + l15, 32 + 8 * l4), acc);
                *(u32x2v*)(NCG + ((size_t)item * 64 + 16 * nt + l15) * 64 + 16 * mt + 4 * l4) = pk4(acc);
                f32x4 ac2 = {0.f, 0.f, 0.f, 0.f};
                ac2 = MFMA16(w0, trfrag(tBBT, 16 * nt, 0, l15, l4), ac2); ac2 = MFMA16(w1, trfrag(tBBT, 16 * nt, 32, l15, l4), ac2);
                *(u32x2v*)(LCT + ((size_t)item * 64 + 16 * nt + l15) * 64 + 32 * (mt >> 1) + 8 * l4 + 4 * (mt & 1)) = pk4(ac2);
                const bf16x8 ab0 = ldsfrag(tABRT, 16 * nt + l15, 8 * l4), ab1 = ldsfrag(tABRT, 16 * nt + l15, 32 + 8 * l4);
                { const u32x2v rr = *(const LAS u32x2v*)(tRT + (16 * nt + l15) * TP + 16 * mt + 4 * l4);
                  f32x4 a3 = {__uint_as_float(rr.x << 16), __uint_as_float(rr.x & 0xffff0000u), __uint_as_float(rr.y << 16), __uint_as_float(rr.y & 0xffff0000u)};
                  a3 = MFMA16(w0, ab0, a3); a3 = MFMA16(w1, ab1, a3);
                  *(u32x2v*)(RWTG + ((size_t)item * 64 + 16 * nt + l15) * 64 + 16 * mt + 4 * l4) = pk4(a3); }
                { f32x4 a4 = {0.f, 0.f, 0.f, 0.f};
                  a4 = MFMA16(v0, ldsfrag(tAKRT, 16 * nt + l15, 8 * l4), a4); a4 = MFMA16(v1, ldsfrag(tAKRT, 16 * nt + l15, 32 + 8 * l4), a4);
                  a4 = MFMA16(u0, ab0, a4); a4 = MFMA16(u1, ab1, a4);
                  int R, idx, len, sbase; rw_seq_rows(d, b, 64 * c + 16 * nt + l15, R, idx, len, sbase);
                  *(u32x2v*)(YRW + (size_t)R * 512 + h * 64 + 16 * mt + 4 * l4) = pk4(a4); }
            }
            if (tid < 64) PLG[(size_t)item * 64 + tid] = CLL[64 + tid];
        } else {
            {
                const bf16x8 a0 = ldsfrag(tW, 16 * mt + l15, 8 * l4), a1 = ldsfrag(tW, 16 * mt + l15, 32 + 8 * l4);
#pragma unroll
                for (int q = 0; q < 2; ++q) { const int nt = nt0 + q;
                    f32x4 acc = {0.f, 0.f, 0.f, 0.f};
                    acc = MFMA16(a0, __builtin_bit_cast(bf16x8, pf_s[2 * q]), acc); acc = MFMA16(a1, __builtin_bit_cast(bf16x8, pf_s[2 * q + 1]), acc);
                    LAS u32x2v* up = (LAS u32x2v*)(tUL + (16 * nt + l15) * TP + 16 * mt + 4 * l4); const u32x2v ul = *up;
                    acc[0] += __uint_as_float(ul.x << 16); acc[1] += __uint_as_float(ul.x & 0xffff0000u); acc[2] += __uint_as_float(ul.y << 16); acc[3] += __uint_as_float(ul.y & 0xffff0000u);
                    *up = pk4(acc);
                }
            }
            RWC_BAR();
            {
                bf16* YRW = d == 0 ? (bf16*)(ws + R_YRW0) : (bf16*)((unsigned char*)F.out + DO_YRW1);
                const bf16x8 s0 = __builtin_bit_cast(bf16x8, pf_s[4]), s1 = __builtin_bit_cast(bf16x8, pf_s[5]);
                const bf16x8 v0 = trfrag(tVT, 16 * mt, 0, l15, l4), v1 = trfrag(tVT, 16 * mt, 32, l15, l4), u0 = ldsfrag(tUL, 16 * mt + l15, 8 * l4), u1 = ldsfrag(tUL, 16 * mt + l15, 32 + 8 * l4);
#pragma unroll
                for (int q = 0; q < 2; ++q) { const int nt = nt0 + q;
                    f32x4 acc = {0.f, 0.f, 0.f, 0.f};
                    acc = MFMA16(s0, ldsfrag(tRT, 16 * nt + l15, 8 * l4), acc); acc = MFMA16(s1, ldsfrag(tRT, 16 * nt + l15, 32 + 8 * l4), acc);
                    acc = MFMA16(v0, ldsfrag(tAKRT, 16 * nt + l15, 8 * l4), acc); acc = MFMA16(v1, ldsfrag(tAKRT, 16 * nt + l15, 32 + 8 * l4), acc);
                    acc = MFMA16(u0, ldsfrag(tABRT, 16 * nt + l15, 8 * l4), acc); acc = MFMA16(u1, ldsfrag(tABRT, 16 * nt + l15, 32 + 8 * l4), acc);
                    int R, idx, len, sbase; rw_seq_rows(d, b, 64 * c + 16 * nt + l15, R, idx, len, sbase);
                    *(u32x2v*)(YRW + (size_t)R * 512 + h * 64 + 16 * mt + 4 * l4) = pk4(acc);
                }
            }
        }
        STG(9);
    }
#ifdef TS_RWC
    if (MODE == TS_RWC - 1 && blockIdx.x == 0 && F.tid == 0) { unsigned long long* ts = (unsigned long long*)(ws + WS_CTL + 512 * 1024); for (int k = 0; k < 11; ++k) ts[40 + k] = tst[k] / 10; }
#endif
#undef STG
#undef RWC_PREFETCH
#undef RWC_LOADRAW
#undef RWC_BAR
    __syncthreads();
}

#ifdef TS_PASSB
#define TSB(...) __VA_ARGS__
#else
#define TSB(...)
#endif
__device__ __forceinline__ void rw_pass_b(Frame& F, const Args& A) {
    constexpr int TP = 72, SLOT = 2 * 64 * TP * 2 + 256;
    unsigned char* ws = F.ws;
    const bf16* LCT = (const bf16*)(ws + RW_LCT); const bf16* NCG = (const bf16*)(ws + RW_NC); const float* PLG = (const float*)(ws + RW_PL);
    const int lane = F.lane, w = F.wave, l15 = lane & 15, l4 = lane >> 4;
    const bool spread = (F.G >= 256) && (F.G % 2 == 0);
    const int pair0 = spread ? ((F.vcu & 1) ? 4 * NCHAIN_RW : (F.vcu >> 1)) : F.vcu, pstep = spread ? (F.G >> 1) : F.G;
#define RWB_BAR() asm volatile("s_waitcnt lgkmcnt(0)\n\ts_barrier" ::: "memory")
    for (int pair = pair0; pair < 4 * NCHAIN_RW; pair += pstep) {
        const int chain = pair >> 2, nt = pair & 3;
        const size_t it0 = (size_t)chain * RW_NCH;
        __syncthreads();
        if (w == 0) {
            f32x4 acc[4];
#pragma unroll
            for (int m = 0; m < 4; ++m) acc[m] = (f32x4){0.f, 0.f, 0.f, 0.f};
            bf16* sg = (bf16*)(ws + RW_NC) + it0 * 4096 + (size_t)(16 * nt + l15) * 64 + 4 * l4; const size_t sdummy = ((size_t)RW_NITEM - it0) * 4096;
            struct OpRegs { bf16x8 a[4][2]; f32x4 pl[4]; u32x2v nc[4]; };
            OpRegs RA, RB;
#define RWB_FETCH(R, slot) do { const LAS bf16* Ls = (const LAS bf16*)(F.lds + (slot) * SLOT); const LAS bf16* Ns = Ls + 64 * TP; const LAS float* Ps = (const LAS float*)(F.lds + (slot) * SLOT + 2 * 64 * TP * 2); \
            _Pragma("unroll") for (int m = 0; m < 4; ++m) { R.a[m][0] = ldsfrag(Ls, 16 * m + l15, 8 * l4); R.a[m][1] = ldsfrag(Ls, 16 * m + l15, 32 + 8 * l4); \
                R.pl[m] = *(const LAS f32x4*)(Ps + 16 * m + 4 * l4); R.nc[m] = *(const LAS u32x2v*)(Ns + l15 * TP + 16 * m + 4 * l4); } } while (0)
#define RWB_STEP(CUR, NXT, cc, nslot) do { u32x2v sb[4]; TSB(tq0 = __builtin_amdgcn_s_memtime(); tacc2 += tq0 - tq2;) \
            _Pragma("unroll") for (int m = 0; m < 4; ++m) { sb[m] = pk4(acc[m]); *(u32x2v*)(sg + ((cc) > 0 ? (size_t)((cc) - 1) * 4096 : sdummy) + 16 * m) = sb[m]; } \
            const v4u q0 = {sb[0].x, sb[0].y, sb[1].x, sb[1].y}, q1 = {sb[2].x, sb[2].y, sb[3].x, sb[3].y}; \
            const bf16x8 b0 = __builtin_bit_cast(bf16x8, q0), b1 = __builtin_bit_cast(bf16x8, q1); \
            f32x4 dl[4]; \
            _Pragma("unroll") for (int m = 0; m < 4; ++m) { dl[m] = (f32x4){0.f, 0.f, 0.f, 0.f}; dl[m] = MFMA16(CUR.a[m][0], b0, dl[m]); dl[m] = MFMA16(CUR.a[m][1], b1, dl[m]); } \
            TSB(asm volatile("" :: "v"(dl[0]), "v"(dl[1]), "v"(dl[2]), "v"(dl[3])); tq1 = __builtin_amdgcn_s_memtime(); tacc0 += tq1 - tq0;) RWB_BAR(); TSB(tq2 = __builtin_amdgcn_s_memtime(); tacc1 += tq2 - tq1;) RWB_FETCH(NXT, nslot); \
            _Pragma("unroll") for (int m = 0; m < 4; ++m) { \
                acc[m][0] = acc[m][0] * CUR.pl[m][0] + dl[m][0] + __uint_as_float(CUR.nc[m].x << 16); acc[m][1] = acc[m][1] * CUR.pl[m][1] + dl[m][1] + __uint_as_float(CUR.nc[m].x & 0xffff0000u); \
                acc[m][2] = acc[m][2] * CUR.pl[m][2] + dl[m][2] + __uint_as_float(CUR.nc[m].y << 16); acc[m][3] = acc[m][3] * CUR.pl[m][3] + dl[m][3] + __uint_as_float(CUR.nc[m].y & 0xffff0000u); } } while (0)
            RWB_BAR();
            TSB(unsigned long long tq0 = 0, tq1 = 0, tq2 = __builtin_amdgcn_s_memtime(), tacc0 = 0, tacc1 = 0, tacc2 = 0;)
            RWB_FETCH(RA, 0);
            for (int c6 = 0; c6 < RW_NCH; c6 += 6) {
                RWB_STEP(RA, RB, c6 + 0, 1); RWB_STEP(RB, RA, c6 + 1, 2); RWB_STEP(RA, RB, c6 + 2, 0);
                RWB_STEP(RB, RA, c6 + 3, 1); RWB_STEP(RA, RB, c6 + 4, 2); RWB_STEP(RB, RA, c6 + 5, 0);
            }
            TSB(if (blockIdx.x == 0 && F.tid == 0) { unsigned long long* ts = (unsigned long long*)(ws + WS_CTL + 512 * 1024); ts[40] = tacc0 / 10; ts[41] = tacc1 / 10; ts[42] = tacc2 / 10; })
#undef RWB_FETCH
#undef RWB_STEP
        } else if (w < 4) {
            RWB_BAR();
            for (int c = 0; c < RW_NCH; ++c) RWB_BAR();
        } else {
            const int t = F.tid - 256, row = t >> 2, cp = (t & 3) * 16;
            v4u L0[6], L1[6], N0[6], P0[6];
#define RWB_LOADG(k, cc) do { const size_t it_ = it0 + ((cc) < RW_NCH ? (cc) : RW_NCH - 1); \
            L0[k] = *(const GAS v4u*)(LCT + it_ * 4096 + t * 16); L1[k] = *(const GAS v4u*)(LCT + it_ * 4096 + t * 16 + 8); \
            if (t < 128) N0[k] = *(const GAS v4u*)(NCG + (it_ * 64 + 16 * nt + (t >> 3)) * 64 + 8 * (t & 7)); \
            if (t < 16) P0[k] = *(const GAS v4u*)(PLG + it_ * 64 + 4 * t); } while (0)
#define RWB_WRITEL(k, slot) do { LAS bf16* Ls = (LAS bf16*)(F.lds + (slot) * SLOT); LAS bf16* Ns = Ls + 64 * TP; \
            *(LAS v4u*)(Ls + row * TP + cp) = L0[k]; *(LAS v4u*)(Ls + row * TP + cp + 8) = L1[k]; if (t < 128) *(LAS v4u*)(Ns + (t >> 3) * TP + 8 * (t & 7)) = N0[k]; \
            if (t < 16) *(LAS v4u*)(F.lds + (slot) * SLOT + 2 * 64 * TP * 2 + 16 * t) = P0[k]; } while (0)
#pragma unroll
            for (int k = 0; k < 6; ++k) RWB_LOADG(k, k);
            RWB_WRITEL(0, 0); RWB_LOADG(0, 6); RWB_WRITEL(1, 1); RWB_LOADG(1, 7);
            RWB_BAR();
            TSB(unsigned long long lq0 = 0, lq1 = 0, lq2 = __builtin_amdgcn_s_memtime(), lacc0 = 0, lacc1 = 0, lacc2 = 0;)
            for (int c6 = 0; c6 < RW_NCH; c6 += 6) {
#pragma unroll
                for (int k = 0; k < 6; ++k) {
                    TSB(lq0 = __builtin_amdgcn_s_memtime(); lacc2 += lq0 - lq2;) RWB_BAR(); TSB(lq1 = __builtin_amdgcn_s_memtime(); lacc0 += lq1 - lq0;)
                    RWB_WRITEL((k + 2) % 6, (k + 2) % 3); TSB(asm volatile("s_waitcnt lgkmcnt(0)" ::: "memory"); lq2 = __builtin_amdgcn_s_memtime(); lacc1 += lq2 - lq1;) RWB_LOADG((k + 2) % 6, c6 + k + 8);
                }
            }
            TSB(if (blockIdx.x == 0 && t == 0) { unsigned long long* ts = (unsigned long long*)(ws + WS_CTL + 512 * 1024); ts[44] = lacc0 / 10; ts[45] = lacc1 / 10; ts[46] = lacc2 / 10; })
#undef RWB_LOADG
#undef RWB_WRITEL
        }
    }
#undef RWB_BAR
    __syncthreads();
}

__device__ __forceinline__ void rw_pass_c2(Frame& F, const Args& A) {
    unsigned char* ws = F.ws;
    const bf16* NCG = (const bf16*)(ws + RW_NC); const bf16* RWTG = (const bf16*)((unsigned char*)F.out + DO_CST);
    const int lane = F.lane, l15 = lane & 15, l4 = lane >> 4;
    const int gw = F.vcu * NWAVES + F.wave, nw = F.G * NWAVES;
    for (int u = gw; u < RW_NITEM * 4; u += nw) {
        const int item = u >> 2, nt = u & 3;
        const int chain = item / RW_NCH, c = item % RW_NCH, d = chain >> 4, b = (chain >> 3) & 1, h = chain & 7;
        if (c == 0) continue;
        bf16* YRW = d == 0 ? (bf16*)(ws + R_YRW0) : (bf16*)((unsigned char*)F.out + DO_YRW1);
        int R, idx, len, sbase; rw_seq_rows(d, b, 64 * c + 16 * nt + l15, R, idx, len, sbase);
        bf16* yp = YRW + (size_t)R * 512 + h * 64 + 4 * l4;
        const bf16* rp = RWTG + ((size_t)item * 64 + 16 * nt + l15) * 64 + 8 * l4;
        const bf16* sp = NCG + (size_t)(item - 1) * 4096 + l15 * 64 + 8 * l4;
        const v4u b0 = *(const GAS v4u*)rp, b1 = *(const GAS v4u*)(rp + 32);
        v4u a0[4], a1[4]; u32x2v ci[4];
#pragma unroll
        for (int mt = 0; mt < 4; ++mt) { a0[mt] = *(const GAS v4u*)(sp + mt * 1024); a1[mt] = *(const GAS v4u*)(sp + mt * 1024 + 32); ci[mt] = *(const GAS u32x2v*)(yp + 16 * mt); }
#pragma unroll
        for (int mt = 0; mt < 4; ++mt) {
            f32x4 acc = {__uint_as_float(ci[mt].x << 16), __uint_as_float(ci[mt].x & 0xffff0000u), __uint_as_float(ci[mt].y << 16), __uint_as_float(ci[mt].y & 0xffff0000u)};
            acc = MFMA16(__builtin_bit_cast(bf16x8, a0[mt]), __builtin_bit_cast(bf16x8, b0), acc); acc = MFMA16(__builtin_bit_cast(bf16x8, a1[mt]), __builtin_bit_cast(bf16x8, b1), acc);
            *(u32x2v*)(yp + 16 * mt) = pk4(acc);
        }
    }
    __syncthreads();
}
#ifndef MK_N_LAUNCHES
#define MK_N_LAUNCHES 1
#endif
constexpr int NPHASE = 23;
#ifndef PHMASK
#define PHMASK 0xffffffffu
#endif
#define PH_ON(k) (((PHMASK) >> (k)) & 1u)
__global__ void __launch_bounds__(NTHREADS, 2) mk_fwd(Args args) {
    extern __shared__ __attribute__((aligned(16))) unsigned char lds[];
    Frame F;
    F.lds = (LAS unsigned char*)lds;
    F.MISC = (volatile LAS unsigned*)(F.lds + MISC_OFF);
    F.tid = threadIdx.x; F.lane = F.tid & 63; F.wave = __builtin_amdgcn_readfirstlane(F.tid >> 6);
    F.G = gridDim.x; { const int bx = blockIdx.x; F.vcu = (F.G % 8 == 0) ? (bx % 8) * (F.G / 8) + bx / 8 : bx; }
    F.ws = args.ws; F.out = args.out; const Args& A = args;
    unsigned char* ws = args.ws;
    F.ctl = (gu32*)(ws + WS_CTL);
    for (int u = F.tid; u < (LDS_BYTES - LDSCTL_OFF) / 4; u += NTHREADS) ((LAS unsigned*)(F.lds + LDSCTL_OFF))[u] = 0u;
    __syncthreads();
    const bool use_bar = (args.ph_hi - args.ph_lo) > 1;
    XcdBarrier bar; bar.bar = (unsigned*)(F.ctl + CW_BAR) + args.li * XCD_BAR_WORDS; bar.x = 0; bar.st = nullptr;
    if (use_bar) bar = xcd_barrier_post((unsigned*)(F.ctl + CW_BAR) + args.li * XCD_BAR_WORDS, F.MISC + 8);
    const float* MOD = (const float*)(ws + WS_MOD);
    bf16* XN = (bf16*)(ws + WS_XN);
    float* XC = (float*)(ws + WS_XC);
    const int bid = (int)blockIdx.x;
    const int lo = args.ph_lo, hi = args.ph_hi;
#define IN(k) (PH_ON(k) && lo <= (k) && (k) < hi)
#ifdef TS_A
#define TSTAMP(i) do { if (blockIdx.x == TS_BLK && F.tid == 0) ((unsigned long long*)(ws + WS_CTL + 512 * 1024))[i] = __builtin_amdgcn_s_memrealtime(); } while (0)
#else
#define TSTAMP(i) do {} while (0)
#endif
#ifndef TS_OFF
#define TS_OFF 0
#endif
#ifndef TS_BLK
#define TS_BLK 0
#endif
#define SEAM(k) do { if ((k) + 1 < hi) xcd_barrier(bar); TSTAMP((k) + 1); } while (0)
    TSTAMP(0);
    if (IN(0)) { p0_prologue(F, A); SEAM(0); }
    if (IN(1)) { p1_mod_finalize(F, A); SEAM(1); }
    if (IN(2)) { norm_rows(F, A, A.in[I_X], A.in[I_CTX], MA_ROWS, A.in[I_NORM_MIX], MOD, 0, 1, XN); SEAM(2); }
    if (IN(3)) { { const pg8::RecInDst rd{(bf16*)(ws + R_QM), (R_KM - R_QM) / 2, (R_VM - R_QM) / 2, (R_OM - R_QM) / 2, (bf16*)(ws + R_RAW), (bf16*)(ws + R_TWAD), (bf16*)(ws + R_SGD), (float*)(ws + R_GATES)};
            { pg8::Gemm g{XN, (const bf16*)(ws + WS_WREC), ML_ROWS, REC_N, D}; pg8::StaticOrder S; S.init(ML_ROWS, REC_N, F.G, bid);
              pg8::EpiRecIn E{rd};
              pg8::gemm_phase<pg8::EpiRecIn, pg8::StaticOrder, true, true>(F.lds + RING_OFF, g, S, E); }
            ctx_gemm2(F, XN + (size_t)ML_ROWS * D, D, (const bf16*)(ws + WS_WREC), D, MC_ROWS, REC_N, D, [=](int row, int col, float v) { pg8::recin_store1(rd, (size_t)(ML_ROWS + row), col, v); });
        } SEAM(3); }
    if (IN(4)) { ml_pass_a(F, A); p0_weights_tail<3>(F, A, NITEM_ML, F.vcu); SEAM(4); }
    if (IN(5)) { ml_pass_b(F, A); SEAM(5); }
    if (IN(6)) { ml_pass_c(F, A); p0_weights_tail<4>(F, A, NITEM_ML, F.vcu); SEAM(6); }
    if (IN(7)) { rw_chunk_pass<0>(F, A); SEAM(7); }
    if (IN(8)) { rw_pass_b(F, A);
            { const bool spread = (F.G >= 256) && (F.G % 2 == 0);
              if (!spread || (F.vcu & 1)) {
                int kg = 128; asm volatile("" : "+s"(kg)); pg8::Gemm g{(const bf16*)(ws + R_SGD), (const bf16*)(ws + WS_WG2), MA_ROWS, 512, kg}; pg8::StaticOrder S; S.init(MA_ROWS, 512, spread ? F.G / 2 : F.G, spread ? (F.vcu >> 1) : F.vcu);
                pg8::EpiStoreBf16<1536> E{(bf16*)(ws + R_RAW), 0, 1.f};
                pg8::gemm_phase<pg8::EpiStoreBf16<1536>, pg8::StaticOrder, true, true>(F.lds + RING_OFF, g, S, E); } }
        SEAM(8); }
    if (IN(9)) { rw_pass_c2(F, A); SEAM(9); }
    if (IN(10)) { merge_rows(F, A); SEAM(10); }
    if (IN(11)) { { pg8::Gemm g{(const bf16*)(ws + R_MIX), (const bf16*)(ws + WS_WOUT), ML_ROWS, D, D}; pg8::StaticOrder S; S.init(ML_ROWS, D, F.G, bid);
            pg8::EpiResid E{A.in[I_X], A.in[I_CTX], F.out, XC, MOD + 2 * 1024};
            pg8::gemm_phase<pg8::EpiResid, pg8::StaticOrder, true, true>(F.lds + RING_OFF, g, S, E);
            { const float* src = A.in[I_CTX]; const float* gate = MOD + 2 * 6144 + 2 * 1024;
              ctx_gemm2(F, (const bf16*)(ws + R_MIX) + (size_t)ML_ROWS * D, D, (const bf16*)(ws + WS_WOUT), D, MC_ROWS, D, D, [=](int row, int col, float v) { XC[(size_t)row * D + col] = src[(size_t)row * D + col] + gate[col] * v; }); } } SEAM(11); }
    if (IN(12)) { norm_rows(F, A, F.out, XC, MA_ROWS, A.in[I_NORM_FFN], MOD, 3, 4, XN); SEAM(12); }
    if (IN(13)) { { pg8::Gemm g{XN, (const bf16*)(ws + WS_W1), MA_ROWS, FF, D}; pg8::StaticOrder S; S.init(MA_ROWS, FF, F.G, bid);
            pg8::EpiSqRelu<FF> E{(bf16*)(ws + R_H)};
            pg8::gemm_phase<pg8::EpiSqRelu<FF>, pg8::StaticOrder, true, true>(F.lds + RING_OFF, g, S, E);
            p0_weights_tail<1>(F, A, (MA_ROWS / 256) * (FF / 256), bid); } SEAM(13); }
    if (IN(14)) { { pg8::Gemm g{(const bf16*)(ws + R_H), (const bf16*)(ws + WS_W2), ML_ROWS, D, FF}; pg8::StaticOrder S; S.init(ML_ROWS, D, F.G, bid);
            pg8::EpiResid E{F.out, XC, F.out, XC, MOD + 5 * 1024};
            pg8::gemm_phase<pg8::EpiResid, pg8::StaticOrder, true, true>(F.lds + RING_OFF, g, S, E);
            { const float* gate = MOD + 2 * 6144 + 5 * 1024; TSTAMP(40);
              ctx_gemm(F, (const bf16*)(ws + R_H) + (size_t)ML_ROWS * FF, FF, (const bf16*)(ws + WS_W2), FF, MC_ROWS, D, FF, [=](int row, int col, float v) { XC[(size_t)row * D + col] += gate[col] * v; }); TSTAMP(41); } } SEAM(14); }
    if (IN(15)) { norm_rows(F, A, F.out, XC, MA_ROWS, A.in[I_NORM_MIX] + D, MOD + 3 * 6144, 0, 1, XN); SEAM(15); }
    if (IN(16)) { { pg8::Gemm g{XN, (const bf16*)(ws + WS_WATT), MA_ROWS, ATT_N, D}; pg8::StaticOrder S; S.init(MA_ROWS, ATT_N, F.G, bid);
            pg8::EpiStoreBf16<ATT_N> E{(bf16*)(ws + R_ATT), 0, 1.f};
            pg8::gemm_phase<pg8::EpiStoreBf16<ATT_N>, pg8::StaticOrder, true, true>(F.lds + RING_OFF, g, S, E);
            p0_weights_tail<2>(F, A, (MA_ROWS / 256) * (ATT_N / 256), bid); } SEAM(16); }
    if (IN(17)) { qk_prep(F, A); SEAM(17); }
    if (IN(18)) { attn_phase(F, A, (char*)lds + RING_OFF); SEAM(18); }
    if (IN(19)) { { pg8::Gemm g{(const bf16*)(ws + R_QB), (const bf16*)(ws + WS_WOUT) + (size_t)D * D, ML_ROWS, D, D}; pg8::StaticOrder S; S.init(ML_ROWS, D, F.G, bid);
            pg8::EpiResid E{F.out, XC, F.out, XC, MOD + 3 * 6144 + 2 * 1024};
            pg8::gemm_phase<pg8::EpiResid, pg8::StaticOrder, true, true>(F.lds + RING_OFF, g, S, E); } SEAM(19); }
    if (IN(20)) { norm_rows(F, A, F.out, XC, ML_ROWS, A.in[I_NORM_FFN] + D, MOD + 3 * 6144, 3, 4, XN); SEAM(20); }
    if (IN(21)) { { pg8::Gemm g{XN, (const bf16*)(ws + WS_W1) + (size_t)D * FF, ML_ROWS, FF, D}; pg8::StaticOrder S; S.init(ML_ROWS, FF, F.G, bid);
            pg8::EpiSqRelu<FF> E{(bf16*)(ws + R_H)};
            pg8::gemm_phase<pg8::EpiSqRelu<FF>, pg8::StaticOrder, true, true>(F.lds + RING_OFF, g, S, E); } SEAM(21); }
    if (IN(22)) { { pg8::Gemm g{(const bf16*)(ws + R_H), (const bf16*)(ws + WS_W2) + (size_t)D * FF, ML_ROWS, D, FF}; pg8::StaticOrder S; S.init(ML_ROWS, D, F.G, bid);
            pg8::EpiResid E{F.out, XC, F.out, XC, MOD + 3 * 6144 + 5 * 1024};
            pg8::gemm_phase<pg8::EpiResid, pg8::StaticOrder, true, true>(F.lds + RING_OFF, g, S, E); } SEAM(22); }
#ifdef TS_A
    if (blockIdx.x == TS_BLK && F.tid == 0) { const unsigned long long* ts = (const unsigned long long*)(ws + WS_CTL + 512 * 1024);
        __builtin_amdgcn_s_waitcnt(0); F.out[0] += ((float)(ts[TS_B] - ts[TS_A]) - (float)(TS_OFF)) * 0.001f; }
#endif
#undef IN
#undef SEAM
}

extern "C" void kernel_launch(void* const* d_in, const int* in_sizes, int n_in, void* d_out, int out_size, void* d_ws, size_t ws_size, hipStream_t stream) {
    static int grid = 0;
    if (grid == 0) {
        if (n_in != N_IN || out_size != ML_ROWS * D || ws_size < WS_END) { fprintf(stderr, "kernel_launch: unexpected shapes (n_in %d, out %d, ws %zu); nothing launched\n", n_in, out_size, ws_size); grid = -1; return; }
        int dev = 0, cus = 0, per_cu = 0;
        if (hipGetDevice(&dev) != hipSuccess || hipDeviceGetAttribute(&cus, hipDeviceAttributeMultiprocessorCount, dev) != hipSuccess) { grid = -1; return; }
        if (hipFuncSetAttribute((const void*)mk_fwd, hipFuncAttributeMaxDynamicSharedMemorySize, LDS_BYTES) != hipSuccess) { fprintf(stderr, "kernel_launch: hipFuncSetAttribute failed\n"); grid = -1; return; }
        if (hipOccupancyMaxActiveBlocksPerMultiprocessor(&per_cu, (const void*)mk_fwd, NTHREADS, LDS_BYTES) != hipSuccess || per_cu < 1) { fprintf(stderr, "kernel_launch: occupancy query says %d blocks per CU\n", per_cu); per_cu = 1; }
        (void)hipGetLastError();
        grid = cus;
    }
    if (grid < 0) return;
    (void)hipMemsetAsync((char*)d_ws + WS_CTL, 0, CTL_ZERO_BYTES, stream);
    Args a{};
    for (int i = 0; i < N_IN; ++i) a.in[i] = (const float*)d_in[i];
    a.out = (float*)d_out; a.ws = (unsigned char*)d_ws;
#if MK_N_LAUNCHES == 1
    a.ph_lo = 0; a.ph_hi = NPHASE; a.li = 0;
    { void* kargs[] = {&a}; hipError_t e = hipLaunchCooperativeKernel((const void*)mk_fwd, dim3(grid), dim3(NTHREADS), kargs, LDS_BYTES, stream);
      if (e != hipSuccess) fprintf(stderr, "kernel_launch: cooperative launch failed: %s\n", hipGetErrorString(e)); }
#else
    for (int p = 0; p < NPHASE; ++p) { a.ph_lo = p; a.ph_hi = p + 1; a.li = 0; hipLaunchKernelGGL(mk_fwd, dim3(grid), dim3(NTHREADS), LDS_BYTES, stream, a); }
#endif
}
```

```cpp
#include <hip/hip_runtime.h>
#include <hip/hip_bf16.h>
#include <cstdio>
#include <cstdint>
#include <cmath>
namespace pg8 {
#define PG8_LAS __attribute__((address_space(3)))
typedef unsigned short bf16_t;
typedef short bf16x8 __attribute__((ext_vector_type(8)));
typedef float f32x4 __attribute__((ext_vector_type(4)));
typedef unsigned u32x4 __attribute__((ext_vector_type(4)));
constexpr int BM = 256, BK = 64, HALF = 128, HTB = HALF * BK * 2  , STAGE_BYTES = 8 * HTB, NXCD = 8, WGM = 8;

__host__ __device__ __forceinline__ int lds_byte(int r, int c) { const int st = (r >> 4) * 2 + (c >> 5), rr = r & 15, cc = c & 31, ob = rr * 64 + cc * 2; return st * 1024 + (ob ^ (((ob >> 9) & 1) << 5)); }
__host__ __device__ __forceinline__ void stage_rc(int b, int& R, int& C) { const int st = b / 1024, sb = b % 1024, swz = sb ^ (((sb >> 9) & 1) << 5); R = (st >> 1) * 16 + swz / 64; C = (st & 1) * 32 + (swz % 64) / 2; }
__host__ __device__ __forceinline__ int perm32(int rho) { const int n = rho >> 4, i = rho & 15; return 8 * (i >> 2) + 4 * n + (i & 3); }

struct Unit { int pm, pn; };
struct Gemm { const bf16_t* A; const bf16_t* Bt; int M, N, K; };

struct StaticOrder {
    int nM, nN, nwg, G, c;
    __host__ __device__ void init(int M, int N, int G_, int c_) { nM = M / BM; nN = N / BM; nwg = nM * nN; G = G_; c = c_; }
    __host__ __device__ bool next(int i, Unit& u) const {
        const long L = (long)i * G + c; if (L >= nwg) return false;
        int wgid = (int)L; { const int q = nwg / NXCD, r = nwg % NXCD, xcd = wgid % NXCD, off = wgid / NXCD; wgid = (xcd < r ? xcd * (q + 1) : r * (q + 1) + (xcd - r) * q) + off; }
        const int nig = WGM * nN, gid = wgid / nig, fm = gid * WGM, gsz = (nM - fm) < WGM ? (nM - fm) : WGM;
        u.pm = fm + ((wgid % nig) % gsz); u.pn = (wgid % nig) / gsz; return true;
    }
    __device__ __forceinline__ void a_ready(const Unit&) const {}
    __device__ __forceinline__ void done(const Unit&) const {}
};

__device__ __forceinline__ unsigned cvt_pk_bf16(float lo, float hi) { unsigned r; asm volatile("v_cvt_pk_bf16_f32 %0, %1, %2" : "=v"(r) : "v"(lo), "v"(hi)); return r; }
typedef float f32x2 __attribute__((ext_vector_type(2)));
__device__ __forceinline__ f32x2 gelu_pk(f32x2 v) {
    const f32x2 av = __builtin_elementwise_abs(v), d = av * 0.2316418882f + 1.0f;
    f32x2 t; t.x = __builtin_amdgcn_rcpf(d.x); t.y = __builtin_amdgcn_rcpf(d.y);
    f32x2 q = t * 0.5307027145f + (-0.7265760135f); q = q * t + 0.7107068705f; q = q * t + (-0.142248368f); q = q * t + 0.127414796f; q = q * t;
    const f32x2 s = (v * v) * (-0.72134752044f);
    f32x2 e; e.x = __builtin_amdgcn_exp2f(s.x); e.y = __builtin_amdgcn_exp2f(s.y);
    const f32x2 m = v * (q * e), r = v - m;
    f32x2 o; o.x = v.x < 0.f ? m.x : r.x; o.y = v.y < 0.f ? m.y : r.y; return o;
}

template <int ACT  > struct EpiBf16 {
    static constexpr bool PERM = true, AFTER_DRAIN = false; static_assert(ACT == 0 || ACT == 1, "EpiBf16: ACT is 0 (none) or 1 (gelu_pk)");
    bf16_t* O; int ldc; const float* bias; int split_cols; size_t split_stride; float scale0;
    __device__ __forceinline__ void operator()(const f32x4 (&acc)[2][2][4][2], const Unit& u, int wr, int wc, int fr, int fq) const {
        const int row0 = u.pm * BM + wr * 64 + fr; int colt = u.pn * BM; bf16_t* base = O;
        float sc = 1.f; if (split_cols) { const int t = colt / split_cols; base += (size_t)t * split_stride; colt -= t * split_cols; if (t == 0) sc = scale0; }
        const int col0 = colt + wc * 32 + 8 * fq, bcol0 = u.pn * BM + wc * 32 + 8 * fq;
        f32x4 bv[2][2];
#pragma unroll
        for (int bj = 0; bj < 2; ++bj)
#pragma unroll
            for (int n = 0; n < 2; ++n) bv[bj][n] = bias ? *(const f32x4*)(bias + bcol0 + bj * HALF + 4 * n) : (f32x4){0.f, 0.f, 0.f, 0.f};
#pragma unroll
        for (int ai = 0; ai < 2; ++ai)
#pragma unroll
            for (int m = 0; m < 4; ++m) { bf16_t* rowp = base + (size_t)(row0 + ai * HALF + m * 16) * ldc + col0;
#pragma unroll
                for (int bj = 0; bj < 2; ++bj) { f32x4 v0 = acc[ai][bj][m][0] + bv[bj][0], v1 = acc[ai][bj][m][1] + bv[bj][1];
                    if (ACT == 1) { f32x2 a = gelu_pk((f32x2){v0[0], v0[1]}), b = gelu_pk((f32x2){v0[2], v0[3]}), c = gelu_pk((f32x2){v1[0], v1[1]}), d = gelu_pk((f32x2){v1[2], v1[3]});
                        v0 = (f32x4){a.x, a.y, b.x, b.y}; v1 = (f32x4){c.x, c.y, d.x, d.y}; }
                    v0 = v0 * sc; v1 = v1 * sc; u32x4 w; w.x = cvt_pk_bf16(v0[0], v0[1]); w.y = cvt_pk_bf16(v0[2], v0[3]); w.z = cvt_pk_bf16(v1[0], v1[1]); w.w = cvt_pk_bf16(v1[2], v1[3]);
                    *(u32x4*)(rowp + bj * HALF) = w; } }
    }
};

struct PanelStats {
    unsigned* xbuf;
    unsigned* cnt;
    unsigned* tmo;
    int ntn; float eps;
    unsigned code;
    __device__ __forceinline__ bool run(const f32x4 (&v)[2][2][4][2], const Unit& u, int wr, int wc, int fr, int fq, PG8_LAS unsigned char* lds, int wid, int lane) const {
        typedef float f32x2v __attribute__((ext_vector_type(2)));
        PG8_LAS f32x2v* P = (PG8_LAS f32x2v*)lds;
        PG8_LAS f32x2v* S = (PG8_LAS f32x2v*)(lds + 8192);
        PG8_LAS unsigned* flag = (PG8_LAS unsigned*)(lds + 8192 + 2048);
#pragma unroll
        for (int ai = 0; ai < 2; ++ai)
#pragma unroll
            for (int m = 0; m < 4; ++m) {
                float s = 0.f;
#pragma unroll
                for (int bj = 0; bj < 2; ++bj)
#pragma unroll
                    for (int n = 0; n < 2; ++n) { const f32x4 x = v[ai][bj][m][n]; s += (x[0] + x[1]) + (x[2] + x[3]); }
                s += __shfl_xor(s, 16); s += __shfl_xor(s, 32);
                const float mw = s * (1.0f / 64.0f); float q = 0.f;
#pragma unroll
                for (int bj = 0; bj < 2; ++bj)
#pragma unroll
                    for (int n = 0; n < 2; ++n) { const f32x4 d = v[ai][bj][m][n] - mw; q += (d[0] * d[0] + d[1] * d[1]) + (d[2] * d[2] + d[3] * d[3]); }
                q += __shfl_xor(q, 16); q += __shfl_xor(q, 32);
                if (fq == 0) P[(ai * HALF + wr * 64 + m * 16 + fr) * 4 + wc] = (f32x2v){mw, q};
            }
        asm volatile("s_waitcnt lgkmcnt(0)" ::: "memory"); __builtin_amdgcn_s_barrier(); asm volatile("" ::: "memory");
#if defined(BROKEN_EXCHANGE_NO_WAIT)
#warning BROKEN CONTROL BUILD: the row-statistics exchange does not wait; results are wrong by design
        if (blockIdx.x >= 64) { const long long t0_ = clock64(); while (clock64() - t0_ < 60000) __builtin_amdgcn_s_sleep(8); }
#endif
        const int row = wid * 32 + (lane & 31);
        if (lane < 32) {
            const f32x2v a = P[row * 4 + 0], b = P[row * 4 + 1], c = P[row * 4 + 2], d = P[row * 4 + 3];
            const float mt = (a.x + b.x + c.x + d.x) * 0.25f;
            const float da = a.x - mt, db = b.x - mt, dc = c.x - mt, dd = d.x - mt;
            const float m2 = (a.y + b.y) + (c.y + d.y) + 64.0f * ((da * da + db * db) + (dc * dc + dd * dd));
            unsigned long long* slot = (unsigned long long*)xbuf + ((size_t)(u.pm * BM + row) * 4 + u.pn);
            __hip_atomic_store(slot, ((unsigned long long)__float_as_uint(m2) << 32) | __float_as_uint(mt), __ATOMIC_RELAXED, __HIP_MEMORY_SCOPE_AGENT);
        }
        asm volatile("s_waitcnt vmcnt(0)" ::: "memory");
        if (lane == 0) __hip_atomic_fetch_add(cnt + 64 * u.pm, 1u, __ATOMIC_RELAXED, __HIP_MEMORY_SCOPE_AGENT);
        if (wid == 0) {
            bool dead = false; const unsigned long long t0 = __builtin_amdgcn_s_memrealtime(); const unsigned want = 8u * (unsigned)ntn;
            for (;;) {
#if defined(BROKEN_EXCHANGE_NO_WAIT)
                break;
#endif
                if ((unsigned)__builtin_amdgcn_readfirstlane(__hip_atomic_load(cnt + 64 * u.pm, __ATOMIC_RELAXED, __HIP_MEMORY_SCOPE_AGENT)) >= want) break;
                if (__builtin_amdgcn_s_memrealtime() - t0 > 2000000ull) {
                    if (lane == 0) { unsigned expect = 0u; __hip_atomic_compare_exchange_strong(tmo + 1, &expect, code | (unsigned)(u.pm & 0xff), __ATOMIC_RELAXED, __ATOMIC_RELAXED, __HIP_MEMORY_SCOPE_AGENT);
                                     __hip_atomic_store(tmo, 1u, __ATOMIC_RELAXED, __HIP_MEMORY_SCOPE_AGENT); }
                    dead = true; break; }
                __builtin_amdgcn_s_sleep(2);
            }
            __builtin_amdgcn_fence(__ATOMIC_ACQUIRE, "agent");
            if (lane == 0) flag[0] = dead ? 1u : 0u;
        }
        asm volatile("s_waitcnt vmcnt(0) lgkmcnt(0)" ::: "memory"); __builtin_amdgcn_s_barrier(); asm volatile("" ::: "memory");
        const bool bad = flag[0] != 0u;
        if (lane < 32) {
            const unsigned long long* slot = (const unsigned long long*)xbuf + (size_t)(u.pm * BM + row) * 4; float mt[4], m2[4]; float ms = 0.f;
#pragma unroll
            for (int t = 0; t < 4; ++t) { if (t < ntn) { const unsigned long long w = __hip_atomic_load(slot + t, __ATOMIC_RELAXED, __HIP_MEMORY_SCOPE_AGENT); mt[t] = __uint_as_float((unsigned)w); m2[t] = __uint_as_float((unsigned)(w >> 32)); } else { mt[t] = 0.f; m2[t] = 0.f; } ms += mt[t]; }
            const float mean = ms / (float)ntn; float q = 0.f;
#pragma unroll
            for (int t = 0; t < 4; ++t) if (t < ntn) { const float dm = mt[t] - mean; q += m2[t] + 256.0f * dm * dm; }
            S[row] = (f32x2v){mean, 1.0f / sqrtf(q / (256.0f * (float)ntn) + eps)};
        }
        asm volatile("s_waitcnt lgkmcnt(0)" ::: "memory"); __builtin_amdgcn_s_barrier(); asm volatile("" ::: "memory");
        return bad;
    }
};
struct EpiLnRes {
    static constexpr bool PERM = false, AFTER_DRAIN = true;
    const float* base; float* out; int ldc; const float* bias; PanelStats st; unsigned poison;
    __device__ __forceinline__ void fused(f32x4 (&acc)[2][2][4][2], const Unit& u, int wr, int wc, int fr, int fq, PG8_LAS unsigned char* lds, int wid, int lane) const {
        typedef float f32x2v __attribute__((ext_vector_type(2)));
        const PG8_LAS f32x2v* S = (const PG8_LAS f32x2v*)(lds + 8192);
        const int col0 = u.pn * BM + wc * 32 + 4 * fq;
#pragma unroll
        for (int bj = 0; bj < 2; ++bj)
#pragma unroll
            for (int n = 0; n < 2; ++n) { const f32x4 bv = bias ? *(const f32x4*)(bias + col0 + bj * HALF + n * 16) : (f32x4){0.f, 0.f, 0.f, 0.f};
#pragma unroll
                for (int ai = 0; ai < 2; ++ai)
#pragma unroll
                    for (int m = 0; m < 4; ++m) acc[ai][bj][m][n] += bv; }
        f32x4 pre[4][2][2];
#pragma unroll
        for (int m = 0; m < 4; ++m) { const size_t off = (size_t)(u.pm * BM + wr * 64 + m * 16 + fr) * ldc + col0;
#pragma unroll
            for (int bj = 0; bj < 2; ++bj)
#pragma unroll
                for (int n = 0; n < 2; ++n) pre[m][bj][n] = *(const f32x4*)(base + off + bj * HALF + n * 16); }
        const bool bad = st.run(acc, u, wr, wc, fr, fq, lds, wid, lane) || poison != 0u;
        const float qnan = __builtin_nanf("");
#pragma unroll
        for (int ai = 0; ai < 2; ++ai)
#pragma unroll
            for (int m = 0; m < 4; ++m) { const int r = ai * HALF + wr * 64 + m * 16 + fr; const f32x2v sr = S[r]; const size_t off = (size_t)(u.pm * BM + r) * ldc + col0;
#pragma unroll
                for (int bj = 0; bj < 2; ++bj)
#pragma unroll
                    for (int n = 0; n < 2; ++n) { const f32x4 bs = ai == 0 ? pre[m][bj][n] : *(const f32x4*)(base + off + bj * HALF + n * 16); f32x4 o = bs + (acc[ai][bj][m][n] - sr.x) * sr.y;
                        if (bad) o = (f32x4){qnan, qnan, qnan, qnan}; *(f32x4*)(out + off + bj * HALF + n * 16) = o; }
                if (m & 1) asm volatile("" ::: "memory"); }
    }
};
struct EpiLnResLn {
    static constexpr bool PERM = false, AFTER_DRAIN = true;
    const float* base; float* out; bf16_t* xn; int ldc; const float* bias; PanelStats st1, st2; unsigned poison;
    __device__ __forceinline__ void fused(f32x4 (&acc)[2][2][4][2], const Unit& u, int wr, int wc, int fr, int fq, PG8_LAS unsigned char* lds, int wid, int lane) const {
        typedef float f32x2v __attribute__((ext_vector_type(2))); typedef unsigned u32x2v __attribute__((ext_vector_type(2)));
        const PG8_LAS f32x2v* S = (const PG8_LAS f32x2v*)(lds + 8192);
        const int col0 = u.pn * BM + wc * 32 + 4 * fq;
#pragma unroll
        for (int bj = 0; bj < 2; ++bj)
#pragma unroll
            for (int n = 0; n < 2; ++n) { const f32x4 bv = bias ? *(const f32x4*)(bias + col0 + bj * HALF + n * 16) : (f32x4){0.f, 0.f, 0.f, 0.f};
#pragma unroll
                for (int ai = 0; ai < 2; ++ai)
#pragma unroll
                    for (int m = 0; m < 4; ++m) acc[ai][bj][m][n] += bv; }
        bool bad = st1.run(acc, u, wr, wc, fr, fq, lds, wid, lane) || poison != 0u;
        const float qnan = __builtin_nanf("");
#pragma unroll
        for (int ai = 0; ai < 2; ++ai)
#pragma unroll
            for (int m = 0; m < 4; ++m) { const int r = ai * HALF + wr * 64 + m * 16 + fr; const f32x2v sr = S[r]; const size_t off = (size_t)(u.pm * BM + r) * ldc + col0;
#pragma unroll
                for (int bj = 0; bj < 2; ++bj)
#pragma unroll
                    for (int n = 0; n < 2; ++n) { const f32x4 bs = *(const f32x4*)(base + off + bj * HALF + n * 16); acc[ai][bj][m][n] = bs + (acc[ai][bj][m][n] - sr.x) * sr.y; }
                asm volatile("" : "+v"(acc[ai][0][m][0]), "+v"(acc[ai][0][m][1]), "+v"(acc[ai][1][m][0]), "+v"(acc[ai][1][m][1]));
                if (m & 1) asm volatile("" ::: "memory"); }
        const bool bad1 = bad;
        bad = st2.run(acc, u, wr, wc, fr, fq, lds, wid, lane) || bad;
#pragma unroll
        for (int ai = 0; ai < 2; ++ai)
#pragma unroll
            for (int m = 0; m < 4; ++m) { const int r = ai * HALF + wr * 64 + m * 16 + fr; const f32x2v sr = S[r]; const size_t off = (size_t)(u.pm * BM + r) * ldc + col0;
#pragma unroll
                for (int bj = 0; bj < 2; ++bj)
#pragma unroll
                    for (int n = 0; n < 2; ++n) { const f32x4 x1 = acc[ai][bj][m][n]; *(f32x4*)(out + off + bj * HALF + n * 16) = bad1 ? (f32x4){qnan, qnan, qnan, qnan} : x1;
                        const f32x4 o = (x1 - sr.x) * sr.y; u32x2v w; w.x = cvt_pk_bf16(o[0], o[1]); w.y = cvt_pk_bf16(o[2], o[3]);
                        if (bad) { w.x = 0x7fc07fc0u; w.y = 0x7fc07fc0u; } *(u32x2v*)(xn + off + bj * HALF + n * 16) = w; }
                asm volatile("" ::: "memory"); }
    }
};

template <class Epi, class Sched, bool ALIGN_EPI = false, bool SP2 = false>
__device__ __forceinline__ void gemm_phase(PG8_LAS unsigned char* lds, const Gemm g, const Sched& S, const Epi& E) {
    const int tid = threadIdx.x, wid = __builtin_amdgcn_readfirstlane(tid >> 6), lane = tid & 63, wr = wid >> 2, wc = wid & 3, fr = lane & 15, fq = lane >> 4;
    const int K = g.K, nt = K / BK;
    unsigned voffA[2], voffB[2];
#pragma unroll
    for (int i = 0; i < 2; ++i) { int R, C; stage_rc(tid * 16 + i * 8192, R, C); const int Rb = Epi::PERM ? ((R & ~31) + perm32(R & 31)) : R;
        voffA[i] = (unsigned)(R * K + C) * 2u; voffB[i] = (unsigned)(Rb * K + C) * 2u; }
    const size_t kstep = (size_t)(BK * 2);
    const size_t hstep = (size_t)HALF * K * 2;
    const size_t tstep = 2 * hstep;
    const unsigned ldsw = (unsigned)wid * 1024u;
    const int aoff = lds_byte(wr * 64 + fr, fq * 8), boff = lds_byte(wc * 32 + fr, fq * 8);
#define PG8_SA(b, h) (((b) * 2 + (h)) * HTB)
#define PG8_SB(b, h) ((4 + (b) * 2 + (h)) * HTB)
#define PG8_STAGE(bufoff, gbase, voff) do { _Pragma("unroll") for (int _i = 0; _i < 2; ++_i) \
        __builtin_amdgcn_global_load_lds((const unsigned*)((const char*)(gbase) + (voff)[_i]), (PG8_LAS unsigned*)(lds + (bufoff) + ldsw + _i * 8192), 16, 0, 0); } while (0)
#define PG8_LDA(dst, b, h) do { _Pragma("unroll") for (int m = 0; m < 4; ++m) _Pragma("unroll") for (int k = 0; k < 2; ++k) dst[m][k] = *(const PG8_LAS bf16x8*)(lds + PG8_SA(b, h) + aoff + m * 2048 + k * 1024); } while (0)
#define PG8_LDB(dst, b, h) do { _Pragma("unroll") for (int n = 0; n < 2; ++n) _Pragma("unroll") for (int k = 0; k < 2; ++k) dst[n][k] = *(const PG8_LAS bf16x8*)(lds + PG8_SB(b, h) + boff + n * 2048 + k * 1024); } while (0)
#define PG8_MMA(ai, bj, At, Bt) do { __builtin_amdgcn_s_setprio(1); _Pragma("unroll") for (int m = 0; m < 4; ++m) _Pragma("unroll") for (int n = 0; n < 2; ++n) _Pragma("unroll") for (int k = 0; k < 2; ++k) \
        acc[ai][bj][m][n] = __builtin_amdgcn_mfma_f32_16x16x32_bf16(Bt[n][k], At[m][k], acc[ai][bj][m][n], 0, 0, 0); __builtin_amdgcn_s_setprio(0); } while (0)
#define PG8_WAIT_V(n) asm volatile("s_waitcnt vmcnt(" #n ")" ::: "memory")
#define PG8_WAIT_L(n) asm volatile("s_waitcnt lgkmcnt(" #n ")" ::: "memory")
#define PG8_BAR __builtin_amdgcn_s_barrier()
#define PG8_SCHED __builtin_amdgcn_sched_barrier(0)
    Unit cur, nxt; int ui = 0;
    if (!S.next(0, cur)) return;
    f32x4 acc[2][2][4][2];
#pragma unroll
    for (int a = 0; a < 2; ++a)
#pragma unroll
        for (int b = 0; b < 2; ++b)
#pragma unroll
            for (int m = 0; m < 4; ++m)
#pragma unroll
                for (int n = 0; n < 2; ++n) acc[a][b][m][n] = (f32x4){0.f, 0.f, 0.f, 0.f};
    bf16x8 At[4][2], B0[2][2], B1[2][2];
    const char* cA = (const char*)g.A + (size_t)cur.pm * tstep; const char* cB = (const char*)g.Bt + (size_t)cur.pn * tstep;
    S.a_ready(cur);
    if constexpr (SP2) {
        PG8_STAGE(PG8_SB(0, 0), cB, voffB); PG8_STAGE(PG8_SB(0, 1), cB + hstep, voffB); PG8_STAGE(PG8_SA(0, 0), cA, voffA); PG8_STAGE(PG8_SA(0, 1), cA + hstep, voffA);
        if (wr == 1) PG8_BAR;
        PG8_WAIT_V(2); PG8_BAR;
        PG8_STAGE(PG8_SB(1, 0), cB + kstep, voffB); PG8_STAGE(PG8_SA(1, 0), cA + kstep, voffA); PG8_STAGE(PG8_SB(1, 1), cB + hstep + kstep, voffB);
        PG8_WAIT_V(6); PG8_BAR;
    } else {
        PG8_STAGE(PG8_SB(0, 0), cB, voffB); PG8_STAGE(PG8_SA(0, 0), cA, voffA); PG8_STAGE(PG8_SB(0, 1), cB + hstep, voffB); PG8_STAGE(PG8_SA(0, 1), cA + hstep, voffA);
        if (wr == 1) PG8_BAR;
        PG8_WAIT_V(4); PG8_BAR;
        PG8_STAGE(PG8_SB(1, 0), cB + kstep, voffB); PG8_STAGE(PG8_SA(1, 0), cA + kstep, voffA); PG8_STAGE(PG8_SB(1, 1), cB + hstep + kstep, voffB);
        PG8_WAIT_V(6); PG8_BAR;
    }
    for (;;) {
        const bool has_next = S.next(ui + 1, nxt);
        const char* nA = has_next ? (const char*)g.A + (size_t)nxt.pm * tstep : cA; const char* nB = has_next ? (const char*)g.Bt + (size_t)nxt.pn * tstep : cB;
        for (int t = 0; t < nt; t += 2) {
            const bool last = (t == nt - 2);
            const char* a1 = cA + (size_t)(t + 1) * kstep;
            const char* a2 = last ? nA : cA + (size_t)(t + 2) * kstep; const char* b2 = last ? nB : cB + (size_t)(t + 2) * kstep;
            const char* a3 = a2 + kstep; const char* b3 = b2 + kstep;
            if (last && has_next) S.a_ready(nxt);
            if constexpr (SP2) {
            PG8_LDB(B0, 0, 0); PG8_LDB(B1, 0, 1); PG8_SCHED; PG8_LDA(At, 0, 0); PG8_STAGE(PG8_SA(1, 1), a1 + hstep, voffA);
            PG8_WAIT_V(8); PG8_WAIT_L(0); PG8_BAR; PG8_MMA(0, 0, At, B0); PG8_MMA(0, 1, At, B1); PG8_BAR; PG8_SCHED;
            PG8_LDA(At, 0, 1); PG8_STAGE(PG8_SB(0, 0), b2, voffB); PG8_STAGE(PG8_SB(0, 1), b2 + hstep, voffB); PG8_STAGE(PG8_SA(0, 0), a2, voffA);
            PG8_WAIT_V(8); PG8_WAIT_L(0); PG8_BAR; PG8_MMA(1, 0, At, B0); PG8_MMA(1, 1, At, B1); PG8_BAR; PG8_SCHED;
            PG8_LDB(B0, 1, 0); PG8_LDB(B1, 1, 1); PG8_SCHED; PG8_LDA(At, 1, 0); PG8_STAGE(PG8_SA(0, 1), a2 + hstep, voffA);
            PG8_WAIT_V(8); PG8_WAIT_L(0); PG8_BAR; PG8_MMA(0, 0, At, B0); PG8_MMA(0, 1, At, B1); PG8_BAR; PG8_SCHED;
            PG8_LDA(At, 1, 1); PG8_STAGE(PG8_SB(1, 0), b3, voffB); PG8_STAGE(PG8_SB(1, 1), b3 + hstep, voffB); PG8_STAGE(PG8_SA(1, 0), a3, voffA);
            PG8_WAIT_V(8); PG8_WAIT_L(0); PG8_BAR; PG8_MMA(1, 0, At, B0); PG8_MMA(1, 1, At, B1); PG8_BAR; PG8_SCHED;
            } else {
            PG8_LDB(B0, 0, 0); PG8_SCHED; PG8_LDA(At, 0, 0); PG8_STAGE(PG8_SA(1, 1), a1 + hstep, voffA);
            PG8_WAIT_L(8); PG8_BAR; PG8_WAIT_L(0); PG8_MMA(0, 0, At, B0); PG8_BAR; PG8_SCHED;
            PG8_LDB(B1, 0, 1); PG8_STAGE(PG8_SB(0, 0), b2, voffB);
            PG8_BAR; PG8_WAIT_L(0); PG8_MMA(0, 1, At, B1); PG8_BAR;
            PG8_LDA(At, 0, 1); PG8_STAGE(PG8_SA(0, 0), a2, voffA);
            PG8_BAR; PG8_WAIT_L(0); PG8_MMA(1, 0, At, B0); PG8_BAR; PG8_SCHED;
            PG8_STAGE(PG8_SB(0, 1), b2 + hstep, voffB);
            PG8_WAIT_V(6); PG8_BAR; PG8_MMA(1, 1, At, B1); PG8_BAR;
            PG8_LDB(B0, 1, 0); PG8_SCHED; PG8_LDA(At, 1, 0); PG8_STAGE(PG8_SA(0, 1), a2 + hstep, voffA);
            PG8_WAIT_L(8); PG8_BAR; PG8_WAIT_L(0); PG8_MMA(0, 0, At, B0); PG8_BAR; PG8_SCHED;
            PG8_LDB(B1, 1, 1); PG8_STAGE(PG8_SB(1, 0), b3, voffB);
            PG8_BAR; PG8_WAIT_L(0); PG8_MMA(0, 1, At, B1); PG8_BAR;
            PG8_LDA(At, 1, 1); PG8_STAGE(PG8_SA(1, 0), a3, voffA);
            PG8_BAR; PG8_WAIT_L(0); PG8_MMA(1, 0, At, B0); PG8_BAR; PG8_SCHED;
            PG8_STAGE(PG8_SB(1, 1), b3 + hstep, voffB);
            PG8_WAIT_V(6); PG8_BAR; PG8_MMA(1, 1, At, B1); PG8_BAR;
            }
        }
        if constexpr (ALIGN_EPI) { if (wr == 0) PG8_BAR; }
        if constexpr (!Epi::AFTER_DRAIN) { E(acc, cur, wr, wc, fr, fq); S.done(cur); }
        if (!has_next) break;
#pragma unroll
        for (int a = 0; a < 2; ++a)
#pragma unroll
            for (int b = 0; b < 2; ++b)
#pragma unroll
                for (int m = 0; m < 4; ++m)
#pragma unroll
                    for (int n = 0; n < 2; ++n) acc[a][b][m][n] = (f32x4){0.f, 0.f, 0.f, 0.f};
        cur = nxt; cA = nA; cB = nB; ++ui;
        if constexpr (ALIGN_EPI) { if (wr == 1) PG8_BAR; }
    }
    PG8_WAIT_V(0);
    if constexpr (!ALIGN_EPI) { if (wr == 0) PG8_BAR; }
    PG8_BAR;
    if constexpr (Epi::AFTER_DRAIN) { E.fused(acc, cur, wr, wc, fr, fq, lds, wid, lane); S.done(cur); }
#undef PG8_SA
#undef PG8_SB
#undef PG8_STAGE
#undef PG8_LDA
#undef PG8_LDB
#undef PG8_MMA
#undef PG8_WAIT_V
#undef PG8_WAIT_L
#undef PG8_BAR
#undef PG8_SCHED
}
}
namespace pg8 {
__device__ __forceinline__ int erow(int ai, int m, int wr, int fr) { return ai * HALF + wr * 64 + m * 16 + fr; }
template <bool PERM> __device__ __forceinline__ int ecol(int bj, int n, int wc, int fq) { return PERM ? (bj * HALF + wc * 32 + 8 * fq + 4 * n) : (bj * HALF + wc * 32 + 16 * n + 4 * fq); }
typedef unsigned u32x2e __attribute__((ext_vector_type(2)));
__device__ __forceinline__ u32x2e pack4(f32x4 v) { u32x2e w; w.x = cvt_pk_bf16(v[0], v[1]); w.y = cvt_pk_bf16(v[2], v[3]); return w; }
__device__ __forceinline__ float sigm(float x) { return 1.0f - __builtin_amdgcn_rcpf(1.0f + __expf(x)); }
__device__ __forceinline__ float tanh_(float x) { return 1.0f - 2.0f * __builtin_amdgcn_rcpf(1.0f + __expf(2.0f * x)); }

struct RecInDst { bf16_t* QM; size_t off_km, off_vm, off_om; bf16_t *RAWb, *TWAD, *SGD; float* GATES; };
__device__ __forceinline__ void recin_store4(const RecInDst& d, size_t row, int pn, int c, f32x4 v) {
    if (pn < 8) {
        const size_t off = (pn < 2) ? 0 : (pn < 4 ? d.off_km : (pn < 6 ? d.off_vm : d.off_om));
        if (pn == 2 || pn == 3) v = v * 0.08838834764831845f;
        *(u32x2e*)(d.QM + off + row * 512 + (pn & 1) * 256 + c) = pack4(v);
    } else if (pn < 14) {
        *(u32x2e*)(d.RAWb + row * 1536 + (pn - 8) * 256 + c) = pack4(v);
    } else if (pn == 14) {
        if (c < 128) { v[0] = tanh_(v[0]); v[1] = tanh_(v[1]); v[2] = tanh_(v[2]); v[3] = tanh_(v[3]); }
        *(u32x2e*)(d.TWAD + row * 256 + c) = pack4(v);
    } else {
        if (c < 128) { v[0] = sigm(v[0]); v[1] = sigm(v[1]); v[2] = sigm(v[2]); v[3] = sigm(v[3]); *(u32x2e*)(d.SGD + row * 128 + c) = pack4(v); }
        else if (c < 144) { *(f32x4*)(d.GATES + row * 16 + (c - 128)) = v; }
    }
}
__device__ __forceinline__ void recin_store1(const RecInDst& d, size_t row, int col, float v) {
    const int pn = col >> 8, c = col & 255;
    if (pn < 8) {
        const size_t off = (pn < 2) ? 0 : (pn < 4 ? d.off_km : (pn < 6 ? d.off_vm : d.off_om));
        if (pn == 2 || pn == 3) v *= 0.08838834764831845f;
        d.QM[off + row * 512 + (pn & 1) * 256 + c] = (bf16_t)(cvt_pk_bf16(v, 0.f) & 0xffffu);
    } else if (pn < 14) d.RAWb[row * 1536 + (pn - 8) * 256 + c] = (bf16_t)(cvt_pk_bf16(v, 0.f) & 0xffffu);
    else if (pn == 14) d.TWAD[row * 256 + c] = (bf16_t)(cvt_pk_bf16(c < 128 ? tanh_(v) : v, 0.f) & 0xffffu);
    else if (c < 128) d.SGD[row * 128 + c] = (bf16_t)(cvt_pk_bf16(sigm(v), 0.f) & 0xffffu);
    else if (c < 144) d.GATES[row * 16 + (c - 128)] = v;
}
struct EpiRecIn {
    static constexpr bool PERM = false, AFTER_DRAIN = false;
    RecInDst d;
    __device__ __forceinline__ void operator()(const f32x4 (&acc)[2][2][4][2], const Unit& u, int wr, int wc, int fr, int fq) const {
        const int pn = u.pn;
#pragma unroll
        for (int ai = 0; ai < 2; ++ai)
#pragma unroll
            for (int m = 0; m < 4; ++m) {
                const size_t row = (size_t)u.pm * BM + erow(ai, m, wr, fr);
#pragma unroll
                for (int bj = 0; bj < 2; ++bj)
#pragma unroll
                    for (int n = 0; n < 2; ++n) recin_store4(d, row, pn, ecol<false>(bj, n, wc, fq), acc[ai][bj][m][n]);
            }
    }
};
template <int ldc> struct EpiStoreBf16 {
    static constexpr bool PERM = true, AFTER_DRAIN = false;
    bf16_t* O; int scale_pm; float scale;
    __device__ __forceinline__ void operator()(const f32x4 (&acc)[2][2][4][2], const Unit& u, int wr, int wc, int fr, int fq) const {
        const float sc = (u.pm < scale_pm) ? scale : 1.0f;
#pragma unroll
        for (int ai = 0; ai < 2; ++ai)
#pragma unroll
            for (int m = 0; m < 4; ++m) {
                bf16_t* rowp = O + ((size_t)u.pm * BM + erow(ai, m, wr, fr)) * ldc + (size_t)u.pn * BM;
#pragma unroll
                for (int bj = 0; bj < 2; ++bj) {
                    const f32x4 v0 = acc[ai][bj][m][0] * sc, v1 = acc[ai][bj][m][1] * sc;
                    u32x4 w; w.x = cvt_pk_bf16(v0[0], v0[1]); w.y = cvt_pk_bf16(v0[2], v0[3]); w.z = cvt_pk_bf16(v1[0], v1[1]); w.w = cvt_pk_bf16(v1[2], v1[3]);
                    *(u32x4*)(rowp + ecol<true>(bj, 0, wc, fq)) = w;
                }
            }
    }
};
template <int ldc> struct EpiSqRelu {
    static constexpr bool PERM = true, AFTER_DRAIN = false;
    bf16_t* O;
    __device__ __forceinline__ void operator()(const f32x4 (&acc)[2][2][4][2], const Unit& u, int wr, int wc, int fr, int fq) const {
#pragma unroll
        for (int ai = 0; ai < 2; ++ai)
#pragma unroll
            for (int m = 0; m < 4; ++m) {
                bf16_t* rowp = O + ((size_t)u.pm * BM + erow(ai, m, wr, fr)) * ldc + (size_t)u.pn * BM;
#pragma unroll
                for (int bj = 0; bj < 2; ++bj) {
                    f32x4 v0 = acc[ai][bj][m][0], v1 = acc[ai][bj][m][1];
#pragma unroll
                    for (int e = 0; e < 4; ++e) { const float a = fmaxf(v0[e], 0.f), b = fmaxf(v1[e], 0.f); v0[e] = a * a; v1[e] = b * b; }
                    u32x4 w; w.x = cvt_pk_bf16(v0[0], v0[1]); w.y = cvt_pk_bf16(v0[2], v0[3]); w.z = cvt_pk_bf16(v1[0], v1[1]); w.w = cvt_pk_bf16(v1[2], v1[3]);
                    *(u32x4*)(rowp + ecol<true>(bj, 0, wc, fq)) = w;
                }
            }
    }
};
struct EpiResid {
    static constexpr bool PERM = false, AFTER_DRAIN = false;
    const float* src_lat; const float* src_ctx; float* dst_lat; float* dst_ctx; const float* gate;
    __device__ __forceinline__ void operator()(const f32x4 (&acc)[2][2][4][2], const Unit& u, int wr, int wc, int fr, int fq) const {
        const int row0 = u.pm * BM; const bool isctx = row0 >= 16384;
        const float* s = isctx ? src_ctx + (size_t)(row0 - 16384) * 1024 : src_lat + (size_t)row0 * 1024;
        float* d = isctx ? dst_ctx + (size_t)(row0 - 16384) * 1024 : dst_lat + (size_t)row0 * 1024;
        const float* g = gate + (isctx ? 2 : (row0 >> 13)) * 6144 + u.pn * BM;
        f32x4 gv[2][2];
#pragma unroll
        for (int bj = 0; bj < 2; ++bj)
#pragma unroll
            for (int n = 0; n < 2; ++n) gv[bj][n] = *(const f32x4*)(g + ecol<false>(bj, n, wc, fq));
        constexpr int RB = 2;
#pragma unroll
        for (int ai = 0; ai < 2; ++ai)
#pragma unroll
            for (int m0 = 0; m0 < 4; m0 += RB) {
                f32x4 x[RB][2][2];
#pragma unroll
                for (int mm = 0; mm < RB; ++mm) { const size_t off = (size_t)erow(ai, m0 + mm, wr, fr) * 1024 + (size_t)u.pn * BM;
#pragma unroll
                    for (int bj = 0; bj < 2; ++bj)
#pragma unroll
                        for (int n = 0; n < 2; ++n) x[mm][bj][n] = *(const f32x4*)(s + off + ecol<false>(bj, n, wc, fq)); }
#pragma unroll
                for (int mm = 0; mm < RB; ++mm) { const size_t off = (size_t)erow(ai, m0 + mm, wr, fr) * 1024 + (size_t)u.pn * BM;
#pragma unroll
                    for (int bj = 0; bj < 2; ++bj)
#pragma unroll
                        for (int n = 0; n < 2; ++n) *(f32x4*)(d + off + ecol<false>(bj, n, wc, fq)) = x[mm][bj][n] + gv[bj][n] * acc[ai][bj][m0 + mm][n]; }
            }
    }
};
struct EpiResidN {
    static constexpr bool PERM = false, AFTER_DRAIN = false;
    const float* src; float* dst; const float* gate;
    const float* ng; const float* nsc;
    bf16_t* XN; float* SS;
    __device__ __forceinline__ void operator()(const f32x4 (&acc)[2][2][4][2], const Unit& u, int wr, int wc, int fr_, int fq_) const {
        int lz = 0; asm volatile("" : "+v"(lz));
        const int fr = fr_ + lz, fq = fq_ + lz;
        const int row0 = u.pm * BM, vec = row0 >> 13;
        const float* s = src + (size_t)row0 * 1024 + (size_t)u.pn * BM; float* d = dst + (size_t)row0 * 1024 + (size_t)u.pn * BM; bf16_t* xn = XN + (size_t)row0 * 1024 + (size_t)u.pn * BM;
        const float* g = gate + vec * 6144 + u.pn * BM; const float* gn = ng + u.pn * BM; const float* sn = nsc + vec * 6144 + u.pn * BM;
        f32x4 gv[2][2];
#pragma unroll
        for (int bj = 0; bj < 2; ++bj)
#pragma unroll
            for (int n = 0; n < 2; ++n) gv[bj][n] = *(const f32x4*)(g + ecol<false>(bj, n, wc, fq));
#pragma unroll
        for (int ai = 0; ai < 2; ++ai)
#pragma unroll
            for (int m = 0; m < 4; ++m) {
                const int r = erow(ai, m, wr, fr); const size_t off = (size_t)r * 1024; float q = 0.f;
#pragma unroll
                for (int bj = 0; bj < 2; ++bj)
#pragma unroll
                    for (int n = 0; n < 2; ++n) { const int c = ecol<false>(bj, n, wc, fq); const f32x4 x = *(const f32x4*)(s + off + c) + gv[bj][n] * acc[ai][bj][m][n];
                        *(f32x4*)(d + off + c) = x; const f32x4 gs = *(const f32x4*)(gn + c) * (*(const f32x4*)(sn + c) + 1.0f); *(u32x2e*)(xn + off + c) = pack4(x * gs); q += (x[0] * x[0] + x[1] * x[1]) + (x[2] * x[2] + x[3] * x[3]); }
                q += __shfl_xor(q, 16); q += __shfl_xor(q, 32);
                if (fq == 0) SS[(size_t)(row0 + r) * 16 + u.pn * 4 + wc] = q;
            }
    }
};
__device__ __forceinline__ float row_rs(const float* SS, size_t row, int fq) {
    const f32x4 p = *(const f32x4*)(SS + row * 16 + 4 * fq); float t = (p[0] + p[1]) + (p[2] + p[3]);
    t += __shfl_xor(t, 16); t += __shfl_xor(t, 32);
    return 1.0f / sqrtf(t * (1.0f / 1024.0f) + 1e-6f);
}
template <int ldc> struct EpiSqReluN {
    static constexpr bool PERM = true, AFTER_DRAIN = false;
    bf16_t* O; const float* SS; const float* bias;
    __device__ __forceinline__ void operator()(const f32x4 (&acc)[2][2][4][2], const Unit& u, int wr, int wc, int fr, int fq) const {
        const float* bp = bias + ((u.pm * BM) >> 13) * 4096 + u.pn * BM;
#pragma unroll
        for (int ai = 0; ai < 2; ++ai)
#pragma unroll
            for (int m = 0; m < 4; ++m) {
                const size_t row = (size_t)u.pm * BM + erow(ai, m, wr, fr); const float rs = row_rs(SS, row, fq);
                bf16_t* rowp = O + row * ldc + (size_t)u.pn * BM;
#pragma unroll
                for (int bj = 0; bj < 2; ++bj) { const int c = ecol<true>(bj, 0, wc, fq);
                    f32x4 v0 = acc[ai][bj][m][0] * rs + *(const f32x4*)(bp + c), v1 = acc[ai][bj][m][1] * rs + *(const f32x4*)(bp + c + 4);
#pragma unroll
                    for (int e_ = 0; e_ < 4; ++e_) { const float a = fmaxf(v0[e_], 0.f), b = fmaxf(v1[e_], 0.f); v0[e_] = a * a; v1[e_] = b * b; }
                    u32x4 w; w.x = cvt_pk_bf16(v0[0], v0[1]); w.y = cvt_pk_bf16(v0[2], v0[3]); w.z = cvt_pk_bf16(v1[0], v1[1]); w.w = cvt_pk_bf16(v1[2], v1[3]);
                    *(u32x4*)(rowp + c) = w; }
            }
    }
};
template <int ldc> struct EpiStoreF32N {
    static constexpr bool PERM = false, AFTER_DRAIN = false;
    float* O; const float* SS; const float* bias;
    __device__ __forceinline__ void operator()(const f32x4 (&acc)[2][2][4][2], const Unit& u, int wr, int wc, int fr, int fq) const {
        const float* bp = bias + ((u.pm * BM) >> 13) * 4096 + u.pn * BM;
#pragma unroll
        for (int ai = 0; ai < 2; ++ai)
#pragma unroll
            for (int m = 0; m < 4; ++m) {
                const size_t row = (size_t)u.pm * BM + erow(ai, m, wr, fr); const float rs = row_rs(SS, row, fq);
                float* rowp = O + row * ldc + (size_t)u.pn * BM;
#pragma unroll
                for (int bj = 0; bj < 2; ++bj)
#pragma unroll
                    for (int n = 0; n < 2; ++n) { const int c = ecol<false>(bj, n, wc, fq); *(f32x4*)(rowp + c) = acc[ai][bj][m][n] * rs + *(const f32x4*)(bp + c); }
            }
    }
};
template <int ldc> struct EpiStoreF32 {
    static constexpr bool PERM = false, AFTER_DRAIN = false;
    float* O;
    __device__ __forceinline__ void operator()(const f32x4 (&acc)[2][2][4][2], const Unit& u, int wr, int wc, int fr, int fq) const {
#pragma unroll
        for (int ai = 0; ai < 2; ++ai)
#pragma unroll
            for (int m = 0; m < 4; ++m) {
                float* rowp = O + ((size_t)u.pm * BM + erow(ai, m, wr, fr)) * ldc + (size_t)u.pn * BM;
#pragma unroll
                for (int bj = 0; bj < 2; ++bj)
#pragma unroll
                    for (int n = 0; n < 2; ++n) *(f32x4*)(rowp + ecol<false>(bj, n, wc, fq)) = acc[ai][bj][m][n];
            }
    }
};
}
#include <hip/hip_bf16.h>
#include <cmath>
namespace attn_body {
using bf16=__hip_bfloat16;
using bf16x8=__attribute__((ext_vector_type(8)))short;
using s16x4=__attribute__((ext_vector_type(4)))short;
using f32x16=__attribute__((ext_vector_type(16)))float;
using u32x4=__attribute__((ext_vector_type(4)))unsigned;
constexpr int BATCH=2,NHEAD=16,SEQ=8192,CTXL=256,KVP=64,D=64,DM=NHEAD*D;
constexpr int NW=8,QBLK=32,QB=QBLK*NW,KVBLK=64,NQB=SEQ/QB;
constexpr int ATTN_PITCH=DM, ATTN_UNIT_ROWS=QB;
__device__ __forceinline__ int crow(int r,int hi){return (r&3)+8*(r>>2)+4*hi;}
#define SBAR() __builtin_amdgcn_sched_barrier(0)
__device__ __forceinline__ void cmask(f32x16&p0,f32x16&p1,int jb,int qrel,int hi){
  const float NEG=-INFINITY; int kb=64*jb+4*hi;
  #pragma unroll
  for(int r=0;r<16;++r){int kv=kb+(r&3)+8*(r>>2); if(kv>qrel)p0[r]=NEG; if(kv+32>qrel)p1[r]=NEG;}
}

__device__ __forceinline__ void wmask(f32x16&p0,f32x16&p1,int dbase,int hi){
  const float NEG=-INFINITY; const int kb=dbase+4*hi;
  #pragma unroll
  for(int r=0;r<16;++r){int d=kb+(r&3)+8*(r>>2); if(d>128||d<-128)p0[r]=NEG; if(d+32>128||d+32<-128)p1[r]=NEG;}
}
constexpr int NSLOT=3, SLOTB=8192;
constexpr int LDS_K=0, LDS_V=NSLOT*SLOTB, LDS_WS=2*NSLOT*SLOTB, LDS_OST=LDS_WS+NW*64*4, LDS_BYTES=LDS_OST+NW*4096;
constexpr float C2=0.125f*1.4426950408889634f;
__device__ __forceinline__ void glds16(const void*gsrc,unsigned lds_dst){unsigned keep;
  asm volatile("s_mov_b32 %0, m0\n\ts_mov_b32 m0, %2\n\ts_nop 0\n\tglobal_load_lds_dwordx4 %1, off\n\ts_mov_b32 m0, %0":"=&s"(keep):"v"(gsrc),"s"(lds_dst):"memory");}
__device__ __forceinline__ float max3f(float a,float b,float c){float r;asm("v_max3_f32 %0, %1, %2, %3":"=v"(r):"v"(a),"v"(b),"v"(c));return r;}
__device__ __forceinline__ float max2f(float a,float b){float r;asm("v_max_f32_e32 %0, %1, %2":"=v"(r):"v"(a),"v"(b));return r;}
__device__ __forceinline__ float fadd_s(float a,float b){float r;asm("v_add_f32_e32 %0, %1, %2":"=v"(r):"v"(a),"v"(b));return r;}
__device__ __forceinline__ float fsub_s(float a,float b){float r;asm("v_sub_f32_e32 %0, %1, %2":"=v"(r):"v"(a),"v"(b));return r;}
typedef float f32x2_t __attribute__((ext_vector_type(2))); typedef __bf16 bf16x2_t __attribute__((ext_vector_type(2)));
__device__ __forceinline__ unsigned cvtpk_s(float lo,float hi){f32x2_t v={lo,hi};bf16x2_t b=__builtin_convertvector(v,bf16x2_t);return __builtin_bit_cast(unsigned,b);}
#define WAIT_BAR(N) asm volatile("s_waitcnt vmcnt(" #N ") lgkmcnt(0)\n\ts_barrier":::"memory")

__device__ __forceinline__ void qkt(f32x16&p0,f32x16&p1,const char*Kslot,const bf16x8*qr,const f32x16&negm,int r32,int hi){
  const char*kb=Kslot+hi*1024+r32*16;
  #pragma unroll
  for(int d0=0;d0<4;++d0){
    const bf16x8 b0=*reinterpret_cast<const bf16x8*>(kb+d0*2048);
    const bf16x8 b1=*reinterpret_cast<const bf16x8*>(kb+d0*2048+512);
    if(d0==0){p0=__builtin_amdgcn_mfma_f32_32x32x16_bf16(b0,qr[0],negm,0,0,0);p1=__builtin_amdgcn_mfma_f32_32x32x16_bf16(b1,qr[0],negm,0,0,0);}
    else{p0=__builtin_amdgcn_mfma_f32_32x32x16_bf16(b0,qr[d0],p0,0,0,0);p1=__builtin_amdgcn_mfma_f32_32x32x16_bf16(b1,qr[d0],p1,0,0,0);}}
}
typedef __attribute__((address_space(3))) const char* lds_cptr;
typedef short v4i16_t __attribute__((ext_vector_type(4)));
__device__ __forceinline__ void kload8(bf16x8*kf,lds_cptr kp){
  kf[0]=*(const __attribute__((address_space(3))) bf16x8*)(kp);      kf[1]=*(const __attribute__((address_space(3))) bf16x8*)(kp+512);
  kf[2]=*(const __attribute__((address_space(3))) bf16x8*)(kp+2048); kf[3]=*(const __attribute__((address_space(3))) bf16x8*)(kp+2560);
  kf[4]=*(const __attribute__((address_space(3))) bf16x8*)(kp+4096); kf[5]=*(const __attribute__((address_space(3))) bf16x8*)(kp+4608);
  kf[6]=*(const __attribute__((address_space(3))) bf16x8*)(kp+6144); kf[7]=*(const __attribute__((address_space(3))) bf16x8*)(kp+6656);
}
__device__ __forceinline__ void kload2(bf16x8*kf,lds_cptr kp,int j){ kf[2*j]=*(const __attribute__((address_space(3))) bf16x8*)(kp+j*2048); kf[2*j+1]=*(const __attribute__((address_space(3))) bf16x8*)(kp+j*2048+512); }
__device__ __forceinline__ s16x4 vtr(lds_cptr p){ return __builtin_bit_cast(s16x4,__builtin_amdgcn_ds_read_tr16_b64_v4i16((__attribute__((address_space(3))) v4i16_t*)p)); }
__device__ __forceinline__ float rowmax(const f32x16&p0,const f32x16&p1){
  float a=max3f(p0[0],p0[1],p1[0]),b=max3f(p0[2],p0[3],p1[1]);a=max3f(a,p1[2],p1[3]);
  #pragma unroll
  for(int r=4;r<16;r+=4){a=max3f(a,p0[r],p0[r+1]);b=max3f(b,p0[r+2],p0[r+3]);a=max3f(a,p1[r],p1[r+1]);b=max3f(b,p1[r+2],p1[r+3]);}
  const float m=max2f(a,b);
  auto rr=__builtin_amdgcn_permlane32_swap(__float_as_uint(m),__float_as_uint(m),false,false);
  return max2f(__uint_as_float(rr[0]),__uint_as_float(rr[1]));
}
__device__ __forceinline__ void pv(f32x16*o,int vb,bf16x8 pa0,bf16x8 pa1,bf16x8 pa2,bf16x8 pa3){
  #pragma unroll
  for(int d0=0;d0<2;++d0){s16x4 lo[4],hi[4];
    #pragma unroll
    for(int ks=0;ks<4;++ks){
      asm volatile("ds_read_b64_tr_b16 %0,%1 offset:%c2":"=&v"(lo[ks]):"v"(vb),"i"(d0*4096+ks*1024):"memory");
      asm volatile("ds_read_b64_tr_b16 %0,%1 offset:%c2":"=&v"(hi[ks]):"v"(vb),"i"(d0*4096+ks*1024+512):"memory");}
    asm volatile("s_waitcnt lgkmcnt(0)":::"memory");SBAR();
    #define PK(k) (bf16x8){lo[k][0],lo[k][1],lo[k][2],lo[k][3],hi[k][0],hi[k][1],hi[k][2],hi[k][3]}
    o[d0]=__builtin_amdgcn_mfma_f32_32x32x16_bf16(pa0,PK(0),o[d0],0,0,0);
    o[d0]=__builtin_amdgcn_mfma_f32_32x32x16_bf16(pa1,PK(1),o[d0],0,0,0);
    o[d0]=__builtin_amdgcn_mfma_f32_32x32x16_bf16(pa2,PK(2),o[d0],0,0,0);
    o[d0]=__builtin_amdgcn_mfma_f32_32x32x16_bf16(pa3,PK(3),o[d0],0,0,0);
    #undef PK
  }
}

#ifndef ATTN_STORE16
#define ATTN_STORE16(p,v) (*(u32x4*)(p)=(v))
#endif
template<int THRL,int MODE> __device__ __forceinline__ void attn_unit(int b,int h,int qb,const bf16*Q,const bf16*__restrict__ Kh,const bf16*__restrict__ Vh,bf16*O,char*shm,float sink_l2){
  const int tid=threadIdx.x,lane=tid&63,r32=lane&31,hi=lane>>5; const int wid=__builtin_amdgcn_readfirstlane(tid>>6);
  const long rowbase=(long)b*SEQ; const int q0=qb*QB;
  const bf16*Qw=Q+(rowbase+q0+wid*QBLK)*DM+h*D;
  const int wlo=(MODE==1)?(q0>=128?q0-128:0):0, whi=(MODE==1)?((q0+QB+128<=SEQ)?q0+QB+128:SEQ):0;
  #define TROW(t) ((MODE==1)?(((t)<4)?(SEQ+64*(t)):(wlo+64*((t)-4))):(64*(t)))
  const unsigned lds0=(unsigned)(uintptr_t)shm;
  float*wsf=(float*)(shm+LDS_WS)+wid*64;
  const bf16*ksrc=Kh+(long)lane*KVP+wid*8;
  const bf16*vsrc=Vh+(long)(16*(wid&3)+(lane>>2))*KVP+(wid>>2)*32+(lane&3)*8;
  const unsigned kdst=lds0+LDS_K+wid*1024, vdst=lds0+LDS_V+wid*1024;
  #define DMA_K(t,slot) glds16(ksrc+(long)TROW(t)*KVP,(unsigned)__builtin_amdgcn_readfirstlane(kdst+(slot)))
  #define DMA_V(t,slot) glds16(vsrc+(long)TROW(t)*KVP,(unsigned)__builtin_amdgcn_readfirstlane(vdst+(slot)))
  const int vb0=(int)(lds0+LDS_V)+((lane>>4)&1)*32+(lane&3)*8+(4*hi+((lane&15)>>2))*64;
  const char*Kbase=shm+LDS_K; bf16x8 kf[8];
  const lds_cptr shm3=(lds_cptr)shm; const lds_cptr kp0=shm3+LDS_K+hi*1024+r32*16; const lds_cptr vp0=shm3+LDS_V+((lane>>4)&1)*32+(lane&3)*8+(4*hi+((lane&15)>>2))*64;
  const int NT=(MODE==1)?(4+(whi-wlo)/KVBLK):((SEQ+CTXL)/KVBLK);
  DMA_K(0,0);DMA_V(0,0);DMA_K(1,SLOTB);
  bf16x8 qr[4];
  #pragma unroll
  for(int d0=0;d0<4;++d0)qr[d0]=*reinterpret_cast<const bf16x8*>(&Qw[(long)r32*DM+d0*16+hi*8]);
  float mhat=0.f,l_reg=0.f;f32x16 o[2];o[0]=f32x16{};o[1]=f32x16{};f32x16 negm=f32x16{};asm volatile("":"+v"(negm));
  const int qrel=wid*QBLK+r32;
  #define CMASK(P0,P1,t) do{ if(MODE==1&&(t)>=4) wmask(P0,P1,TROW(t)-(q0+qrel),hi); }while(0)
  bool resc=false;
  #define START(P0,P1) do{ const float rm=rowmax(P0,P1); resc=false; \
    { const float dl=rm; mhat=fadd_s(mhat,dl); \
      _Pragma("unroll") for(int r=0;r<16;++r){P0[r]=fsub_s(P0[r],dl);P1[r]=fsub_s(P1[r],dl);} \
      _Pragma("unroll") for(int r=0;r<16;++r)negm[r]=-mhat; asm volatile("":"+v"(negm)); } \
    _Pragma("unroll") for(int r=0;r<16;++r)P0[r]=__builtin_amdgcn_exp2f(P0[r]); }while(0)
  #define RESC() do{ if(resc){ asm volatile("s_waitcnt lgkmcnt(0)":::"memory"); \
      _Pragma("unroll") for(int d_=0;d_<2;++d_) _Pragma("unroll") for(int r=0;r<16;++r)o[d_][r]*=wsf[crow(r,hi)]; } }while(0)
  f32x16 pA0,pA1,pB0,pB1;
  int sl_prev=0,sl_cur=0,sl_next=SLOTB;
  #define ROT() do{sl_prev=sl_cur;sl_cur=sl_next;sl_next=(sl_next==(NSLOT-1)*SLOTB)?0:sl_next+SLOTB;}while(0)
  DMA_K(2,2*SLOTB);
  WAIT_BAR(3);
  qkt(pA0,pA1,Kbase,qr,negm,r32,hi);asm volatile("s_nop 15\n\ts_nop 7":"+v"(pA0),"+v"(pA1));CMASK(pA0,pA1,0);
  START(pA0,pA1);
  _Pragma("unroll") for(int r=0;r<16;++r)pA1[r]=__builtin_amdgcn_exp2f(pA1[r]);
  WAIT_BAR(0);
  DMA_K(3,0);DMA_V(1,SLOTB);
  ROT();
  kload8(kf,kp0+sl_cur);
  WAIT_BAR(2);
  s16x4 vlo[8],vhi[8]; u32x4 pw0,pw1,pw2,pw3;
  #define PKW(P,B) cvtpk_s(P[B],P[B+1])
  #define PAF(k) __builtin_bit_cast(bf16x8,pw##k)
  #define VFR(i) (bf16x8){vlo[i][0],vlo[i][1],vlo[i][2],vlo[i][3],vhi[i][0],vhi[i][1],vhi[i][2],vhi[i][3]}
  #define PIN(x) asm volatile("":"+v"(x))
  #define MX3(a,b,c) __builtin_fmaxf(__builtin_fmaxf((a),(b)),(c))
  #define GAPA(MF,A0,A1,A2,A3,W0,W1,PW) do{ MF; sacc+=A0; sacc+=A1; sacc+=A2; sacc+=A3; PIN(sacc); W0; W1; PIN(PW); SBAR(); }while(0)
  #define EX(v) __builtin_amdgcn_exp2f(v)
  #define GAPB(MF,X,B) do{ MF; X[B]=EX(X[B]); X[B+1]=EX(X[B+1]); X[B+2]=EX(X[B+2]); X[B+3]=EX(X[B+3]); PIN(X); SBAR(); }while(0)
  #define VRD(i) do{ vlo[i]=vtr(vp_+(((i)>>2)*4096+((i)&3)*1024)); vhi[i]=vtr(vp_+(((i)>>2)*4096+((i)&3)*1024+512)); }while(0)
  #define KRD(G,j) do{ if(G){ kload2(kf,kp0+sl_next,j); SBAR(); } }while(0)
  #define STEP(C0,C1,P0,P1,t,GK,GV,GL) do{ SBAR(); \
    const lds_cptr vp_=vp0+sl_prev; \
    VRD(0); SBAR(); float sacc=(P0[0]+P0[1]); \
    GAPA(C0=__builtin_amdgcn_mfma_f32_32x32x16_bf16(kf[0],qr[0],negm,0,0,0), P0[2],P0[3],P0[4],P0[5],     pw0[0]=PKW(P0,0), pw0[1]=PKW(P0,2), pw0); \
    VRD(4); SBAR(); GAPA(C1=__builtin_amdgcn_mfma_f32_32x32x16_bf16(kf[1],qr[0],negm,0,0,0), P0[6],P0[7],P0[8],P0[9],     pw0[2]=PKW(P0,4), pw0[3]=PKW(P0,6), pw0); \
    VRD(1); SBAR(); GAPA(C0=__builtin_amdgcn_mfma_f32_32x32x16_bf16(kf[2],qr[1],C0,0,0,0),   P0[10],P0[11],P0[12],P0[13], pw1[0]=PKW(P0,8), pw1[1]=PKW(P0,10), pw1); \
    VRD(5); SBAR(); GAPA(C1=__builtin_amdgcn_mfma_f32_32x32x16_bf16(kf[3],qr[1],C1,0,0,0),   P0[14],P0[15],P1[0],P1[1],   pw1[2]=PKW(P0,12),pw1[3]=PKW(P0,14), pw1); \
    VRD(2); SBAR(); GAPA(C0=__builtin_amdgcn_mfma_f32_32x32x16_bf16(kf[4],qr[2],C0,0,0,0),   P1[2],P1[3],P1[4],P1[5],     pw2[0]=PKW(P1,0), pw2[1]=PKW(P1,2), pw2); \
    VRD(6); SBAR(); GAPA(C1=__builtin_amdgcn_mfma_f32_32x32x16_bf16(kf[5],qr[2],C1,0,0,0),   P1[6],P1[7],P1[8],P1[9],     pw2[2]=PKW(P1,4), pw2[3]=PKW(P1,6), pw2); \
    VRD(3); SBAR(); GAPA(C0=__builtin_amdgcn_mfma_f32_32x32x16_bf16(kf[6],qr[3],C0,0,0,0),   P1[10],P1[11],P1[12],P1[13], pw3[0]=PKW(P1,8), pw3[1]=PKW(P1,10), pw3); \
    VRD(7); SBAR(); GAPA(C1=__builtin_amdgcn_mfma_f32_32x32x16_bf16(kf[7],qr[3],C1,0,0,0),   P1[14],P1[15],0.f,0.f,       pw3[2]=PKW(P1,12),pw3[3]=PKW(P1,14), pw3); \
    l_reg+=sacc; \
    if(GK){DMA_K((t)+3,sl_cur);} if(GV){DMA_V((t)+1,sl_next);} \
    CMASK(C0,C1,t); \
    { float a=MX3(C0[0],C0[1],C1[0]),b=MX3(C0[2],C0[3],C1[1]); a=MX3(a,C1[2],C1[3]); \
      _Pragma("unroll") for(int r=4;r<16;r+=4){a=MX3(a,C0[r],C0[r+1]);b=MX3(b,C0[r+2],C0[r+3]);a=MX3(a,C1[r],C1[r+1]);b=MX3(b,C1[r+2],C1[r+3]);} \
      float rm=__builtin_fmaxf(a,b); { auto rr=__builtin_amdgcn_permlane32_swap(__float_as_uint(rm),__float_as_uint(rm),false,false); rm=__builtin_fmaxf(__uint_as_float(rr[0]),__uint_as_float(rr[1])); } \
      resc=false; \
      if(__builtin_expect(__any(rm>(float)THRL),0)){ const float dl=__builtin_fmaxf(rm,0.f); mhat+=dl; \
        _Pragma("unroll") for(int r=0;r<16;++r){C0[r]-=dl;C1[r]-=dl;} \
        _Pragma("unroll") for(int r=0;r<16;++r)negm[r]=-mhat; asm volatile("":"+v"(negm)); \
        const float f=__builtin_amdgcn_exp2f(-dl); l_reg*=f; if(hi==0)wsf[r32]=f; resc=true; } } \
    SBAR(); \
    GAPB(o[0]=__builtin_amdgcn_mfma_f32_32x32x16_bf16(PAF(0),VFR(0),o[0],0,0,0), C0,0); \
    GAPB(o[1]=__builtin_amdgcn_mfma_f32_32x32x16_bf16(PAF(0),VFR(4),o[1],0,0,0), C0,4); \
    KRD(GL,0); GAPB(o[0]=__builtin_amdgcn_mfma_f32_32x32x16_bf16(PAF(1),VFR(1),o[0],0,0,0), C0,8); \
    KRD(GL,1); GAPB(o[1]=__builtin_amdgcn_mfma_f32_32x32x16_bf16(PAF(1),VFR(5),o[1],0,0,0), C0,12); \
    KRD(GL,2); GAPB(o[0]=__builtin_amdgcn_mfma_f32_32x32x16_bf16(PAF(2),VFR(2),o[0],0,0,0), C1,0); \
    KRD(GL,3); GAPB(o[1]=__builtin_amdgcn_mfma_f32_32x32x16_bf16(PAF(2),VFR(6),o[1],0,0,0), C1,4); \
    GAPB(o[0]=__builtin_amdgcn_mfma_f32_32x32x16_bf16(PAF(3),VFR(3),o[0],0,0,0), C1,8); \
    GAPB(o[1]=__builtin_amdgcn_mfma_f32_32x32x16_bf16(PAF(3),VFR(7),o[1],0,0,0), C1,12); \
    }while(0)
  int t=1;
  #undef CMASK
  #define CMASK(P0,P1,t) do{ if(MODE==1&&(t)>=4) wmask(P0,P1,TROW(t)-(q0+qrel),hi); }while(0)
  for(;t+5<NT;t+=2){
    STEP(pB0,pB1,pA0,pA1,t,true,true,true);     WAIT_BAR(2); RESC(); ROT();
    STEP(pA0,pA1,pB0,pB1,t+1,true,true,true);   WAIT_BAR(2); RESC(); ROT();
  }
  #undef CMASK
  #define CMASK(P0,P1,t) do{ if(MODE==1&&(t)>=4) wmask(P0,P1,TROW(t)-(q0+qrel),hi); }while(0)
  #define ENDW(tt) do{ if((tt)+3<NT){WAIT_BAR(2);} else if((tt)+2<NT){WAIT_BAR(1);} else {WAIT_BAR(0);} }while(0)
  for(;t+1<NT;t+=2){
    STEP(pB0,pB1,pA0,pA1,t,(t+3<NT),(t+1<NT),(t+1<NT));       ENDW(t);   RESC(); ROT();
    STEP(pA0,pA1,pB0,pB1,t+1,(t+4<NT),(t+2<NT),(t+2<NT));     ENDW(t+1); RESC(); ROT();
  }
  STEP(pB0,pB1,pA0,pA1,NT-1,false,false,false); RESC();
  { float sacc=pB0[0]+pB0[1]; _Pragma("unroll") for(int r=2;r<16;++r)sacc+=pB0[r]; _Pragma("unroll") for(int r=0;r<16;++r)sacc+=pB1[r]; l_reg+=sacc;
    pw0=(u32x4){PKW(pB0,0),PKW(pB0,2),PKW(pB0,4),PKW(pB0,6)};pw1=(u32x4){PKW(pB0,8),PKW(pB0,10),PKW(pB0,12),PKW(pB0,14)};pw2=(u32x4){PKW(pB1,0),PKW(pB1,2),PKW(pB1,4),PKW(pB1,6)};pw3=(u32x4){PKW(pB1,8),PKW(pB1,10),PKW(pB1,12),PKW(pB1,14)};
    SBAR(); pv(o,vb0+sl_cur,PAF(0),PAF(1),PAF(2),PAF(3)); }
  #undef PKW
  #undef PAF
  #undef VFR
  #undef PIN
  #undef MX3
  #undef GAPA
  #undef GAPB
  #undef EX
  #undef VRD
  #undef KRD
  #undef STEP
  #undef ENDW
  {auto rr=__builtin_amdgcn_permlane32_swap(__float_as_uint(l_reg),__float_as_uint(l_reg),false,false);l_reg=__uint_as_float(rr[0])+__uint_as_float(rr[1]);}
  if(MODE==1) l_reg+=__builtin_amdgcn_exp2f(sink_l2-mhat);
  if(hi==0)wsf[32+r32]=l_reg;asm volatile("s_waitcnt lgkmcnt(0)":::"memory");
  float rli[16];
  #pragma unroll
  for(int r=0;r<16;++r)rli[r]=__builtin_amdgcn_rcpf(wsf[32+crow(r,hi)]);
  bf16*Ow=O+(rowbase+q0+wid*QBLK)*DM+h*D;
  { bf16*stg=(bf16*)(shm+LDS_OST)+wid*2048;
    #pragma unroll
    for(int r=0;r<16;++r){const int orow=crow(r,hi);
      #pragma unroll
      for(int d0=0;d0<2;++d0)stg[orow*64+d0*32+r32]=__float2bfloat16(o[d0][r]*rli[r]);}
    asm volatile("s_waitcnt lgkmcnt(0)":::"memory");
    #pragma unroll
    for(int i=0;i<4;++i){const int row=i*8+(lane>>3),ch=lane&7; const u32x4 v=*(const u32x4*)(stg+row*64+ch*8); ATTN_STORE16(Ow+(long)row*DM+ch*8,v);} }
  asm volatile("s_waitcnt lgkmcnt(0)\n\ts_barrier":::"memory");
  #undef DMA_K
  #undef DMA_V
  #undef CMASK
  #undef START
  #undef RESC
  #undef ROT
  #undef TROW
}
constexpr int ATTN_LDS_BYTES=LDS_BYTES;
#undef SBAR
#undef WAIT_BAR
}
#define GAS __attribute__((address_space(1)))
#define LAS __attribute__((address_space(3)))
typedef unsigned short bf16;
typedef unsigned v4u __attribute__((ext_vector_type(4)));
typedef float f32x4 __attribute__((ext_vector_type(4)));
typedef short bf16x8 __attribute__((ext_vector_type(8)));
typedef GAS unsigned gu32;
typedef GAS unsigned long long gu64;
#define RLX_AGENT __ATOMIC_RELAXED, __HIP_MEMORY_SCOPE_AGENT
#define LDS_WAIT() asm volatile("s_waitcnt lgkmcnt(0)" ::: "memory")
#define VM_WAIT() asm volatile("s_waitcnt vmcnt(0)" ::: "memory")
__device__ __forceinline__ unsigned long long rt() { return __builtin_amdgcn_s_memrealtime(); }
typedef float f32x2c_t __attribute__((ext_vector_type(2))); typedef __bf16 bf16x2c_t __attribute__((ext_vector_type(2)));
__device__ __forceinline__ unsigned pk2(float lo, float hi) { f32x2c_t v = {lo, hi}; bf16x2c_t r = __builtin_convertvector(v, bf16x2c_t); return __builtin_bit_cast(unsigned, r); }
__device__ __forceinline__ unsigned f2bf(float f) { return pk2(f, 0.f) & 0xffffu; }

#define XB_TMO      128
#define XB_XCNT(j)  (256  + 64 * (j))
#define XB_XSUB(j)  (1280 + 64 * (j))
#define XB_XGEN(j)  (2304 + 64 * (j))
#define XB_TOP      3328
#define XB_TOPGEN   3392
#define XCD_BAR_WORDS 3456
#define XB_SPIN_CAP (1u << 18)

__device__ __forceinline__ unsigned xb_ld(unsigned* p)              { return __hip_atomic_load(p, __ATOMIC_RELAXED, __HIP_MEMORY_SCOPE_AGENT); }
__device__ __forceinline__ unsigned xb_add(unsigned* p, unsigned v) { return __hip_atomic_fetch_add(p, v, __ATOMIC_RELAXED, __HIP_MEMORY_SCOPE_AGENT); }
__device__ __forceinline__ unsigned xb_xcc_id() { return (unsigned)__builtin_amdgcn_s_getreg((3 << 11) | 20) & 0xFu; }
#define XB_SPIN(cond, bar) do { unsigned _sp = 0; while (cond) { __builtin_amdgcn_s_sleep(1); \
    if ((++_sp & 255u) == 0u) { if (xb_ld(&(bar)[XB_TMO])) break; if (_sp > XB_SPIN_CAP) { atomicAdd(&(bar)[XB_TMO], 1u); break; } } } } while (0)

struct XcdBarrier {
    unsigned* bar; unsigned x;
    volatile LAS unsigned* st;
};

__device__ __forceinline__ XcdBarrier xcd_barrier_post(unsigned* bar, volatile LAS unsigned* st) {
    XcdBarrier b; b.bar = bar; b.x = xb_xcc_id(); b.st = st;
    if (threadIdx.x == 0) (void)xb_add(&bar[XB_XCNT(b.x)], 1u);
    return b;
}
__device__ __forceinline__ void xcd_barrier_complete(unsigned* bar, unsigned x, unsigned& nloc, unsigned& nx) {
    const unsigned G = gridDim.x * gridDim.y * gridDim.z;
    unsigned sum, cnt, mine, sp = 0u;
    for (;;) {
        sum = 0u; cnt = 0u; mine = 0u;
#pragma unroll
        for (unsigned j = 0; j < 16; ++j) { const unsigned c = xb_ld(&bar[XB_XCNT(j)]); sum += c; cnt += (c > 0u) ? 1u : 0u; mine = (j == x) ? c : mine; }
        if (sum == G) break;
        __builtin_amdgcn_s_sleep(1);
        if ((++sp & 255u) == 0u) { if (xb_ld(&bar[XB_TMO])) break; if (sp > XB_SPIN_CAP) { atomicAdd(&bar[XB_TMO], 1u); break; } }
    }
    nloc = mine > 0u ? mine : 1u; nx = cnt > 0u ? cnt : 1u;
}

__device__ __forceinline__ void xcd_barrier(const XcdBarrier& b) {
    asm volatile("s_waitcnt vmcnt(0)" ::: "memory");
    __syncthreads();
    if (threadIdx.x == 0) {
        unsigned* bar = b.bar;
        __builtin_amdgcn_s_waitcnt(0);
        unsigned nloc = b.st[0], nx = b.st[1];
        if (nloc == 0u) { xcd_barrier_complete(bar, b.x, nloc, nx); b.st[0] = nloc; b.st[1] = nx; }
        const unsigned old = xb_add(&bar[XB_XSUB(b.x)], 1u);
        const unsigned gen = old / nloc;
        if (old + 1u == (gen + 1u) * nloc) {
            __builtin_amdgcn_fence(__ATOMIC_RELEASE, "agent");
            asm volatile("s_waitcnt vmcnt(0)" ::: "memory");
            const unsigned og = xb_add(&bar[XB_TOP], 1u);
            const unsigned tg = og / nx;
            if (og + 1u == (tg + 1u) * nx) xb_add(&bar[XB_TOPGEN], 1u);
            else XB_SPIN(xb_ld(&bar[XB_TOPGEN]) == tg, bar);
            __builtin_amdgcn_fence(__ATOMIC_ACQUIRE, "agent");
            xb_add(&bar[XB_XGEN(b.x)], 1u);
            asm volatile("s_waitcnt vmcnt(0)" ::: "memory");
        } else {
            XB_SPIN(xb_ld(&bar[XB_XGEN(b.x)]) == gen, bar);
            __builtin_amdgcn_fence(__ATOMIC_ACQUIRE, "agent");
            asm volatile("s_waitcnt vmcnt(0)" ::: "memory");
        }
    }
    __syncthreads();
}
constexpr int NWAVES = 8, NTHREADS = 512;
constexpr int BATCH = 2, T = 8192, D = 1024, CTXL = 256, FF = 4096;
constexpr int ML_ROWS = BATCH * T;
constexpr int MC_ROWS = BATCH * CTXL;
constexpr int MA_ROWS = ML_ROWS + MC_ROWS;
constexpr int REC_N = 4096;
constexpr int ATT_N = 1536;
constexpr int KV_LEN = T + CTXL;
constexpr int NCHUNK = KV_LEN / 128;
constexpr int NCHAIN_ML = 16;
constexpr int NITEM_ML = NCHAIN_ML * NCHUNK;
constexpr int NCHAIN_RW = 32;
constexpr float NORM_EPS = 1e-6f, GN_EPS = 64e-5f;

constexpr size_t MiB = 1u << 20;
constexpr size_t WS_CTL = 0, CTL_ZERO_BYTES = 1 * MiB;
constexpr size_t WS_MODP = 1 * MiB;
constexpr size_t WS_MOD = 4 * MiB;
constexpr size_t WS_ROPE = WS_MOD + 512 * 1024;
constexpr size_t WS_BIAS = WS_MOD + 640 * 1024;
constexpr size_t WS_SSC = WS_MOD + 800 * 1024;
constexpr size_t WS_SS = 7 * MiB;
constexpr size_t WS_MISC = 5 * MiB;
constexpr size_t WS_WREC = 8 * MiB;
constexpr size_t WS_WATT = 17 * MiB;
constexpr size_t WS_WOUT = 20 * MiB;
constexpr size_t WS_W1 = 24 * MiB;
constexpr size_t WS_W2 = 40 * MiB;
constexpr size_t WS_WG2 = 56 * MiB;
constexpr size_t WS_W2T = WS_WG2 + 128 * 1024;
constexpr size_t WS_XC = 57 * MiB;
constexpr size_t WS_XN = 59 * MiB;
constexpr size_t WS_R = 92 * MiB;
constexpr size_t WS_END = 256 * MiB;
constexpr size_t SZ_A = (size_t)MA_ROWS * 512 * 2;
constexpr size_t R_QM = WS_R, R_KM = R_QM + SZ_A, R_OM = R_KM + SZ_A;
constexpr size_t R_RAW = R_OM + SZ_A;
constexpr size_t R_TWAD = R_RAW + 3 * SZ_A;
constexpr size_t R_SGD = R_TWAD + SZ_A / 2;
constexpr size_t R_GATES = R_SGD + SZ_A / 4;
constexpr size_t R_YRW0 = R_GATES + (size_t)MA_ROWS * 16 * 4;
constexpr size_t R_VM = R_YRW0 + SZ_A;
static_assert(R_VM + 2 * SZ_A <= WS_END, "recurrent map: VM plus the free tail hold the 33 MiB RWKV N buffer");
constexpr size_t R_GATE = R_VM;
constexpr size_t R_MIX = R_QM;
constexpr size_t R_HML = WS_XN;
constexpr size_t DO_CST = 0, DO_YRW1 = 34 * MiB;
static_assert((size_t)NITEM_ML * 16384 * 2 <= DO_YRW1 && DO_YRW1 + SZ_A <= (size_t)ML_ROWS * D * 4, "d_out scratch map");
constexpr size_t R_ATT = WS_R;
constexpr size_t R_QB = R_ATT + (size_t)MA_ROWS * ATT_N * 4;
constexpr size_t SZ_KV = (size_t)BATCH * 2 * KV_LEN * 64 * 2;
constexpr size_t R_KW = R_QB + (size_t)ML_ROWS * D * 2, R_VW = R_KW + SZ_KV, R_KG = R_VW + SZ_KV, R_VG = R_KG + SZ_KV;
static_assert(R_VG + SZ_KV <= WS_END, "attention map");
constexpr size_t R_PART = WS_R + (size_t)MA_ROWS * FF * 2;
constexpr size_t R_H = WS_R;
static_assert(R_H + (size_t)MA_ROWS * FF * 2 + (size_t)4 * MC_ROWS * D * 4 <= WS_END, "ffn map");
constexpr size_t MI_BT = WS_MISC;
constexpr size_t MI_AT = MI_BT + (size_t)8 * MA_ROWS * 4;
constexpr size_t MI_CHS = MI_AT + (size_t)8 * MA_ROWS * 4;
constexpr size_t MI_MCH = MI_CHS + 16 * 66 * 2 * 4;
constexpr size_t MI_DN = MI_MCH + 16 * 66 * 4 + 256;
static_assert(MI_DN + (size_t)NITEM_ML * 128 * 4 <= WS_SS && WS_SS + (size_t)ML_ROWS * 16 * 4 <= WS_WREC && WS_SSC + 512 * 64 * 4 <= WS_MISC && WS_BIAS + 9 * 4096 * 4 <= WS_SSC, "misc map");
constexpr int LDSX_RSC = 153856;

constexpr int CW_TMO = 0, CW_CODE = 1;
constexpr int CW_BAR = 4096;
constexpr int CW_DBG = 65536;

constexpr int RING_OFF = 0, RING_BYTES = 131072;
constexpr int LDSCTL_OFF = RING_BYTES, MISC_OFF = LDSCTL_OFF + 320;
constexpr int LDS_BYTES = 163840;
constexpr int LDSX_OFF = 132096;
struct Frame {
    LAS unsigned char* lds;
    volatile LAS unsigned* MISC;
    gu32* ctl;
    int tid, lane, wave;
    int vcu, G;
    unsigned char* ws; float* out;
};
__device__ __forceinline__ float bf2f(bf16 b) { return __uint_as_float((unsigned)b << 16); }
__device__ __forceinline__ float wave_sum(float v);
__device__ __forceinline__ float wave_max(float v) {
#pragma unroll
    for (int o = 1; o < 64; o <<= 1) v = fmaxf(v, __shfl_xor(v, o));
    return v;
}
template <int CTRL> __device__ __forceinline__ float dpp_mov(float v) { return __builtin_bit_cast(float, __builtin_amdgcn_update_dpp(0, __builtin_bit_cast(int, v), CTRL, 0xF, 0xF, true)); }
__device__ __forceinline__ float sum8(float v) { v += dpp_mov<0xB1>(v); v += dpp_mov<0x4E>(v); v += dpp_mov<0x141>(v); return v; }
__device__ __forceinline__ float sum16(float v) { v = sum8(v); v += dpp_mov<0x140>(v); return v; }
__device__ __forceinline__ float wave_sum(float v) { v = sum16(v); v += __shfl_xor(v, 16); v += __shfl_xor(v, 32); return v; }
__device__ __forceinline__ float sigmoidf_(float x) { return __builtin_amdgcn_rcpf(1.0f + __expf(-x)); }
typedef float f32x2v __attribute__((ext_vector_type(2)));
typedef unsigned u32x2v __attribute__((ext_vector_type(2)));
#define MFMA16(a, b, c) __builtin_amdgcn_mfma_f32_16x16x32_bf16(a, b, c, 0, 0, 0)
template <int P = 72> __device__ __forceinline__ bf16x8 ldsfrag(const LAS bf16* t, int row, int col) { return *(const LAS bf16x8*)(t + row * P + col); }
typedef short v4i16_t __attribute__((ext_vector_type(4)));
template <int P = 72> __device__ __forceinline__ bf16x8 trfrag(const LAS bf16* t, int c0, int k0, int l15, int l4) {
    const LAS bf16* p = t + (k0 + 8 * l4 + (l15 >> 2)) * P + c0 + 4 * (l15 & 3);
    const v4i16_t lo = __builtin_amdgcn_ds_read_tr16_b64_v4i16((LAS v4i16_t*)p), hi = __builtin_amdgcn_ds_read_tr16_b64_v4i16((LAS v4i16_t*)(p + 4 * P));
    return (bf16x8){lo[0], lo[1], lo[2], lo[3], hi[0], hi[1], hi[2], hi[3]};
}
__device__ __forceinline__ bf16x8 gfrag(const bf16* p) { return __builtin_bit_cast(bf16x8, *(const GAS v4u*)p); }
__device__ __forceinline__ u32x2v pk4(f32x4 v) { u32x2v o; o.x = pk2(v[0], v[1]); o.y = pk2(v[2], v[3]); return o; }

enum { I_X = 0, I_C, I_CTX, I_CCTX, I_NORM_MIX, I_NORM_FFN, I_MOD_W, I_MOD_B, I_OUT_W, I_FFN_W1, I_FFN_W2, I_REC_IN_W, I_ML_GATE_B, I_ML_NORM_G, I_RW_CONV,
       I_RW_W0, I_RW_W2, I_RW_A0, I_RW_A2, I_RW_G2, I_RW_KK, I_RW_KA, I_RW_RK, I_RW_NORM_G, I_ATT_IN_W, I_WIN_Q_NORM, I_WIN_K_NORM, I_WIN_SINK, I_GLB_Q_NORM, I_GLB_K_NORM, N_IN };
struct Args { const float* in[N_IN]; float* out; unsigned char* ws; int ph_lo, ph_hi, li, pad; };

template <int MAP> __device__ __forceinline__ int src_col(int n) {
    if (MAP == 0) return n;
    if (n < 2048) return n;
    if (n < 3968) return n + 16;
    if (n < 3984) return n - 1920;
    return -1;
}
template <int MAP> __device__ __forceinline__ void p0_transpose_item(const float* W, int K, int srcN, int dstN, bf16* WT, LAS float* scr, int item, int lane) {
    const int nblk = dstN / 32, kb = item / nblk, nb = item % nblk, k0 = 64 * kb, n0 = 32 * nb;
    const int sc = src_col<MAP>(n0 + (lane & 31));
    float v[32];
#pragma unroll
    for (int i = 0; i < 32; ++i) { const int kk = 2 * i + (lane >> 5); v[i] = (sc >= 0) ? W[(size_t)(k0 + kk) * srcN + sc] : 0.f; }
#pragma unroll
    for (int i = 0; i < 32; ++i) { const int kk = 2 * i + (lane >> 5); scr[kk * 33 + (lane & 31)] = v[i]; }
    LDS_WAIT(); asm volatile("" ::: "memory");
    const int c = lane & 7;
#pragma unroll
    for (int j = 0; j < 4; ++j) { const int n = (lane >> 3) + 8 * j; const LAS float* s = scr + (8 * c) * 33 + n;
        v4u o; o.x = pk2(s[0 * 33], s[1 * 33]); o.y = pk2(s[2 * 33], s[3 * 33]); o.z = pk2(s[4 * 33], s[5 * 33]); o.w = pk2(s[6 * 33], s[7 * 33]);
        *(GAS v4u*)(WT + (size_t)(n0 + n) * K + k0 + 8 * c) = o; }
    LDS_WAIT(); asm volatile("" ::: "memory");
}
template <int PART> struct P0W {
    static constexpr int I_A = PART == 0 ? (D / 64) * (REC_N / 32) : (PART == 1 ? (D / 64) * (ATT_N / 32) : 0);
    static constexpr int I_OUT = (PART == 1 || PART == 4) ? (D / 64) * (D / 32) : 0, I_1 = (PART == 1 || PART == 3) ? (D / 64) * (FF / 32) : 0, I_2 = (PART == 2 || PART == 4) ? (FF / 64) * (D / 32) : 0, I_G2 = PART == 0 ? (128 / 64) * (512 / 32) : 0;
    static constexpr int NITEMS = I_A + I_OUT + I_1 + I_2 + I_G2;
};
template <int PART> __device__ __forceinline__ void p0_weight_item(Frame& F, const Args& A, int r) {
    typedef P0W<PART> P;
    LAS float* scr = (LAS float*)(F.lds + RING_OFF + F.wave * 16384);
    constexpr int l = (PART == 0 || PART >= 3) ? 0 : 1;
    unsigned char* ws = F.ws;
    if (r < P::I_A) { if (PART == 0) p0_transpose_item<1>(A.in[I_REC_IN_W], D, 3984, REC_N, (bf16*)(ws + WS_WREC), scr, r, F.lane); else p0_transpose_item<0>(A.in[I_ATT_IN_W], D, ATT_N, ATT_N, (bf16*)(ws + WS_WATT), scr, r, F.lane); return; } r -= P::I_A;
    if (r < P::I_OUT) { p0_transpose_item<0>(A.in[I_OUT_W] + (size_t)l * D * D, D, D, D, (bf16*)(ws + WS_WOUT) + (size_t)l * D * D, scr, r, F.lane); return; } r -= P::I_OUT;
    if (r < P::I_1) { p0_transpose_item<0>(A.in[I_FFN_W1] + (size_t)l * D * FF, D, FF, FF, (bf16*)(ws + WS_W1) + (size_t)l * D * FF, scr, r, F.lane); return; } r -= P::I_1;
    if (r < P::I_2) { p0_transpose_item<0>(A.in[I_FFN_W2] + (size_t)l * D * FF, FF, D, D, (bf16*)(ws + WS_W2) + (size_t)l * D * FF, scr, r, F.lane); return; } r -= P::I_2;
    if (PART == 0) p0_transpose_item<0>(A.in[I_RW_G2], 128, 512, 512, (bf16*)(ws + WS_WG2), scr, r, F.lane);
}
template <int PART> __device__ __forceinline__ void p0_weights_tail(Frame& F, const Args& A, int ntile, int bid) {
    const int nx = ntile % F.G; __syncthreads();
    int gw, NGW; if (nx == 0) { gw = bid * NWAVES + F.wave; NGW = F.G * NWAVES; } else if (bid >= nx) { gw = (bid - nx) * NWAVES + F.wave; NGW = (F.G - nx) * NWAVES; } else return;
    for (int it = gw; it < P0W<PART>::NITEMS; it += NGW) p0_weight_item<PART>(F, A, it);
}
__device__ __forceinline__ void p0_prologue(Frame& F, const Args& A) {
    const int gw = F.vcu * NWAVES + F.wave, NGW = F.G * NWAVES;
    unsigned char* ws = F.ws;
    constexpr int NGEMV = 2 * 48 * 16;
    float* MODP = (float*)(ws + WS_MODP);
    for (int it = gw; it < NGEMV + P0W<0>::NITEMS; it += NGW) {
        if (it >= NGEMV) { p0_weight_item<0>(F, A, it - NGEMV); continue; }
        const int l = it / (48 * 16), cc = (it / 16) % 48, kc = it % 16, hl = F.lane >> 5, l31 = F.lane & 31;
        float sv[3];
#pragma unroll
        for (int v = 0; v < 3; ++v) { const float cvv = (v < 2) ? A.in[I_C][v * D + kc * 64 + F.lane] : A.in[I_CCTX][kc * 64 + F.lane]; sv[v] = cvv * sigmoidf_(cvv); }
        const float* Wp = A.in[I_MOD_W] + ((size_t)l * D + kc * 64 + hl) * 6144 + cc * 128 + 4 * l31;
        f32x4 a0 = {0, 0, 0, 0}, a1 = a0, a2 = a0;
#pragma unroll 16
        for (int i = 0; i < 32; ++i) { const f32x4 w = *(const f32x4*)(Wp + (size_t)(2 * i) * 6144); const int k = 2 * i + hl; a0 += w * __shfl(sv[0], k); a1 += w * __shfl(sv[1], k); a2 += w * __shfl(sv[2], k); }
#pragma unroll
        for (int e = 0; e < 4; ++e) { a0[e] += __shfl_xor(a0[e], 32); a1[e] += __shfl_xor(a1[e], 32); a2[e] += __shfl_xor(a2[e], 32); }
        if (hl == 0) { float* o = MODP + ((size_t)(l * 16 + kc) * 3) * 6144 + cc * 128 + 4 * l31;
            *(f32x4*)(o) = a0; *(f32x4*)(o + 6144) = a1; *(f32x4*)(o + 2 * 6144) = a2; }
    }
    { bf16* W2T = (bf16*)(ws + WS_W2T);
      for (int e = F.vcu * NTHREADS + F.tid; e < 2 * 2 * 8 * 64 * 64; e += F.G * NTHREADS) {
          const int i = e & 63, ch = (e >> 6) & 63, h = (e >> 12) & 7, d = (e >> 15) & 1, which = e >> 16;
          const float* src = which == 0 ? A.in[I_RW_W2] : A.in[I_RW_A2];
          W2T[e] = (bf16)f2bf(src[(size_t)(d * 64 + i) * 512 + h * 64 + ch]); } }
    { float* ROPE = (float*)(ws + WS_ROPE);
      for (int e = F.vcu * NTHREADS + F.tid; e < 128 * 16; e += F.G * NTHREADS) { const float ang = (float)(e >> 4) * exp2f(-(float)(e & 15) * (13.287712379549449f / 16.0f)); float sn, cs; sincosf(ang, &sn, &cs); ROPE[2 * e] = cs; ROPE[2 * e + 1] = sn; } }
}
__device__ __forceinline__ void p1_mod_finalize(Frame& F, const Args& A) {
    const float* MODP = (const float*)(F.ws + WS_MODP); float* MOD = (float*)(F.ws + WS_MOD);
    for (int i = F.vcu * NTHREADS + F.tid; i < 2 * 3 * 6144; i += F.G * NTHREADS) {
        const int l = i / (3 * 6144), v = (i / 6144) % 3, n = i % 6144;
        float s = A.in[I_MOD_B][l * 6144 + n];
#pragma unroll
        for (int kc = 0; kc < 16; ++kc) s += MODP[((size_t)(l * 16 + kc) * 3 + v) * 6144 + n];
        MOD[i] = s;
    }
}
__device__ __forceinline__ void norm_rows(Frame& F, const Args& A, const float* lat, const float* ctx, int nrows, const float* g, const float* mod, int ch_shift, int ch_scale, bf16* XN, const float* cpart = nullptr, const float* cgate = nullptr) {
    const int gw = F.vcu * NWAVES + F.wave, NGW = F.G * NWAVES;
    constexpr int NR = 2;
    for (int row0 = NR * gw; row0 < nrows; row0 += NR * NGW) {
        f32x4 v[NR][4]; float ss[NR];
#pragma unroll
        for (int q = 0; q < NR; ++q) { const int row = row0 + q; const float* src = (row < ML_ROWS) ? lat + (size_t)row * D : ctx + (size_t)(row - ML_ROWS) * D; ss[q] = 0.f;
#pragma unroll
            for (int j = 0; j < 4; ++j) { v[q][j] = *(const f32x4*)(src + 256 * j + 4 * F.lane);
                if (cpart && row >= ML_ROWS) { const float* pp = cpart + (size_t)(row - ML_ROWS) * D + 256 * j + 4 * F.lane; const f32x4 ps = (*(const f32x4*)pp + *(const f32x4*)(pp + (size_t)MC_ROWS * D)) + (*(const f32x4*)(pp + (size_t)2 * MC_ROWS * D) + *(const f32x4*)(pp + (size_t)3 * MC_ROWS * D)); v[q][j] += ps * *(const f32x4*)(cgate + 256 * j + 4 * F.lane); }
                ss[q] += (v[q][j].x * v[q][j].x + v[q][j].y * v[q][j].y) + (v[q][j].z * v[q][j].z + v[q][j].w * v[q][j].w); } }
        f32x4 gsc[NR][4], sh[NR][4];
#pragma unroll
        for (int q = 0; q < NR; ++q) { const int row = row0 + q; const float* mv = mod + ((row < ML_ROWS) ? (row >> 13) : 2) * 6144;
#pragma unroll
            for (int j = 0; j < 4; ++j) { const int c = 256 * j + 4 * F.lane; gsc[q][j] = *(const f32x4*)(g + c) * (*(const f32x4*)(mv + ch_scale * 1024 + c) + 1.0f); sh[q][j] = *(const f32x4*)(mv + ch_shift * 1024 + c); } }
#pragma unroll
        for (int q = 0; q < NR; ++q) { const int row = row0 + q;
            const float rs = __builtin_amdgcn_rsqf(wave_sum(ss[q]) * (1.f / D) + NORM_EPS);
            unsigned long long* o8 = (unsigned long long*)(XN + (size_t)row * D);
#pragma unroll
            for (int j = 0; j < 4; ++j) {
                const f32x4 y = (v[q][j] * rs) * gsc[q][j] + sh[q][j];
                o8[64 * j + F.lane] = (unsigned long long)pk2(y.x, y.y) | ((unsigned long long)pk2(y.z, y.w) << 32);
            } }
    }
}

__device__ __forceinline__ int ml_chunk_base(int d, int b, int c) {
    if (c < 2) return ML_ROWS + b * CTXL + (d == 0 ? 128 * c : 128 * (1 - c));
    const int cc = c - 2; return b * T + (d == 0 ? 128 * cc : T - 128 * (cc + 1));
}
__device__ __forceinline__ void ml_pass_a(Frame& F, const Args& A) {
    constexpr int P = 136;
    unsigned char* ws = F.ws;
    const bf16* KM = (const bf16*)(ws + R_KM); const bf16* VM = (const bf16*)(ws + R_VM); const float* GATES = (const float*)(ws + R_GATES);
    float* BT = (float*)(ws + MI_BT); float* AT = (float*)(ws + MI_AT); float* CHS = (float*)(ws + MI_CHS); float* DN = (float*)(ws + MI_DN);
    bf16* CST = (bf16*)((unsigned char*)F.out + DO_CST);
    LAS bf16* Kt = (LAS bf16*)(F.lds); LAS bf16* Vt = Kt + 128 * P; LAS float* wl = (LAS float*)(F.lds + 2 * 128 * P * 2);
    const int w = F.wave;
    v4u kreg[4], vreg[4];
#define MLA_LOAD(it_) do { const int ch_ = (it_) / NCHUNK, c_ = (it_) % NCHUNK, d_ = ch_ >> 3, b_ = (ch_ >> 2) & 1, h_ = ch_ & 3; const int base_ = ml_chunk_base(d_, b_, c_); \
        _Pragma("unroll") for (int j = 0; j < 4; ++j) { const int idx = F.tid + 512 * j, row = idx >> 4, chk = idx & 15; \
            kreg[j] = *(const GAS v4u*)(KM + (size_t)(base_ + row) * 512 + h_ * 128 + 8 * chk); vreg[j] = *(const GAS v4u*)(VM + (size_t)(base_ + row) * 512 + h_ * 128 + 8 * chk); } } while (0)
    if (F.vcu < NITEM_ML) MLA_LOAD(F.vcu);
    for (int item = F.vcu; item < NITEM_ML; item += F.G) {
        const int chain = item / NCHUNK, c = item % NCHUNK, d = chain >> 3, b = (chain >> 2) & 1, h = chain & 3;
        const int base = ml_chunk_base(d, b, c);
        int lz = 0; asm volatile("" : "+s"(lz));
        const int tid = F.tid + lz, lane = tid & 63, l15 = lane & 15, l4 = lane >> 4;
        __syncthreads();
        if (w == 0) {
            const float bi = A.in[I_ML_GATE_B][(2 * d) * 4 + h], bfg = A.in[I_ML_GATE_B][(2 * d + 1) * 4 + h];
            float iv[2], lf[2];
#pragma unroll
            for (int e = 0; e < 2; ++e) { const int s = 2 * lane + e, o = d == 0 ? s : 127 - s; const float* gp = GATES + (size_t)(base + o) * 16 + 8 * d + h;
                iv[e] = gp[0] + bi; const float f = gp[4] + bfg; lf[e] = (f >= 0.f) ? -log1pf(__expf(-f)) : f - log1pf(__expf(f)); }
            const float pair = lf[0] + lf[1]; float incl = pair;
#pragma unroll
            for (int o = 1; o < 64; o <<= 1) { const float t_ = __shfl_up(incl, o); if (lane >= o) incl += t_; }
            const float excl = incl - pair; float bb[2] = {excl + lf[0], excl + pair}; float aa[2] = {iv[0] - bb[0], iv[1] - bb[1]};
            const float amax = wave_max(fmaxf(aa[0], aa[1])); const float bend = __shfl(bb[1], 63);
#pragma unroll
            for (int e = 0; e < 2; ++e) { const int s = 2 * lane + e, o = d == 0 ? s : 127 - s; const size_t gi = (size_t)(d * 4 + h) * MA_ROWS + base + o; BT[gi] = bb[e]; AT[gi] = aa[e]; wl[o] = __expf(aa[e] - amax); }
            if (lane == 0) { CHS[(chain * NCHUNK + c) * 2] = bend; CHS[(chain * NCHUNK + c) * 2 + 1] = amax; }
        }
#pragma unroll
        for (int j = 0; j < 4; ++j) { const int idx = tid + 512 * j, row = idx >> 4, ch = idx & 15; *(LAS v4u*)(Kt + row * P + 8 * ch) = kreg[j]; }
        __syncthreads();
#pragma unroll
        for (int j = 0; j < 4; ++j) { const int idx = tid + 512 * j, row = idx >> 4, ch = idx & 15; const float ws_ = wl[row]; const unsigned* pv_ = (const unsigned*)&vreg[j]; v4u o; unsigned* po = (unsigned*)&o;
#pragma unroll
            for (int q = 0; q < 4; ++q) po[q] = pk2(__uint_as_float(pv_[q] << 16) * ws_, __uint_as_float(pv_[q] & 0xffff0000u) * ws_);
            *(LAS v4u*)(Vt + row * P + 8 * ch) = o; }
        { const int dk = tid >> 2, q = tid & 3; float s = 0.f;
#pragma unroll 8
            for (int j = 0; j < 32; ++j) { const int so = 32 * q + j; s += bf2f(Kt[so * P + dk]) * wl[so]; }
            s += dpp_mov<0xB1>(s); s += dpp_mov<0x4E>(s);
            if (q == 0) DN[(size_t)item * 128 + dk] = s; }
        __syncthreads();
        { const int itn = item + F.G; if (itn < NITEM_ML) MLA_LOAD(itn); }
        f32x4 acc[8];
#pragma unroll
        for (int n8 = 0; n8 < 8; ++n8) acc[n8] = (f32x4){0.f, 0.f, 0.f, 0.f};
#pragma unroll
        for (int kk = 0; kk < 4; ++kk) {
            const bf16x8 vf = trfrag<P>(Vt, 16 * w, 32 * kk, l15, l4);
#pragma unroll
            for (int n8 = 0; n8 < 8; ++n8) acc[n8] = MFMA16(trfrag<P>(Kt, 16 * n8, 32 * kk, l15, l4), vf, acc[n8]);
        }
        bf16* cst = CST + (size_t)item * 16384 + (size_t)(16 * w + l15) * 128 + 4 * l4;
#pragma unroll
        for (int n8 = 0; n8 < 8; ++n8) *(u32x2v*)(cst + 16 * n8) = pk4(acc[n8]);
    }
#undef MLA_LOAD
    __syncthreads();
}
__device__ __forceinline__ void ml_pass_b(Frame& F, const Args& A) {
    unsigned char* ws = F.ws;
    const float* CHS = (const float*)(ws + MI_CHS); float* MCH = (float*)(ws + MI_MCH); float* DN = (float*)(ws + MI_DN);
    unsigned* CST = (unsigned*)((unsigned char*)F.out + DO_CST);
    constexpr int PER_CHAIN = 8192 + 128, NWORK = NCHAIN_ML * PER_CHAIN, NB = 11;
    static_assert(NCHUNK % NB == 0, "chunk batches");
    for (int wi = F.vcu * NTHREADS + F.tid; wi < NWORK; wi += F.G * NTHREADS) {
        const int chain = wi / PER_CHAIN, e = wi % PER_CHAIN;
        float m = 0.f, c0 = 0.f, c1 = 0.f;
        const float* chs = CHS + (size_t)chain * NCHUNK * 2;
        if (e < 8192) {
            unsigned* p = CST + (size_t)chain * NCHUNK * 8192 + e;
            for (int cb = 0; cb < NCHUNK; cb += NB) {
                unsigned dl[NB]; float be[NB], am[NB];
#pragma unroll
                for (int k = 0; k < NB; ++k) { dl[k] = p[(size_t)(cb + k) * 8192]; be[k] = chs[(cb + k) * 2]; am[k] = chs[(cb + k) * 2 + 1]; }
#pragma unroll
                for (int k = 0; k < NB; ++k) {
                    p[(size_t)(cb + k) * 8192] = pk2(c0, c1);
                    if (e == 0) MCH[chain * NCHUNK + cb + k] = m;
                    const float g = fmaxf(m, am[k]), so = __expf(m - g), sn = __expf(am[k] - g);
                    c0 = so * c0 + sn * __uint_as_float(dl[k] << 16); c1 = so * c1 + sn * __uint_as_float(dl[k] & 0xffff0000u);
                    m = be[k] + g;
                }
            }
        } else {
            float* p = DN + (size_t)chain * NCHUNK * 128 + (e - 8192);
            for (int cb = 0; cb < NCHUNK; cb += NB) {
                float dl[NB], be[NB], am[NB];
#pragma unroll
                for (int k = 0; k < NB; ++k) { dl[k] = p[(size_t)(cb + k) * 128]; be[k] = chs[(cb + k) * 2]; am[k] = chs[(cb + k) * 2 + 1]; }
#pragma unroll
                for (int k = 0; k < NB; ++k) {
                    p[(size_t)(cb + k) * 128] = c0;
                    const float g = fmaxf(m, am[k]), so = __expf(m - g), sn = __expf(am[k] - g);
                    c0 = so * c0 + sn * dl[k]; m = be[k] + g;
                }
            }
        }
    }
}
__device__ __forceinline__ void ml_pass_c(Frame& F, const Args& A) {
    constexpr int P = 136;
    unsigned char* ws = F.ws;
    const bf16* QM = (const bf16*)(ws + R_QM); const bf16* KM = (const bf16*)(ws + R_KM); const bf16* VM = (const bf16*)(ws + R_VM);
    const float* BT = (const float*)(ws + MI_BT); const float* AT = (const float*)(ws + MI_AT); const float* MCH = (const float*)(ws + MI_MCH); const float* NST = (const float*)(ws + MI_DN);
    const bf16* CST = (const bf16*)((unsigned char*)F.out + DO_CST);
    bf16* HML = (bf16*)(ws + R_HML);
    LAS bf16* Kt = (LAS bf16*)(F.lds); LAS bf16* Vt = Kt + 128 * P; LAS bf16* Ct = Vt + 128 * P;
    LAS bf16* Sl = F.wave < 6 ? (LAS bf16*)(F.lds + 3 * 128 * P * 2 + F.wave * (16 * P * 2)) : (LAS bf16*)(F.lds + LDSX_OFF + (F.wave - 6) * (16 * P * 2));
    LAS float* aw = (LAS float*)(F.lds + LDSX_OFF + 2 * (16 * P * 2)); LAS float* gq = aw + 128; LAS float* bq = gq + 128;
    static_assert(3 * 128 * P * 2 + 6 * 16 * P * 2 <= RING_BYTES && LDSX_OFF + 2 * 16 * P * 2 + 3 * 128 * 4 <= LDS_BYTES, "mLSTM pass C LDS map");
    const int w = F.wave;
    v4u kreg[4], vreg[4], creg[4];
    bf16x8 qn[4]; float m_n = 0.f, aan[2] = {0.f, 0.f}, bbn[2] = {0.f, 0.f};
#define MLC_LOAD(it_) do { const int ch_ = (it_) / NCHUNK, c_ = (it_) % NCHUNK, d_ = ch_ >> 3, b_ = (ch_ >> 2) & 1, h_ = ch_ & 3; const int base_ = ml_chunk_base(d_, b_, c_); \
        _Pragma("unroll") for (int j = 0; j < 4; ++j) { const int idx = F.tid + 512 * j, row = idx >> 4, chk = idx & 15; \
            kreg[j] = *(const GAS v4u*)(KM + (size_t)(base_ + row) * 512 + h_ * 128 + 8 * chk); vreg[j] = *(const GAS v4u*)(VM + (size_t)(base_ + row) * 512 + h_ * 128 + 8 * chk); \
            creg[j] = *(const GAS v4u*)(CST + (size_t)(it_) * 16384 + (size_t)row * 128 + 8 * chk); } \
        m_n = MCH[ch_ * NCHUNK + c_]; \
        { const bf16* qp_ = QM + (size_t)(base_ + 16 * F.wave + (F.lane & 15)) * 512 + h_ * 128 + 8 * (F.lane >> 4); _Pragma("unroll") for (int kk = 0; kk < 4; ++kk) qn[kk] = gfrag(qp_ + 32 * kk); } \
        if (F.wave == 0) { _Pragma("unroll") for (int e = 0; e < 2; ++e) { const int s_ = 2 * F.lane + e, o_ = d_ == 0 ? s_ : 127 - s_; const size_t gi_ = (size_t)(d_ * 4 + h_) * MA_ROWS + base_ + o_; aan[e] = AT[gi_]; bbn[e] = BT[gi_]; } } } while (0)
    if (F.vcu < NITEM_ML) MLC_LOAD(F.vcu);
    for (int item = F.vcu; item < NITEM_ML; item += F.G) {
        const int chain = item / NCHUNK, c = item % NCHUNK, d = chain >> 3, b = (chain >> 2) & 1, h = chain & 3;
        const int base = ml_chunk_base(d, b, c);
        int lz = 0; asm volatile("" : "+s"(lz));
        const int tid = F.tid + lz, lane = tid & 63, l15 = lane & 15, l4 = lane >> 4;
        const float m = m_n;
        const int to = 16 * w + l15;
        bf16x8 qf[4];
#pragma unroll
        for (int kk = 0; kk < 4; ++kk) qf[kk] = qn[kk];
        __syncthreads();
        if (w == 0) {
            float aa[2], bb[2];
#pragma unroll
            for (int e = 0; e < 2; ++e) { aa[e] = aan[e]; bb[e] = bbn[e]; }
            const float pm = fmaxf(aa[0], aa[1]); float incl = pm;
#pragma unroll
            for (int o = 1; o < 64; o <<= 1) { const float t_ = __shfl_up(incl, o); if (lane >= o) incl = fmaxf(incl, t_); }
            float excl = __shfl_up(incl, 1); if (lane == 0) excl = -INFINITY;
            const float g0 = fmaxf(m, fmaxf(excl, aa[0])), g1 = fmaxf(m, incl);
#pragma unroll
            for (int e = 0; e < 2; ++e) { const int s = 2 * lane + e, o = d == 0 ? s : 127 - s; aw[o] = aa[e]; gq[o] = e == 0 ? g0 : g1; bq[o] = bb[e]; }
        }
#pragma unroll
        for (int j = 0; j < 4; ++j) { const int idx = tid + 512 * j, row = idx >> 4, chk = idx & 15; *(LAS v4u*)(Kt + row * P + 8 * chk) = kreg[j]; *(LAS v4u*)(Vt + row * P + 8 * chk) = vreg[j]; *(LAS v4u*)(Ct + row * P + 8 * chk) = creg[j]; }
        __syncthreads();
        { const int itn = item + F.G; if (itn < NITEM_ML) MLC_LOAD(itn); }
        const float gt = gq[to], bt = bq[to];
        float den = 0.f;
#pragma unroll
        for (int m8 = 0; m8 < 8; ++m8) {
            f32x4 st = {0.f, 0.f, 0.f, 0.f};
#pragma unroll
            for (int kk = 0; kk < 4; ++kk) st = MFMA16(ldsfrag<P>(Kt, 16 * m8 + l15, 32 * kk + 8 * l4), qf[kk], st);
            f32x4 vv;
#pragma unroll
            for (int r = 0; r < 4; ++r) { const int so = 16 * m8 + 4 * l4 + r; const bool valid = d == 0 ? (so <= to) : (so >= to); const float wgt = valid ? __expf(aw[so] - gt) : 0.f; vv[r] = st[r] * wgt; den += vv[r]; }
            *(LAS u32x2v*)(Sl + l15 * P + 16 * m8 + 4 * l4) = pk4(vv);
        }
        den += __shfl_xor(den, 16); den += __shfl_xor(den, 32);
        float qn = 0.f;
        { const float* np = NST + (size_t)item * 128 + 8 * l4;
#pragma unroll
            for (int kk = 0; kk < 4; ++kk) { const unsigned* pq = (const unsigned*)&qf[kk];
#pragma unroll
                for (int e = 0; e < 4; ++e) qn += __uint_as_float(pq[e] << 16) * np[32 * kk + 2 * e] + __uint_as_float(pq[e] & 0xffff0000u) * np[32 * kk + 2 * e + 1]; }
            qn += __shfl_xor(qn, 16); qn += __shfl_xor(qn, 32); }
        asm volatile("s_waitcnt lgkmcnt(0)" ::: "memory"); __builtin_amdgcn_wave_barrier();
        bf16x8 sf[4];
#pragma unroll
        for (int kk = 0; kk < 4; ++kk) sf[kk] = ldsfrag<P>(Sl, l15, 32 * kk + 8 * l4);
        const float wprev = __expf(m - gt);
        const float dent = den + wprev * qn;
        const float rdn = __builtin_amdgcn_rcpf(fmaxf(fabsf(dent), __expf(-(bt + gt))));
        bf16* hp = HML + ((size_t)d * MA_ROWS + base + to) * 512 + h * 128 + 4 * l4;
#pragma unroll
        for (int v8 = 0; v8 < 8; ++v8) {
            f32x4 an = {0.f, 0.f, 0.f, 0.f}, ai = {0.f, 0.f, 0.f, 0.f};
#pragma unroll
            for (int kk = 0; kk < 4; ++kk) {
                an = MFMA16(trfrag<P>(Vt, 16 * v8, 32 * kk, l15, l4), sf[kk], an);
                ai = MFMA16(ldsfrag<P>(Ct, 16 * v8 + l15, 32 * kk + 8 * l4), qf[kk], ai);
            }
            f32x4 o; o[0] = (an[0] + wprev * ai[0]) * rdn; o[1] = (an[1] + wprev * ai[1]) * rdn; o[2] = (an[2] + wprev * ai[2]) * rdn; o[3] = (an[3] + wprev * ai[3]) * rdn;
            *(u32x2v*)(hp + 16 * v8) = pk4(o);
        }
    }
#undef MLC_LOAD
    __syncthreads();
}
template <class EPI> __device__ __forceinline__ void ctx_gemm(Frame& F, const bf16* Am, int lda, const bf16* Bt, int ldb, int M, int N, int K, const EPI& epi) {
    LAS f32x4* red = (LAS f32x4*)(F.lds);
    const int lane = F.lane, w = F.wave, l15 = lane & 15, l4 = lane >> 4;
    const int ntn = N / 64, ntiles = (M / 32) * ntn, ks = K / 8;
    for (int tile = F.vcu; tile < ntiles; tile += F.G) {
        const int tm = tile / ntn, tn = tile % ntn;
        f32x4 acc[2][4];
#pragma unroll
        for (int mi = 0; mi < 2; ++mi)
#pragma unroll
            for (int ni = 0; ni < 4; ++ni) acc[mi][ni] = (f32x4){0.f, 0.f, 0.f, 0.f};
        const bf16* ap = Am + (size_t)(32 * tm + l15) * lda + w * ks + 8 * l4;
        const bf16* bp = Bt + (size_t)(64 * tn + l15) * ldb + w * ks + 8 * l4;
#pragma unroll 2
        for (int k0 = 0; k0 < ks; k0 += 32) {
            bf16x8 a[2], b[4];
#pragma unroll
            for (int mi = 0; mi < 2; ++mi) a[mi] = __builtin_bit_cast(bf16x8, *(const GAS v4u*)(ap + (size_t)(16 * mi) * lda + k0));
#pragma unroll
            for (int ni = 0; ni < 4; ++ni) b[ni] = __builtin_bit_cast(bf16x8, *(const GAS v4u*)(bp + (size_t)(16 * ni) * ldb + k0));
#pragma unroll
            for (int mi = 0; mi < 2; ++mi)
#pragma unroll
                for (int ni = 0; ni < 4; ++ni) acc[mi][ni] = MFMA16(a[mi], b[ni], acc[mi][ni]);
        }
        __syncthreads();
#pragma unroll
        for (int mi = 0; mi < 2; ++mi)
#pragma unroll
            for (int ni = 0; ni < 4; ++ni) red[(w * 8 + mi * 4 + ni) * 64 + lane] = acc[mi][ni];
        __syncthreads();
        {
            f32x4 s = red[(0 * 8 + w) * 64 + lane];
#pragma unroll
            for (int ww = 1; ww < 8; ++ww) s += red[(ww * 8 + w) * 64 + lane];
            const int row0 = 32 * tm + 16 * (w >> 2) + 4 * l4, col = 64 * tn + 16 * (w & 3) + l15;
#pragma unroll
            for (int r = 0; r < 4; ++r) epi(row0 + r, col, s[r]);
        }
    }
    __syncthreads();
}
template <int KSPLIT = 1, class EPI> __device__ __forceinline__ void ctx_gemm2(Frame& F, const bf16* Am, int lda, const bf16* Bt, int ldb, int M, int N, int K, const EPI& epi) {
    constexpr int TP = 72, ABYTES = 64 * TP * 2, BBYTES = 128 * TP * 2, STAGE = ABYTES + BBYTES;
    const int tid = F.tid, lane = F.lane, w = F.wave, l15 = lane & 15, l4 = lane >> 4, wm = w >> 2, wn = w & 3;
    const int ntn = N / 128, ntiles = (M / 64) * ntn * KSPLIT, nk = K / 64 / KSPLIT;
    const int arow = tid >> 3, apc = tid & 7;
    for (int tile = F.vcu; tile < ntiles; tile += F.G) {
        const int ksl = tile % KSPLIT, tl = tile / KSPLIT, tm = tl / ntn, tn = tl % ntn;
        const bf16* ap = Am + (size_t)(64 * tm + arow) * lda + 8 * apc + (size_t)ksl * nk * 64;
        const bf16* bp0 = Bt + (size_t)(128 * tn + arow) * ldb + 8 * apc + (size_t)ksl * nk * 64; const bf16* bp1 = bp0 + (size_t)64 * ldb;
        f32x4 acc[2][2];
#pragma unroll
        for (int mi = 0; mi < 2; ++mi)
#pragma unroll
            for (int ni = 0; ni < 2; ++ni) acc[mi][ni] = (f32x4){0.f, 0.f, 0.f, 0.f};
        v4u xa = *(const GAS v4u*)ap, xb0 = *(const GAS v4u*)bp0, xb1 = *(const GAS v4u*)bp1;
        v4u ya = *(const GAS v4u*)(ap + 64), yb0 = *(const GAS v4u*)(bp0 + 64), yb1 = *(const GAS v4u*)(bp1 + 64);
        __syncthreads();
#define CG2_STEP(RA, RB0, RB1, ks_) do { LAS bf16* As = (LAS bf16*)(F.lds + ((ks_) & 1) * STAGE); LAS bf16* Bs = (LAS bf16*)(F.lds + ((ks_) & 1) * STAGE + ABYTES); \
            *(LAS v4u*)(As + arow * TP + 8 * apc) = RA; *(LAS v4u*)(Bs + arow * TP + 8 * apc) = RB0; *(LAS v4u*)(Bs + (arow + 64) * TP + 8 * apc) = RB1; \
            if ((ks_) + 2 < nk) { RA = *(const GAS v4u*)(ap + 64 * ((ks_) + 2)); RB0 = *(const GAS v4u*)(bp0 + 64 * ((ks_) + 2)); RB1 = *(const GAS v4u*)(bp1 + 64 * ((ks_) + 2)); } \
            asm volatile("s_waitcnt lgkmcnt(0)\n\ts_barrier" ::: "memory"); \
            _Pragma("unroll") for (int kk = 0; kk < 2; ++kk) { bf16x8 a[2], b[2]; \
                _Pragma("unroll") for (int mi = 0; mi < 2; ++mi) a[mi] = ldsfrag<TP>(As, 32 * wm + 16 * mi + l15, 32 * kk + 8 * l4); \
                _Pragma("unroll") for (int ni = 0; ni < 2; ++ni) b[ni] = ldsfrag<TP>(Bs, 32 * wn + 16 * ni + l15, 32 * kk + 8 * l4); \
                _Pragma("unroll") for (int mi = 0; mi < 2; ++mi) _Pragma("unroll") for (int ni = 0; ni < 2; ++ni) acc[mi][ni] = MFMA16(a[mi], b[ni], acc[mi][ni]); } } while (0)
        for (int ks = 0; ks < nk; ks += 2) { CG2_STEP(xa, xb0, xb1, ks); CG2_STEP(ya, yb0, yb1, ks + 1); }
#undef CG2_STEP
#pragma unroll
        for (int mi = 0; mi < 2; ++mi)
#pragma unroll
            for (int ni = 0; ni < 2; ++ni) { const int row0 = 64 * tm + 32 * wm + 16 * mi + 4 * l4, col = 128 * tn + 32 * wn + 16 * ni + l15;
#pragma unroll
                for (int r = 0; r < 4; ++r) { if constexpr (KSPLIT == 1) epi(row0 + r, col, acc[mi][ni][r]); else epi(row0 + r, col, acc[mi][ni][r], ksl); } }
    }
    __syncthreads();
}
__device__ __forceinline__ void rw_seq_rows(int d, int b, int p, int& R, int& idx, int& len, int& sbase) {
    if (p < CTXL) { idx = d == 0 ? p : CTXL - 1 - p; len = CTXL; sbase = ML_ROWS + b * CTXL; }
    else { const int q = p - CTXL; idx = d == 0 ? q : T - 1 - q; len = T; sbase = b * T; }
    R = sbase + idx;
}
__device__ __forceinline__ void rw_scan(Frame& F, const Args& A) {
    unsigned char* ws = F.ws;
    const bf16* RAWb = (const bf16*)(ws + R_RAW); const bf16* TWAD = (const bf16*)(ws + R_TWAD);
    LAS float* w2h = (LAS float*)(F.lds); LAS float* a2h = w2h + 4096; LAS float* vecs = a2h + 4096;
    LAS float* ybuf = vecs + 32 * 384; LAS float* twl = ybuf + 2048; LAS float* adl = twl + 2048;
    const int tid = F.tid, lane = F.lane, wv = F.wave;
    for (int chain = F.vcu; chain < NCHAIN_RW; chain += F.G) {
        const int d = chain >> 4, b = (chain >> 3) & 1, h = chain & 7;
        bf16* YRW = d == 0 ? (bf16*)(ws + R_YRW0) : (bf16*)((unsigned char*)F.out + DO_YRW1);
        __syncthreads();
        for (int i = tid; i < 4096; i += NTHREADS) { const int ii = i >> 6, ch = i & 63; w2h[i] = A.in[I_RW_W2][((size_t)d * 64 + ii) * 512 + h * 64 + ch]; a2h[i] = A.in[I_RW_A2][((size_t)d * 64 + ii) * 512 + h * 64 + ch]; }
        const int ppos = tid >> 4, chq = tid & 15, ch0 = 4 * chq, hc = h * 64 + ch0;
        float cw[3][3][4], kkw[4], kaw[4], w0v[4], a0v[4];
#pragma unroll
        for (int k = 0; k < 3; ++k)
#pragma unroll
            for (int g = 0; g < 3; ++g)
#pragma unroll
                for (int e = 0; e < 4; ++e) cw[k][g][e] = A.in[I_RW_CONV][k * 1536 + g * 512 + hc + e];
#pragma unroll
        for (int e = 0; e < 4; ++e) { kkw[e] = A.in[I_RW_KK][hc + e]; kaw[e] = A.in[I_RW_KA][hc + e]; w0v[e] = A.in[I_RW_W0][d * 512 + hc + e]; a0v[e] = A.in[I_RW_A0][d * 512 + hc + e]; }
        float S[8];
#pragma unroll
        for (int j = 0; j < 8; ++j) S[j] = 0.f;
        const int row_i = 8 * wv + (lane >> 3), j0 = 8 * (lane & 7);
        for (int blk = 0; blk < KV_LEN / 32; ++blk) {
            int R, idx, len, sbase; rw_seq_rows(d, b, 32 * blk + ppos, R, idx, len, sbase);
            __syncthreads();
            { const u32x2v tw = *(const GAS u32x2v*)(TWAD + (size_t)R * 256 + d * 64 + ch0), ad = *(const GAS u32x2v*)(TWAD + (size_t)R * 256 + 128 + d * 64 + ch0);
              LAS float* t_ = twl + ppos * 64 + ch0; LAS float* a_ = adl + ppos * 64 + ch0;
              t_[0] = __uint_as_float(tw.x << 16); t_[1] = __uint_as_float(tw.x & 0xffff0000u); t_[2] = __uint_as_float(tw.y << 16); t_[3] = __uint_as_float(tw.y & 0xffff0000u);
              a_[0] = __uint_as_float(ad.x << 16); a_[1] = __uint_as_float(ad.x & 0xffff0000u); a_[2] = __uint_as_float(ad.y << 16); a_[3] = __uint_as_float(ad.y & 0xffff0000u); }
            float cv[3][4];
#pragma unroll
            for (int g = 0; g < 3; ++g)
#pragma unroll
                for (int e = 0; e < 4; ++e) cv[g][e] = 0.f;
#pragma unroll
            for (int k = 0; k < 3; ++k) { const int ii = idx + k - 1; if (ii >= 0 && ii < len) {
#pragma unroll
                for (int g = 0; g < 3; ++g) { const u32x2v x = *(const GAS u32x2v*)(RAWb + (size_t)(sbase + ii) * 1536 + g * 512 + hc);
                    cv[g][0] += cw[k][g][0] * __uint_as_float(x.x << 16); cv[g][1] += cw[k][g][1] * __uint_as_float(x.x & 0xffff0000u); cv[g][2] += cw[k][g][2] * __uint_as_float(x.y << 16); cv[g][3] += cw[k][g][3] * __uint_as_float(x.y & 0xffff0000u); } } }
            float kkv[4], ss = 0.f;
#pragma unroll
            for (int e = 0; e < 4; ++e) { kkv[e] = cv[1][e] * kkw[e]; ss += kkv[e] * kkv[e]; }
            ss += __shfl_xor(ss, 1); ss += __shfl_xor(ss, 2); ss += __shfl_xor(ss, 4); ss += __shfl_xor(ss, 8);
            const float rn = __builtin_amdgcn_rsqf(ss + NORM_EPS);
            __syncthreads();
            float wl_[4], al_[4];
#pragma unroll
            for (int e = 0; e < 4; ++e) { wl_[e] = w0v[e]; al_[e] = a0v[e]; }
            for (int i = 0; i < 64; ++i) { const float tv = twl[ppos * 64 + i], av = adl[ppos * 64 + i]; const f32x4 w2 = *(const LAS f32x4*)(w2h + i * 64 + ch0), a2 = *(const LAS f32x4*)(a2h + i * 64 + ch0);
#pragma unroll
                for (int e = 0; e < 4; ++e) { wl_[e] += tv * w2[e]; al_[e] += av * a2[e]; } }
            LAS float* vb = vecs + ppos * 384 + ch0;
#pragma unroll
            for (int e = 0; e < 4; ++e) {
                const float wdec = __expf(-0.6065306597126334f * sigmoidf_(wl_[e])), a = sigmoidf_(al_[e]), kk = kkv[e] * rn;
                vb[e] = wdec; vb[64 + e] = kk * a; vb[128 + e] = cv[1][e] * (1.0f + (a - 1.0f) * kaw[e]); vb[192 + e] = kk; vb[256 + e] = cv[0][e]; vb[320 + e] = cv[2][e];
            }
            __syncthreads();
            for (int pp = 0; pp < 32; ++pp) {
                const LAS float* v_ = vecs + pp * 384;
                const f32x4 k0 = *(const LAS f32x4*)(v_ + 192 + j0), k1 = *(const LAS f32x4*)(v_ + 192 + j0 + 4);
                float skk = S[0] * k0[0] + S[1] * k0[1] + S[2] * k0[2] + S[3] * k0[3] + S[4] * k1[0] + S[5] * k1[1] + S[6] * k1[2] + S[7] * k1[3];
                skk += __shfl_xor(skk, 1); skk += __shfl_xor(skk, 2); skk += __shfl_xor(skk, 4);
                const f32x4 w0_ = *(const LAS f32x4*)(v_ + j0), w1_ = *(const LAS f32x4*)(v_ + j0 + 4), b0 = *(const LAS f32x4*)(v_ + 64 + j0), b1 = *(const LAS f32x4*)(v_ + 64 + j0 + 4);
                const f32x4 e0 = *(const LAS f32x4*)(v_ + 128 + j0), e1 = *(const LAS f32x4*)(v_ + 128 + j0 + 4), r0 = *(const LAS f32x4*)(v_ + 256 + j0), r1 = *(const LAS f32x4*)(v_ + 256 + j0 + 4);
                const float vi = v_[320 + row_i];
                float y = 0.f;
#pragma unroll
                for (int j = 0; j < 4; ++j) { S[j] = S[j] * w0_[j] - skk * b0[j] + vi * e0[j]; S[4 + j] = S[4 + j] * w1_[j] - skk * b1[j] + vi * e1[j]; y += S[j] * r0[j] + S[4 + j] * r1[j]; }
                y += __shfl_xor(y, 1); y += __shfl_xor(y, 2); y += __shfl_xor(y, 4);
                if ((lane & 7) == 0) ybuf[pp * 64 + row_i] = y;
            }
            __syncthreads();
            { const LAS float* yb = ybuf + ppos * 64 + ch0; u32x2v o; o.x = pk2(yb[0], yb[1]); o.y = pk2(yb[2], yb[3]); *(u32x2v*)(YRW + (size_t)R * 512 + hc) = o; }
        }
    }
    __syncthreads();
}

__device__ __forceinline__ void merge_rows(Frame& F, const Args& A) {
    unsigned char* ws = F.ws;
    const bf16* HML = (const bf16*)(ws + R_HML); const bf16* OM = (const bf16*)(ws + R_OM); const bf16* RAWb = (const bf16*)(ws + R_RAW);
    const bf16* YRW0 = (const bf16*)(ws + R_YRW0); const bf16* YRW1 = (const bf16*)((unsigned char*)F.out + DO_YRW1);
    bf16* MIX = (bf16*)(ws + R_MIX);
    const int gw = F.vcu * NWAVES + F.wave, NGW = F.G * NWAVES, lane = F.lane, c8 = 8 * lane;
    for (int row = gw; row < MA_ROWS; row += NGW) {
        float y[8];
        const v4u in_og = *(const GAS v4u*)(OM + (size_t)row * 512 + c8);
        const v4u in_y0 = *(const GAS v4u*)(YRW0 + (size_t)row * 512 + c8), in_y1 = *(const GAS v4u*)(YRW1 + (size_t)row * 512 + c8);
        const v4u in_gg = *(const GAS v4u*)(RAWb + (size_t)row * 1536 + c8);
        const float bs = ((const float*)(ws + WS_SS))[(size_t)row * 8 + (lane >> 3)];
        int idx, len, sbase; if (row < ML_ROWS) { idx = row & (T - 1); len = T; sbase = row - idx; } else { idx = (row - ML_ROWS) & (CTXL - 1); len = CTXL; sbase = row - idx; }
        v4u in_x[3];
#pragma unroll
        for (int k = 0; k < 3; ++k) { const int ii = idx + k - 1; const bool ok = ii >= 0 && ii < len; const v4u x = *(const GAS v4u*)(RAWb + (size_t)(sbase + (ok ? ii : idx)) * 1536 + 2 * 512 + c8);
            const v4u z0 = {0u, 0u, 0u, 0u}; in_x[k] = ok ? x : z0; }
        { const v4u a = *(const GAS v4u*)(HML + (size_t)row * 512 + c8), b_ = *(const GAS v4u*)(HML + ((size_t)MA_ROWS + row) * 512 + c8); const unsigned* pa = (const unsigned*)&a; const unsigned* pb = (const unsigned*)&b_;
#pragma unroll
            for (int q = 0; q < 4; ++q) { y[2 * q] = __uint_as_float(pa[q] << 16) + __uint_as_float(pb[q] << 16); y[2 * q + 1] = __uint_as_float(pa[q] & 0xffff0000u) + __uint_as_float(pb[q] & 0xffff0000u); } }
        float s = 0.f;
#pragma unroll
        for (int e = 0; e < 8; ++e) s += y[e];
        s += __shfl_xor(s, 1); s += __shfl_xor(s, 2); s += __shfl_xor(s, 4); s += __shfl_xor(s, 8);
        const float mean = s * (1.f / 128.f); float q2 = 0.f;
#pragma unroll
        for (int e = 0; e < 8; ++e) { y[e] -= mean; q2 += y[e] * y[e]; }
        q2 += __shfl_xor(q2, 1); q2 += __shfl_xor(q2, 2); q2 += __shfl_xor(q2, 4); q2 += __shfl_xor(q2, 8);
        const float rstd = __builtin_amdgcn_rsqf(q2 * (1.f / 128.f) + GN_EPS);
        { const unsigned* po = (const unsigned*)&in_og; float o[8];
#pragma unroll
            for (int q = 0; q < 4; ++q) { o[2 * q] = __uint_as_float(po[q] << 16); o[2 * q + 1] = __uint_as_float(po[q] & 0xffff0000u); }
            v4u w; unsigned* pw = (unsigned*)&w;
#pragma unroll
            for (int q = 0; q < 4; ++q) { const float g0 = A.in[I_ML_NORM_G][c8 + 2 * q], g1 = A.in[I_ML_NORM_G][c8 + 2 * q + 1];
                pw[q] = pk2(y[2 * q] * rstd * g0 * sigmoidf_(o[2 * q]), y[2 * q + 1] * rstd * g1 * sigmoidf_(o[2 * q + 1])); }
            *(GAS v4u*)(MIX + (size_t)row * D + c8) = w; }
        float z[8];
        { const unsigned* pa = (const unsigned*)&in_y0; const unsigned* pb = (const unsigned*)&in_y1;
#pragma unroll
            for (int q = 0; q < 4; ++q) { z[2 * q] = __uint_as_float(pa[q] << 16) + __uint_as_float(pb[q] << 16); z[2 * q + 1] = __uint_as_float(pa[q] & 0xffff0000u) + __uint_as_float(pb[q] & 0xffff0000u); } }
        s = 0.f;
#pragma unroll
        for (int e = 0; e < 8; ++e) s += z[e];
        s += __shfl_xor(s, 1); s += __shfl_xor(s, 2); s += __shfl_xor(s, 4);
        const float mean2 = s * (1.f / 64.f); q2 = 0.f;
#pragma unroll
        for (int e = 0; e < 8; ++e) { z[e] -= mean2; q2 += z[e] * z[e]; }
        q2 += __shfl_xor(q2, 1); q2 += __shfl_xor(q2, 2); q2 += __shfl_xor(q2, 4);
        const float rstd2 = __builtin_amdgcn_rsqf(q2 * (1.f / 64.f) + GN_EPS);
        float cv[3][8];
#pragma unroll
        for (int e = 0; e < 8; ++e) cv[2][e] = 0.f;
#pragma unroll
        for (int k = 0; k < 3; ++k) { const unsigned* px = (const unsigned*)&in_x[k]; const float* cwp = A.in[I_RW_CONV] + k * 1536 + 2 * 512 + c8;
#pragma unroll
            for (int q = 0; q < 4; ++q) { cv[2][2 * q] += cwp[2 * q] * __uint_as_float(px[q] << 16); cv[2][2 * q + 1] += cwp[2 * q + 1] * __uint_as_float(px[q] & 0xffff0000u); } }
        { const unsigned* pg = (const unsigned*)&in_gg; v4u w; unsigned* pw = (unsigned*)&w;
#pragma unroll
            for (int q = 0; q < 4; ++q) { const float g0 = __uint_as_float(pg[q] << 16), g1 = __uint_as_float(pg[q] & 0xffff0000u);
                const float o0 = (z[2 * q] * rstd2 * A.in[I_RW_NORM_G][c8 + 2 * q] + bs * cv[2][2 * q]) * g0, o1 = (z[2 * q + 1] * rstd2 * A.in[I_RW_NORM_G][c8 + 2 * q + 1] + bs * cv[2][2 * q + 1]) * g1;
                pw[q] = pk2(o0, o1); }
            *(GAS v4u*)(MIX + (size_t)row * D + 512 + c8) = w; }
    }
}

__device__ __forceinline__ void qk_prep(Frame& F, const Args& A) {
    unsigned char* ws = F.ws;
    const bf16* ATT = (const bf16*)(ws + R_ATT); const float* ROPE = (const float*)(ws + WS_ROPE);
    bf16* QB = (bf16*)(ws + R_QB); bf16* KW = (bf16*)(ws + R_KW); bf16* VW = (bf16*)(ws + R_VW); bf16* KG = (bf16*)(ws + R_KG); bf16* VG = (bf16*)(ws + R_VG);
    const int gw = F.vcu * NWAVES + F.wave, NGW = F.G * NWAVES, lane = F.lane, l15 = lane & 15, hg = lane >> 4;
    const f32x4 gwq = *(const f32x4*)(A.in[I_WIN_Q_NORM] + 4 * l15), gwk = *(const f32x4*)(A.in[I_WIN_K_NORM] + 4 * l15), ggq = *(const f32x4*)(A.in[I_GLB_Q_NORM] + 4 * l15), ggk = *(const f32x4*)(A.in[I_GLB_K_NORM] + 4 * l15);
    for (int row0 = 2 * gw; row0 < MA_ROWS; row0 += 2 * NGW) {
        u32x2v xin[2][6];
#pragma unroll
        for (int q = 0; q < 2; ++q)
#pragma unroll
            for (int grp = 0; grp < 6; ++grp) xin[q][grp] = *(const GAS u32x2v*)(ATT + (size_t)(row0 + q) * ATT_N + 4 * lane + 256 * grp);
        f32x4 cs2[2];
#pragma unroll
        for (int q = 0; q < 2; ++q) { const int row = row0 + q; const bool lat = row < ML_ROWS; const int t = lat ? (row & (T - 1)) : 0;
            cs2[q] = (f32x4){1.f, 0.f, 1.f, 0.f}; if (lat) cs2[q] = *(const f32x4*)(ROPE + ((size_t)((l15 < 8) ? (t >> 6) : (t & 63)) * 16 + ((2 * l15) & 15)) * 2); }
#pragma unroll
        for (int q = 0; q < 2; ++q) {
        const int row = row0 + q;
        const bool lat = row < ML_ROWS; const int b = lat ? (row >> 13) : ((row - ML_ROWS) >> 8); const int t = lat ? (row & (T - 1)) : 0;
        const int pos = lat ? t : T + ((row - ML_ROWS) & (CTXL - 1));
        const f32x4 cssn = cs2[q];
#pragma unroll
        for (int grp = 0; grp < 6; ++grp) {
            const bool qgrp = (grp != 2) && (grp != 5);
            if (qgrp && !lat) continue;
            f32x4 x; { const u32x2v xb = xin[q][grp]; x[0] = __uint_as_float(xb.x << 16); x[1] = __uint_as_float(xb.x & 0xffff0000u); x[2] = __uint_as_float(xb.y << 16); x[3] = __uint_as_float(xb.y & 0xffff0000u); }
            const bool isv = !qgrp && hg >= 2;
            const f32x4 g = grp < 2 ? gwq : grp == 2 ? gwk : grp < 5 ? ggq : ggk;
            const float ss = sum16((x[0] * x[0] + x[1] * x[1]) + (x[2] * x[2] + x[3] * x[3]));
            if (!isv) {
                const float rs = __builtin_amdgcn_rsqf(ss * (1.f / 64.f) + NORM_EPS);
                x = x * rs * g;
                const f32x4 y = {x[0] * cssn[0] - x[1] * cssn[1], x[0] * cssn[1] + x[1] * cssn[0], x[2] * cssn[2] - x[3] * cssn[3], x[2] * cssn[3] + x[3] * cssn[2]};
                x = qgrp ? y * attn_body::C2 : y;
            }
            u32x2v o; o.x = pk2(x[0], x[1]); o.y = pk2(x[2], x[3]);
            if (qgrp) *(u32x2v*)(QB + (size_t)row * D + (grp < 2 ? 256 * grp : 512 + 256 * (grp - 3)) + 4 * lane) = o;
            else { bf16* dst = (grp == 2) ? (hg < 2 ? KW : VW) : (hg < 2 ? KG : VG); *(u32x2v*)(dst + ((size_t)(b * 2 + (hg & 1)) * KV_LEN + pos) * 64 + 4 * l15) = o; }
        }
        }
    }
}

__device__ __forceinline__ void attn_phase(Frame& F, const Args& A, char* lds_generic) {
    unsigned char* ws = F.ws;
    const attn_body::bf16* QB = (const attn_body::bf16*)(ws + R_QB);
    for (int k = 0; k < 4; ++k) {
        const int uid = k * F.G + F.vcu; if (uid >= 1024) break;
        const int grp = uid >> 9, gi = uid & 511;
        int bh, qb;
        if (F.G == 256) { bh = (gi & 255) >> 4; qb = 2 * ((gi & 255) & 15) + (gi >> 8); } else { bh = gi >> 5; qb = gi & 31; }
        const int b = bh >> 3, hq = bh & 7, kvh = hq >> 2;
        if (grp == 0) {
            const attn_body::bf16* Kh = (const attn_body::bf16*)(ws + R_KG) + (size_t)(b * 2 + kvh) * KV_LEN * 64; const attn_body::bf16* Vh = (const attn_body::bf16*)(ws + R_VG) + (size_t)(b * 2 + kvh) * KV_LEN * 64;
            attn_body::attn_unit<8, 0>(b, 8 + hq, qb, QB, Kh, Vh, (attn_body::bf16*)QB, lds_generic, 0.f);
        } else {
            const attn_body::bf16* Kh = (const attn_body::bf16*)(ws + R_KW) + (size_t)(b * 2 + kvh) * KV_LEN * 64; const attn_body::bf16* Vh = (const attn_body::bf16*)(ws + R_VW) + (size_t)(b * 2 + kvh) * KV_LEN * 64;
            attn_body::attn_unit<8, 1>(b, hq, qb, QB, Kh, Vh, (attn_body::bf16*)QB, lds_generic, A.in[I_WIN_SINK][hq] * 1.4426950408889634f);
        }
    }
}
constexpr int RW_NCH = 132;
constexpr int RW_NITEM = NCHAIN_RW * RW_NCH;
constexpr size_t RW_LCT = R_QM, RW_NC = R_VM, RW_PL = R_GATES;
static_assert((size_t)RW_NITEM * 4096 * 2 <= 2 * SZ_A && (size_t)RW_NITEM * 64 * 4 <= (size_t)MA_ROWS * 16 * 4 && WS_W2T + 2 * 2 * 8 * 64 * 64 * 2 <= WS_XC, "rwkv chunk scratch map");

template <int MODE> __device__ __forceinline__ void rw_chunk_pass(Frame& F, const Args& A) {
    constexpr int TP = 72;
    unsigned char* ws = F.ws;
    const bf16* RAWb = (const bf16*)(ws + R_RAW); const bf16* TWAD = (const bf16*)(ws + R_TWAD); const bf16* W2T = (const bf16*)(ws + WS_W2T);
    bf16* LCT = (bf16*)(ws + RW_LCT); bf16* NCG = (bf16*)(ws + RW_NC); float* PLG = (float*)(ws + RW_PL);
    const bf16* SCG = (const bf16*)((unsigned char*)F.out + DO_CST);
    LAS unsigned char* Lb = F.lds;
    LAS bf16* tKT = (LAS bf16*)(Lb + 0); LAS bf16* tRT = (LAS bf16*)(Lb + 9216); LAS bf16* tKH = (LAS bf16*)(Lb + 18432); LAS bf16* tBH = (LAS bf16*)(Lb + 27648);
    LAS bf16* tKTT = (LAS bf16*)(Lb + 36864); LAS bf16* tKBT = (LAS bf16*)(Lb + 46080); LAS bf16* tBBT = (LAS bf16*)(Lb + 55296); LAS bf16* tVT = (LAS bf16*)(Lb + 64512);
    LAS float* WA = (LAS float*)(Lb + 73728);
    LAS float* ABK = (LAS float*)(Lb + 73728);
    LAS bf16* tAKK = (LAS bf16*)(Lb + 91136); LAS bf16* tAKRT = (LAS bf16*)(Lb + 100352); LAS bf16* tABRT = (LAS bf16*)(Lb + 109568); LAS bf16* tW = (LAS bf16*)(Lb + 118784);
    LAS float* CLL = (LAS float*)(Lb + 128000);
    LAS bf16* tTT = tKH; LAS bf16* tX = tBH; LAS bf16* tUL = tKT;
    LAS bf16* tE1 = MODE == 0 ? (LAS bf16*)(Lb + 154112) : tKBT; LAS bf16* tE2 = MODE == 0 ? (LAS bf16*)(Lb + 73728) : tBBT;
    const int tid = F.tid, lane = F.lane, w = F.wave, l15 = lane & 15, l4 = lane >> 4;
#ifdef TS_RWC
    unsigned long long tst[12] = {0,0,0,0,0,0,0,0,0,0,0,0}, tprev = __builtin_amdgcn_s_memtime();
#define STG(k) do { const unsigned long long tn_ = __builtin_amdgcn_s_memtime(); tst[k] += tn_ - tprev; tprev = tn_; } while (0)
#else
#define STG(k) do {} while (0)
#endif
    LAS float* cst = (LAS float*)(Lb + LDSX_OFF); LAS bf16* W2L = (LAS bf16*)(Lb + LDSX_OFF + 3584);
    const int pos = tid >> 3, part = tid & 7, ch0 = 8 * part;
    constexpr int IPW = 17;
    const int item_lo = F.vcu * IPW, item_hi = (item_lo + IPW < RW_NITEM) ? item_lo + IPW : RW_NITEM;
    v4u pf_a0, pf_a1, pf_raw[3][3]; int pf_valid = 0;
    v4u pf_s[6];
#define RWC_PREFETCH(itn) do { const int ch_ = (itn) / RW_NCH, c_ = (itn) % RW_NCH, d_ = ch_ >> 4, b_ = (ch_ >> 3) & 1; \
        int R, idx, len, sbase; rw_seq_rows(d_, b_, 64 * c_ + 16 * (w & 3) + l15, R, idx, len, sbase); const bf16* ap = TWAD + (size_t)R * 256 + (w >> 2) * 128 + d_ * 64 + 8 * l4; \
        pf_a0 = *(const GAS v4u*)ap; pf_a1 = *(const GAS v4u*)(ap + 32); } while (0)
#define RWC_LOADRAW(itn) do { const int ch_ = (itn) / RW_NCH, c_ = (itn) % RW_NCH, d_ = ch_ >> 4, b_ = (ch_ >> 3) & 1, h_ = ch_ & 7; \
        int R, idx, len, sbase; rw_seq_rows(d_, b_, 64 * c_ + pos, R, idx, len, sbase); pf_valid = 0; \
        _Pragma("unroll") for (int k = 0; k < 3; ++k) { const int ii = idx + k - 1; const bool ok = ii >= 0 && ii < len; pf_valid |= ok ? (1 << k) : 0; const int iic = ok ? ii : idx; \
            _Pragma("unroll") for (int g = 0; g < 3; ++g) pf_raw[k][g] = *(const GAS v4u*)(RAWb + (size_t)(sbase + iic) * 1536 + g * 512 + h_ * 64 + ch0); } } while (0)
#define RWC_BAR() asm volatile("s_waitcnt lgkmcnt(0)\n\ts_barrier" ::: "memory")
    int cur_chain = -1;
    if (item_lo < item_hi) RWC_PREFETCH(item_lo);
    for (int item = item_lo; item < item_hi; ++item) {
        const int chain = item / RW_NCH, c = item % RW_NCH, d = chain >> 4, b = (chain >> 3) & 1, h = chain & 7;
        int lz = 0; asm volatile("" : "+s"(lz));
        const int tid = F.tid + lz, lane = tid & 63, l15 = lane & 15, l4 = lane >> 4, pos = tid >> 3, part = tid & 7, ch0 = 8 * part;
        RWC_LOADRAW(item);
        RWC_BAR();
        if (chain != cur_chain) {
            cur_chain = chain;
            for (int i = tid; i < 896; i += NTHREADS) {
                float v;
                if (i < 576) v = A.in[I_RW_CONV][((i >> 6) / 3) * 1536 + ((i >> 6) % 3) * 512 + h * 64 + (i & 63)];
                else if (i < 640) v = A.in[I_RW_KK][h * 64 + (i & 63)];
                else if (i < 704) v = A.in[I_RW_KA][h * 64 + (i & 63)];
                else if (i < 768) v = A.in[I_RW_W0][d * 512 + h * 64 + (i & 63)];
                else if (i < 832) v = A.in[I_RW_A0][d * 512 + h * 64 + (i & 63)];
                else v = A.in[I_RW_RK][h * 64 + (i & 63)];
                cst[i] = v;
            }
            for (int i = tid; i < 2 * 64 * 8; i += NTHREADS) {
                const int which = i >> 9, ch = (i >> 3) & 63, pc = i & 7;
                *(LAS v4u*)(W2L + which * (64 * TP) + ch * TP + 8 * pc) = *(const GAS v4u*)(W2T + ((size_t)((which * 2 + d) * 8 + h) * 64 + ch) * 64 + 8 * pc);
            }
            RWC_BAR();
        }
        STG(0);
        {
            const int which = w >> 2, mt = w & 3;
            const bf16x8 a0 = __builtin_bit_cast(bf16x8, pf_a0), a1 = __builtin_bit_cast(bf16x8, pf_a1);
            const LAS bf16* bt = W2L + which * (64 * TP);
#pragma unroll
            for (int nt = 0; nt < 4; ++nt) {
                f32x4 acc = {0.f, 0.f, 0.f, 0.f};
                acc = MFMA16(a0, ldsfrag(bt, 16 * nt + l15, 8 * l4), acc); acc = MFMA16(a1, ldsfrag(bt, 16 * nt + l15, 32 + 8 * l4), acc);
                const float bv = cst[704 + which * 64 + 16 * nt + l15];
#pragma unroll
                for (int r = 0; r < 4; ++r) WA[which * (64 * 65) + (16 * mt + 4 * l4 + r) * 65 + 16 * nt + l15] = acc[r] + bv;
            }
        }
        RWC_BAR();
        STG(1);
        float kkv[8], keyv[8], betv[8], rv[8], vv[8], lamv[8];
        {
            float cv[3][8];
            {
                f32x2v c2[3][4];
#pragma unroll
                for (int g = 0; g < 3; ++g)
#pragma unroll
                    for (int q = 0; q < 4; ++q) c2[g][q] = (f32x2v){0.f, 0.f};
#pragma unroll
                for (int k = 0; k < 3; ++k) { const bool okk = (pf_valid >> k) & 1;
#pragma unroll
                    for (int g = 0; g < 3; ++g) { const unsigned* px = (const unsigned*)&pf_raw[k][g];
                        const LAS f32x2v* cp = (const LAS f32x2v*)(cst + (k * 3 + g) * 64 + ch0);
#pragma unroll
                        for (int q = 0; q < 4; ++q) { const unsigned xw = (k == 1 || okk) ? px[q] : 0u;
                            const f32x2v x2 = {__uint_as_float(xw << 16), __uint_as_float(xw & 0xffff0000u)};
                            c2[g][q] += cp[q] * x2; } } }
#pragma unroll
                for (int g = 0; g < 3; ++g)
#pragma unroll
                    for (int q = 0; q < 4; ++q) { cv[g][2 * q] = c2[g][q].x; cv[g][2 * q + 1] = c2[g][q].y; }
            }
            if (d == 0) {
                float bs = 0.f;
#pragma unroll
                for (int e = 0; e < 8; ++e) bs += cv[0][e] * cv[1][e] * cst[832 + ch0 + e];
                bs = sum8(bs);
                if (part == 0) { int R, idx, len, sbase; rw_seq_rows(d, b, 64 * c + pos, R, idx, len, sbase); ((float*)(ws + WS_SS))[(size_t)R * 8 + h] = bs; }
            }
            float ss = 0.f;
#pragma unroll
            for (int e = 0; e < 8; ++e) { kkv[e] = cv[1][e] * cst[576 + ch0 + e]; ss += kkv[e] * kkv[e]; }
            ss = sum8(ss);
            const float rn = __builtin_amdgcn_rsqf(ss + NORM_EPS);
#pragma unroll
            for (int e = 0; e < 8; ++e) {
                const float wl_ = WA[pos * 65 + ch0 + e], al_ = WA[64 * 65 + pos * 65 + ch0 + e];
                const float a = sigmoidf_(al_); lamv[e] = (0.6065306597126334f * 1.4426950408889634f) * sigmoidf_(wl_);
                kkv[e] *= rn; betv[e] = kkv[e] * a; keyv[e] = cv[1][e] * (1.0f + (a - 1.0f) * cst[640 + ch0 + e]); rv[e] = cv[0][e]; vv[e] = cv[2][e];
                WA[pos * 65 + ch0 + e] = lamv[e];
            }
        }
        RWC_BAR();
        STG(2);
        {
            const int ch = tid >> 3; float x[8]; float run = 0.f;
#pragma unroll
            for (int q = 0; q < 8; ++q) { run += WA[(8 * part + q) * 65 + ch]; x[q] = run; }
            float inc = run;
            { float t_ = dpp_mov<0x111>(inc); if (part >= 1) inc += t_; t_ = dpp_mov<0x112>(inc); if (part >= 2) inc += t_; t_ = dpp_mov<0x114>(inc); if (part >= 4) inc += t_; }
            const float excl = inc - run;
#pragma unroll
            for (int q = 0; q < 8; ++q) WA[(8 * part + q) * 65 + ch] = x[q] + excl;
            if (part == 7) { CLL[ch] = inc; CLL[64 + ch] = __builtin_amdgcn_exp2f(-inc); }
        }
        RWC_BAR();
        STG(3);
        {
            float kt[8], rt[8], kh[8], bh[8], kb[8], bbn[8];
#pragma unroll
            for (int e = 0; e < 8; ++e) {
                const float cl = WA[pos * 65 + ch0 + e];
                const float eI = __builtin_amdgcn_exp2f(cl), eB = eI * CLL[64 + ch0 + e];
                kt[e] = kkv[e] * __builtin_amdgcn_exp2f(lamv[e] - cl); rt[e] = rv[e] * __builtin_amdgcn_exp2f(-cl); kh[e] = keyv[e] * eI; bh[e] = betv[e] * eI; kb[e] = keyv[e] * eB; bbn[e] = -betv[e] * eB;
            }
            v4u o;
            o.x = pk2(kt[0], kt[1]); o.y = pk2(kt[2], kt[3]); o.z = pk2(kt[4], kt[5]); o.w = pk2(kt[6], kt[7]); *(LAS v4u*)(tKT + pos * TP + ch0) = o; *(LAS v4u*)(tKTT + pos * TP + ch0) = o;
            o.x = pk2(rt[0], rt[1]); o.y = pk2(rt[2], rt[3]); o.z = pk2(rt[4], rt[5]); o.w = pk2(rt[6], rt[7]); *(LAS v4u*)(tRT + pos * TP + ch0) = o;
            o.x = pk2(kh[0], kh[1]); o.y = pk2(kh[2], kh[3]); o.z = pk2(kh[4], kh[5]); o.w = pk2(kh[6], kh[7]); *(LAS v4u*)(tKH + pos * TP + ch0) = o;
            o.x = pk2(bh[0], bh[1]); o.y = pk2(bh[2], bh[3]); o.z = pk2(bh[4], bh[5]); o.w = pk2(bh[6], bh[7]); *(LAS v4u*)(tBH + pos * TP + ch0) = o;
            o.x = pk2(vv[0], vv[1]); o.y = pk2(vv[2], vv[3]); o.z = pk2(vv[4], vv[5]); o.w = pk2(vv[6], vv[7]); *(LAS v4u*)(tVT + pos * TP + ch0) = o;
            if (MODE == 0) {
                o.x = pk2(kb[0], kb[1]); o.y = pk2(kb[2], kb[3]); o.z = pk2(kb[4], kb[5]); o.w = pk2(kb[6], kb[7]); *(LAS v4u*)(tKBT + pos * TP + ch0) = o;
                o.x = pk2(bbn[0], bbn[1]); o.y = pk2(bbn[2], bbn[3]); o.z = pk2(bbn[4], bbn[5]); o.w = pk2(bbn[6], bbn[7]); *(LAS v4u*)(tBBT + pos * TP + ch0) = o;
            }
        }
        RWC_BAR();
        STG(4);
        {
            const int st = w & 3;
            if (w < 4) {
                const bf16x8 a0 = ldsfrag(tBH, 16 * st + l15, 8 * l4), a1 = ldsfrag(tBH, 16 * st + l15, 32 + 8 * l4);
#pragma unroll
                for (int tt = 0; tt < 4; ++tt) {
                    f32x4 acc = {0.f, 0.f, 0.f, 0.f};
                    acc = MFMA16(a0, ldsfrag(tKT, 16 * tt + l15, 8 * l4), acc); acc = MFMA16(a1, ldsfrag(tKT, 16 * tt + l15, 32 + 8 * l4), acc);
                    const int t = 16 * tt + l15, s0 = 16 * st + 4 * l4;
#pragma unroll
                    for (int r = 0; r < 4; ++r) if (s0 + r >= t) acc[r] = 0.f;
                    *(LAS f32x4*)(ABK + t * 68 + s0) = acc; *(LAS u32x2v*)(tE1 + t * TP + s0) = pk4(acc);
                    {
                        f32x4 ac2 = {0.f, 0.f, 0.f, 0.f};
                        ac2 = MFMA16(a0, ldsfrag(tRT, 16 * tt + l15, 8 * l4), ac2); ac2 = MFMA16(a1, ldsfrag(tRT, 16 * tt + l15, 32 + 8 * l4), ac2);
#pragma unroll
                        for (int r = 0; r < 4; ++r) ac2[r] = (s0 + r > t) ? 0.f : -ac2[r];
                        *(LAS u32x2v*)(tABRT + t * TP + s0) = pk4(ac2);
                    }
                }
            } else {
                const bf16x8 b0 = ldsfrag(tKH, 16 * st + l15, 8 * l4), b1 = ldsfrag(tKH, 16 * st + l15, 32 + 8 * l4);
#pragma unroll
                for (int tt = 0; tt < 4; ++tt) {
                    f32x4 acc = {0.f, 0.f, 0.f, 0.f};
                    acc = MFMA16(ldsfrag(tKT, 16 * tt + l15, 8 * l4), b0, acc); acc = MFMA16(ldsfrag(tKT, 16 * tt + l15, 32 + 8 * l4), b1, acc);
                    const int s = 16 * st + l15, t0 = 16 * tt + 4 * l4;
#pragma unroll
                    for (int r = 0; r < 4; ++r) if (s >= t0 + r) acc[r] = 0.f;
                    *(LAS u32x2v*)(tAKK + s * TP + t0) = pk4(acc);
                    {
                        f32x4 ac2 = {0.f, 0.f, 0.f, 0.f};
                        ac2 = MFMA16(b0, ldsfrag(tRT, 16 * tt + l15, 8 * l4), ac2); ac2 = MFMA16(b1, ldsfrag(tRT, 16 * tt + l15, 32 + 8 * l4), ac2);
                        const int t = 16 * tt + l15, s0 = 16 * st + 4 * l4;
#pragma unroll
                        for (int r = 0; r < 4; ++r) if (s0 + r > t) ac2[r] = 0.f;
                        *(LAS u32x2v*)(tAKRT + t * TP + s0) = pk4(ac2);
                    }
                }
            }
        }
        RWC_BAR();
        STG(5);
        { const int itn = (item + 1 < item_hi) ? item + 1 : item; RWC_PREFETCH(itn); }
        if (MODE == 1) { const bf16* Sg_ = SCG + (size_t)item * 4096; const int mt_ = w & 3, n0_ = 2 * (w >> 2);
#pragma unroll
            for (int q = 0; q < 2; ++q) { pf_s[2 * q] = *(const GAS v4u*)(Sg_ + (size_t)(16 * (n0_ + q) + l15) * 64 + 8 * l4); pf_s[2 * q + 1] = *(const GAS v4u*)(Sg_ + (size_t)(16 * (n0_ + q) + l15) * 64 + 32 + 8 * l4); }
            pf_s[4] = *(const GAS v4u*)(Sg_ + (size_t)(16 * mt_ + l15) * 64 + 8 * l4); pf_s[5] = *(const GAS v4u*)(Sg_ + (size_t)(16 * mt_ + l15) * 64 + 32 + 8 * l4); }
        if (tid < 128) {
            const int kind = tid >> 6, bb_ = (tid >> 4) & 3, x = tid & 15; float u[16];
            if (kind == 0) {
#pragma unroll
                for (int y = 0; y < 16; ++y) { float s = (y == x) ? 1.f : 0.f; const LAS float* ar = ABK + (16 * bb_ + y) * 68 + 16 * bb_;
#pragma unroll
                    for (int z = 0; z < y; ++z) s -= u[z] * ar[z];
                    u[y] = s; }
            } else {
#pragma unroll
                for (int z = 15; z >= 0; --z) { float s = (z == x) ? 1.f : 0.f;
#pragma unroll
                    for (int z2 = z + 1; z2 < 16; ++z2) s -= ABK[(16 * bb_ + z2) * 68 + 16 * bb_ + z] * u[z2];
                    u[z] = s; }
            }
            LAS bf16* dst = (kind == 0 ? tKT : tKH) + (16 * bb_ + x) * TP;
            const v4u zz = {0u, 0u, 0u, 0u};
#pragma unroll
            for (int q = 0; q < 8; ++q) *(LAS v4u*)(dst + 8 * q) = zz;
            v4u o0, o1; o0.x = pk2(u[0], u[1]); o0.y = pk2(u[2], u[3]); o0.z = pk2(u[4], u[5]); o0.w = pk2(u[6], u[7]); o1.x = pk2(u[8], u[9]); o1.y = pk2(u[10], u[11]); o1.z = pk2(u[12], u[13]); o1.w = pk2(u[14], u[15]);
            asm volatile("" ::: "memory");
            *(LAS v4u*)(dst + 16 * bb_) = o0; *(LAS v4u*)(dst + 16 * bb_ + 8) = o1;
        } else {
            for (int tl = w - 2; tl < 16; tl += 6) { const int it_ = tl >> 2, stl = tl & 3;
                f32x4 acc = {0.f, 0.f, 0.f, 0.f};
                acc = MFMA16(trfrag(tAKK, 16 * stl, 0, l15, l4), trfrag(tVT, 16 * it_, 0, l15, l4), acc); acc = MFMA16(trfrag(tAKK, 16 * stl, 32, l15, l4), trfrag(tVT, 16 * it_, 32, l15, l4), acc);
                *(LAS u32x2v*)(tX + (16 * it_ + l15) * TP + 16 * stl + 4 * l4) = pk4(acc); }
        }
        RWC_BAR();
        STG(10);
        {
            const int mt5 = w & 3, n50 = 2 * (w >> 2);
            const bf16x8 zf = {0, 0, 0, 0, 0, 0, 0, 0};
            {
                bf16x8 a0 = ldsfrag(tE1, 16 * mt5 + l15, 8 * l4), a1 = ldsfrag(tE1, 16 * mt5 + l15, 32 + 8 * l4);
                if (!((mt5 & 1) && (mt5 >> 1) == 0 && l4 < 2)) a0 = zf;
                if (!((mt5 & 1) && (mt5 >> 1) == 1 && l4 < 2)) a1 = zf;
#pragma unroll
                for (int q = 0; q < 2; ++q) { const int nt = n50 + q; f32x4 acc = {0.f, 0.f, 0.f, 0.f};
                    acc = MFMA16(a0, ldsfrag(tKT, 16 * nt + l15, 8 * l4), acc); acc = MFMA16(a1, ldsfrag(tKT, 16 * nt + l15, 32 + 8 * l4), acc);
                    *(LAS u32x2v*)(tE2 + (16 * nt + l15) * TP + 16 * mt5 + 4 * l4) = pk4(acc); }
            }
            RWC_BAR();
            {
                const bf16x8 g0 = ldsfrag(tKH, 16 * mt5 + l15, 8 * l4), g1 = ldsfrag(tKH, 16 * mt5 + l15, 32 + 8 * l4);
                const bf16x8 p0 = ldsfrag(tE2, 16 * mt5 + l15, 8 * l4), p1 = ldsfrag(tE2, 16 * mt5 + l15, 32 + 8 * l4);
                f32x4 accA[2], accB[2];
#pragma unroll
                for (int q = 0; q < 2; ++q) { const int nt = n50 + q;
                    accA[q] = (f32x4){0.f, 0.f, 0.f, 0.f}; accA[q] = MFMA16(g0, ldsfrag(tE2, 16 * nt + l15, 8 * l4), accA[q]); accA[q] = MFMA16(g1, ldsfrag(tE2, 16 * nt + l15, 32 + 8 * l4), accA[q]);
                    accB[q] = (f32x4){0.f, 0.f, 0.f, 0.f}; accB[q] = MFMA16(p0, ldsfrag(tKH, 16 * nt + l15, 8 * l4), accB[q]); accB[q] = MFMA16(p1, ldsfrag(tKH, 16 * nt + l15, 32 + 8 * l4), accB[q]); }
#pragma unroll
                for (int q = 0; q < 2; ++q) { const int nt = n50 + q;
                    { LAS u32x2v* tp = (LAS u32x2v*)(tKT + (16 * nt + l15) * TP + 16 * mt5 + 4 * l4); const u32x2v old = *tp; f32x4 v;
                      v[0] = __uint_as_float(old.x << 16) - accA[q][0]; v[1] = __uint_as_float(old.x & 0xffff0000u) - accA[q][1]; v[2] = __uint_as_float(old.y << 16) - accA[q][2]; v[3] = __uint_as_float(old.y & 0xffff0000u) - accA[q][3]; *tp = pk4(v); }
                    { const u32x2v old = *(const LAS u32x2v*)(tKH + (16 * nt + l15) * TP + 16 * mt5 + 4 * l4); f32x4 v;
                      v[0] = __uint_as_float(old.x << 16) - accB[q][0]; v[1] = __uint_as_float(old.x & 0xffff0000u) - accB[q][1]; v[2] = __uint_as_float(old.y << 16) - accB[q][2]; v[3] = __uint_as_float(old.y & 0xffff0000u) - accB[q][3];
                      *(LAS u32x2v*)(tW + (16 * nt + l15) * TP + 16 * mt5 + 4 * l4) = pk4(v); } }
            }
            RWC_BAR();
            {
                bf16x8 a0 = ldsfrag(tE1, 16 * mt5 + l15, 8 * l4);
                if (mt5 < 2) a0 = zf;
#pragma unroll
                for (int q = 0; q < 2; ++q) { const int nt = n50 + q; f32x4 acc = {0.f, 0.f, 0.f, 0.f};
                    acc = MFMA16(a0, ldsfrag(tKT, 16 * nt + l15, 8 * l4), acc);
                    *(LAS u32x2v*)(tE2 + (16 * nt + l15) * TP + 16 * mt5 + 4 * l4) = pk4(acc); }
            }
            RWC_BAR();
            {
                const bf16x8 p0 = ldsfrag(tE2, 16 * mt5 + l15, 8 * l4), p1 = ldsfrag(tE2, 16 * mt5 + l15, 32 + 8 * l4);
#pragma unroll
                for (int q = 0; q < 2; ++q) { const int nt = n50 + q; f32x4 acc = {0.f, 0.f, 0.f, 0.f};
                    acc = MFMA16(p0, ldsfrag(tW, 16 * nt + l15, 8 * l4), acc); acc = MFMA16(p1, ldsfrag(tW, 16 * nt + l15, 32 + 8 * l4), acc);
                    const u32x2v old = *(const LAS u32x2v*)(tW + (16 * nt + l15) * TP + 16 * mt5 + 4 * l4); f32x4 v;
                    v[0] = __uint_as_float(old.x << 16) - acc[0]; v[1] = __uint_as_float(old.x & 0xffff0000u) - acc[1]; v[2] = __uint_as_float(old.y << 16) - acc[2]; v[3] = __uint_as_float(old.y & 0xffff0000u) - acc[3];
                    *(LAS u32x2v*)(tTT + (16 * nt + l15) * TP + 16 * mt5 + 4 * l4) = pk4(v); }
            }
        }
        RWC_BAR();
        STG(6);
        if (w < 4) {
            const bf16x8 a0 = MODE == 0 ? ldsfrag(tTT, 16 * w + l15, 8 * l4) : trfrag(tKTT, 16 * w, 0, l15, l4), a1 = MODE == 0 ? ldsfrag(tTT, 16 * w + l15, 32 + 8 * l4) : trfrag(tKTT, 16 * w, 32, l15, l4);
#pragma unroll
            for (int nt = 0; nt < 4; ++nt) {
                f32x4 acc = {0.f, 0.f, 0.f, 0.f};
                const bf16x8 b0 = MODE == 0 ? trfrag(tKTT, 16 * nt, 0, l15, l4) : ldsfrag(tTT, 16 * nt + l15, 8 * l4), b1 = MODE == 0 ? trfrag(tKTT, 16 * nt, 32, l15, l4) : ldsfrag(tTT, 16 * nt + l15, 32 + 8 * l4);
                acc = MFMA16(a0, b0, acc); acc = MFMA16(a1, b1, acc);
                *(LAS u32x2v*)(tW + (16 * nt + l15) * TP + 16 * w + 4 * l4) = pk4(acc);
            }
        } else {
            const int mtu = w - 4;
            const bf16x8 a0 = ldsfrag(tTT, 16 * mtu + l15, 8 * l4), a1 = ldsfrag(tTT, 16 * mtu + l15, 32 + 8 * l4);
#pragma unroll
            for (int nt = 0; nt < 4; ++nt) {
                f32x4 acc = {0.f, 0.f, 0.f, 0.f};
                acc = MFMA16(a0, ldsfrag(tX, 16 * nt + l15, 8 * l4), acc); acc = MFMA16(a1, ldsfrag(tX, 16 * nt + l15, 32 + 8 * l4), acc);
                *(LAS u32x2v*)(tUL + (16 * nt + l15) * TP + 16 * mtu + 4 * l4) = pk4(acc);
            }
        }
        STG(7);
        const int mt = w & 3, nt0 = 2 * (w >> 2);
        RWC_BAR();
        STG(8);
        if (MODE == 0) {
            const bf16x8 k0 = trfrag(tKBT, 16 * mt, 0, l15, l4), k1 = trfrag(tKBT, 16 * mt, 32, l15, l4), bb0 = trfrag(tBBT, 16 * mt, 0, l15, l4), bb1 = trfrag(tBBT, 16 * mt, 32, l15, l4);
            const bf16x8 w0 = ldsfrag(tW, 16 * mt + l15, 8 * l4), w1 = ldsfrag(tW, 16 * mt + l15, 32 + 8 * l4);
            const bf16x8 v0 = trfrag(tVT, 16 * mt, 0, l15, l4), v1 = trfrag(tVT, 16 * mt, 32, l15, l4), u0 = ldsfrag(tUL, 16 * mt + l15, 8 * l4), u1 = ldsfrag(tUL, 16 * mt + l15, 32 + 8 * l4);
            bf16* YRW = d == 0 ? (bf16*)(ws + R_YRW0) : (bf16*)((unsigned char*)F.out + DO_YRW1);
            bf16* RWTG = (bf16*)((unsigned char*)F.out + DO_CST);
#pragma unroll
            for (int q = 0; q < 2; ++q) { const int nt = nt0 + q;
                f32x4 acc = {0.f, 0.f, 0.f, 0.f};
                acc = MFMA16(k0, trfrag(tVT, 16 * nt, 0, l15, l4), acc); acc = MFMA16(k1, trfrag(tVT, 16 * nt, 32, l15, l4), acc);
                acc = MFMA16(bb0, ldsfrag(tUL, 16 * nt + l15, 8 * l4), acc); acc = MFMA16(bb1, ldsfrag(tUL, 16 * nt + l15, 32 + 8 * l4), acc);
                *(u32x2v*)(NCG + ((size_t)item * 64 + 16 * nt + l15) * 64 + 16 * mt + 4 * l4) = pk4(acc);
                f32x4 ac2 = {0.f, 0.f, 0.f, 0.f};
                ac2 = MFMA16(w0, trfrag(tBBT, 16 * nt, 0, l15, l4), ac2); ac2 = MFMA16(w1, trfrag(tBBT, 16 * nt, 32, l15, l4), ac2);
                *(u32x2v*)(LCT + ((size_t)item * 64 + 16 * nt + l15) * 64 + 32 * (mt >> 1) + 8 * l4 + 4 * (mt & 1)) = pk4(ac2);
                const bf16x8 ab0 = ldsfrag(tABRT, 16 * nt + l15, 8 * l4), ab1 = ldsfrag(tABRT, 16 * nt + l15, 32 + 8 * l4);
                { const u32x2v rr = *(const LAS u32x2v*)(tRT + (16 * nt + l15) * TP + 16 * mt + 4 * l4);
                  f32x4 a3 = {__uint_as_float(rr.x << 16), __uint_as_float(rr.x & 0xffff0000u), __uint_as_float(rr.y << 16), __uint_as_float(rr.y & 0xffff0000u)};
                  a3 = MFMA16(w0, ab0, a3); a3 = MFMA16(w1, ab1, a3);
                  *(u32x2v*)(RWTG + ((size_t)item * 64 + 16 * nt + l15) * 64 + 16 * mt + 4 * l4) = pk4(a3); }
                { f32x4 a4 = {0.f, 0.f, 0.f, 0.f};
                  a4 = MFMA16(v0, ldsfrag(tAKRT, 16 * nt + l15, 8 * l4), a4); a4 = MFMA16(v1, ldsfrag(tAKRT, 16 * nt + l15, 32 + 8 * l4), a4);
                  a4 = MFMA16(u0, ab0, a4); a4 = MFMA16(u1, ab1, a4);
                  int R, idx, len, sbase; rw_seq_rows(d, b, 64 * c + 16 * nt + l15, R, idx, len, sbase);
                  *(u32x2v*)(YRW + (size_t)R * 512 + h * 64 + 16 * mt + 4 * l4) = pk4(a4); }
            }
            if (tid < 64) PLG[(size_t)item * 64 + tid] = CLL[64 + tid];
        } else {
            {
                const bf16x8 a0 = ldsfrag(tW, 16 * mt + l15, 8 * l4), a1 = ldsfrag(tW, 16 * mt + l15, 32 + 8 * l4);
#pragma unroll
                for (int q = 0; q < 2; ++q) { const int nt = nt0 + q;
                    f32x4 acc = {0.f, 0.f, 0.f, 0.f};
                    acc = MFMA16(a0, __builtin_bit_cast(bf16x8, pf_s[2 * q]), acc); acc = MFMA16(a1, __builtin_bit_cast(bf16x8, pf_s[2 * q + 1]), acc);
                    LAS u32x2v* up = (LAS u32x2v*)(tUL + (16 * nt + l15) * TP + 16 * mt + 4 * l4); const u32x2v ul = *up;
                    acc[0] += __uint_as_float(ul.x << 16); acc[1] += __uint_as_float(ul.x & 0xffff0000u); acc[2] += __uint_as_float(ul.y << 16); acc[3] += __uint_as_float(ul.y & 0xffff0000u);
                    *up = pk4(acc);
                }
            }
            RWC_BAR();
            {
                bf16* YRW = d == 0 ? (bf16*)(ws + R_YRW0) : (bf16*)((unsigned char*)F.out + DO_YRW1);
                const bf16x8 s0 = __builtin_bit_cast(bf16x8, pf_s[4]), s1 = __builtin_bit_cast(bf16x8, pf_s[5]);
                const bf16x8 v0 = trfrag(tVT, 16 * mt, 0, l15, l4), v1 = trfrag(tVT, 16 * mt, 32, l15, l4), u0 = ldsfrag(tUL, 16 * mt + l15, 8 * l4), u1 = ldsfrag(tUL, 16 * mt + l15, 32 + 8 * l4);
#pragma unroll
                for (int q = 0; q < 2; ++q) { const int nt = nt0 + q;
                    f32x4 acc = {0.f, 0.f, 0.f, 0.f};
                    acc = MFMA16(s0, ldsfrag(tRT, 16 * nt + l15, 8 * l4), acc); acc = MFMA16(s1, ldsfrag(tRT, 16 * nt + l15, 32 + 8 * l4), acc);
                    acc = MFMA16(v0, ldsfrag(tAKRT, 16 * nt + l15, 8 * l4), acc); acc = MFMA16(v1, ldsfrag(tAKRT, 16 * nt + l15, 32 + 8 * l4), acc);
                    acc = MFMA16(u0, ldsfrag(tABRT, 16 * nt + l15, 8 * l4), acc); acc = MFMA16(u1, ldsfrag(tABRT, 16 * nt + l15, 32 + 8 * l4), acc);
                    int R, idx, len, sbase; rw_seq_rows(d, b, 64 * c + 16 * nt + l15, R, idx, len, sbase);
                    *(u32x2v*)(YRW + (size_t)R * 512 + h * 64 + 16 * mt + 4 * l4) = pk4(acc);
                }
            }
        }
        STG(9);
    }
#ifdef TS_RWC
    if (MODE == TS_RWC - 1 && blockIdx.x == 0 && F.tid == 0) { unsigned long long* ts = (unsigned long long*)(ws + WS_CTL + 512 * 1024); for (int k = 0; k < 11; ++k) ts[40 + k] = tst[k] / 10; }
#endif
#undef STG
#undef RWC_PREFETCH
#undef RWC_LOADRAW
#undef RWC_BAR
    __syncthreads();
}

#ifdef TS_PASSB
#define TSB(...) __VA_ARGS__
#else
#define TSB(...)
#endif
__device__ __forceinline__ void rw_pass_b(Frame& F, const Args& A) {
    constexpr int TP = 72, SLOT = 2 * 64 * TP * 2 + 256;
    unsigned char* ws = F.ws;
    const bf16* LCT = (const bf16*)(ws + RW_LCT); const bf16* NCG = (const bf16*)(ws + RW_NC); const float* PLG = (const float*)(ws + RW_PL);
    const int lane = F.lane, w = F.wave, l15 = lane & 15, l4 = lane >> 4;
    const bool spread = (F.G >= 256) && (F.G % 2 == 0);
    const int pair0 = spread ? ((F.vcu & 1) ? 4 * NCHAIN_RW : (F.vcu >> 1)) : F.vcu, pstep = spread ? (F.G >> 1) : F.G;
#define RWB_BAR() asm volatile("s_waitcnt lgkmcnt(0)\n\ts_barrier" ::: "memory")
    for (int pair = pair0; pair < 4 * NCHAIN_RW; pair += pstep) {
        const int chain = pair >> 2, nt = pair & 3;
        const size_t it0 = (size_t)chain * RW_NCH;
        __syncthreads();
        if (w == 0) {
            f32x4 acc[4];
#pragma unroll
            for (int m = 0; m < 4; ++m) acc[m] = (f32x4){0.f, 0.f, 0.f, 0.f};
            bf16* sg = (bf16*)(ws + RW_NC) + it0 * 4096 + (size_t)(16 * nt + l15) * 64 + 4 * l4; const size_t sdummy = ((size_t)RW_NITEM - it0) * 4096;
            struct OpRegs { bf16x8 a[4][2]; f32x4 pl[4]; u32x2v nc[4]; };
            OpRegs RA, RB;
#define RWB_FETCH(R, slot) do { const LAS bf16* Ls = (const LAS bf16*)(F.lds + (slot) * SLOT); const LAS bf16* Ns = Ls + 64 * TP; const LAS float* Ps = (const LAS float*)(F.lds + (slot) * SLOT + 2 * 64 * TP * 2); \
            _Pragma("unroll") for (int m = 0; m < 4; ++m) { R.a[m][0] = ldsfrag(Ls, 16 * m + l15, 8 * l4); R.a[m][1] = ldsfrag(Ls, 16 * m + l15, 32 + 8 * l4); \
                R.pl[m] = *(const LAS f32x4*)(Ps + 16 * m + 4 * l4); R.nc[m] = *(const LAS u32x2v*)(Ns + l15 * TP + 16 * m + 4 * l4); } } while (0)
#define RWB_STEP(CUR, NXT, cc, nslot) do { u32x2v sb[4]; TSB(tq0 = __builtin_amdgcn_s_memtime(); tacc2 += tq0 - tq2;) \
            _Pragma("unroll") for (int m = 0; m < 4; ++m) { sb[m] = pk4(acc[m]); *(u32x2v*)(sg + ((cc) > 0 ? (size_t)((cc) - 1) * 4096 : sdummy) + 16 * m) = sb[m]; } \
            const v4u q0 = {sb[0].x, sb[0].y, sb[1].x, sb[1].y}, q1 = {sb[2].x, sb[2].y, sb[3].x, sb[3].y}; \
            const bf16x8 b0 = __builtin_bit_cast(bf16x8, q0), b1 = __builtin_bit_cast(bf16x8, q1); \
            f32x4 dl[4]; \
            _Pragma("unroll") for (int m = 0; m < 4; ++m) { dl[m] = (f32x4){0.f, 0.f, 0.f, 0.f}; dl[m] = MFMA16(CUR.a[m][0], b0, dl[m]); dl[m] = MFMA16(CUR.a[m][1], b1, dl[m]); } \
            TSB(asm volatile("" :: "v"(dl[0]), "v"(dl[1]), "v"(dl[2]), "v"(dl[3])); tq1 = __builtin_amdgcn_s_memtime(); tacc0 += tq1 - tq0;) RWB_BAR(); TSB(tq2 = __builtin_amdgcn_s_memtime(); tacc1 += tq2 - tq1;) RWB_FETCH(NXT, nslot); \
            _Pragma("unroll") for (int m = 0; m < 4; ++m) { \
                acc[m][0] = acc[m][0] * CUR.pl[m][0] + dl[m][0] + __uint_as_float(CUR.nc[m].x << 16); acc[m][1] = acc[m][1] * CUR.pl[m][1] + dl[m][1] + __uint_as_float(CUR.nc[m].x & 0xffff0000u); \
                acc[m][2] = acc[m][2] * CUR.pl[m][2] + dl[m][2] + __uint_as_float(CUR.nc[m].y << 16); acc[m][3] = acc[m][3] * CUR.pl[m][3] + dl[m][3] + __uint_as_float(CUR.nc[m].y & 0xffff0000u); } } while (0)
            RWB_BAR();
            TSB(unsigned long long tq0 = 0, tq1 = 0, tq2 = __builtin_amdgcn_s_memtime(), tacc0 = 0, tacc1 = 0, tacc2 = 0;)
            RWB_FETCH(RA, 0);
            for (int c6 = 0; c6 < RW_NCH; c6 += 6) {
                RWB_STEP(RA, RB, c6 + 0, 1); RWB_STEP(RB, RA, c6 + 1, 2); RWB_STEP(RA, RB, c6 + 2, 0);
                RWB_STEP(RB, RA, c6 + 3, 1); RWB_STEP(RA, RB, c6 + 4, 2); RWB_STEP(RB, RA, c6 + 5, 0);
            }
            TSB(if (blockIdx.x == 0 && F.tid == 0) { unsigned long long* ts = (unsigned long long*)(ws + WS_CTL + 512 * 1024); ts[40] = tacc0 / 10; ts[41] = tacc1 / 10; ts[42] = tacc2 / 10; })
#undef RWB_FETCH
#undef RWB_STEP
        } else if (w < 4) {
            RWB_BAR();
            for (int c = 0; c < RW_NCH; ++c) RWB_BAR();
        } else {
            const int t = F.tid - 256, row = t >> 2, cp = (t & 3) * 16;
            v4u L0[6], L1[6], N0[6], P0[6];
#define RWB_LOADG(k, cc) do { const size_t it_ = it0 + ((cc) < RW_NCH ? (cc) : RW_NCH - 1); \
            L0[k] = *(const GAS v4u*)(LCT + it_ * 4096 + t * 16); L1[k] = *(const GAS v4u*)(LCT + it_ * 4096 + t * 16 + 8); \
            if (t < 128) N0[k] = *(const GAS v4u*)(NCG + (it_ * 64 + 16 * nt + (t >> 3)) * 64 + 8 * (t & 7)); \
            if (t < 16) P0[k] = *(const GAS v4u*)(PLG + it_ * 64 + 4 * t); } while (0)
#define RWB_WRITEL(k, slot) do { LAS bf16* Ls = (LAS bf16*)(F.lds + (slot) * SLOT); LAS bf16* Ns = Ls + 64 * TP; \
            *(LAS v4u*)(Ls + row * TP + cp) = L0[k]; *(LAS v4u*)(Ls + row * TP + cp + 8) = L1[k]; if (t < 128) *(LAS v4u*)(Ns + (t >> 3) * TP + 8 * (t & 7)) = N0[k]; \
            if (t < 16) *(LAS v4u*)(F.lds + (slot) * SLOT + 2 * 64 * TP * 2 + 16 * t) = P0[k]; } while (0)
#pragma unroll
            for (int k = 0; k < 6; ++k) RWB_LOADG(k, k);
            RWB_WRITEL(0, 0); RWB_LOADG(0, 6); RWB_WRITEL(1, 1); RWB_LOADG(1, 7);
            RWB_BAR();
            TSB(unsigned long long lq0 = 0, lq1 = 0, lq2 = __builtin_amdgcn_s_memtime(), lacc0 = 0, lacc1 = 0, lacc2 = 0;)
            for (int c6 = 0; c6 < RW_NCH; c6 += 6) {
#pragma unroll
                for (int k = 0; k < 6; ++k) {
                    TSB(lq0 = __builtin_amdgcn_s_memtime(); lacc2 += lq0 - lq2;) RWB_BAR(); TSB(lq1 = __builtin_amdgcn_s_memtime(); lacc0 += lq1 - lq0;)
                    RWB_WRITEL((k + 2) % 6, (k + 2) % 3); TSB(asm volatile("s_waitcnt lgkmcnt(0)" ::: "memory"); lq2 = __builtin_amdgcn_s_memtime(); lacc1 += lq2 - lq1;) RWB_LOADG((k + 2) % 6, c6 + k + 8);
                }
            }
            TSB(if (blockIdx.x == 0 && t == 0) { unsigned long long* ts = (unsigned long long*)(ws + WS_CTL + 512 * 1024); ts[44] = lacc0 / 10; ts[45] = lacc1 / 10; ts[46] = lacc2 / 10; })
#undef RWB_LOADG
#undef RWB_WRITEL
        }
    }
#undef RWB_BAR
    __syncthreads();
}

__device__ __forceinline__ void rw_pass_c2(Frame& F, const Args& A) {
    unsigned char* ws = F.ws;
    const bf16* NCG = (const bf16*)(ws + RW_NC); const bf16* RWTG = (const bf16*)((unsigned char*)F.out + DO_CST);
    const int lane = F.lane, l15 = lane & 15, l4 = lane >> 4;
    const int gw = F.vcu * NWAVES + F.wave, nw = F.G * NWAVES;
    const int srow = 4 * (((l15 >> 2) & 1) * 2 + (l15 >> 3)) + (l15 & 3);
    const int ycol = 16 * (l4 >> 1) + 8 * (l4 & 1);
    for (int u = gw; u < RW_NITEM * 4; u += nw) {
        const int item = u >> 2, nt = u & 3;
        const int chain = item / RW_NCH, c = item % RW_NCH, d = chain >> 4, b = (chain >> 3) & 1, h = chain & 7;
        if (c == 0) continue;
        bf16* YRW = d == 0 ? (bf16*)(ws + R_YRW0) : (bf16*)((unsigned char*)F.out + DO_YRW1);
        int R, idx, len, sbase; rw_seq_rows(d, b, 64 * c + 16 * nt + l15, R, idx, len, sbase);
        bf16* yp = YRW + (size_t)R * 512 + h * 64 + ycol;
        const bf16* rp = RWTG + ((size_t)item * 64 + 16 * nt + l15) * 64 + 8 * l4;
        const bf16* sp = NCG + (size_t)(item - 1) * 4096 + srow * 64 + 8 * l4;
        const v4u b0 = *(const GAS v4u*)rp, b1 = *(const GAS v4u*)(rp + 32);
        v4u a0[4], a1[4], cq[2];
#pragma unroll
        for (int mt = 0; mt < 4; ++mt) { a0[mt] = *(const GAS v4u*)(sp + mt * 1024); a1[mt] = *(const GAS v4u*)(sp + mt * 1024 + 32); }
#pragma unroll
        for (int p = 0; p < 2; ++p) cq[p] = *(const GAS v4u*)(yp + 32 * p);
#pragma unroll
        for (int p = 0; p < 2; ++p) {
            unsigned ax = cq[p].x, ay = cq[p].y, bx = cq[p].z, by = cq[p].w;
            { auto r = __builtin_amdgcn_permlane32_swap(ax, bx, false, false); ax = r[0]; bx = r[1]; } { auto r = __builtin_amdgcn_permlane32_swap(ay, by, false, false); ay = r[0]; by = r[1]; }
            f32x4 accA = {__uint_as_float(ax << 16), __uint_as_float(ax & 0xffff0000u), __uint_as_float(ay << 16), __uint_as_float(ay & 0xffff0000u)};
            f32x4 accB = {__uint_as_float(bx << 16), __uint_as_float(bx & 0xffff0000u), __uint_as_float(by << 16), __uint_as_float(by & 0xffff0000u)};
            accA = MFMA16(__builtin_bit_cast(bf16x8, a0[2 * p]), __builtin_bit_cast(bf16x8, b0), accA); accA = MFMA16(__builtin_bit_cast(bf16x8, a1[2 * p]), __builtin_bit_cast(bf16x8, b1), accA);
            accB = MFMA16(__builtin_bit_cast(bf16x8, a0[2 * p + 1]), __builtin_bit_cast(bf16x8, b0), accB); accB = MFMA16(__builtin_bit_cast(bf16x8, a1[2 * p + 1]), __builtin_bit_cast(bf16x8, b1), accB);
            u32x2v pa = pk4(accA), pb = pk4(accB);
            { auto r = __builtin_amdgcn_permlane32_swap(pa.x, pb.x, false, false); pa.x = r[0]; pb.x = r[1]; } { auto r = __builtin_amdgcn_permlane32_swap(pa.y, pb.y, false, false); pa.y = r[0]; pb.y = r[1]; }
            const v4u o = {pa.x, pa.y, pb.x, pb.y};
            *(GAS v4u*)(yp + 32 * p) = o;
        }
    }
    __syncthreads();
}
#ifndef MK_N_LAUNCHES
#define MK_N_LAUNCHES 1
#endif
constexpr int NPHASE = 23;
#ifndef PHMASK
#define PHMASK 0xffffffffu
#endif
#define PH_ON(k) (((PHMASK) >> (k)) & 1u)
__global__ void __launch_bounds__(NTHREADS, 2) mk_fwd(Args args) {
    extern __shared__ __attribute__((aligned(16))) unsigned char lds[];
    Frame F;
    F.lds = (LAS unsigned char*)lds;
    F.MISC = (volatile LAS unsigned*)(F.lds + MISC_OFF);
    F.tid = threadIdx.x; F.lane = F.tid & 63; F.wave = __builtin_amdgcn_readfirstlane(F.tid >> 6);
    F.G = gridDim.x; { const int bx = blockIdx.x; F.vcu = (F.G % 8 == 0) ? (bx % 8) * (F.G / 8) + bx / 8 : bx; }
    F.ws = args.ws; F.out = args.out; const Args& A = args;
    unsigned char* ws = args.ws;
    F.ctl = (gu32*)(ws + WS_CTL);
    for (int u = F.tid; u < (LDS_BYTES - LDSCTL_OFF) / 4; u += NTHREADS) ((LAS unsigned*)(F.lds + LDSCTL_OFF))[u] = 0u;
    __syncthreads();
    const bool use_bar = (args.ph_hi - args.ph_lo) > 1;
    XcdBarrier bar; bar.bar = (unsigned*)(F.ctl + CW_BAR) + args.li * XCD_BAR_WORDS; bar.x = 0; bar.st = nullptr;
    if (use_bar) bar = xcd_barrier_post((unsigned*)(F.ctl + CW_BAR) + args.li * XCD_BAR_WORDS, F.MISC + 8);
    const float* MOD = (const float*)(ws + WS_MOD);
    bf16* XN = (bf16*)(ws + WS_XN);
    float* XC = (float*)(ws + WS_XC);
    const int bid = (int)blockIdx.x;
    const int lo = args.ph_lo, hi = args.ph_hi;
#define IN(k) (PH_ON(k) && lo <= (k) && (k) < hi)
#ifdef TS_A
#define TSTAMP(i) do { if (blockIdx.x == TS_BLK && F.tid == 0) ((unsigned long long*)(ws + WS_CTL + 512 * 1024))[i] = __builtin_amdgcn_s_memrealtime(); } while (0)
#else
#define TSTAMP(i) do {} while (0)
#endif
#ifndef TS_OFF
#define TS_OFF 0
#endif
#ifndef TS_BLK
#define TS_BLK 0
#endif
#define SEAM(k) do { if ((k) + 1 < hi) xcd_barrier(bar); TSTAMP((k) + 1); } while (0)
    TSTAMP(0);
    if (IN(0)) { p0_prologue(F, A); SEAM(0); }
    if (IN(1)) { p1_mod_finalize(F, A); SEAM(1); }
    if (IN(2)) { norm_rows(F, A, A.in[I_X], A.in[I_CTX], MA_ROWS, A.in[I_NORM_MIX], MOD, 0, 1, XN); SEAM(2); }
    if (IN(3)) { { const pg8::RecInDst rd{(bf16*)(ws + R_QM), (R_KM - R_QM) / 2, (R_VM - R_QM) / 2, (R_OM - R_QM) / 2, (bf16*)(ws + R_RAW), (bf16*)(ws + R_TWAD), (bf16*)(ws + R_SGD), (float*)(ws + R_GATES)};
            { pg8::Gemm g{XN, (const bf16*)(ws + WS_WREC), ML_ROWS, REC_N, D}; pg8::StaticOrder S; S.init(ML_ROWS, REC_N, F.G, bid);
              pg8::EpiRecIn E{rd};
              pg8::gemm_phase<pg8::EpiRecIn, pg8::StaticOrder, true, true>(F.lds + RING_OFF, g, S, E); }
            ctx_gemm2(F, XN + (size_t)ML_ROWS * D, D, (const bf16*)(ws + WS_WREC), D, MC_ROWS, REC_N, D, [=](int row, int col, float v) { pg8::recin_store1(rd, (size_t)(ML_ROWS + row), col, v); });
        } SEAM(3); }
    if (IN(4)) { ml_pass_a(F, A); p0_weights_tail<3>(F, A, NITEM_ML, F.vcu); SEAM(4); }
    if (IN(5)) { ml_pass_b(F, A); SEAM(5); }
    if (IN(6)) { ml_pass_c(F, A); p0_weights_tail<4>(F, A, NITEM_ML, F.vcu); SEAM(6); }
    if (IN(7)) { rw_chunk_pass<0>(F, A); SEAM(7); }
    if (IN(8)) { rw_pass_b(F, A);
            { const bool spread = (F.G >= 256) && (F.G % 2 == 0);
              if (!spread || (F.vcu & 1)) {
                int kg = 128; asm volatile("" : "+s"(kg)); pg8::Gemm g{(const bf16*)(ws + R_SGD), (const bf16*)(ws + WS_WG2), MA_ROWS, 512, kg}; pg8::StaticOrder S; S.init(MA_ROWS, 512, spread ? F.G / 2 : F.G, spread ? (F.vcu >> 1) : F.vcu);
                pg8::EpiStoreBf16<1536> E{(bf16*)(ws + R_RAW), 0, 1.f};
                pg8::gemm_phase<pg8::EpiStoreBf16<1536>, pg8::StaticOrder, true, true>(F.lds + RING_OFF, g, S, E); } }
        SEAM(8); }
    if (IN(9)) { rw_pass_c2(F, A); SEAM(9); }
    if (IN(10)) { merge_rows(F, A); SEAM(10); }
    if (IN(11)) { { pg8::Gemm g{(const bf16*)(ws + R_MIX), (const bf16*)(ws + WS_WOUT), ML_ROWS, D, D}; pg8::StaticOrder S; S.init(ML_ROWS, D, F.G, bid);
            pg8::EpiResid E{A.in[I_X], A.in[I_CTX], F.out, XC, MOD + 2 * 1024};
            pg8::gemm_phase<pg8::EpiResid, pg8::StaticOrder, true, true>(F.lds + RING_OFF, g, S, E);
            { const float* src = A.in[I_CTX]; const float* gate = MOD + 2 * 6144 + 2 * 1024;
              ctx_gemm2(F, (const bf16*)(ws + R_MIX) + (size_t)ML_ROWS * D, D, (const bf16*)(ws + WS_WOUT), D, MC_ROWS, D, D, [=](int row, int col, float v) { XC[(size_t)row * D + col] = src[(size_t)row * D + col] + gate[col] * v; }); } } SEAM(11); }
    if (IN(12)) { norm_rows(F, A, F.out, XC, MA_ROWS, A.in[I_NORM_FFN], MOD, 3, 4, XN); SEAM(12); }
    if (IN(13)) { { pg8::Gemm g{XN, (const bf16*)(ws + WS_W1), MA_ROWS, FF, D}; pg8::StaticOrder S; S.init(MA_ROWS, FF, F.G, bid);
            pg8::EpiSqRelu<FF> E{(bf16*)(ws + R_H)};
            pg8::gemm_phase<pg8::EpiSqRelu<FF>, pg8::StaticOrder, true, true>(F.lds + RING_OFF, g, S, E);
            p0_weights_tail<1>(F, A, (MA_ROWS / 256) * (FF / 256), bid); } SEAM(13); }
    if (IN(14)) { { pg8::Gemm g{(const bf16*)(ws + R_H), (const bf16*)(ws + WS_W2), ML_ROWS, D, FF}; pg8::StaticOrder S; S.init(ML_ROWS, D, F.G, bid);
            pg8::EpiResid E{F.out, XC, F.out, XC, MOD + 5 * 1024};
            pg8::gemm_phase<pg8::EpiResid, pg8::StaticOrder, true, true>(F.lds + RING_OFF, g, S, E);
            { const float* gate = MOD + 2 * 6144 + 5 * 1024; TSTAMP(40);
              ctx_gemm(F, (const bf16*)(ws + R_H) + (size_t)ML_ROWS * FF, FF, (const bf16*)(ws + WS_W2), FF, MC_ROWS, D, FF, [=](int row, int col, float v) { XC[(size_t)row * D + col] += gate[col] * v; }); TSTAMP(41); } } SEAM(14); }
    if (IN(15)) { norm_rows(F, A, F.out, XC, MA_ROWS, A.in[I_NORM_MIX] + D, MOD + 3 * 6144, 0, 1, XN); SEAM(15); }
    if (IN(16)) { { pg8::Gemm g{XN, (const bf16*)(ws + WS_WATT), MA_ROWS, ATT_N, D}; pg8::StaticOrder S; S.init(MA_ROWS, ATT_N, F.G, bid);
            pg8::EpiStoreBf16<ATT_N> E{(bf16*)(ws + R_ATT), 0, 1.f};
            pg8::gemm_phase<pg8::EpiStoreBf16<ATT_N>, pg8::StaticOrder, true, true>(F.lds + RING_OFF, g, S, E);
            p0_weights_tail<2>(F, A, (MA_ROWS / 256) * (ATT_N / 256), bid); } SEAM(16); }
    if (IN(17)) { qk_prep(F, A); SEAM(17); }
    if (IN(18)) { attn_phase(F, A, (char*)lds + RING_OFF); SEAM(18); }
    if (IN(19)) { { pg8::Gemm g{(const bf16*)(ws + R_QB), (const bf16*)(ws + WS_WOUT) + (size_t)D * D, ML_ROWS, D, D}; pg8::StaticOrder S; S.init(ML_ROWS, D, F.G, bid);
            pg8::EpiResid E{F.out, XC, F.out, XC, MOD + 3 * 6144 + 2 * 1024};
            pg8::gemm_phase<pg8::EpiResid, pg8::StaticOrder, true, true>(F.lds + RING_OFF, g, S, E); } SEAM(19); }
    if (IN(20)) { norm_rows(F, A, F.out, XC, ML_ROWS, A.in[I_NORM_FFN] + D, MOD + 3 * 6144, 3, 4, XN); SEAM(20); }
    if (IN(21)) { { pg8::Gemm g{XN, (const bf16*)(ws + WS_W1) + (size_t)D * FF, ML_ROWS, FF, D}; pg8::StaticOrder S; S.init(ML_ROWS, FF, F.G, bid);
            pg8::EpiSqRelu<FF> E{(bf16*)(ws + R_H)};
            pg8::gemm_phase<pg8::EpiSqRelu<FF>, pg8::StaticOrder, true, true>(F.lds + RING_OFF, g, S, E); } SEAM(21); }
    if (IN(22)) { { pg8::Gemm g{(const bf16*)(ws + R_H), (const bf16*)(ws + WS_W2) + (size_t)D * FF, ML_ROWS, D, FF}; pg8::StaticOrder S; S.init(ML_ROWS, D, F.G, bid);
            pg8::EpiResid E{F.out, XC, F.out, XC, MOD + 3 * 6144 + 5 * 1024};
            pg8::gemm_phase<pg8::EpiResid, pg8::StaticOrder, true, true>(F.lds + RING_OFF, g, S, E); } SEAM(22); }
#ifdef TS_A
    if (blockIdx.x == TS_BLK && F.tid == 0) { const unsigned long long* ts = (const unsigned long long*)(ws + WS_CTL + 512 * 1024);
        __builtin_amdgcn_s_waitcnt(0); F.out[0] += ((float)(ts[TS_B] - ts[TS_A]) - (float)(TS_OFF)) * 0.001f; }
#endif
#undef IN
#undef SEAM
}

extern "C" void kernel_launch(void* const* d_in, const int* in_sizes, int n_in, void* d_out, int out_size, void* d_ws, size_t ws_size, hipStream_t stream) {
    static int grid = 0;
    if (grid == 0) {
        if (n_in != N_IN || out_size != ML_ROWS * D || ws_size < WS_END) { fprintf(stderr, "kernel_launch: unexpected shapes (n_in %d, out %d, ws %zu); nothing launched\n", n_in, out_size, ws_size); grid = -1; return; }
        int dev = 0, cus = 0, per_cu = 0;
        if (hipGetDevice(&dev) != hipSuccess || hipDeviceGetAttribute(&cus, hipDeviceAttributeMultiprocessorCount, dev) != hipSuccess) { grid = -1; return; }
        if (hipFuncSetAttribute((const void*)mk_fwd, hipFuncAttributeMaxDynamicSharedMemorySize, LDS_BYTES) != hipSuccess) { fprintf(stderr, "kernel_launch: hipFuncSetAttribute failed\n"); grid = -1; return; }
        if (hipOccupancyMaxActiveBlocksPerMultiprocessor(&per_cu, (const void*)mk_fwd, NTHREADS, LDS_BYTES) != hipSuccess || per_cu < 1) { fprintf(stderr, "kernel_launch: occupancy query says %d blocks per CU\n", per_cu); per_cu = 1; }
        (void)hipGetLastError();
        grid = cus;
    }
    if (grid < 0) return;
    (void)hipMemsetAsync((char*)d_ws + WS_CTL, 0, CTL_ZERO_BYTES, stream);
    Args a{};
    for (int i = 0; i < N_IN; ++i) a.in[i] = (const float*)d_in[i];
    a.out = (float*)d_out; a.ws = (unsigned char*)d_ws;
#if MK_N_LAUNCHES == 1
    a.ph_lo = 0; a.ph_hi = NPHASE; a.li = 0;
    { void* kargs[] = {&a}; hipError_t e = hipLaunchCooperativeKernel((const void*)mk_fwd, dim3(grid), dim3(NTHREADS), kargs, LDS_BYTES, stream);
      if (e != hipSuccess) fprintf(stderr, "kernel_launch: cooperative launch failed: %s\n", hipGetErrorString(e)); }
#else
    for (int p = 0; p < NPHASE; ++p) { a.ph_lo = p; a.ph_hi = p + 1; a.li = 0; hipLaunchKernelGGL(mk_fwd, dim3(grid), dim3(NTHREADS), LDS_BYTES, stream, a); }
#endif
}
```

```cpp
#include <hip/hip_runtime.h>
#include <hip/hip_bf16.h>
#include <cstdio>
#include <cstdint>
#include <cmath>
namespace pg8 {
#define PG8_LAS __attribute__((address_space(3)))
typedef unsigned short bf16_t;
typedef short bf16x8 __attribute__((ext_vector_type(8)));
typedef float f32x4 __attribute__((ext_vector_type(4)));
typedef unsigned u32x4 __attribute__((ext_vector_type(4)));
constexpr int BM = 256, BK = 64, HALF = 128, HTB = HALF * BK * 2  , STAGE_BYTES = 8 * HTB, NXCD = 8, WGM = 8;

__host__ __device__ __forceinline__ int lds_byte(int r, int c) { const int st = (r >> 4) * 2 + (c >> 5), rr = r & 15, cc = c & 31, ob = rr * 64 + cc * 2; return st * 1024 + (ob ^ (((ob >> 9) & 1) << 5)); }
__host__ __device__ __forceinline__ void stage_rc(int b, int& R, int& C) { const int st = b / 1024, sb = b % 1024, swz = sb ^ (((sb >> 9) & 1) << 5); R = (st >> 1) * 16 + swz / 64; C = (st & 1) * 32 + (swz % 64) / 2; }
__host__ __device__ __forceinline__ int perm32(int rho) { const int n = rho >> 4, i = rho & 15; return 8 * (i >> 2) + 4 * n + (i & 3); }

struct Unit { int pm, pn; };
struct Gemm { const bf16_t* A; const bf16_t* Bt; int M, N, K; };

struct StaticOrder {
    int nM, nN, nwg, G, c;
    __host__ __device__ void init(int M, int N, int G_, int c_) { nM = M / BM; nN = N / BM; nwg = nM * nN; G = G_; c = c_; }
    __host__ __device__ bool next(int i, Unit& u) const {
        const long L = (long)i * G + c; if (L >= nwg) return false;
        int wgid = (int)L; { const int q = nwg / NXCD, r = nwg % NXCD, xcd = wgid % NXCD, off = wgid / NXCD; wgid = (xcd < r ? xcd * (q + 1) : r * (q + 1) + (xcd - r) * q) + off; }
        const int nig = WGM * nN, gid = wgid / nig, fm = gid * WGM, gsz = (nM - fm) < WGM ? (nM - fm) : WGM;
        u.pm = fm + ((wgid % nig) % gsz); u.pn = (wgid % nig) / gsz; return true;
    }
    __device__ __forceinline__ void a_ready(const Unit&) const {}
    __device__ __forceinline__ void done(const Unit&) const {}
};

__device__ __forceinline__ unsigned cvt_pk_bf16(float lo, float hi) { unsigned r; asm volatile("v_cvt_pk_bf16_f32 %0, %1, %2" : "=v"(r) : "v"(lo), "v"(hi)); return r; }
typedef float f32x2 __attribute__((ext_vector_type(2)));
__device__ __forceinline__ f32x2 gelu_pk(f32x2 v) {
    const f32x2 av = __builtin_elementwise_abs(v), d = av * 0.2316418882f + 1.0f;
    f32x2 t; t.x = __builtin_amdgcn_rcpf(d.x); t.y = __builtin_amdgcn_rcpf(d.y);
    f32x2 q = t * 0.5307027145f + (-0.7265760135f); q = q * t + 0.7107068705f; q = q * t + (-0.142248368f); q = q * t + 0.127414796f; q = q * t;
    const f32x2 s = (v * v) * (-0.72134752044f);
    f32x2 e; e.x = __builtin_amdgcn_exp2f(s.x); e.y = __builtin_amdgcn_exp2f(s.y);
    const f32x2 m = v * (q * e), r = v - m;
    f32x2 o; o.x = v.x < 0.f ? m.x : r.x; o.y = v.y < 0.f ? m.y : r.y; return o;
}

template <int ACT  > struct EpiBf16 {
    static constexpr bool PERM = true, AFTER_DRAIN = false; static_assert(ACT == 0 || ACT == 1, "EpiBf16: ACT is 0 (none) or 1 (gelu_pk)");
    bf16_t* O; int ldc; const float* bias; int split_cols; size_t split_stride; float scale0;
    __device__ __forceinline__ void operator()(const f32x4 (&acc)[2][2][4][2], const Unit& u, int wr, int wc, int fr, int fq) const {
        const int row0 = u.pm * BM + wr * 64 + fr; int colt = u.pn * BM; bf16_t* base = O;
        float sc = 1.f; if (split_cols) { const int t = colt / split_cols; base += (size_t)t * split_stride; colt -= t * split_cols; if (t == 0) sc = scale0; }
        const int col0 = colt + wc * 32 + 8 * fq, bcol0 = u.pn * BM + wc * 32 + 8 * fq;
        f32x4 bv[2][2];
#pragma unroll
        for (int bj = 0; bj < 2; ++bj)
#pragma unroll
            for (int n = 0; n < 2; ++n) bv[bj][n] = bias ? *(const f32x4*)(bias + bcol0 + bj * HALF + 4 * n) : (f32x4){0.f, 0.f, 0.f, 0.f};
#pragma unroll
        for (int ai = 0; ai < 2; ++ai)
#pragma unroll
            for (int m = 0; m < 4; ++m) { bf16_t* rowp = base + (size_t)(row0 + ai * HALF + m * 16) * ldc + col0;
#pragma unroll
                for (int bj = 0; bj < 2; ++bj) { f32x4 v0 = acc[ai][bj][m][0] + bv[bj][0], v1 = acc[ai][bj][m][1] + bv[bj][1];
                    if (ACT == 1) { f32x2 a = gelu_pk((f32x2){v0[0], v0[1]}), b = gelu_pk((f32x2){v0[2], v0[3]}), c = gelu_pk((f32x2){v1[0], v1[1]}), d = gelu_pk((f32x2){v1[2], v1[3]});
                        v0 = (f32x4){a.x, a.y, b.x, b.y}; v1 = (f32x4){c.x, c.y, d.x, d.y}; }
                    v0 = v0 * sc; v1 = v1 * sc; u32x4 w; w.x = cvt_pk_bf16(v0[0], v0[1]); w.y = cvt_pk_bf16(v0[2], v0[3]); w.z = cvt_pk_bf16(v1[0], v1[1]); w.w = cvt_pk_bf16(v1[2], v1[3]);
                    *(u32x4*)(rowp + bj * HALF) = w; } }
    }
};

struct PanelStats {
    unsigned* xbuf;
    unsigned* cnt;
    unsigned* tmo;
    int ntn; float eps;
    unsigned code;
    __device__ __forceinline__ bool run(const f32x4 (&v)[2][2][4][2], const Unit& u, int wr, int wc, int fr, int fq, PG8_LAS unsigned char* lds, int wid, int lane) const {
        typedef float f32x2v __attribute__((ext_vector_type(2)));
        PG8_LAS f32x2v* P = (PG8_LAS f32x2v*)lds;
        PG8_LAS f32x2v* S = (PG8_LAS f32x2v*)(lds + 8192);
        PG8_LAS unsigned* flag = (PG8_LAS unsigned*)(lds + 8192 + 2048);
#pragma unroll
        for (int ai = 0; ai < 2; ++ai)
#pragma unroll
            for (int m = 0; m < 4; ++m) {
                float s = 0.f;
#pragma unroll
                for (int bj = 0; bj < 2; ++bj)
#pragma unroll
                    for (int n = 0; n < 2; ++n) { const f32x4 x = v[ai][bj][m][n]; s += (x[0] + x[1]) + (x[2] + x[3]); }
                s += __shfl_xor(s, 16); s += __shfl_xor(s, 32);
                const float mw = s * (1.0f / 64.0f); float q = 0.f;
#pragma unroll
                for (int bj = 0; bj < 2; ++bj)
#pragma unroll
                    for (int n = 0; n < 2; ++n) { const f32x4 d = v[ai][bj][m][n] - mw; q += (d[0] * d[0] + d[1] * d[1]) + (d[2] * d[2] + d[3] * d[3]); }
                q += __shfl_xor(q, 16); q += __shfl_xor(q, 32);
                if (fq == 0) P[(ai * HALF + wr * 64 + m * 16 + fr) * 4 + wc] = (f32x2v){mw, q};
            }
        asm volatile("s_waitcnt lgkmcnt(0)" ::: "memory"); __builtin_amdgcn_s_barrier(); asm volatile("" ::: "memory");
#if defined(BROKEN_EXCHANGE_NO_WAIT)
#warning BROKEN CONTROL BUILD: the row-statistics exchange does not wait; results are wrong by design
        if (blockIdx.x >= 64) { const long long t0_ = clock64(); while (clock64() - t0_ < 60000) __builtin_amdgcn_s_sleep(8); }
#endif
        const int row = wid * 32 + (lane & 31);
        if (lane < 32) {
            const f32x2v a = P[row * 4 + 0], b = P[row * 4 + 1], c = P[row * 4 + 2], d = P[row * 4 + 3];
            const float mt = (a.x + b.x + c.x + d.x) * 0.25f;
            const float da = a.x - mt, db = b.x - mt, dc = c.x - mt, dd = d.x - mt;
            const float m2 = (a.y + b.y) + (c.y + d.y) + 64.0f * ((da * da + db * db) + (dc * dc + dd * dd));
            unsigned long long* slot = (unsigned long long*)xbuf + ((size_t)(u.pm * BM + row) * 4 + u.pn);
            __hip_atomic_store(slot, ((unsigned long long)__float_as_uint(m2) << 32) | __float_as_uint(mt), __ATOMIC_RELAXED, __HIP_MEMORY_SCOPE_AGENT);
        }
        asm volatile("s_waitcnt vmcnt(0)" ::: "memory");
        if (lane == 0) __hip_atomic_fetch_add(cnt + 64 * u.pm, 1u, __ATOMIC_RELAXED, __HIP_MEMORY_SCOPE_AGENT);
        if (wid == 0) {
            bool dead = false; const unsigned long long t0 = __builtin_amdgcn_s_memrealtime(); const unsigned want = 8u * (unsigned)ntn;
            for (;;) {
#if defined(BROKEN_EXCHANGE_NO_WAIT)
                break;
#endif
                if ((unsigned)__builtin_amdgcn_readfirstlane(__hip_atomic_load(cnt + 64 * u.pm, __ATOMIC_RELAXED, __HIP_MEMORY_SCOPE_AGENT)) >= want) break;
                if (__builtin_amdgcn_s_memrealtime() - t0 > 2000000ull) {
                    if (lane == 0) { unsigned expect = 0u; __hip_atomic_compare_exchange_strong(tmo + 1, &expect, code | (unsigned)(u.pm & 0xff), __ATOMIC_RELAXED, __ATOMIC_RELAXED, __HIP_MEMORY_SCOPE_AGENT);
                                     __hip_atomic_store(tmo, 1u, __ATOMIC_RELAXED, __HIP_MEMORY_SCOPE_AGENT); }
                    dead = true; break; }
                __builtin_amdgcn_s_sleep(2);
            }
            __builtin_amdgcn_fence(__ATOMIC_ACQUIRE, "agent");
            if (lane == 0) flag[0] = dead ? 1u : 0u;
        }
        asm volatile("s_waitcnt vmcnt(0) lgkmcnt(0)" ::: "memory"); __builtin_amdgcn_s_barrier(); asm volatile("" ::: "memory");
        const bool bad = flag[0] != 0u;
        if (lane < 32) {
            const unsigned long long* slot = (const unsigned long long*)xbuf + (size_t)(u.pm * BM + row) * 4; float mt[4], m2[4]; float ms = 0.f;
#pragma unroll
            for (int t = 0; t < 4; ++t) { if (t < ntn) { const unsigned long long w = __hip_atomic_load(slot + t, __ATOMIC_RELAXED, __HIP_MEMORY_SCOPE_AGENT); mt[t] = __uint_as_float((unsigned)w); m2[t] = __uint_as_float((unsigned)(w >> 32)); } else { mt[t] = 0.f; m2[t] = 0.f; } ms += mt[t]; }
            const float mean = ms / (float)ntn; float q = 0.f;
#pragma unroll
            for (int t = 0; t < 4; ++t) if (t < ntn) { const float dm = mt[t] - mean; q += m2[t] + 256.0f * dm * dm; }
            S[row] = (f32x2v){mean, 1.0f / sqrtf(q / (256.0f * (float)ntn) + eps)};
        }
        asm volatile("s_waitcnt lgkmcnt(0)" ::: "memory"); __builtin_amdgcn_s_barrier(); asm volatile("" ::: "memory");
        return bad;
    }
};
struct EpiLnRes {
    static constexpr bool PERM = false, AFTER_DRAIN = true;
    const float* base; float* out; int ldc; const float* bias; PanelStats st; unsigned poison;
    __device__ __forceinline__ void fused(f32x4 (&acc)[2][2][4][2], const Unit& u, int wr, int wc, int fr, int fq, PG8_LAS unsigned char* lds, int wid, int lane) const {
        typedef float f32x2v __attribute__((ext_vector_type(2)));
        const PG8_LAS f32x2v* S = (const PG8_LAS f32x2v*)(lds + 8192);
        const int col0 = u.pn * BM + wc * 32 + 4 * fq;
#pragma unroll
        for (int bj = 0; bj < 2; ++bj)
#pragma unroll
            for (int n = 0; n < 2; ++n) { const f32x4 bv = bias ? *(const f32x4*)(bias + col0 + bj * HALF + n * 16) : (f32x4){0.f, 0.f, 0.f, 0.f};
#pragma unroll
                for (int ai = 0; ai < 2; ++ai)
#pragma unroll
                    for (int m = 0; m < 4; ++m) acc[ai][bj][m][n] += bv; }
        f32x4 pre[4][2][2];
#pragma unroll
        for (int m = 0; m < 4; ++m) { const size_t off = (size_t)(u.pm * BM + wr * 64 + m * 16 + fr) * ldc + col0;
#pragma unroll
            for (int bj = 0; bj < 2; ++bj)
#pragma unroll
                for (int n = 0; n < 2; ++n) pre[m][bj][n] = *(const f32x4*)(base + off + bj * HALF + n * 16); }
        const bool bad = st.run(acc, u, wr, wc, fr, fq, lds, wid, lane) || poison != 0u;
        const float qnan = __builtin_nanf("");
#pragma unroll
        for (int ai = 0; ai < 2; ++ai)
#pragma unroll
            for (int m = 0; m < 4; ++m) { const int r = ai * HALF + wr * 64 + m * 16 + fr; const f32x2v sr = S[r]; const size_t off = (size_t)(u.pm * BM + r) * ldc + col0;
#pragma unroll
                for (int bj = 0; bj < 2; ++bj)
#pragma unroll
                    for (int n = 0; n < 2; ++n) { const f32x4 bs = ai == 0 ? pre[m][bj][n] : *(const f32x4*)(base + off + bj * HALF + n * 16); f32x4 o = bs + (acc[ai][bj][m][n] - sr.x) * sr.y;
                        if (bad) o = (f32x4){qnan, qnan, qnan, qnan}; *(f32x4*)(out + off + bj * HALF + n * 16) = o; }
                if (m & 1) asm volatile("" ::: "memory"); }
    }
};
struct EpiLnResLn {
    static constexpr bool PERM = false, AFTER_DRAIN = true;
    const float* base; float* out; bf16_t* xn; int ldc; const float* bias; PanelStats st1, st2; unsigned poison;
    __device__ __forceinline__ void fused(f32x4 (&acc)[2][2][4][2], const Unit& u, int wr, int wc, int fr, int fq, PG8_LAS unsigned char* lds, int wid, int lane) const {
        typedef float f32x2v __attribute__((ext_vector_type(2))); typedef unsigned u32x2v __attribute__((ext_vector_type(2)));
        const PG8_LAS f32x2v* S = (const PG8_LAS f32x2v*)(lds + 8192);
        const int col0 = u.pn * BM + wc * 32 + 4 * fq;
#pragma unroll
        for (int bj = 0; bj < 2; ++bj)
#pragma unroll
            for (int n = 0; n < 2; ++n) { const f32x4 bv = bias ? *(const f32x4*)(bias + col0 + bj * HALF + n * 16) : (f32x4){0.f, 0.f, 0.f, 0.f};
#pragma unroll
                for (int ai = 0; ai < 2; ++ai)
#pragma unroll
                    for (int m = 0; m < 4; ++m) acc[ai][bj][m][n] += bv; }
        bool bad = st1.run(acc, u, wr, wc, fr, fq, lds, wid, lane) || poison != 0u;
        const float qnan = __builtin_nanf("");
#pragma unroll
        for (int ai = 0; ai < 2; ++ai)
#pragma unroll
            for (int m = 0; m < 4; ++m) { const int r = ai * HALF + wr * 64 + m * 16 + fr; const f32x2v sr = S[r]; const size_t off = (size_t)(u.pm * BM + r) * ldc + col0;
#pragma unroll
                for (int bj = 0; bj < 2; ++bj)
#pragma unroll
                    for (int n = 0; n < 2; ++n) { const f32x4 bs = *(const f32x4*)(base + off + bj * HALF + n * 16); acc[ai][bj][m][n] = bs + (acc[ai][bj][m][n] - sr.x) * sr.y; }
                asm volatile("" : "+v"(acc[ai][0][m][0]), "+v"(acc[ai][0][m][1]), "+v"(acc[ai][1][m][0]), "+v"(acc[ai][1][m][1]));
                if (m & 1) asm volatile("" ::: "memory"); }
        const bool bad1 = bad;
        bad = st2.run(acc, u, wr, wc, fr, fq, lds, wid, lane) || bad;
#pragma unroll
        for (int ai = 0; ai < 2; ++ai)
#pragma unroll
            for (int m = 0; m < 4; ++m) { const int r = ai * HALF + wr * 64 + m * 16 + fr; const f32x2v sr = S[r]; const size_t off = (size_t)(u.pm * BM + r) * ldc + col0;
#pragma unroll
                for (int bj = 0; bj < 2; ++bj)
#pragma unroll
                    for (int n = 0; n < 2; ++n) { const f32x4 x1 = acc[ai][bj][m][n]; *(f32x4*)(out + off + bj * HALF + n * 16) = bad1 ? (f32x4){qnan, qnan, qnan, qnan} : x1;
                        const f32x4 o = (x1 - sr.x) * sr.y; u32x2v w; w.x = cvt_pk_bf16(o[0], o[1]); w.y = cvt_pk_bf16(o[2], o[3]);
                        if (bad) { w.x = 0x7fc07fc0u; w.y = 0x7fc07fc0u; } *(u32x2v*)(xn + off + bj * HALF + n * 16) = w; }
                asm volatile("" ::: "memory"); }
    }
};

template <class Epi, class Sched, bool ALIGN_EPI = false, bool SP2 = false>
__device__ __forceinline__ void gemm_phase(PG8_LAS unsigned char* lds, const Gemm g, const Sched& S, const Epi& E) {
    const int tid = threadIdx.x, wid = __builtin_amdgcn_readfirstlane(tid >> 6), lane = tid & 63, wr = wid >> 2, wc = wid & 3, fr = lane & 15, fq = lane >> 4;
    const int K = g.K, nt = K / BK;
    unsigned voffA[2], voffB[2];
#pragma unroll
    for (int i = 0; i < 2; ++i) { int R, C; stage_rc(tid * 16 + i * 8192, R, C); const int Rb = Epi::PERM ? ((R & ~31) + perm32(R & 31)) : R;
        voffA[i] = (unsigned)(R * K + C) * 2u; voffB[i] = (unsigned)(Rb * K + C) * 2u; }
    const size_t kstep = (size_t)(BK * 2);
    const size_t hstep = (size_t)HALF * K * 2;
    const size_t tstep = 2 * hstep;
    const unsigned ldsw = (unsigned)wid * 1024u;
    const int aoff = lds_byte(wr * 64 + fr, fq * 8), boff = lds_byte(wc * 32 + fr, fq * 8);
#define PG8_SA(b, h) (((b) * 2 + (h)) * HTB)
#define PG8_SB(b, h) ((4 + (b) * 2 + (h)) * HTB)
#define PG8_STAGE(bufoff, gbase, voff) do { _Pragma("unroll") for (int _i = 0; _i < 2; ++_i) \
        __builtin_amdgcn_global_load_lds((const unsigned*)((const char*)(gbase) + (voff)[_i]), (PG8_LAS unsigned*)(lds + (bufoff) + ldsw + _i * 8192), 16, 0, 0); } while (0)
#define PG8_LDA(dst, b, h) do { _Pragma("unroll") for (int m = 0; m < 4; ++m) _Pragma("unroll") for (int k = 0; k < 2; ++k) dst[m][k] = *(const PG8_LAS bf16x8*)(lds + PG8_SA(b, h) + aoff + m * 2048 + k * 1024); } while (0)
#define PG8_LDB(dst, b, h) do { _Pragma("unroll") for (int n = 0; n < 2; ++n) _Pragma("unroll") for (int k = 0; k < 2; ++k) dst[n][k] = *(const PG8_LAS bf16x8*)(lds + PG8_SB(b, h) + boff + n * 2048 + k * 1024); } while (0)
#define PG8_MMA(ai, bj, At, Bt) do { __builtin_amdgcn_s_setprio(1); _Pragma("unroll") for (int m = 0; m < 4; ++m) _Pragma("unroll") for (int n = 0; n < 2; ++n) _Pragma("unroll") for (int k = 0; k < 2; ++k) \
        acc[ai][bj][m][n] = __builtin_amdgcn_mfma_f32_16x16x32_bf16(Bt[n][k], At[m][k], acc[ai][bj][m][n], 0, 0, 0); __builtin_amdgcn_s_setprio(0); } while (0)
#define PG8_WAIT_V(n) asm volatile("s_waitcnt vmcnt(" #n ")" ::: "memory")
#define PG8_WAIT_L(n) asm volatile("s_waitcnt lgkmcnt(" #n ")" ::: "memory")
#define PG8_BAR __builtin_amdgcn_s_barrier()
#define PG8_SCHED __builtin_amdgcn_sched_barrier(0)
    Unit cur, nxt; int ui = 0;
    if (!S.next(0, cur)) return;
    f32x4 acc[2][2][4][2];
#pragma unroll
    for (int a = 0; a < 2; ++a)
#pragma unroll
        for (int b = 0; b < 2; ++b)
#pragma unroll
            for (int m = 0; m < 4; ++m)
#pragma unroll
                for (int n = 0; n < 2; ++n) acc[a][b][m][n] = (f32x4){0.f, 0.f, 0.f, 0.f};
    bf16x8 At[4][2], B0[2][2], B1[2][2];
    const char* cA = (const char*)g.A + (size_t)cur.pm * tstep; const char* cB = (const char*)g.Bt + (size_t)cur.pn * tstep;
    S.a_ready(cur);
    if constexpr (SP2) {
        PG8_STAGE(PG8_SB(0, 0), cB, voffB); PG8_STAGE(PG8_SB(0, 1), cB + hstep, voffB); PG8_STAGE(PG8_SA(0, 0), cA, voffA); PG8_STAGE(PG8_SA(0, 1), cA + hstep, voffA);
        if (wr == 1) PG8_BAR;
        PG8_WAIT_V(2); PG8_BAR;
        PG8_STAGE(PG8_SB(1, 0), cB + kstep, voffB); PG8_STAGE(PG8_SA(1, 0), cA + kstep, voffA); PG8_STAGE(PG8_SB(1, 1), cB + hstep + kstep, voffB);
        PG8_WAIT_V(6); PG8_BAR;
    } else {
        PG8_STAGE(PG8_SB(0, 0), cB, voffB); PG8_STAGE(PG8_SA(0, 0), cA, voffA); PG8_STAGE(PG8_SB(0, 1), cB + hstep, voffB); PG8_STAGE(PG8_SA(0, 1), cA + hstep, voffA);
        if (wr == 1) PG8_BAR;
        PG8_WAIT_V(4); PG8_BAR;
        PG8_STAGE(PG8_SB(1, 0), cB + kstep, voffB); PG8_STAGE(PG8_SA(1, 0), cA + kstep, voffA); PG8_STAGE(PG8_SB(1, 1), cB + hstep + kstep, voffB);
        PG8_WAIT_V(6); PG8_BAR;
    }
    for (;;) {
        const bool has_next = S.next(ui + 1, nxt);
        const char* nA = has_next ? (const char*)g.A + (size_t)nxt.pm * tstep : cA; const char* nB = has_next ? (const char*)g.Bt + (size_t)nxt.pn * tstep : cB;
        for (int t = 0; t < nt; t += 2) {
            const bool last = (t == nt - 2);
            const char* a1 = cA + (size_t)(t + 1) * kstep;
            const char* a2 = last ? nA : cA + (size_t)(t + 2) * kstep; const char* b2 = last ? nB : cB + (size_t)(t + 2) * kstep;
            const char* a3 = a2 + kstep; const char* b3 = b2 + kstep;
            if (last && has_next) S.a_ready(nxt);
            if constexpr (SP2) {
            PG8_LDB(B0, 0, 0); PG8_LDB(B1, 0, 1); PG8_SCHED; PG8_LDA(At, 0, 0); PG8_STAGE(PG8_SA(1, 1), a1 + hstep, voffA);
            PG8_WAIT_V(8); PG8_WAIT_L(0); PG8_BAR; PG8_MMA(0, 0, At, B0); PG8_MMA(0, 1, At, B1); PG8_BAR; PG8_SCHED;
            PG8_LDA(At, 0, 1); PG8_STAGE(PG8_SB(0, 0), b2, voffB); PG8_STAGE(PG8_SB(0, 1), b2 + hstep, voffB); PG8_STAGE(PG8_SA(0, 0), a2, voffA);
            PG8_WAIT_V(8); PG8_WAIT_L(0); PG8_BAR; PG8_MMA(1, 0, At, B0); PG8_MMA(1, 1, At, B1); PG8_BAR; PG8_SCHED;
            PG8_LDB(B0, 1, 0); PG8_LDB(B1, 1, 1); PG8_SCHED; PG8_LDA(At, 1, 0); PG8_STAGE(PG8_SA(0, 1), a2 + hstep, voffA);
            PG8_WAIT_V(8); PG8_WAIT_L(0); PG8_BAR; PG8_MMA(0, 0, At, B0); PG8_MMA(0, 1, At, B1); PG8_BAR; PG8_SCHED;
            PG8_LDA(At, 1, 1); PG8_STAGE(PG8_SB(1, 0), b3, voffB); PG8_STAGE(PG8_SB(1, 1), b3 + hstep, voffB); PG8_STAGE(PG8_SA(1, 0), a3, voffA);
            PG8_WAIT_V(8); PG8_WAIT_L(0); PG8_BAR; PG8_MMA(1, 0, At, B0); PG8_MMA(1, 1, At, B1); PG8_BAR; PG8_SCHED;
            } else {
            PG8_LDB(B0, 0, 0); PG8_SCHED; PG8_LDA(At, 0, 0); PG8_STAGE(PG8_SA(1, 1), a1 + hstep, voffA);
            PG8_WAIT_L(8); PG8_BAR; PG8_WAIT_L(0); PG8_MMA(0, 0, At, B0); PG8_BAR; PG8_SCHED;
            PG8_LDB(B1, 0, 1); PG8_STAGE(PG8_SB(0, 0), b2, voffB);
            PG8_BAR; PG8_WAIT_L(0); PG8_MMA(0, 1, At, B1); PG8_BAR;
            PG8_LDA(At, 0, 1); PG8_STAGE(PG8_SA(0, 0), a2, voffA);
            PG8_BAR; PG8_WAIT_L(0); PG8_MMA(1, 0, At, B0); PG8_BAR; PG8_SCHED;
            PG8_STAGE(PG8_SB(0, 1), b2 + hstep, voffB);
            PG8_WAIT_V(6); PG8_BAR; PG8_MMA(1, 1, At, B1); PG8_BAR;
            PG8_LDB(B0, 1, 0); PG8_SCHED; PG8_LDA(At, 1, 0); PG8_STAGE(PG8_SA(0, 1), a2 + hstep, voffA);
            PG8_WAIT_L(8); PG8_BAR; PG8_WAIT_L(0); PG8_MMA(0, 0, At, B0); PG8_BAR; PG8_SCHED;
            PG8_LDB(B1, 1, 1); PG8_STAGE(PG8_SB(1, 0), b3, voffB);
            PG8_BAR; PG8_WAIT_L(0); PG8_MMA(0, 1, At, B1); PG8_BAR;
            PG8_LDA(At, 1, 1); PG8_STAGE(PG8_SA(1, 0), a3, voffA);
            PG8_BAR; PG8_WAIT_L(0); PG8_MMA(1, 0, At, B0); PG8_BAR; PG8_SCHED;
            PG8_STAGE(PG8_SB(1, 1), b3 + hstep, voffB);
            PG8_WAIT_V(6); PG8_BAR; PG8_MMA(1, 1, At, B1); PG8_BAR;
            }
        }
        if constexpr (ALIGN_EPI) { if (wr == 0) PG8_BAR; }
        if constexpr (!Epi::AFTER_DRAIN) { E(acc, cur, wr, wc, fr, fq); S.done(cur); }
        if (!has_next) break;
#pragma unroll
        for (int a = 0; a < 2; ++a)
#pragma unroll
            for (int b = 0; b < 2; ++b)
#pragma unroll
                for (int m = 0; m < 4; ++m)
#pragma unroll
                    for (int n = 0; n < 2; ++n) acc[a][b][m][n] = (f32x4){0.f, 0.f, 0.f, 0.f};
        cur = nxt; cA = nA; cB = nB; ++ui;
        if constexpr (ALIGN_EPI) { if (wr == 1) PG8_BAR; }
    }
    PG8_WAIT_V(0);
    if constexpr (!ALIGN_EPI) { if (wr == 0) PG8_BAR; }
    PG8_BAR;
    if constexpr (Epi::AFTER_DRAIN) { E.fused(acc, cur, wr, wc, fr, fq, lds, wid, lane); S.done(cur); }
#undef PG8_SA
#undef PG8_SB
#undef PG8_STAGE
#undef PG8_LDA
#undef PG8_LDB
#undef PG8_MMA
#undef PG8_WAIT_V
#undef PG8_WAIT_L
#undef PG8_BAR
#undef PG8_SCHED
}
}
namespace pg8 {
__device__ __forceinline__ int erow(int ai, int m, int wr, int fr) { return ai * HALF + wr * 64 + m * 16 + fr; }
template <bool PERM> __device__ __forceinline__ int ecol(int bj, int n, int wc, int fq) { return PERM ? (bj * HALF + wc * 32 + 8 * fq + 4 * n) : (bj * HALF + wc * 32 + 16 * n + 4 * fq); }
typedef unsigned u32x2e __attribute__((ext_vector_type(2)));
__device__ __forceinline__ u32x2e pack4(f32x4 v) { u32x2e w; w.x = cvt_pk_bf16(v[0], v[1]); w.y = cvt_pk_bf16(v[2], v[3]); return w; }
__device__ __forceinline__ float sigm(float x) { return 1.0f - __builtin_amdgcn_rcpf(1.0f + __expf(x)); }
__device__ __forceinline__ float tanh_(float x) { return 1.0f - 2.0f * __builtin_amdgcn_rcpf(1.0f + __expf(2.0f * x)); }

struct RecInDst { bf16_t* QM; size_t off_km, off_vm, off_om; bf16_t *RAWb, *TWAD, *SGD; float* GATES; };
__device__ __forceinline__ void recin_store4(const RecInDst& d, size_t row, int pn, int c, f32x4 v) {
    if (pn < 8) {
        const size_t off = (pn < 2) ? 0 : (pn < 4 ? d.off_km : (pn < 6 ? d.off_vm : d.off_om));
        if (pn == 2 || pn == 3) v = v * 0.08838834764831845f;
        *(u32x2e*)(d.QM + off + row * 512 + (pn & 1) * 256 + c) = pack4(v);
    } else if (pn < 14) {
        *(u32x2e*)(d.RAWb + row * 1536 + (pn - 8) * 256 + c) = pack4(v);
    } else if (pn == 14) {
        if (c < 128) { v[0] = tanh_(v[0]); v[1] = tanh_(v[1]); v[2] = tanh_(v[2]); v[3] = tanh_(v[3]); }
        *(u32x2e*)(d.TWAD + row * 256 + c) = pack4(v);
    } else {
        if (c < 128) { v[0] = sigm(v[0]); v[1] = sigm(v[1]); v[2] = sigm(v[2]); v[3] = sigm(v[3]); *(u32x2e*)(d.SGD + row * 128 + c) = pack4(v); }
        else if (c < 144) { *(f32x4*)(d.GATES + row * 16 + (c - 128)) = v; }
    }
}
__device__ __forceinline__ void recin_store1(const RecInDst& d, size_t row, int col, float v) {
    const int pn = col >> 8, c = col & 255;
    if (pn < 8) {
        const size_t off = (pn < 2) ? 0 : (pn < 4 ? d.off_km : (pn < 6 ? d.off_vm : d.off_om));
        if (pn == 2 || pn == 3) v *= 0.08838834764831845f;
        d.QM[off + row * 512 + (pn & 1) * 256 + c] = (bf16_t)(cvt_pk_bf16(v, 0.f) & 0xffffu);
    } else if (pn < 14) d.RAWb[row * 1536 + (pn - 8) * 256 + c] = (bf16_t)(cvt_pk_bf16(v, 0.f) & 0xffffu);
    else if (pn == 14) d.TWAD[row * 256 + c] = (bf16_t)(cvt_pk_bf16(c < 128 ? tanh_(v) : v, 0.f) & 0xffffu);
    else if (c < 128) d.SGD[row * 128 + c] = (bf16_t)(cvt_pk_bf16(sigm(v), 0.f) & 0xffffu);
    else if (c < 144) d.GATES[row * 16 + (c - 128)] = v;
}
__device__ __forceinline__ void recin_store8(const RecInDst& d, size_t row, int pn, int c, f32x4 v0, f32x4 v1) {
    if (pn < 8) {
        const size_t off = (pn < 2) ? 0 : (pn < 4 ? d.off_km : (pn < 6 ? d.off_vm : d.off_om));
        if (pn == 2 || pn == 3) { v0 = v0 * 0.08838834764831845f; v1 = v1 * 0.08838834764831845f; }
        const u32x2e a = pack4(v0), b = pack4(v1); u32x4 w; w.x = a.x; w.y = a.y; w.z = b.x; w.w = b.y;
        *(u32x4*)(d.QM + off + row * 512 + (pn & 1) * 256 + c) = w;
    } else if (pn < 14) {
        const u32x2e a = pack4(v0), b = pack4(v1); u32x4 w; w.x = a.x; w.y = a.y; w.z = b.x; w.w = b.y;
        *(u32x4*)(d.RAWb + row * 1536 + (pn - 8) * 256 + c) = w;
    } else if (pn == 14) {
        if (c < 128) { v0[0] = tanh_(v0[0]); v0[1] = tanh_(v0[1]); v0[2] = tanh_(v0[2]); v0[3] = tanh_(v0[3]); v1[0] = tanh_(v1[0]); v1[1] = tanh_(v1[1]); v1[2] = tanh_(v1[2]); v1[3] = tanh_(v1[3]); }
        const u32x2e a = pack4(v0), b = pack4(v1); u32x4 w; w.x = a.x; w.y = a.y; w.z = b.x; w.w = b.y;
        *(u32x4*)(d.TWAD + row * 256 + c) = w;
    } else {
        if (c < 128) { v0[0] = sigm(v0[0]); v0[1] = sigm(v0[1]); v0[2] = sigm(v0[2]); v0[3] = sigm(v0[3]); v1[0] = sigm(v1[0]); v1[1] = sigm(v1[1]); v1[2] = sigm(v1[2]); v1[3] = sigm(v1[3]);
            const u32x2e a = pack4(v0), b = pack4(v1); u32x4 w; w.x = a.x; w.y = a.y; w.z = b.x; w.w = b.y;
            *(u32x4*)(d.SGD + row * 128 + c) = w; }
        else if (c < 144) { *(f32x4*)(d.GATES + row * 16 + (c - 128)) = v0; *(f32x4*)(d.GATES + row * 16 + (c - 128) + 4) = v1; }
    }
}
struct EpiRecIn {
    static constexpr bool PERM = true, AFTER_DRAIN = false;
    RecInDst d;
    __device__ __forceinline__ void operator()(const f32x4 (&acc)[2][2][4][2], const Unit& u, int wr, int wc, int fr, int fq) const {
        const int pn = u.pn;
#pragma unroll
        for (int ai = 0; ai < 2; ++ai)
#pragma unroll
            for (int m = 0; m < 4; ++m) {
                const size_t row = (size_t)u.pm * BM + erow(ai, m, wr, fr);
#pragma unroll
                for (int bj = 0; bj < 2; ++bj) recin_store8(d, row, pn, ecol<true>(bj, 0, wc, fq), acc[ai][bj][m][0], acc[ai][bj][m][1]);
            }
    }
};
template <int ldc> struct EpiStoreBf16 {
    static constexpr bool PERM = true, AFTER_DRAIN = false;
    bf16_t* O; int scale_pm; float scale;
    __device__ __forceinline__ void operator()(const f32x4 (&acc)[2][2][4][2], const Unit& u, int wr, int wc, int fr, int fq) const {
        const float sc = (u.pm < scale_pm) ? scale : 1.0f;
#pragma unroll
        for (int ai = 0; ai < 2; ++ai)
#pragma unroll
            for (int m = 0; m < 4; ++m) {
                bf16_t* rowp = O + ((size_t)u.pm * BM + erow(ai, m, wr, fr)) * ldc + (size_t)u.pn * BM;
#pragma unroll
                for (int bj = 0; bj < 2; ++bj) {
                    const f32x4 v0 = acc[ai][bj][m][0] * sc, v1 = acc[ai][bj][m][1] * sc;
                    u32x4 w; w.x = cvt_pk_bf16(v0[0], v0[1]); w.y = cvt_pk_bf16(v0[2], v0[3]); w.z = cvt_pk_bf16(v1[0], v1[1]); w.w = cvt_pk_bf16(v1[2], v1[3]);
                    *(u32x4*)(rowp + ecol<true>(bj, 0, wc, fq)) = w;
                }
            }
    }
};
template <int ldc> struct EpiSqRelu {
    static constexpr bool PERM = true, AFTER_DRAIN = false;
    bf16_t* O;
    __device__ __forceinline__ void operator()(const f32x4 (&acc)[2][2][4][2], const Unit& u, int wr, int wc, int fr, int fq) const {
#pragma unroll
        for (int ai = 0; ai < 2; ++ai)
#pragma unroll
            for (int m = 0; m < 4; ++m) {
                bf16_t* rowp = O + ((size_t)u.pm * BM + erow(ai, m, wr, fr)) * ldc + (size_t)u.pn * BM;
#pragma unroll
                for (int bj = 0; bj < 2; ++bj) {
                    f32x4 v0 = acc[ai][bj][m][0], v1 = acc[ai][bj][m][1];
#pragma unroll
                    for (int e = 0; e < 4; ++e) { const float a = fmaxf(v0[e], 0.f), b = fmaxf(v1[e], 0.f); v0[e] = a * a; v1[e] = b * b; }
                    u32x4 w; w.x = cvt_pk_bf16(v0[0], v0[1]); w.y = cvt_pk_bf16(v0[2], v0[3]); w.z = cvt_pk_bf16(v1[0], v1[1]); w.w = cvt_pk_bf16(v1[2], v1[3]);
                    *(u32x4*)(rowp + ecol<true>(bj, 0, wc, fq)) = w;
                }
            }
    }
};
struct EpiResid {
    static constexpr bool PERM = false, AFTER_DRAIN = false;
    const float* src_lat; const float* src_ctx; float* dst_lat; float* dst_ctx; const float* gate;
    __device__ __forceinline__ void operator()(const f32x4 (&acc)[2][2][4][2], const Unit& u, int wr, int wc, int fr, int fq) const {
        const int row0 = u.pm * BM; const bool isctx = row0 >= 16384;
        const float* s = isctx ? src_ctx + (size_t)(row0 - 16384) * 1024 : src_lat + (size_t)row0 * 1024;
        float* d = isctx ? dst_ctx + (size_t)(row0 - 16384) * 1024 : dst_lat + (size_t)row0 * 1024;
        const float* g = gate + (isctx ? 2 : (row0 >> 13)) * 6144 + u.pn * BM;
        f32x4 gv[2][2];
#pragma unroll
        for (int bj = 0; bj < 2; ++bj)
#pragma unroll
            for (int n = 0; n < 2; ++n) gv[bj][n] = *(const f32x4*)(g + ecol<false>(bj, n, wc, fq));
        constexpr int RB = 2;
#pragma unroll
        for (int ai = 0; ai < 2; ++ai)
#pragma unroll
            for (int m0 = 0; m0 < 4; m0 += RB) {
                f32x4 x[RB][2][2];
#pragma unroll
                for (int mm = 0; mm < RB; ++mm) { const size_t off = (size_t)erow(ai, m0 + mm, wr, fr) * 1024 + (size_t)u.pn * BM;
#pragma unroll
                    for (int bj = 0; bj < 2; ++bj)
#pragma unroll
                        for (int n = 0; n < 2; ++n) x[mm][bj][n] = *(const f32x4*)(s + off + ecol<false>(bj, n, wc, fq)); }
#pragma unroll
                for (int mm = 0; mm < RB; ++mm) { const size_t off = (size_t)erow(ai, m0 + mm, wr, fr) * 1024 + (size_t)u.pn * BM;
#pragma unroll
                    for (int bj = 0; bj < 2; ++bj)
#pragma unroll
                        for (int n = 0; n < 2; ++n) *(f32x4*)(d + off + ecol<false>(bj, n, wc, fq)) = x[mm][bj][n] + gv[bj][n] * acc[ai][bj][m0 + mm][n]; }
            }
    }
};
struct EpiResidN {
    static constexpr bool PERM = false, AFTER_DRAIN = false;
    const float* src; float* dst; const float* gate;
    const float* ng; const float* nsc;
    bf16_t* XN; float* SS;
    __device__ __forceinline__ void operator()(const f32x4 (&acc)[2][2][4][2], const Unit& u, int wr, int wc, int fr_, int fq_) const {
        int lz = 0; asm volatile("" : "+v"(lz));
        const int fr = fr_ + lz, fq = fq_ + lz;
        const int row0 = u.pm * BM, vec = row0 >> 13;
        const float* s = src + (size_t)row0 * 1024 + (size_t)u.pn * BM; float* d = dst + (size_t)row0 * 1024 + (size_t)u.pn * BM; bf16_t* xn = XN + (size_t)row0 * 1024 + (size_t)u.pn * BM;
        const float* g = gate + vec * 6144 + u.pn * BM; const float* gn = ng + u.pn * BM; const float* sn = nsc + vec * 6144 + u.pn * BM;
        f32x4 gv[2][2];
#pragma unroll
        for (int bj = 0; bj < 2; ++bj)
#pragma unroll
            for (int n = 0; n < 2; ++n) gv[bj][n] = *(const f32x4*)(g + ecol<false>(bj, n, wc, fq));
#pragma unroll
        for (int ai = 0; ai < 2; ++ai)
#pragma unroll
            for (int m = 0; m < 4; ++m) {
                const int r = erow(ai, m, wr, fr); const size_t off = (size_t)r * 1024; float q = 0.f;
#pragma unroll
                for (int bj = 0; bj < 2; ++bj)
#pragma unroll
                    for (int n = 0; n < 2; ++n) { const int c = ecol<false>(bj, n, wc, fq); const f32x4 x = *(const f32x4*)(s + off + c) + gv[bj][n] * acc[ai][bj][m][n];
                        *(f32x4*)(d + off + c) = x; const f32x4 gs = *(const f32x4*)(gn + c) * (*(const f32x4*)(sn + c) + 1.0f); *(u32x2e*)(xn + off + c) = pack4(x * gs); q += (x[0] * x[0] + x[1] * x[1]) + (x[2] * x[2] + x[3] * x[3]); }
                q += __shfl_xor(q, 16); q += __shfl_xor(q, 32);
                if (fq == 0) SS[(size_t)(row0 + r) * 16 + u.pn * 4 + wc] = q;
            }
    }
};
__device__ __forceinline__ float row_rs(const float* SS, size_t row, int fq) {
    const f32x4 p = *(const f32x4*)(SS + row * 16 + 4 * fq); float t = (p[0] + p[1]) + (p[2] + p[3]);
    t += __shfl_xor(t, 16); t += __shfl_xor(t, 32);
    return 1.0f / sqrtf(t * (1.0f / 1024.0f) + 1e-6f);
}
template <int ldc> struct EpiSqReluN {
    static constexpr bool PERM = true, AFTER_DRAIN = false;
    bf16_t* O; const float* SS; const float* bias;
    __device__ __forceinline__ void operator()(const f32x4 (&acc)[2][2][4][2], const Unit& u, int wr, int wc, int fr, int fq) const {
        const float* bp = bias + ((u.pm * BM) >> 13) * 4096 + u.pn * BM;
#pragma unroll
        for (int ai = 0; ai < 2; ++ai)
#pragma unroll
            for (int m = 0; m < 4; ++m) {
                const size_t row = (size_t)u.pm * BM + erow(ai, m, wr, fr); const float rs = row_rs(SS, row, fq);
                bf16_t* rowp = O + row * ldc + (size_t)u.pn * BM;
#pragma unroll
                for (int bj = 0; bj < 2; ++bj) { const int c = ecol<true>(bj, 0, wc, fq);
                    f32x4 v0 = acc[ai][bj][m][0] * rs + *(const f32x4*)(bp + c), v1 = acc[ai][bj][m][1] * rs + *(const f32x4*)(bp + c + 4);
#pragma unroll
                    for (int e_ = 0; e_ < 4; ++e_) { const float a = fmaxf(v0[e_], 0.f), b = fmaxf(v1[e_], 0.f); v0[e_] = a * a; v1[e_] = b * b; }
                    u32x4 w; w.x = cvt_pk_bf16(v0[0], v0[1]); w.y = cvt_pk_bf16(v0[2], v0[3]); w.z = cvt_pk_bf16(v1[0], v1[1]); w.w = cvt_pk_bf16(v1[2], v1[3]);
                    *(u32x4*)(rowp + c) = w; }
            }
    }
};
template <int ldc> struct EpiStoreF32N {
    static constexpr bool PERM = false, AFTER_DRAIN = false;
    float* O; const float* SS; const float* bias;
    __device__ __forceinline__ void operator()(const f32x4 (&acc)[2][2][4][2], const Unit& u, int wr, int wc, int fr, int fq) const {
        const float* bp = bias + ((u.pm * BM) >> 13) * 4096 + u.pn * BM;
#pragma unroll
        for (int ai = 0; ai < 2; ++ai)
#pragma unroll
            for (int m = 0; m < 4; ++m) {
                const size_t row = (size_t)u.pm * BM + erow(ai, m, wr, fr); const float rs = row_rs(SS, row, fq);
                float* rowp = O + row * ldc + (size_t)u.pn * BM;
#pragma unroll
                for (int bj = 0; bj < 2; ++bj)
#pragma unroll
                    for (int n = 0; n < 2; ++n) { const int c = ecol<false>(bj, n, wc, fq); *(f32x4*)(rowp + c) = acc[ai][bj][m][n] * rs + *(const f32x4*)(bp + c); }
            }
    }
};
template <int ldc> struct EpiStoreF32 {
    static constexpr bool PERM = false, AFTER_DRAIN = false;
    float* O;
    __device__ __forceinline__ void operator()(const f32x4 (&acc)[2][2][4][2], const Unit& u, int wr, int wc, int fr, int fq) const {
#pragma unroll
        for (int ai = 0; ai < 2; ++ai)
#pragma unroll
            for (int m = 0; m < 4; ++m) {
                float* rowp = O + ((size_t)u.pm * BM + erow(ai, m, wr, fr)) * ldc + (size_t)u.pn * BM;
#pragma unroll
                for (int bj = 0; bj < 2; ++bj)
#pragma unroll
                    for (int n = 0; n < 2; ++n) *(f32x4*)(rowp + ecol<false>(bj, n, wc, fq)) = acc[ai][bj][m][n];
            }
    }
};
}
#include <hip/hip_bf16.h>
#include <cmath>
namespace attn_body {
using bf16=__hip_bfloat16;
using bf16x8=__attribute__((ext_vector_type(8)))short;
using s16x4=__attribute__((ext_vector_type(4)))short;
using f32x16=__attribute__((ext_vector_type(16)))float;
using u32x4=__attribute__((ext_vector_type(4)))unsigned;
constexpr int BATCH=2,NHEAD=16,SEQ=8192,CTXL=256,KVP=64,D=64,DM=NHEAD*D;
constexpr int NW=8,QBLK=32,QB=QBLK*NW,KVBLK=64,NQB=SEQ/QB;
constexpr int ATTN_PITCH=DM, ATTN_UNIT_ROWS=QB;
__device__ __forceinline__ int crow(int r,int hi){return (r&3)+8*(r>>2)+4*hi;}
#define SBAR() __builtin_amdgcn_sched_barrier(0)
__device__ __forceinline__ void cmask(f32x16&p0,f32x16&p1,int jb,int qrel,int hi){
  const float NEG=-INFINITY; int kb=64*jb+4*hi;
  #pragma unroll
  for(int r=0;r<16;++r){int kv=kb+(r&3)+8*(r>>2); if(kv>qrel)p0[r]=NEG; if(kv+32>qrel)p1[r]=NEG;}
}

__device__ __forceinline__ void wmask(f32x16&p0,f32x16&p1,int dbase,int hi){
  const float NEG=-INFINITY; const int kb=dbase+4*hi;
  #pragma unroll
  for(int r=0;r<16;++r){int d=kb+(r&3)+8*(r>>2); if(d>128||d<-128)p0[r]=NEG; if(d+32>128||d+32<-128)p1[r]=NEG;}
}
constexpr int NSLOT=3, SLOTB=8192;
constexpr int LDS_K=0, LDS_V=NSLOT*SLOTB, LDS_WS=2*NSLOT*SLOTB, LDS_OST=LDS_WS+NW*64*4, LDS_BYTES=LDS_OST+NW*4096;
constexpr float C2=0.125f*1.4426950408889634f;
__device__ __forceinline__ void glds16(const void*gsrc,unsigned lds_dst){unsigned keep;
  asm volatile("s_mov_b32 %0, m0\n\ts_mov_b32 m0, %2\n\ts_nop 0\n\tglobal_load_lds_dwordx4 %1, off\n\ts_mov_b32 m0, %0":"=&s"(keep):"v"(gsrc),"s"(lds_dst):"memory");}
__device__ __forceinline__ float max3f(float a,float b,float c){float r;asm("v_max3_f32 %0, %1, %2, %3":"=v"(r):"v"(a),"v"(b),"v"(c));return r;}
__device__ __forceinline__ float max2f(float a,float b){float r;asm("v_max_f32_e32 %0, %1, %2":"=v"(r):"v"(a),"v"(b));return r;}
__device__ __forceinline__ float fadd_s(float a,float b){float r;asm("v_add_f32_e32 %0, %1, %2":"=v"(r):"v"(a),"v"(b));return r;}
__device__ __forceinline__ float fsub_s(float a,float b){float r;asm("v_sub_f32_e32 %0, %1, %2":"=v"(r):"v"(a),"v"(b));return r;}
typedef float f32x2_t __attribute__((ext_vector_type(2))); typedef __bf16 bf16x2_t __attribute__((ext_vector_type(2)));
__device__ __forceinline__ unsigned cvtpk_s(float lo,float hi){f32x2_t v={lo,hi};bf16x2_t b=__builtin_convertvector(v,bf16x2_t);return __builtin_bit_cast(unsigned,b);}
#define WAIT_BAR(N) asm volatile("s_waitcnt vmcnt(" #N ") lgkmcnt(0)\n\ts_barrier":::"memory")

__device__ __forceinline__ void qkt(f32x16&p0,f32x16&p1,const char*Kslot,const bf16x8*qr,const f32x16&negm,int r32,int hi){
  const char*kb=Kslot+hi*1024+r32*16;
  #pragma unroll
  for(int d0=0;d0<4;++d0){
    const bf16x8 b0=*reinterpret_cast<const bf16x8*>(kb+d0*2048);
    const bf16x8 b1=*reinterpret_cast<const bf16x8*>(kb+d0*2048+512);
    if(d0==0){p0=__builtin_amdgcn_mfma_f32_32x32x16_bf16(b0,qr[0],negm,0,0,0);p1=__builtin_amdgcn_mfma_f32_32x32x16_bf16(b1,qr[0],negm,0,0,0);}
    else{p0=__builtin_amdgcn_mfma_f32_32x32x16_bf16(b0,qr[d0],p0,0,0,0);p1=__builtin_amdgcn_mfma_f32_32x32x16_bf16(b1,qr[d0],p1,0,0,0);}}
}
typedef __attribute__((address_space(3))) const char* lds_cptr;
typedef short v4i16_t __attribute__((ext_vector_type(4)));
__device__ __forceinline__ void kload8(bf16x8*kf,lds_cptr kp){
  kf[0]=*(const __attribute__((address_space(3))) bf16x8*)(kp);      kf[1]=*(const __attribute__((address_space(3))) bf16x8*)(kp+512);
  kf[2]=*(const __attribute__((address_space(3))) bf16x8*)(kp+2048); kf[3]=*(const __attribute__((address_space(3))) bf16x8*)(kp+2560);
  kf[4]=*(const __attribute__((address_space(3))) bf16x8*)(kp+4096); kf[5]=*(const __attribute__((address_space(3))) bf16x8*)(kp+4608);
  kf[6]=*(const __attribute__((address_space(3))) bf16x8*)(kp+6144); kf[7]=*(const __attribute__((address_space(3))) bf16x8*)(kp+6656);
}
__device__ __forceinline__ void kload2(bf16x8*kf,lds_cptr kp,int j){ kf[2*j]=*(const __attribute__((address_space(3))) bf16x8*)(kp+j*2048); kf[2*j+1]=*(const __attribute__((address_space(3))) bf16x8*)(kp+j*2048+512); }
__device__ __forceinline__ s16x4 vtr(lds_cptr p){ return __builtin_bit_cast(s16x4,__builtin_amdgcn_ds_read_tr16_b64_v4i16((__attribute__((address_space(3))) v4i16_t*)p)); }
__device__ __forceinline__ float rowmax(const f32x16&p0,const f32x16&p1){
  float a=max3f(p0[0],p0[1],p1[0]),b=max3f(p0[2],p0[3],p1[1]);a=max3f(a,p1[2],p1[3]);
  #pragma unroll
  for(int r=4;r<16;r+=4){a=max3f(a,p0[r],p0[r+1]);b=max3f(b,p0[r+2],p0[r+3]);a=max3f(a,p1[r],p1[r+1]);b=max3f(b,p1[r+2],p1[r+3]);}
  const float m=max2f(a,b);
  auto rr=__builtin_amdgcn_permlane32_swap(__float_as_uint(m),__float_as_uint(m),false,false);
  return max2f(__uint_as_float(rr[0]),__uint_as_float(rr[1]));
}
__device__ __forceinline__ void pv(f32x16*o,int vb,bf16x8 pa0,bf16x8 pa1,bf16x8 pa2,bf16x8 pa3){
  #pragma unroll
  for(int d0=0;d0<2;++d0){s16x4 lo[4],hi[4];
    #pragma unroll
    for(int ks=0;ks<4;++ks){
      asm volatile("ds_read_b64_tr_b16 %0,%1 offset:%c2":"=&v"(lo[ks]):"v"(vb),"i"(d0*4096+ks*1024):"memory");
      asm volatile("ds_read_b64_tr_b16 %0,%1 offset:%c2":"=&v"(hi[ks]):"v"(vb),"i"(d0*4096+ks*1024+512):"memory");}
    asm volatile("s_waitcnt lgkmcnt(0)":::"memory");SBAR();
    #define PK(k) (bf16x8){lo[k][0],lo[k][1],lo[k][2],lo[k][3],hi[k][0],hi[k][1],hi[k][2],hi[k][3]}
    o[d0]=__builtin_amdgcn_mfma_f32_32x32x16_bf16(pa0,PK(0),o[d0],0,0,0);
    o[d0]=__builtin_amdgcn_mfma_f32_32x32x16_bf16(pa1,PK(1),o[d0],0,0,0);
    o[d0]=__builtin_amdgcn_mfma_f32_32x32x16_bf16(pa2,PK(2),o[d0],0,0,0);
    o[d0]=__builtin_amdgcn_mfma_f32_32x32x16_bf16(pa3,PK(3),o[d0],0,0,0);
    #undef PK
  }
}

#ifndef ATTN_STORE16
#define ATTN_STORE16(p,v) (*(u32x4*)(p)=(v))
#endif
template<int THRL,int MODE> __device__ __forceinline__ void attn_unit(int b,int h,int qb,const bf16*Q,const bf16*__restrict__ Kh,const bf16*__restrict__ Vh,bf16*O,char*shm,float sink_l2){
  const int tid=threadIdx.x,lane=tid&63,r32=lane&31,hi=lane>>5; const int wid=__builtin_amdgcn_readfirstlane(tid>>6);
  const long rowbase=(long)b*SEQ; const int q0=qb*QB;
  const bf16*Qw=Q+(rowbase+q0+wid*QBLK)*DM+h*D;
  const int wlo=(MODE==1)?(q0>=128?q0-128:0):0, whi=(MODE==1)?((q0+QB+128<=SEQ)?q0+QB+128:SEQ):0;
  #define TROW(t) ((MODE==1)?(((t)<4)?(SEQ+64*(t)):(wlo+64*((t)-4))):(64*(t)))
  const unsigned lds0=(unsigned)(uintptr_t)shm;
  float*wsf=(float*)(shm+LDS_WS)+wid*64;
  const bf16*ksrc=Kh+(long)lane*KVP+wid*8;
  const bf16*vsrc=Vh+(long)(16*(wid&3)+(lane>>2))*KVP+(wid>>2)*32+(lane&3)*8;
  const unsigned kdst=lds0+LDS_K+wid*1024, vdst=lds0+LDS_V+wid*1024;
  #define DMA_K(t,slot) glds16(ksrc+(long)TROW(t)*KVP,(unsigned)__builtin_amdgcn_readfirstlane(kdst+(slot)))
  #define DMA_V(t,slot) glds16(vsrc+(long)TROW(t)*KVP,(unsigned)__builtin_amdgcn_readfirstlane(vdst+(slot)))
  const int vb0=(int)(lds0+LDS_V)+((lane>>4)&1)*32+(lane&3)*8+(4*hi+((lane&15)>>2))*64;
  const char*Kbase=shm+LDS_K; bf16x8 kf[8];
  const lds_cptr shm3=(lds_cptr)shm; const lds_cptr kp0=shm3+LDS_K+hi*1024+r32*16; const lds_cptr vp0=shm3+LDS_V+((lane>>4)&1)*32+(lane&3)*8+(4*hi+((lane&15)>>2))*64;
  const int NT=(MODE==1)?(4+(whi-wlo)/KVBLK):((SEQ+CTXL)/KVBLK);
  DMA_K(0,0);DMA_V(0,0);DMA_K(1,SLOTB);
  bf16x8 qr[4];
  #pragma unroll
  for(int d0=0;d0<4;++d0)qr[d0]=*reinterpret_cast<const bf16x8*>(&Qw[(long)r32*DM+d0*16+hi*8]);
  float mhat=0.f,l_reg=0.f;f32x16 o[2];o[0]=f32x16{};o[1]=f32x16{};f32x16 negm=f32x16{};asm volatile("":"+v"(negm));
  const int qrel=wid*QBLK+r32;
  #define CMASK(P0,P1,t) do{ if(MODE==1&&(t)>=4) wmask(P0,P1,TROW(t)-(q0+qrel),hi); }while(0)
  bool resc=false;
  #define START(P0,P1) do{ const float rm=rowmax(P0,P1); resc=false; \
    { const float dl=rm; mhat=fadd_s(mhat,dl); \
      _Pragma("unroll") for(int r=0;r<16;++r){P0[r]=fsub_s(P0[r],dl);P1[r]=fsub_s(P1[r],dl);} \
      _Pragma("unroll") for(int r=0;r<16;++r)negm[r]=-mhat; asm volatile("":"+v"(negm)); } \
    _Pragma("unroll") for(int r=0;r<16;++r)P0[r]=__builtin_amdgcn_exp2f(P0[r]); }while(0)
  #define RESC() do{ if(resc){ asm volatile("s_waitcnt lgkmcnt(0)":::"memory"); \
      _Pragma("unroll") for(int d_=0;d_<2;++d_) _Pragma("unroll") for(int r=0;r<16;++r)o[d_][r]*=wsf[crow(r,hi)]; } }while(0)
  f32x16 pA0,pA1,pB0,pB1;
  int sl_prev=0,sl_cur=0,sl_next=SLOTB;
  #define ROT() do{sl_prev=sl_cur;sl_cur=sl_next;sl_next=(sl_next==(NSLOT-1)*SLOTB)?0:sl_next+SLOTB;}while(0)
  DMA_K(2,2*SLOTB);
  WAIT_BAR(3);
  qkt(pA0,pA1,Kbase,qr,negm,r32,hi);asm volatile("s_nop 15\n\ts_nop 7":"+v"(pA0),"+v"(pA1));CMASK(pA0,pA1,0);
  START(pA0,pA1);
  _Pragma("unroll") for(int r=0;r<16;++r)pA1[r]=__builtin_amdgcn_exp2f(pA1[r]);
  WAIT_BAR(0);
  DMA_K(3,0);DMA_V(1,SLOTB);
  ROT();
  kload8(kf,kp0+sl_cur);
  WAIT_BAR(2);
  s16x4 vlo[8],vhi[8]; u32x4 pw0,pw1,pw2,pw3;
  #define PKW(P,B) cvtpk_s(P[B],P[B+1])
  #define PAF(k) __builtin_bit_cast(bf16x8,pw##k)
  #define VFR(i) (bf16x8){vlo[i][0],vlo[i][1],vlo[i][2],vlo[i][3],vhi[i][0],vhi[i][1],vhi[i][2],vhi[i][3]}
  #define PIN(x) asm volatile("":"+v"(x))
  #define MX3(a,b,c) __builtin_fmaxf(__builtin_fmaxf((a),(b)),(c))
  #define GAPA(MF,A0,A1,A2,A3,W0,W1,PW) do{ MF; sacc+=A0; sacc+=A1; sacc+=A2; sacc+=A3; PIN(sacc); W0; W1; PIN(PW); SBAR(); }while(0)
  #define EX(v) __builtin_amdgcn_exp2f(v)
  #define GAPB(MF,X,B) do{ MF; X[B]=EX(X[B]); X[B+1]=EX(X[B+1]); X[B+2]=EX(X[B+2]); X[B+3]=EX(X[B+3]); PIN(X); SBAR(); }while(0)
  #define VRD(i) do{ vlo[i]=vtr(vp_+(((i)>>2)*4096+((i)&3)*1024)); vhi[i]=vtr(vp_+(((i)>>2)*4096+((i)&3)*1024+512)); }while(0)
  #define KRD(G,j) do{ if(G){ kload2(kf,kp0+sl_next,j); SBAR(); } }while(0)
  #define STEP(C0,C1,P0,P1,t,GK,GV,GL) do{ SBAR(); \
    const lds_cptr vp_=vp0+sl_prev; \
    VRD(0); SBAR(); float sacc=(P0[0]+P0[1]); \
    GAPA(C0=__builtin_amdgcn_mfma_f32_32x32x16_bf16(kf[0],qr[0],negm,0,0,0), P0[2],P0[3],P0[4],P0[5],     pw0[0]=PKW(P0,0), pw0[1]=PKW(P0,2), pw0); \
    VRD(4); SBAR(); GAPA(C1=__builtin_amdgcn_mfma_f32_32x32x16_bf16(kf[1],qr[0],negm,0,0,0), P0[6],P0[7],P0[8],P0[9],     pw0[2]=PKW(P0,4), pw0[3]=PKW(P0,6), pw0); \
    VRD(1); SBAR(); GAPA(C0=__builtin_amdgcn_mfma_f32_32x32x16_bf16(kf[2],qr[1],C0,0,0,0),   P0[10],P0[11],P0[12],P0[13], pw1[0]=PKW(P0,8), pw1[1]=PKW(P0,10), pw1); \
    VRD(5); SBAR(); GAPA(C1=__builtin_amdgcn_mfma_f32_32x32x16_bf16(kf[3],qr[1],C1,0,0,0),   P0[14],P0[15],P1[0],P1[1],   pw1[2]=PKW(P0,12),pw1[3]=PKW(P0,14), pw1); \
    VRD(2); SBAR(); GAPA(C0=__builtin_amdgcn_mfma_f32_32x32x16_bf16(kf[4],qr[2],C0,0,0,0),   P1[2],P1[3],P1[4],P1[5],     pw2[0]=PKW(P1,0), pw2[1]=PKW(P1,2), pw2); \
    VRD(6); SBAR(); GAPA(C1=__builtin_amdgcn_mfma_f32_32x32x16_bf16(kf[5],qr[2],C1,0,0,0),   P1[6],P1[7],P1[8],P1[9],     pw2[2]=PKW(P1,4), pw2[3]=PKW(P1,6), pw2); \
    VRD(3); SBAR(); GAPA(C0=__builtin_amdgcn_mfma_f32_32x32x16_bf16(kf[6],qr[3],C0,0,0,0),   P1[10],P1[11],P1[12],P1[13], pw3[0]=PKW(P1,8), pw3[1]=PKW(P1,10), pw3); \
    VRD(7); SBAR(); GAPA(C1=__builtin_amdgcn_mfma_f32_32x32x16_bf16(kf[7],qr[3],C1,0,0,0),   P1[14],P1[15],0.f,0.f,       pw3[2]=PKW(P1,12),pw3[3]=PKW(P1,14), pw3); \
    l_reg+=sacc; \
    if(GK){DMA_K((t)+3,sl_cur);} if(GV){DMA_V((t)+1,sl_next);} \
    CMASK(C0,C1,t); \
    { float a=MX3(C0[0],C0[1],C1[0]),b=MX3(C0[2],C0[3],C1[1]); a=MX3(a,C1[2],C1[3]); \
      _Pragma("unroll") for(int r=4;r<16;r+=4){a=MX3(a,C0[r],C0[r+1]);b=MX3(b,C0[r+2],C0[r+3]);a=MX3(a,C1[r],C1[r+1]);b=MX3(b,C1[r+2],C1[r+3]);} \
      float rm=__builtin_fmaxf(a,b); { auto rr=__builtin_amdgcn_permlane32_swap(__float_as_uint(rm),__float_as_uint(rm),false,false); rm=__builtin_fmaxf(__uint_as_float(rr[0]),__uint_as_float(rr[1])); } \
      resc=false; \
      if(__builtin_expect(__any(rm>(float)THRL),0)){ const float dl=__builtin_fmaxf(rm,0.f); mhat+=dl; \
        _Pragma("unroll") for(int r=0;r<16;++r){C0[r]-=dl;C1[r]-=dl;} \
        _Pragma("unroll") for(int r=0;r<16;++r)negm[r]=-mhat; asm volatile("":"+v"(negm)); \
        const float f=__builtin_amdgcn_exp2f(-dl); l_reg*=f; if(hi==0)wsf[r32]=f; resc=true; } } \
    SBAR(); \
    GAPB(o[0]=__builtin_amdgcn_mfma_f32_32x32x16_bf16(PAF(0),VFR(0),o[0],0,0,0), C0,0); \
    GAPB(o[1]=__builtin_amdgcn_mfma_f32_32x32x16_bf16(PAF(0),VFR(4),o[1],0,0,0), C0,4); \
    KRD(GL,0); GAPB(o[0]=__builtin_amdgcn_mfma_f32_32x32x16_bf16(PAF(1),VFR(1),o[0],0,0,0), C0,8); \
    KRD(GL,1); GAPB(o[1]=__builtin_amdgcn_mfma_f32_32x32x16_bf16(PAF(1),VFR(5),o[1],0,0,0), C0,12); \
    KRD(GL,2); GAPB(o[0]=__builtin_amdgcn_mfma_f32_32x32x16_bf16(PAF(2),VFR(2),o[0],0,0,0), C1,0); \
    KRD(GL,3); GAPB(o[1]=__builtin_amdgcn_mfma_f32_32x32x16_bf16(PAF(2),VFR(6),o[1],0,0,0), C1,4); \
    GAPB(o[0]=__builtin_amdgcn_mfma_f32_32x32x16_bf16(PAF(3),VFR(3),o[0],0,0,0), C1,8); \
    GAPB(o[1]=__builtin_amdgcn_mfma_f32_32x32x16_bf16(PAF(3),VFR(7),o[1],0,0,0), C1,12); \
    }while(0)
  int t=1;
  #undef CMASK
  #define CMASK(P0,P1,t) do{ if(MODE==1&&(t)>=4) wmask(P0,P1,TROW(t)-(q0+qrel),hi); }while(0)
  for(;t+5<NT;t+=2){
    STEP(pB0,pB1,pA0,pA1,t,true,true,true);     WAIT_BAR(2); RESC(); ROT();
    STEP(pA0,pA1,pB0,pB1,t+1,true,true,true);   WAIT_BAR(2); RESC(); ROT();
  }
  #undef CMASK
  #define CMASK(P0,P1,t) do{ if(MODE==1&&(t)>=4) wmask(P0,P1,TROW(t)-(q0+qrel),hi); }while(0)
  #define ENDW(tt) do{ if((tt)+3<NT){WAIT_BAR(2);} else if((tt)+2<NT){WAIT_BAR(1);} else {WAIT_BAR(0);} }while(0)
  for(;t+1<NT;t+=2){
    STEP(pB0,pB1,pA0,pA1,t,(t+3<NT),(t+1<NT),(t+1<NT));       ENDW(t);   RESC(); ROT();
    STEP(pA0,pA1,pB0,pB1,t+1,(t+4<NT),(t+2<NT),(t+2<NT));     ENDW(t+1); RESC(); ROT();
  }
  STEP(pB0,pB1,pA0,pA1,NT-1,false,false,false); RESC();
  { float sacc=pB0[0]+pB0[1]; _Pragma("unroll") for(int r=2;r<16;++r)sacc+=pB0[r]; _Pragma("unroll") for(int r=0;r<16;++r)sacc+=pB1[r]; l_reg+=sacc;
    pw0=(u32x4){PKW(pB0,0),PKW(pB0,2),PKW(pB0,4),PKW(pB0,6)};pw1=(u32x4){PKW(pB0,8),PKW(pB0,10),PKW(pB0,12),PKW(pB0,14)};pw2=(u32x4){PKW(pB1,0),PKW(pB1,2),PKW(pB1,4),PKW(pB1,6)};pw3=(u32x4){PKW(pB1,8),PKW(pB1,10),PKW(pB1,12),PKW(pB1,14)};
    SBAR(); pv(o,vb0+sl_cur,PAF(0),PAF(1),PAF(2),PAF(3)); }
  #undef PKW
  #undef PAF
  #undef VFR
  #undef PIN
  #undef MX3
  #undef GAPA
  #undef GAPB
  #undef EX
  #undef VRD
  #undef KRD
  #undef STEP
  #undef ENDW
  {auto rr=__builtin_amdgcn_permlane32_swap(__float_as_uint(l_reg),__float_as_uint(l_reg),false,false);l_reg=__uint_as_float(rr[0])+__uint_as_float(rr[1]);}
  if(MODE==1) l_reg+=__builtin_amdgcn_exp2f(sink_l2-mhat);
  if(hi==0)wsf[32+r32]=l_reg;asm volatile("s_waitcnt lgkmcnt(0)":::"memory");
  float rli[16];
  #pragma unroll
  for(int r=0;r<16;++r)rli[r]=__builtin_amdgcn_rcpf(wsf[32+crow(r,hi)]);
  bf16*Ow=O+(rowbase+q0+wid*QBLK)*DM+h*D;
  { bf16*stg=(bf16*)(shm+LDS_OST)+wid*2048;
    #pragma unroll
    for(int r=0;r<16;++r){const int orow=crow(r,hi);
      #pragma unroll
      for(int d0=0;d0<2;++d0)stg[orow*64+d0*32+r32]=__float2bfloat16(o[d0][r]*rli[r]);}
    asm volatile("s_waitcnt lgkmcnt(0)":::"memory");
    #pragma unroll
    for(int i=0;i<4;++i){const int row=i*8+(lane>>3),ch=lane&7; const u32x4 v=*(const u32x4*)(stg+row*64+ch*8); ATTN_STORE16(Ow+(long)row*DM+ch*8,v);} }
  asm volatile("s_waitcnt lgkmcnt(0)\n\ts_barrier":::"memory");
  #undef DMA_K
  #undef DMA_V
  #undef CMASK
  #undef START
  #undef RESC
  #undef ROT
  #undef TROW
}
constexpr int ATTN_LDS_BYTES=LDS_BYTES;
#undef SBAR
#undef WAIT_BAR
}
#define GAS __attribute__((address_space(1)))
#define LAS __attribute__((address_space(3)))
typedef unsigned short bf16;
typedef unsigned v4u __attribute__((ext_vector_type(4)));
typedef float f32x4 __attribute__((ext_vector_type(4)));
typedef short bf16x8 __attribute__((ext_vector_type(8)));
typedef GAS unsigned gu32;
typedef GAS unsigned long long gu64;
#define RLX_AGENT __ATOMIC_RELAXED, __HIP_MEMORY_SCOPE_AGENT
#define LDS_WAIT() asm volatile("s_waitcnt lgkmcnt(0)" ::: "memory")
#define VM_WAIT() asm volatile("s_waitcnt vmcnt(0)" ::: "memory")
__device__ __forceinline__ unsigned long long rt() { return __builtin_amdgcn_s_memrealtime(); }
typedef float f32x2c_t __attribute__((ext_vector_type(2))); typedef __bf16 bf16x2c_t __attribute__((ext_vector_type(2)));
__device__ __forceinline__ unsigned pk2(float lo, float hi) { f32x2c_t v = {lo, hi}; bf16x2c_t r = __builtin_convertvector(v, bf16x2c_t); return __builtin_bit_cast(unsigned, r); }
__device__ __forceinline__ unsigned f2bf(float f) { return pk2(f, 0.f) & 0xffffu; }

#define XB_TMO      128
#define XB_XCNT(j)  (256  + 64 * (j))
#define XB_XSUB(j)  (1280 + 64 * (j))
#define XB_XGEN(j)  (2304 + 64 * (j))
#define XB_TOP      3328
#define XB_TOPGEN   3392
#define XCD_BAR_WORDS 3456
#define XB_SPIN_CAP (1u << 18)

__device__ __forceinline__ unsigned xb_ld(unsigned* p)              { return __hip_atomic_load(p, __ATOMIC_RELAXED, __HIP_MEMORY_SCOPE_AGENT); }
__device__ __forceinline__ unsigned xb_add(unsigned* p, unsigned v) { return __hip_atomic_fetch_add(p, v, __ATOMIC_RELAXED, __HIP_MEMORY_SCOPE_AGENT); }
__device__ __forceinline__ unsigned xb_xcc_id() { return (unsigned)__builtin_amdgcn_s_getreg((3 << 11) | 20) & 0xFu; }
#define XB_SPIN(cond, bar) do { unsigned _sp = 0; while (cond) { __builtin_amdgcn_s_sleep(1); \
    if ((++_sp & 255u) == 0u) { if (xb_ld(&(bar)[XB_TMO])) break; if (_sp > XB_SPIN_CAP) { atomicAdd(&(bar)[XB_TMO], 1u); break; } } } } while (0)

struct XcdBarrier {
    unsigned* bar; unsigned x;
    volatile LAS unsigned* st;
};

__device__ __forceinline__ XcdBarrier xcd_barrier_post(unsigned* bar, volatile LAS unsigned* st) {
    XcdBarrier b; b.bar = bar; b.x = xb_xcc_id(); b.st = st;
    if (threadIdx.x == 0) (void)xb_add(&bar[XB_XCNT(b.x)], 1u);
    return b;
}
__device__ __forceinline__ void xcd_barrier_complete(unsigned* bar, unsigned x, unsigned& nloc, unsigned& nx) {
    const unsigned G = gridDim.x * gridDim.y * gridDim.z;
    unsigned sum, cnt, mine, sp = 0u;
    for (;;) {
        sum = 0u; cnt = 0u; mine = 0u;
#pragma unroll
        for (unsigned j = 0; j < 16; ++j) { const unsigned c = xb_ld(&bar[XB_XCNT(j)]); sum += c; cnt += (c > 0u) ? 1u : 0u; mine = (j == x) ? c : mine; }
        if (sum == G) break;
        __builtin_amdgcn_s_sleep(1);
        if ((++sp & 255u) == 0u) { if (xb_ld(&bar[XB_TMO])) break; if (sp > XB_SPIN_CAP) { atomicAdd(&bar[XB_TMO], 1u); break; } }
    }
    nloc = mine > 0u ? mine : 1u; nx = cnt > 0u ? cnt : 1u;
}

__device__ __forceinline__ void xcd_barrier(const XcdBarrier& b) {
    asm volatile("s_waitcnt vmcnt(0)" ::: "memory");
    __syncthreads();
    if (threadIdx.x == 0) {
        unsigned* bar = b.bar;
        __builtin_amdgcn_s_waitcnt(0);
        unsigned nloc = b.st[0], nx = b.st[1];
        if (nloc == 0u) { xcd_barrier_complete(bar, b.x, nloc, nx); b.st[0] = nloc; b.st[1] = nx; }
        const unsigned old = xb_add(&bar[XB_XSUB(b.x)], 1u);
        const unsigned gen = old / nloc;
        if (old + 1u == (gen + 1u) * nloc) {
            __builtin_amdgcn_fence(__ATOMIC_RELEASE, "agent");
            asm volatile("s_waitcnt vmcnt(0)" ::: "memory");
            const unsigned og = xb_add(&bar[XB_TOP], 1u);
            const unsigned tg = og / nx;
            if (og + 1u == (tg + 1u) * nx) xb_add(&bar[XB_TOPGEN], 1u);
            else XB_SPIN(xb_ld(&bar[XB_TOPGEN]) == tg, bar);
            __builtin_amdgcn_fence(__ATOMIC_ACQUIRE, "agent");
            xb_add(&bar[XB_XGEN(b.x)], 1u);
            asm volatile("s_waitcnt vmcnt(0)" ::: "memory");
        } else {
            XB_SPIN(xb_ld(&bar[XB_XGEN(b.x)]) == gen, bar);
            __builtin_amdgcn_fence(__ATOMIC_ACQUIRE, "agent");
            asm volatile("s_waitcnt vmcnt(0)" ::: "memory");
        }
    }
    __syncthreads();
}
constexpr int NWAVES = 8, NTHREADS = 512;
constexpr int BATCH = 2, T = 8192, D = 1024, CTXL = 256, FF = 4096;
constexpr int ML_ROWS = BATCH * T;
constexpr int MC_ROWS = BATCH * CTXL;
constexpr int MA_ROWS = ML_ROWS + MC_ROWS;
constexpr int REC_N = 4096;
constexpr int ATT_N = 1536;
constexpr int KV_LEN = T + CTXL;
constexpr int NCHUNK = KV_LEN / 128;
constexpr int NCHAIN_ML = 16;
constexpr int NITEM_ML = NCHAIN_ML * NCHUNK;
constexpr int NCHAIN_RW = 32;
constexpr float NORM_EPS = 1e-6f, GN_EPS = 64e-5f;

constexpr size_t MiB = 1u << 20;
constexpr size_t WS_CTL = 0, CTL_ZERO_BYTES = 1 * MiB;
constexpr size_t WS_MODP = 1 * MiB;
constexpr size_t WS_MOD = 4 * MiB;
constexpr size_t WS_ROPE = WS_MOD + 512 * 1024;
constexpr size_t WS_BIAS = WS_MOD + 640 * 1024;
constexpr size_t WS_SSC = WS_MOD + 800 * 1024;
constexpr size_t WS_SS = 7 * MiB;
constexpr size_t WS_MISC = 5 * MiB;
constexpr size_t WS_WREC = 8 * MiB;
constexpr size_t WS_WATT = 17 * MiB;
constexpr size_t WS_WOUT = 20 * MiB;
constexpr size_t WS_W1 = 24 * MiB;
constexpr size_t WS_W2 = 40 * MiB;
constexpr size_t WS_WG2 = 56 * MiB;
constexpr size_t WS_W2T = WS_WG2 + 128 * 1024;
constexpr size_t WS_XC = 57 * MiB;
constexpr size_t WS_XN = 59 * MiB;
constexpr size_t WS_R = 92 * MiB;
constexpr size_t WS_END = 256 * MiB;
constexpr size_t SZ_A = (size_t)MA_ROWS * 512 * 2;
constexpr size_t R_QM = WS_R, R_KM = R_QM + SZ_A, R_OM = R_KM + SZ_A;
constexpr size_t R_RAW = R_OM + SZ_A;
constexpr size_t R_TWAD = R_RAW + 3 * SZ_A;
constexpr size_t R_SGD = R_TWAD + SZ_A / 2;
constexpr size_t R_GATES = R_SGD + SZ_A / 4;
constexpr size_t R_YRW0 = R_GATES + (size_t)MA_ROWS * 16 * 4;
constexpr size_t R_VM = R_YRW0 + SZ_A;
static_assert(R_VM + 2 * SZ_A <= WS_END, "recurrent map: VM plus the free tail hold the 33 MiB RWKV N buffer");
constexpr size_t R_GATE = R_VM;
constexpr size_t R_MIX = R_QM;
constexpr size_t R_HML = WS_XN;
constexpr size_t DO_CST = 0, DO_YRW1 = 34 * MiB;
static_assert((size_t)NITEM_ML * 16384 * 2 <= DO_YRW1 && DO_YRW1 + SZ_A <= (size_t)ML_ROWS * D * 4, "d_out scratch map");
constexpr size_t R_ATT = WS_R;
constexpr size_t R_QB = R_ATT + (size_t)MA_ROWS * ATT_N * 4;
constexpr size_t SZ_KV = (size_t)BATCH * 2 * KV_LEN * 64 * 2;
constexpr size_t R_KW = R_QB + (size_t)ML_ROWS * D * 2, R_VW = R_KW + SZ_KV, R_KG = R_VW + SZ_KV, R_VG = R_KG + SZ_KV;
static_assert(R_VG + SZ_KV <= WS_END, "attention map");
constexpr size_t R_PART = WS_R + (size_t)MA_ROWS * FF * 2;
constexpr size_t R_H = WS_R;
static_assert(R_H + (size_t)MA_ROWS * FF * 2 + (size_t)4 * MC_ROWS * D * 4 <= WS_END, "ffn map");
constexpr size_t MI_BT = WS_MISC;
constexpr size_t MI_AT = MI_BT + (size_t)8 * MA_ROWS * 4;
constexpr size_t MI_CHS = MI_AT + (size_t)8 * MA_ROWS * 4;
constexpr size_t MI_MCH = MI_CHS + 16 * 66 * 2 * 4;
constexpr size_t MI_DN = MI_MCH + 16 * 66 * 4 + 256;
static_assert(MI_DN + (size_t)NITEM_ML * 128 * 4 <= WS_SS && WS_SS + (size_t)ML_ROWS * 16 * 4 <= WS_WREC && WS_SSC + 512 * 64 * 4 <= WS_MISC && WS_BIAS + 9 * 4096 * 4 <= WS_SSC, "misc map");
constexpr int LDSX_RSC = 153856;

constexpr int CW_TMO = 0, CW_CODE = 1;
constexpr int CW_BAR = 4096;
constexpr int CW_DBG = 65536;

constexpr int RING_OFF = 0, RING_BYTES = 131072;
constexpr int LDSCTL_OFF = RING_BYTES, MISC_OFF = LDSCTL_OFF + 320;
constexpr int LDS_BYTES = 163840;
constexpr int LDSX_OFF = 132096;
struct Frame {
    LAS unsigned char* lds;
    volatile LAS unsigned* MISC;
    gu32* ctl;
    int tid, lane, wave;
    int vcu, G;
    unsigned char* ws; float* out;
};
__device__ __forceinline__ float bf2f(bf16 b) { return __uint_as_float((unsigned)b << 16); }
__device__ __forceinline__ float wave_sum(float v);
__device__ __forceinline__ float wave_max(float v) {
#pragma unroll
    for (int o = 1; o < 64; o <<= 1) v = fmaxf(v, __shfl_xor(v, o));
    return v;
}
template <int CTRL> __device__ __forceinline__ float dpp_mov(float v) { return __builtin_bit_cast(float, __builtin_amdgcn_update_dpp(0, __builtin_bit_cast(int, v), CTRL, 0xF, 0xF, true)); }
__device__ __forceinline__ float sum8(float v) { v += dpp_mov<0xB1>(v); v += dpp_mov<0x4E>(v); v += dpp_mov<0x141>(v); return v; }
__device__ __forceinline__ float sum16(float v) { v = sum8(v); v += dpp_mov<0x140>(v); return v; }
__device__ __forceinline__ float wave_sum(float v) { v = sum16(v); v += __shfl_xor(v, 16); v += __shfl_xor(v, 32); return v; }
__device__ __forceinline__ float sigmoidf_(float x) { return __builtin_amdgcn_rcpf(1.0f + __expf(-x)); }
typedef float f32x2v __attribute__((ext_vector_type(2)));
typedef unsigned u32x2v __attribute__((ext_vector_type(2)));
#define MFMA16(a, b, c) __builtin_amdgcn_mfma_f32_16x16x32_bf16(a, b, c, 0, 0, 0)
template <int P = 72> __device__ __forceinline__ bf16x8 ldsfrag(const LAS bf16* t, int row, int col) { return *(const LAS bf16x8*)(t + row * P + col); }
typedef short v4i16_t __attribute__((ext_vector_type(4)));
template <int P = 72> __device__ __forceinline__ bf16x8 trfrag(const LAS bf16* t, int c0, int k0, int l15, int l4) {
    const LAS bf16* p = t + (k0 + 8 * l4 + (l15 >> 2)) * P + c0 + 4 * (l15 & 3);
    const v4i16_t lo = __builtin_amdgcn_ds_read_tr16_b64_v4i16((LAS v4i16_t*)p), hi = __builtin_amdgcn_ds_read_tr16_b64_v4i16((LAS v4i16_t*)(p + 4 * P));
    return (bf16x8){lo[0], lo[1], lo[2], lo[3], hi[0], hi[1], hi[2], hi[3]};
}
__device__ __forceinline__ bf16x8 gfrag(const bf16* p) { return __builtin_bit_cast(bf16x8, *(const GAS v4u*)p); }
__device__ __forceinline__ u32x2v pk4(f32x4 v) { u32x2v o; o.x = pk2(v[0], v[1]); o.y = pk2(v[2], v[3]); return o; }

enum { I_X = 0, I_C, I_CTX, I_CCTX, I_NORM_MIX, I_NORM_FFN, I_MOD_W, I_MOD_B, I_OUT_W, I_FFN_W1, I_FFN_W2, I_REC_IN_W, I_ML_GATE_B, I_ML_NORM_G, I_RW_CONV,
       I_RW_W0, I_RW_W2, I_RW_A0, I_RW_A2, I_RW_G2, I_RW_KK, I_RW_KA, I_RW_RK, I_RW_NORM_G, I_ATT_IN_W, I_WIN_Q_NORM, I_WIN_K_NORM, I_WIN_SINK, I_GLB_Q_NORM, I_GLB_K_NORM, N_IN };
struct Args { const float* in[N_IN]; float* out; unsigned char* ws; int ph_lo, ph_hi, li, pad; };

template <int MAP> __device__ __forceinline__ int src_col(int n) {
    if (MAP == 0) return n;
    if (n < 2048) return n;
    if (n < 3968) return n + 16;
    if (n < 3984) return n - 1920;
    return -1;
}
template <int MAP> __device__ __forceinline__ void p0_transpose_item(const float* W, int K, int srcN, int dstN, bf16* WT, LAS float* scr, int item, int lane) {
    const int nblk = dstN / 32, kb = item / nblk, nb = item % nblk, k0 = 64 * kb, n0 = 32 * nb;
    const int sc = src_col<MAP>(n0 + (lane & 31));
    float v[32];
#pragma unroll
    for (int i = 0; i < 32; ++i) { const int kk = 2 * i + (lane >> 5); v[i] = (sc >= 0) ? W[(size_t)(k0 + kk) * srcN + sc] : 0.f; }
#pragma unroll
    for (int i = 0; i < 32; ++i) { const int kk = 2 * i + (lane >> 5); scr[kk * 33 + (lane & 31)] = v[i]; }
    LDS_WAIT(); asm volatile("" ::: "memory");
    const int c = lane & 7;
#pragma unroll
    for (int j = 0; j < 4; ++j) { const int n = (lane >> 3) + 8 * j; const LAS float* s = scr + (8 * c) * 33 + n;
        v4u o; o.x = pk2(s[0 * 33], s[1 * 33]); o.y = pk2(s[2 * 33], s[3 * 33]); o.z = pk2(s[4 * 33], s[5 * 33]); o.w = pk2(s[6 * 33], s[7 * 33]);
        *(GAS v4u*)(WT + (size_t)(n0 + n) * K + k0 + 8 * c) = o; }
    LDS_WAIT(); asm volatile("" ::: "memory");
}
template <int PART> struct P0W {
    static constexpr int I_A = PART == 0 ? (D / 64) * (REC_N / 32) : (PART == 1 ? (D / 64) * (ATT_N / 32) : 0);
    static constexpr int I_OUT = (PART == 1 || PART == 4) ? (D / 64) * (D / 32) : 0, I_1 = (PART == 1 || PART == 3) ? (D / 64) * (FF / 32) : 0, I_2 = (PART == 2 || PART == 4) ? (FF / 64) * (D / 32) : 0, I_G2 = PART == 0 ? (128 / 64) * (512 / 32) : 0;
    static constexpr int NITEMS = I_A + I_OUT + I_1 + I_2 + I_G2;
};
template <int PART> __device__ __forceinline__ void p0_weight_item(Frame& F, const Args& A, int r) {
    typedef P0W<PART> P;
    LAS float* scr = (LAS float*)(F.lds + RING_OFF + F.wave * 16384);
    constexpr int l = (PART == 0 || PART >= 3) ? 0 : 1;
    unsigned char* ws = F.ws;
    if (r < P::I_A) { if (PART == 0) p0_transpose_item<1>(A.in[I_REC_IN_W], D, 3984, REC_N, (bf16*)(ws + WS_WREC), scr, r, F.lane); else p0_transpose_item<0>(A.in[I_ATT_IN_W], D, ATT_N, ATT_N, (bf16*)(ws + WS_WATT), scr, r, F.lane); return; } r -= P::I_A;
    if (r < P::I_OUT) { p0_transpose_item<0>(A.in[I_OUT_W] + (size_t)l * D * D, D, D, D, (bf16*)(ws + WS_WOUT) + (size_t)l * D * D, scr, r, F.lane); return; } r -= P::I_OUT;
    if (r < P::I_1) { p0_transpose_item<0>(A.in[I_FFN_W1] + (size_t)l * D * FF, D, FF, FF, (bf16*)(ws + WS_W1) + (size_t)l * D * FF, scr, r, F.lane); return; } r -= P::I_1;
    if (r < P::I_2) { p0_transpose_item<0>(A.in[I_FFN_W2] + (size_t)l * D * FF, FF, D, D, (bf16*)(ws + WS_W2) + (size_t)l * D * FF, scr, r, F.lane); return; } r -= P::I_2;
    if (PART == 0) p0_transpose_item<0>(A.in[I_RW_G2], 128, 512, 512, (bf16*)(ws + WS_WG2), scr, r, F.lane);
}
template <int PART> __device__ __forceinline__ void p0_weights_tail(Frame& F, const Args& A, int ntile, int bid) {
    const int nx = ntile % F.G; __syncthreads();
    int gw, NGW; if (nx == 0) { gw = bid * NWAVES + F.wave; NGW = F.G * NWAVES; } else if (bid >= nx) { gw = (bid - nx) * NWAVES + F.wave; NGW = (F.G - nx) * NWAVES; } else return;
    for (int it = gw; it < P0W<PART>::NITEMS; it += NGW) p0_weight_item<PART>(F, A, it);
}
__device__ __forceinline__ void p0_prologue(Frame& F, const Args& A) {
    const int gw = F.vcu * NWAVES + F.wave, NGW = F.G * NWAVES;
    unsigned char* ws = F.ws;
    constexpr int NGEMV = 2 * 48 * 16;
    float* MODP = (float*)(ws + WS_MODP);
    for (int it = gw; it < NGEMV + P0W<0>::NITEMS; it += NGW) {
        if (it >= NGEMV) { p0_weight_item<0>(F, A, it - NGEMV); continue; }
        const int l = it / (48 * 16), cc = (it / 16) % 48, kc = it % 16, hl = F.lane >> 5, l31 = F.lane & 31;
        float sv[3];
#pragma unroll
        for (int v = 0; v < 3; ++v) { const float cvv = (v < 2) ? A.in[I_C][v * D + kc * 64 + F.lane] : A.in[I_CCTX][kc * 64 + F.lane]; sv[v] = cvv * sigmoidf_(cvv); }
        const float* Wp = A.in[I_MOD_W] + ((size_t)l * D + kc * 64 + hl) * 6144 + cc * 128 + 4 * l31;
        f32x4 a0 = {0, 0, 0, 0}, a1 = a0, a2 = a0;
#pragma unroll 16
        for (int i = 0; i < 32; ++i) { const f32x4 w = *(const f32x4*)(Wp + (size_t)(2 * i) * 6144); const int k = 2 * i + hl; a0 += w * __shfl(sv[0], k); a1 += w * __shfl(sv[1], k); a2 += w * __shfl(sv[2], k); }
#pragma unroll
        for (int e = 0; e < 4; ++e) { a0[e] += __shfl_xor(a0[e], 32); a1[e] += __shfl_xor(a1[e], 32); a2[e] += __shfl_xor(a2[e], 32); }
        if (hl == 0) { float* o = MODP + ((size_t)(l * 16 + kc) * 3) * 6144 + cc * 128 + 4 * l31;
            *(f32x4*)(o) = a0; *(f32x4*)(o + 6144) = a1; *(f32x4*)(o + 2 * 6144) = a2; }
    }
    { bf16* W2T = (bf16*)(ws + WS_W2T);
      for (int e = F.vcu * NTHREADS + F.tid; e < 2 * 2 * 8 * 64 * 64; e += F.G * NTHREADS) {
          const int i = e & 63, ch = (e >> 6) & 63, h = (e >> 12) & 7, d = (e >> 15) & 1, which = e >> 16;
          const float* src = which == 0 ? A.in[I_RW_W2] : A.in[I_RW_A2];
          W2T[e] = (bf16)f2bf(src[(size_t)(d * 64 + i) * 512 + h * 64 + ch]); } }
    { float* ROPE = (float*)(ws + WS_ROPE);
      for (int e = F.vcu * NTHREADS + F.tid; e < 128 * 16; e += F.G * NTHREADS) { const float ang = (float)(e >> 4) * exp2f(-(float)(e & 15) * (13.287712379549449f / 16.0f)); float sn, cs; sincosf(ang, &sn, &cs); ROPE[2 * e] = cs; ROPE[2 * e + 1] = sn; } }
}
__device__ __forceinline__ void p1_mod_finalize(Frame& F, const Args& A) {
    const float* MODP = (const float*)(F.ws + WS_MODP); float* MOD = (float*)(F.ws + WS_MOD);
    for (int i = F.vcu * NTHREADS + F.tid; i < 2 * 3 * 6144; i += F.G * NTHREADS) {
        const int l = i / (3 * 6144), v = (i / 6144) % 3, n = i % 6144;
        float s = A.in[I_MOD_B][l * 6144 + n];
#pragma unroll
        for (int kc = 0; kc < 16; ++kc) s += MODP[((size_t)(l * 16 + kc) * 3 + v) * 6144 + n];
        MOD[i] = s;
    }
}
__device__ __forceinline__ void norm_rows(Frame& F, const Args& A, const float* lat, const float* ctx, int nrows, const float* g, const float* mod, int ch_shift, int ch_scale, bf16* XN, const float* cpart = nullptr, const float* cgate = nullptr) {
    const int gw = F.vcu * NWAVES + F.wave, NGW = F.G * NWAVES;
    constexpr int NR = 2;
    for (int row0 = NR * gw; row0 < nrows; row0 += NR * NGW) {
        f32x4 v[NR][4]; float ss[NR];
#pragma unroll
        for (int q = 0; q < NR; ++q) { const int row = row0 + q; const float* src = (row < ML_ROWS) ? lat + (size_t)row * D : ctx + (size_t)(row - ML_ROWS) * D; ss[q] = 0.f;
#pragma unroll
            for (int j = 0; j < 4; ++j) { v[q][j] = *(const f32x4*)(src + 256 * j + 4 * F.lane);
                if (cpart && row >= ML_ROWS) { const float* pp = cpart + (size_t)(row - ML_ROWS) * D + 256 * j + 4 * F.lane; const f32x4 ps = (*(const f32x4*)pp + *(const f32x4*)(pp + (size_t)MC_ROWS * D)) + (*(const f32x4*)(pp + (size_t)2 * MC_ROWS * D) + *(const f32x4*)(pp + (size_t)3 * MC_ROWS * D)); v[q][j] += ps * *(const f32x4*)(cgate + 256 * j + 4 * F.lane); }
                ss[q] += (v[q][j].x * v[q][j].x + v[q][j].y * v[q][j].y) + (v[q][j].z * v[q][j].z + v[q][j].w * v[q][j].w); } }
        f32x4 gsc[NR][4], sh[NR][4];
#pragma unroll
        for (int q = 0; q < NR; ++q) { const int row = row0 + q; const float* mv = mod + ((row < ML_ROWS) ? (row >> 13) : 2) * 6144;
#pragma unroll
            for (int j = 0; j < 4; ++j) { const int c = 256 * j + 4 * F.lane; gsc[q][j] = *(const f32x4*)(g + c) * (*(const f32x4*)(mv + ch_scale * 1024 + c) + 1.0f); sh[q][j] = *(const f32x4*)(mv + ch_shift * 1024 + c); } }
#pragma unroll
        for (int q = 0; q < NR; ++q) { const int row = row0 + q;
            const float rs = __builtin_amdgcn_rsqf(wave_sum(ss[q]) * (1.f / D) + NORM_EPS);
            unsigned long long* o8 = (unsigned long long*)(XN + (size_t)row * D);
#pragma unroll
            for (int j = 0; j < 4; ++j) {
                const f32x4 y = (v[q][j] * rs) * gsc[q][j] + sh[q][j];
                o8[64 * j + F.lane] = (unsigned long long)pk2(y.x, y.y) | ((unsigned long long)pk2(y.z, y.w) << 32);
            } }
    }
}

__device__ __forceinline__ int ml_chunk_base(int d, int b, int c) {
    if (c < 2) return ML_ROWS + b * CTXL + (d == 0 ? 128 * c : 128 * (1 - c));
    const int cc = c - 2; return b * T + (d == 0 ? 128 * cc : T - 128 * (cc + 1));
}
__device__ __forceinline__ void ml_pass_a(Frame& F, const Args& A) {
    constexpr int P = 136;
    unsigned char* ws = F.ws;
    const bf16* KM = (const bf16*)(ws + R_KM); const bf16* VM = (const bf16*)(ws + R_VM); const float* GATES = (const float*)(ws + R_GATES);
    float* BT = (float*)(ws + MI_BT); float* AT = (float*)(ws + MI_AT); float* CHS = (float*)(ws + MI_CHS); float* DN = (float*)(ws + MI_DN);
    bf16* CST = (bf16*)((unsigned char*)F.out + DO_CST);
    LAS bf16* Kt = (LAS bf16*)(F.lds); LAS bf16* Vt = Kt + 128 * P; LAS float* wl = (LAS float*)(F.lds + 2 * 128 * P * 2);
    const int w = F.wave;
    v4u kreg[4], vreg[4];
#define MLA_LOAD(it_) do { const int ch_ = (it_) / NCHUNK, c_ = (it_) % NCHUNK, d_ = ch_ >> 3, b_ = (ch_ >> 2) & 1, h_ = ch_ & 3; const int base_ = ml_chunk_base(d_, b_, c_); \
        _Pragma("unroll") for (int j = 0; j < 4; ++j) { const int idx = F.tid + 512 * j, row = idx >> 4, chk = idx & 15; \
            kreg[j] = *(const GAS v4u*)(KM + (size_t)(base_ + row) * 512 + h_ * 128 + 8 * chk); vreg[j] = *(const GAS v4u*)(VM + (size_t)(base_ + row) * 512 + h_ * 128 + 8 * chk); } } while (0)
    if (F.vcu < NITEM_ML) MLA_LOAD(F.vcu);
    for (int item = F.vcu; item < NITEM_ML; item += F.G) {
        const int chain = item / NCHUNK, c = item % NCHUNK, d = chain >> 3, b = (chain >> 2) & 1, h = chain & 3;
        const int base = ml_chunk_base(d, b, c);
        int lz = 0; asm volatile("" : "+s"(lz));
        const int tid = F.tid + lz, lane = tid & 63, l15 = lane & 15, l4 = lane >> 4;
        __syncthreads();
        if (w == 0) {
            const float bi = A.in[I_ML_GATE_B][(2 * d) * 4 + h], bfg = A.in[I_ML_GATE_B][(2 * d + 1) * 4 + h];
            float iv[2], lf[2];
#pragma unroll
            for (int e = 0; e < 2; ++e) { const int s = 2 * lane + e, o = d == 0 ? s : 127 - s; const float* gp = GATES + (size_t)(base + o) * 16 + 8 * d + h;
                iv[e] = gp[0] + bi; const float f = gp[4] + bfg; lf[e] = (f >= 0.f) ? -log1pf(__expf(-f)) : f - log1pf(__expf(f)); }
            const float pair = lf[0] + lf[1]; float incl = pair;
#pragma unroll
            for (int o = 1; o < 64; o <<= 1) { const float t_ = __shfl_up(incl, o); if (lane >= o) incl += t_; }
            const float excl = incl - pair; float bb[2] = {excl + lf[0], excl + pair}; float aa[2] = {iv[0] - bb[0], iv[1] - bb[1]};
            const float amax = wave_max(fmaxf(aa[0], aa[1])); const float bend = __shfl(bb[1], 63);
#pragma unroll
            for (int e = 0; e < 2; ++e) { const int s = 2 * lane + e, o = d == 0 ? s : 127 - s; const size_t gi = (size_t)(d * 4 + h) * MA_ROWS + base + o; BT[gi] = bb[e]; AT[gi] = aa[e]; wl[o] = __expf(aa[e] - amax); }
            if (lane == 0) { CHS[(chain * NCHUNK + c) * 2] = bend; CHS[(chain * NCHUNK + c) * 2 + 1] = amax; }
        }
#pragma unroll
        for (int j = 0; j < 4; ++j) { const int idx = tid + 512 * j, row = idx >> 4, ch = idx & 15; *(LAS v4u*)(Kt + row * P + 8 * ch) = kreg[j]; }
        __syncthreads();
#pragma unroll
        for (int j = 0; j < 4; ++j) { const int idx = tid + 512 * j, row = idx >> 4, ch = idx & 15; const float ws_ = wl[row]; const unsigned* pv_ = (const unsigned*)&vreg[j]; v4u o; unsigned* po = (unsigned*)&o;
#pragma unroll
            for (int q = 0; q < 4; ++q) po[q] = pk2(__uint_as_float(pv_[q] << 16) * ws_, __uint_as_float(pv_[q] & 0xffff0000u) * ws_);
            *(LAS v4u*)(Vt + row * P + 8 * ch) = o; }
        { const int dk = tid >> 2, q = tid & 3; float s = 0.f;
#pragma unroll 8
            for (int j = 0; j < 32; ++j) { const int so = 32 * q + j; s += bf2f(Kt[so * P + dk]) * wl[so]; }
            s += dpp_mov<0xB1>(s); s += dpp_mov<0x4E>(s);
            if (q == 0) DN[(size_t)item * 128 + dk] = s; }
        __syncthreads();
        { const int itn = item + F.G; if (itn < NITEM_ML) MLA_LOAD(itn); }
        f32x4 acc[8];
#pragma unroll
        for (int n8 = 0; n8 < 8; ++n8) acc[n8] = (f32x4){0.f, 0.f, 0.f, 0.f};
#pragma unroll
        for (int kk = 0; kk < 4; ++kk) {
            const bf16x8 vf = trfrag<P>(Vt, 16 * w, 32 * kk, l15, l4);
#pragma unroll
            for (int n8 = 0; n8 < 8; ++n8) acc[n8] = MFMA16(trfrag<P>(Kt, 16 * n8, 32 * kk, l15, l4), vf, acc[n8]);
        }
        bf16* cst = CST + (size_t)item * 16384 + (size_t)(16 * w + l15) * 128 + 4 * l4;
#pragma unroll
        for (int n8 = 0; n8 < 8; ++n8) *(u32x2v*)(cst + 16 * n8) = pk4(acc[n8]);
    }
#undef MLA_LOAD
    __syncthreads();
}
__device__ __forceinline__ void ml_pass_b(Frame& F, const Args& A) {
    unsigned char* ws = F.ws;
    const float* CHS = (const float*)(ws + MI_CHS); float* MCH = (float*)(ws + MI_MCH); float* DN = (float*)(ws + MI_DN);
    unsigned* CST = (unsigned*)((unsigned char*)F.out + DO_CST);
    constexpr int PER_CHAIN = 8192 + 128, NWORK = NCHAIN_ML * PER_CHAIN, NB = 11;
    static_assert(NCHUNK % NB == 0, "chunk batches");
    for (int wi = F.vcu * NTHREADS + F.tid; wi < NWORK; wi += F.G * NTHREADS) {
        const int chain = wi / PER_CHAIN, e = wi % PER_CHAIN;
        float m = 0.f, c0 = 0.f, c1 = 0.f;
        const float* chs = CHS + (size_t)chain * NCHUNK * 2;
        if (e < 8192) {
            unsigned* p = CST + (size_t)chain * NCHUNK * 8192 + e;
            for (int cb = 0; cb < NCHUNK; cb += NB) {
                unsigned dl[NB]; float be[NB], am[NB];
#pragma unroll
                for (int k = 0; k < NB; ++k) { dl[k] = p[(size_t)(cb + k) * 8192]; be[k] = chs[(cb + k) * 2]; am[k] = chs[(cb + k) * 2 + 1]; }
#pragma unroll
                for (int k = 0; k < NB; ++k) {
                    p[(size_t)(cb + k) * 8192] = pk2(c0, c1);
                    if (e == 0) MCH[chain * NCHUNK + cb + k] = m;
                    const float g = fmaxf(m, am[k]), so = __expf(m - g), sn = __expf(am[k] - g);
                    c0 = so * c0 + sn * __uint_as_float(dl[k] << 16); c1 = so * c1 + sn * __uint_as_float(dl[k] & 0xffff0000u);
                    m = be[k] + g;
                }
            }
        } else {
            float* p = DN + (size_t)chain * NCHUNK * 128 + (e - 8192);
            for (int cb = 0; cb < NCHUNK; cb += NB) {
                float dl[NB], be[NB], am[NB];
#pragma unroll
                for (int k = 0; k < NB; ++k) { dl[k] = p[(size_t)(cb + k) * 128]; be[k] = chs[(cb + k) * 2]; am[k] = chs[(cb + k) * 2 + 1]; }
#pragma unroll
                for (int k = 0; k < NB; ++k) {
                    p[(size_t)(cb + k) * 128] = c0;
                    const float g = fmaxf(m, am[k]), so = __expf(m - g), sn = __expf(am[k] - g);
                    c0 = so * c0 + sn * dl[k]; m = be[k] + g;
                }
            }
        }
    }
}
__device__ __forceinline__ void ml_pass_c(Frame& F, const Args& A) {
    constexpr int P = 136;
    unsigned char* ws = F.ws;
    const bf16* QM = (const bf16*)(ws + R_QM); const bf16* KM = (const bf16*)(ws + R_KM); const bf16* VM = (const bf16*)(ws + R_VM);
    const float* BT = (const float*)(ws + MI_BT); const float* AT = (const float*)(ws + MI_AT); const float* MCH = (const float*)(ws + MI_MCH); const float* NST = (const float*)(ws + MI_DN);
    const bf16* CST = (const bf16*)((unsigned char*)F.out + DO_CST);
    bf16* HML = (bf16*)(ws + R_HML);
    LAS bf16* Kt = (LAS bf16*)(F.lds); LAS bf16* Vt = Kt + 128 * P; LAS bf16* Ct = Vt + 128 * P;
    LAS bf16* Sl = F.wave < 6 ? (LAS bf16*)(F.lds + 3 * 128 * P * 2 + F.wave * (16 * P * 2)) : (LAS bf16*)(F.lds + LDSX_OFF + (F.wave - 6) * (16 * P * 2));
    LAS float* aw = (LAS float*)(F.lds + LDSX_OFF + 2 * (16 * P * 2)); LAS float* gq = aw + 128; LAS float* bq = gq + 128;
    static_assert(3 * 128 * P * 2 + 6 * 16 * P * 2 <= RING_BYTES && LDSX_OFF + 2 * 16 * P * 2 + 3 * 128 * 4 <= LDS_BYTES, "mLSTM pass C LDS map");
    const int w = F.wave;
    v4u kreg[4], vreg[4], creg[4];
    bf16x8 qn[4]; float m_n = 0.f, aan[2] = {0.f, 0.f}, bbn[2] = {0.f, 0.f};
#define MLC_LOAD(it_) do { const int ch_ = (it_) / NCHUNK, c_ = (it_) % NCHUNK, d_ = ch_ >> 3, b_ = (ch_ >> 2) & 1, h_ = ch_ & 3; const int base_ = ml_chunk_base(d_, b_, c_); \
        _Pragma("unroll") for (int j = 0; j < 4; ++j) { const int idx = F.tid + 512 * j, row = idx >> 4, chk = idx & 15; \
            kreg[j] = *(const GAS v4u*)(KM + (size_t)(base_ + row) * 512 + h_ * 128 + 8 * chk); vreg[j] = *(const GAS v4u*)(VM + (size_t)(base_ + row) * 512 + h_ * 128 + 8 * chk); \
            creg[j] = *(const GAS v4u*)(CST + (size_t)(it_) * 16384 + (size_t)row * 128 + 8 * chk); } \
        m_n = MCH[ch_ * NCHUNK + c_]; \
        { const bf16* qp_ = QM + (size_t)(base_ + 16 * F.wave + (F.lane & 15)) * 512 + h_ * 128 + 8 * (F.lane >> 4); _Pragma("unroll") for (int kk = 0; kk < 4; ++kk) qn[kk] = gfrag(qp_ + 32 * kk); } \
        if (F.wave == 0) { _Pragma("unroll") for (int e = 0; e < 2; ++e) { const int s_ = 2 * F.lane + e, o_ = d_ == 0 ? s_ : 127 - s_; const size_t gi_ = (size_t)(d_ * 4 + h_) * MA_ROWS + base_ + o_; aan[e] = AT[gi_]; bbn[e] = BT[gi_]; } } } while (0)
    if (F.vcu < NITEM_ML) MLC_LOAD(F.vcu);
    for (int item = F.vcu; item < NITEM_ML; item += F.G) {
        const int chain = item / NCHUNK, c = item % NCHUNK, d = chain >> 3, b = (chain >> 2) & 1, h = chain & 3;
        const int base = ml_chunk_base(d, b, c);
        int lz = 0; asm volatile("" : "+s"(lz));
        const int tid = F.tid + lz, lane = tid & 63, l15 = lane & 15, l4 = lane >> 4;
        const float m = m_n;
        const int to = 16 * w + l15;
        bf16x8 qf[4];
#pragma unroll
        for (int kk = 0; kk < 4; ++kk) qf[kk] = qn[kk];
        __syncthreads();
        if (w == 0) {
            float aa[2], bb[2];
#pragma unroll
            for (int e = 0; e < 2; ++e) { aa[e] = aan[e]; bb[e] = bbn[e]; }
            const float pm = fmaxf(aa[0], aa[1]); float incl = pm;
#pragma unroll
            for (int o = 1; o < 64; o <<= 1) { const float t_ = __shfl_up(incl, o); if (lane >= o) incl = fmaxf(incl, t_); }
            float excl = __shfl_up(incl, 1); if (lane == 0) excl = -INFINITY;
            const float g0 = fmaxf(m, fmaxf(excl, aa[0])), g1 = fmaxf(m, incl);
#pragma unroll
            for (int e = 0; e < 2; ++e) { const int s = 2 * lane + e, o = d == 0 ? s : 127 - s; aw[o] = aa[e]; gq[o] = e == 0 ? g0 : g1; bq[o] = bb[e]; }
        }
#pragma unroll
        for (int j = 0; j < 4; ++j) { const int idx = tid + 512 * j, row = idx >> 4, chk = idx & 15; *(LAS v4u*)(Kt + row * P + 8 * chk) = kreg[j]; *(LAS v4u*)(Vt + row * P + 8 * chk) = vreg[j]; *(LAS v4u*)(Ct + row * P + 8 * chk) = creg[j]; }
        __syncthreads();
        { const int itn = item + F.G; if (itn < NITEM_ML) MLC_LOAD(itn); }
        const float gt = gq[to], bt = bq[to];
        float den = 0.f;
#pragma unroll
        for (int m8 = 0; m8 < 8; ++m8) {
            f32x4 st = {0.f, 0.f, 0.f, 0.f};
#pragma unroll
            for (int kk = 0; kk < 4; ++kk) st = MFMA16(ldsfrag<P>(Kt, 16 * m8 + l15, 32 * kk + 8 * l4), qf[kk], st);
            f32x4 vv;
#pragma unroll
            for (int r = 0; r < 4; ++r) { const int so = 16 * m8 + 4 * l4 + r; const bool valid = d == 0 ? (so <= to) : (so >= to); const float wgt = valid ? __expf(aw[so] - gt) : 0.f; vv[r] = st[r] * wgt; den += vv[r]; }
            *(LAS u32x2v*)(Sl + l15 * P + 16 * m8 + 4 * l4) = pk4(vv);
        }
        den += __shfl_xor(den, 16); den += __shfl_xor(den, 32);
        float qn = 0.f;
        { const float* np = NST + (size_t)item * 128 + 8 * l4;
#pragma unroll
            for (int kk = 0; kk < 4; ++kk) { const unsigned* pq = (const unsigned*)&qf[kk];
#pragma unroll
                for (int e = 0; e < 4; ++e) qn += __uint_as_float(pq[e] << 16) * np[32 * kk + 2 * e] + __uint_as_float(pq[e] & 0xffff0000u) * np[32 * kk + 2 * e + 1]; }
            qn += __shfl_xor(qn, 16); qn += __shfl_xor(qn, 32); }
        asm volatile("s_waitcnt lgkmcnt(0)" ::: "memory"); __builtin_amdgcn_wave_barrier();
        bf16x8 sf[4];
#pragma unroll
        for (int kk = 0; kk < 4; ++kk) sf[kk] = ldsfrag<P>(Sl, l15, 32 * kk + 8 * l4);
        const float wprev = __expf(m - gt);
        const float dent = den + wprev * qn;
        const float rdn = __builtin_amdgcn_rcpf(fmaxf(fabsf(dent), __expf(-(bt + gt))));
        bf16* hp = HML + ((size_t)d * MA_ROWS + base + to) * 512 + h * 128 + 4 * l4;
#pragma unroll
        for (int v8 = 0; v8 < 8; ++v8) {
            f32x4 an = {0.f, 0.f, 0.f, 0.f}, ai = {0.f, 0.f, 0.f, 0.f};
#pragma unroll
            for (int kk = 0; kk < 4; ++kk) {
                an = MFMA16(trfrag<P>(Vt, 16 * v8, 32 * kk, l15, l4), sf[kk], an);
                ai = MFMA16(ldsfrag<P>(Ct, 16 * v8 + l15, 32 * kk + 8 * l4), qf[kk], ai);
            }
            f32x4 o; o[0] = (an[0] + wprev * ai[0]) * rdn; o[1] = (an[1] + wprev * ai[1]) * rdn; o[2] = (an[2] + wprev * ai[2]) * rdn; o[3] = (an[3] + wprev * ai[3]) * rdn;
            *(u32x2v*)(hp + 16 * v8) = pk4(o);
        }
    }
#undef MLC_LOAD
    __syncthreads();
}
template <class EPI> __device__ __forceinline__ void ctx_gemm(Frame& F, const bf16* Am, int lda, const bf16* Bt, int ldb, int M, int N, int K, const EPI& epi) {
    LAS f32x4* red = (LAS f32x4*)(F.lds);
    const int lane = F.lane, w = F.wave, l15 = lane & 15, l4 = lane >> 4;
    const int ntn = N / 64, ntiles = (M / 32) * ntn, ks = K / 8;
    for (int tile = F.vcu; tile < ntiles; tile += F.G) {
        const int tm = tile / ntn, tn = tile % ntn;
        f32x4 acc[2][4];
#pragma unroll
        for (int mi = 0; mi < 2; ++mi)
#pragma unroll
            for (int ni = 0; ni < 4; ++ni) acc[mi][ni] = (f32x4){0.f, 0.f, 0.f, 0.f};
        const bf16* ap = Am + (size_t)(32 * tm + l15) * lda + w * ks + 8 * l4;
        const bf16* bp = Bt + (size_t)(64 * tn + l15) * ldb + w * ks + 8 * l4;
#pragma unroll 2
        for (int k0 = 0; k0 < ks; k0 += 32) {
            bf16x8 a[2], b[4];
#pragma unroll
            for (int mi = 0; mi < 2; ++mi) a[mi] = __builtin_bit_cast(bf16x8, *(const GAS v4u*)(ap + (size_t)(16 * mi) * lda + k0));
#pragma unroll
            for (int ni = 0; ni < 4; ++ni) b[ni] = __builtin_bit_cast(bf16x8, *(const GAS v4u*)(bp + (size_t)(16 * ni) * ldb + k0));
#pragma unroll
            for (int mi = 0; mi < 2; ++mi)
#pragma unroll
                for (int ni = 0; ni < 4; ++ni) acc[mi][ni] = MFMA16(a[mi], b[ni], acc[mi][ni]);
        }
        __syncthreads();
#pragma unroll
        for (int mi = 0; mi < 2; ++mi)
#pragma unroll
            for (int ni = 0; ni < 4; ++ni) red[(w * 8 + mi * 4 + ni) * 64 + lane] = acc[mi][ni];
        __syncthreads();
        {
            f32x4 s = red[(0 * 8 + w) * 64 + lane];
#pragma unroll
            for (int ww = 1; ww < 8; ++ww) s += red[(ww * 8 + w) * 64 + lane];
            const int row0 = 32 * tm + 16 * (w >> 2) + 4 * l4, col = 64 * tn + 16 * (w & 3) + l15;
#pragma unroll
            for (int r = 0; r < 4; ++r) epi(row0 + r, col, s[r]);
        }
    }
    __syncthreads();
}
template <int KSPLIT = 1, class EPI> __device__ __forceinline__ void ctx_gemm2(Frame& F, const bf16* Am, int lda, const bf16* Bt, int ldb, int M, int N, int K, const EPI& epi) {
    constexpr int TP = 72, ABYTES = 64 * TP * 2, BBYTES = 128 * TP * 2, STAGE = ABYTES + BBYTES;
    const int tid = F.tid, lane = F.lane, w = F.wave, l15 = lane & 15, l4 = lane >> 4, wm = w >> 2, wn = w & 3;
    const int ntn = N / 128, ntiles = (M / 64) * ntn * KSPLIT, nk = K / 64 / KSPLIT;
    const int arow = tid >> 3, apc = tid & 7;
    for (int tile = F.vcu; tile < ntiles; tile += F.G) {
        const int ksl = tile % KSPLIT, tl = tile / KSPLIT, tm = tl / ntn, tn = tl % ntn;
        const bf16* ap = Am + (size_t)(64 * tm + arow) * lda + 8 * apc + (size_t)ksl * nk * 64;
        const bf16* bp0 = Bt + (size_t)(128 * tn + arow) * ldb + 8 * apc + (size_t)ksl * nk * 64; const bf16* bp1 = bp0 + (size_t)64 * ldb;
        f32x4 acc[2][2];
#pragma unroll
        for (int mi = 0; mi < 2; ++mi)
#pragma unroll
            for (int ni = 0; ni < 2; ++ni) acc[mi][ni] = (f32x4){0.f, 0.f, 0.f, 0.f};
        v4u xa = *(const GAS v4u*)ap, xb0 = *(const GAS v4u*)bp0, xb1 = *(const GAS v4u*)bp1;
        v4u ya = *(const GAS v4u*)(ap + 64), yb0 = *(const GAS v4u*)(bp0 + 64), yb1 = *(const GAS v4u*)(bp1 + 64);
        __syncthreads();
#define CG2_STEP(RA, RB0, RB1, ks_) do { LAS bf16* As = (LAS bf16*)(F.lds + ((ks_) & 1) * STAGE); LAS bf16* Bs = (LAS bf16*)(F.lds + ((ks_) & 1) * STAGE + ABYTES); \
            *(LAS v4u*)(As + arow * TP + 8 * apc) = RA; *(LAS v4u*)(Bs + arow * TP + 8 * apc) = RB0; *(LAS v4u*)(Bs + (arow + 64) * TP + 8 * apc) = RB1; \
            if ((ks_) + 2 < nk) { RA = *(const GAS v4u*)(ap + 64 * ((ks_) + 2)); RB0 = *(const GAS v4u*)(bp0 + 64 * ((ks_) + 2)); RB1 = *(const GAS v4u*)(bp1 + 64 * ((ks_) + 2)); } \
            asm volatile("s_waitcnt lgkmcnt(0)\n\ts_barrier" ::: "memory"); \
            _Pragma("unroll") for (int kk = 0; kk < 2; ++kk) { bf16x8 a[2], b[2]; \
                _Pragma("unroll") for (int mi = 0; mi < 2; ++mi) a[mi] = ldsfrag<TP>(As, 32 * wm + 16 * mi + l15, 32 * kk + 8 * l4); \
                _Pragma("unroll") for (int ni = 0; ni < 2; ++ni) b[ni] = ldsfrag<TP>(Bs, 32 * wn + 16 * ni + l15, 32 * kk + 8 * l4); \
                _Pragma("unroll") for (int mi = 0; mi < 2; ++mi) _Pragma("unroll") for (int ni = 0; ni < 2; ++ni) acc[mi][ni] = MFMA16(a[mi], b[ni], acc[mi][ni]); } } while (0)
        for (int ks = 0; ks < nk; ks += 2) { CG2_STEP(xa, xb0, xb1, ks); CG2_STEP(ya, yb0, yb1, ks + 1); }
#undef CG2_STEP
#pragma unroll
        for (int mi = 0; mi < 2; ++mi)
#pragma unroll
            for (int ni = 0; ni < 2; ++ni) { const int row0 = 64 * tm + 32 * wm + 16 * mi + 4 * l4, col = 128 * tn + 32 * wn + 16 * ni + l15;
#pragma unroll
                for (int r = 0; r < 4; ++r) { if constexpr (KSPLIT == 1) epi(row0 + r, col, acc[mi][ni][r]); else epi(row0 + r, col, acc[mi][ni][r], ksl); } }
    }
    __syncthreads();
}
__device__ __forceinline__ void rw_seq_rows(int d, int b, int p, int& R, int& idx, int& len, int& sbase) {
    if (p < CTXL) { idx = d == 0 ? p : CTXL - 1 - p; len = CTXL; sbase = ML_ROWS + b * CTXL; }
    else { const int q = p - CTXL; idx = d == 0 ? q : T - 1 - q; len = T; sbase = b * T; }
    R = sbase + idx;
}
__device__ __forceinline__ void rw_scan(Frame& F, const Args& A) {
    unsigned char* ws = F.ws;
    const bf16* RAWb = (const bf16*)(ws + R_RAW); const bf16* TWAD = (const bf16*)(ws + R_TWAD);
    LAS float* w2h = (LAS float*)(F.lds); LAS float* a2h = w2h + 4096; LAS float* vecs = a2h + 4096;
    LAS float* ybuf = vecs + 32 * 384; LAS float* twl = ybuf + 2048; LAS float* adl = twl + 2048;
    const int tid = F.tid, lane = F.lane, wv = F.wave;
    for (int chain = F.vcu; chain < NCHAIN_RW; chain += F.G) {
        const int d = chain >> 4, b = (chain >> 3) & 1, h = chain & 7;
        bf16* YRW = d == 0 ? (bf16*)(ws + R_YRW0) : (bf16*)((unsigned char*)F.out + DO_YRW1);
        __syncthreads();
        for (int i = tid; i < 4096; i += NTHREADS) { const int ii = i >> 6, ch = i & 63; w2h[i] = A.in[I_RW_W2][((size_t)d * 64 + ii) * 512 + h * 64 + ch]; a2h[i] = A.in[I_RW_A2][((size_t)d * 64 + ii) * 512 + h * 64 + ch]; }
        const int ppos = tid >> 4, chq = tid & 15, ch0 = 4 * chq, hc = h * 64 + ch0;
        float cw[3][3][4], kkw[4], kaw[4], w0v[4], a0v[4];
#pragma unroll
        for (int k = 0; k < 3; ++k)
#pragma unroll
            for (int g = 0; g < 3; ++g)
#pragma unroll
                for (int e = 0; e < 4; ++e) cw[k][g][e] = A.in[I_RW_CONV][k * 1536 + g * 512 + hc + e];
#pragma unroll
        for (int e = 0; e < 4; ++e) { kkw[e] = A.in[I_RW_KK][hc + e]; kaw[e] = A.in[I_RW_KA][hc + e]; w0v[e] = A.in[I_RW_W0][d * 512 + hc + e]; a0v[e] = A.in[I_RW_A0][d * 512 + hc + e]; }
        float S[8];
#pragma unroll
        for (int j = 0; j < 8; ++j) S[j] = 0.f;
        const int row_i = 8 * wv + (lane >> 3), j0 = 8 * (lane & 7);
        for (int blk = 0; blk < KV_LEN / 32; ++blk) {
            int R, idx, len, sbase; rw_seq_rows(d, b, 32 * blk + ppos, R, idx, len, sbase);
            __syncthreads();
            { const u32x2v tw = *(const GAS u32x2v*)(TWAD + (size_t)R * 256 + d * 64 + ch0), ad = *(const GAS u32x2v*)(TWAD + (size_t)R * 256 + 128 + d * 64 + ch0);
              LAS float* t_ = twl + ppos * 64 + ch0; LAS float* a_ = adl + ppos * 64 + ch0;
              t_[0] = __uint_as_float(tw.x << 16); t_[1] = __uint_as_float(tw.x & 0xffff0000u); t_[2] = __uint_as_float(tw.y << 16); t_[3] = __uint_as_float(tw.y & 0xffff0000u);
              a_[0] = __uint_as_float(ad.x << 16); a_[1] = __uint_as_float(ad.x & 0xffff0000u); a_[2] = __uint_as_float(ad.y << 16); a_[3] = __uint_as_float(ad.y & 0xffff0000u); }
            float cv[3][4];
#pragma unroll
            for (int g = 0; g < 3; ++g)
#pragma unroll
                for (int e = 0; e < 4; ++e) cv[g][e] = 0.f;
#pragma unroll
            for (int k = 0; k < 3; ++k) { const int ii = idx + k - 1; if (ii >= 0 && ii < len) {
#pragma unroll
                for (int g = 0; g < 3; ++g) { const u32x2v x = *(const GAS u32x2v*)(RAWb + (size_t)(sbase + ii) * 1536 + g * 512 + hc);
                    cv[g][0] += cw[k][g][0] * __uint_as_float(x.x << 16); cv[g][1] += cw[k][g][1] * __uint_as_float(x.x & 0xffff0000u); cv[g][2] += cw[k][g][2] * __uint_as_float(x.y << 16); cv[g][3] += cw[k][g][3] * __uint_as_float(x.y & 0xffff0000u); } } }
            float kkv[4], ss = 0.f;
#pragma unroll
            for (int e = 0; e < 4; ++e) { kkv[e] = cv[1][e] * kkw[e]; ss += kkv[e] * kkv[e]; }
            ss += __shfl_xor(ss, 1); ss += __shfl_xor(ss, 2); ss += __shfl_xor(ss, 4); ss += __shfl_xor(ss, 8);
            const float rn = __builtin_amdgcn_rsqf(ss + NORM_EPS);
            __syncthreads();
            float wl_[4], al_[4];
#pragma unroll
            for (int e = 0; e < 4; ++e) { wl_[e] = w0v[e]; al_[e] = a0v[e]; }
            for (int i = 0; i < 64; ++i) { const float tv = twl[ppos * 64 + i], av = adl[ppos * 64 + i]; const f32x4 w2 = *(const LAS f32x4*)(w2h + i * 64 + ch0), a2 = *(const LAS f32x4*)(a2h + i * 64 + ch0);
#pragma unroll
                for (int e = 0; e < 4; ++e) { wl_[e] += tv * w2[e]; al_[e] += av * a2[e]; } }
            LAS float* vb = vecs + ppos * 384 + ch0;
#pragma unroll
            for (int e = 0; e < 4; ++e) {
                const float wdec = __expf(-0.6065306597126334f * sigmoidf_(wl_[e])), a = sigmoidf_(al_[e]), kk = kkv[e] * rn;
                vb[e] = wdec; vb[64 + e] = kk * a; vb[128 + e] = cv[1][e] * (1.0f + (a - 1.0f) * kaw[e]); vb[192 + e] = kk; vb[256 + e] = cv[0][e]; vb[320 + e] = cv[2][e];
            }
            __syncthreads();
            for (int pp = 0; pp < 32; ++pp) {
                const LAS float* v_ = vecs + pp * 384;
                const f32x4 k0 = *(const LAS f32x4*)(v_ + 192 + j0), k1 = *(const LAS f32x4*)(v_ + 192 + j0 + 4);
                float skk = S[0] * k0[0] + S[1] * k0[1] + S[2] * k0[2] + S[3] * k0[3] + S[4] * k1[0] + S[5] * k1[1] + S[6] * k1[2] + S[7] * k1[3];
                skk += __shfl_xor(skk, 1); skk += __shfl_xor(skk, 2); skk += __shfl_xor(skk, 4);
                const f32x4 w0_ = *(const LAS f32x4*)(v_ + j0), w1_ = *(const LAS f32x4*)(v_ + j0 + 4), b0 = *(const LAS f32x4*)(v_ + 64 + j0), b1 = *(const LAS f32x4*)(v_ + 64 + j0 + 4);
                const f32x4 e0 = *(const LAS f32x4*)(v_ + 128 + j0), e1 = *(const LAS f32x4*)(v_ + 128 + j0 + 4), r0 = *(const LAS f32x4*)(v_ + 256 + j0), r1 = *(const LAS f32x4*)(v_ + 256 + j0 + 4);
                const float vi = v_[320 + row_i];
                float y = 0.f;
#pragma unroll
                for (int j = 0; j < 4; ++j) { S[j] = S[j] * w0_[j] - skk * b0[j] + vi * e0[j]; S[4 + j] = S[4 + j] * w1_[j] - skk * b1[j] + vi * e1[j]; y += S[j] * r0[j] + S[4 + j] * r1[j]; }
                y += __shfl_xor(y, 1); y += __shfl_xor(y, 2); y += __shfl_xor(y, 4);
                if ((lane & 7) == 0) ybuf[pp * 64 + row_i] = y;
            }
            __syncthreads();
            { const LAS float* yb = ybuf + ppos * 64 + ch0; u32x2v o; o.x = pk2(yb[0], yb[1]); o.y = pk2(yb[2], yb[3]); *(u32x2v*)(YRW + (size_t)R * 512 + hc) = o; }
        }
    }
    __syncthreads();
}

__device__ __forceinline__ void merge_rows(Frame& F, const Args& A) {
    unsigned char* ws = F.ws;
    const bf16* HML = (const bf16*)(ws + R_HML); const bf16* OM = (const bf16*)(ws + R_OM); const bf16* RAWb = (const bf16*)(ws + R_RAW);
    const bf16* YRW0 = (const bf16*)(ws + R_YRW0); const bf16* YRW1 = (const bf16*)((unsigned char*)F.out + DO_YRW1);
    bf16* MIX = (bf16*)(ws + R_MIX);
    const int gw = F.vcu * NWAVES + F.wave, NGW = F.G * NWAVES, lane = F.lane, c8 = 8 * lane;
    for (int row = gw; row < MA_ROWS; row += NGW) {
        float y[8];
        const v4u in_og = *(const GAS v4u*)(OM + (size_t)row * 512 + c8);
        const v4u in_y0 = *(const GAS v4u*)(YRW0 + (size_t)row * 512 + c8), in_y1 = *(const GAS v4u*)(YRW1 + (size_t)row * 512 + c8);
        const v4u in_gg = *(const GAS v4u*)(RAWb + (size_t)row * 1536 + c8);
        const float bs = ((const float*)(ws + WS_SS))[(size_t)row * 8 + (lane >> 3)];
        int idx, len, sbase; if (row < ML_ROWS) { idx = row & (T - 1); len = T; sbase = row - idx; } else { idx = (row - ML_ROWS) & (CTXL - 1); len = CTXL; sbase = row - idx; }
        v4u in_x[3];
#pragma unroll
        for (int k = 0; k < 3; ++k) { const int ii = idx + k - 1; const bool ok = ii >= 0 && ii < len; const v4u x = *(const GAS v4u*)(RAWb + (size_t)(sbase + (ok ? ii : idx)) * 1536 + 2 * 512 + c8);
            const v4u z0 = {0u, 0u, 0u, 0u}; in_x[k] = ok ? x : z0; }
        { const v4u a = *(const GAS v4u*)(HML + (size_t)row * 512 + c8), b_ = *(const GAS v4u*)(HML + ((size_t)MA_ROWS + row) * 512 + c8); const unsigned* pa = (const unsigned*)&a; const unsigned* pb = (const unsigned*)&b_;
#pragma unroll
            for (int q = 0; q < 4; ++q) { y[2 * q] = __uint_as_float(pa[q] << 16) + __uint_as_float(pb[q] << 16); y[2 * q + 1] = __uint_as_float(pa[q] & 0xffff0000u) + __uint_as_float(pb[q] & 0xffff0000u); } }
        float s = 0.f;
#pragma unroll
        for (int e = 0; e < 8; ++e) s += y[e];
        s += __shfl_xor(s, 1); s += __shfl_xor(s, 2); s += __shfl_xor(s, 4); s += __shfl_xor(s, 8);
        const float mean = s * (1.f / 128.f); float q2 = 0.f;
#pragma unroll
        for (int e = 0; e < 8; ++e) { y[e] -= mean; q2 += y[e] * y[e]; }
        q2 += __shfl_xor(q2, 1); q2 += __shfl_xor(q2, 2); q2 += __shfl_xor(q2, 4); q2 += __shfl_xor(q2, 8);
        const float rstd = __builtin_amdgcn_rsqf(q2 * (1.f / 128.f) + GN_EPS);
        { const unsigned* po = (const unsigned*)&in_og; float o[8];
#pragma unroll
            for (int q = 0; q < 4; ++q) { o[2 * q] = __uint_as_float(po[q] << 16); o[2 * q + 1] = __uint_as_float(po[q] & 0xffff0000u); }
            v4u w; unsigned* pw = (unsigned*)&w;
#pragma unroll
            for (int q = 0; q < 4; ++q) { const float g0 = A.in[I_ML_NORM_G][c8 + 2 * q], g1 = A.in[I_ML_NORM_G][c8 + 2 * q + 1];
                pw[q] = pk2(y[2 * q] * rstd * g0 * sigmoidf_(o[2 * q]), y[2 * q + 1] * rstd * g1 * sigmoidf_(o[2 * q + 1])); }
            *(GAS v4u*)(MIX + (size_t)row * D + c8) = w; }
        float z[8];
        { const unsigned* pa = (const unsigned*)&in_y0; const unsigned* pb = (const unsigned*)&in_y1;
#pragma unroll
            for (int q = 0; q < 4; ++q) { z[2 * q] = __uint_as_float(pa[q] << 16) + __uint_as_float(pb[q] << 16); z[2 * q + 1] = __uint_as_float(pa[q] & 0xffff0000u) + __uint_as_float(pb[q] & 0xffff0000u); } }
        s = 0.f;
#pragma unroll
        for (int e = 0; e < 8; ++e) s += z[e];
        s += __shfl_xor(s, 1); s += __shfl_xor(s, 2); s += __shfl_xor(s, 4);
        const float mean2 = s * (1.f / 64.f); q2 = 0.f;
#pragma unroll
        for (int e = 0; e < 8; ++e) { z[e] -= mean2; q2 += z[e] * z[e]; }
        q2 += __shfl_xor(q2, 1); q2 += __shfl_xor(q2, 2); q2 += __shfl_xor(q2, 4);
        const float rstd2 = __builtin_amdgcn_rsqf(q2 * (1.f / 64.f) + GN_EPS);
        float cv[3][8];
#pragma unroll
        for (int e = 0; e < 8; ++e) cv[2][e] = 0.f;
#pragma unroll
        for (int k = 0; k < 3; ++k) { const unsigned* px = (const unsigned*)&in_x[k]; const float* cwp = A.in[I_RW_CONV] + k * 1536 + 2 * 512 + c8;
#pragma unroll
            for (int q = 0; q < 4; ++q) { cv[2][2 * q] += cwp[2 * q] * __uint_as_float(px[q] << 16); cv[2][2 * q + 1] += cwp[2 * q + 1] * __uint_as_float(px[q] & 0xffff0000u); } }
        { const unsigned* pg = (const unsigned*)&in_gg; v4u w; unsigned* pw = (unsigned*)&w;
#pragma unroll
            for (int q = 0; q < 4; ++q) { const float g0 = __uint_as_float(pg[q] << 16), g1 = __uint_as_float(pg[q] & 0xffff0000u);
                const float o0 = (z[2 * q] * rstd2 * A.in[I_RW_NORM_G][c8 + 2 * q] + bs * cv[2][2 * q]) * g0, o1 = (z[2 * q + 1] * rstd2 * A.in[I_RW_NORM_G][c8 + 2 * q + 1] + bs * cv[2][2 * q + 1]) * g1;
                pw[q] = pk2(o0, o1); }
            *(GAS v4u*)(MIX + (size_t)row * D + 512 + c8) = w; }
    }
}

__device__ __forceinline__ void qk_prep(Frame& F, const Args& A) {
    unsigned char* ws = F.ws;
    const bf16* ATT = (const bf16*)(ws + R_ATT); const float* ROPE = (const float*)(ws + WS_ROPE);
    bf16* QB = (bf16*)(ws + R_QB); bf16* KW = (bf16*)(ws + R_KW); bf16* VW = (bf16*)(ws + R_VW); bf16* KG = (bf16*)(ws + R_KG); bf16* VG = (bf16*)(ws + R_VG);
    const int gw = F.vcu * NWAVES + F.wave, NGW = F.G * NWAVES, lane = F.lane, l15 = lane & 15, hg = lane >> 4;
    const f32x4 gwq = *(const f32x4*)(A.in[I_WIN_Q_NORM] + 4 * l15), gwk = *(const f32x4*)(A.in[I_WIN_K_NORM] + 4 * l15), ggq = *(const f32x4*)(A.in[I_GLB_Q_NORM] + 4 * l15), ggk = *(const f32x4*)(A.in[I_GLB_K_NORM] + 4 * l15);
    for (int row0 = 2 * gw; row0 < MA_ROWS; row0 += 2 * NGW) {
        u32x2v xin[2][6];
#pragma unroll
        for (int q = 0; q < 2; ++q)
#pragma unroll
            for (int grp = 0; grp < 6; ++grp) xin[q][grp] = *(const GAS u32x2v*)(ATT + (size_t)(row0 + q) * ATT_N + 4 * lane + 256 * grp);
        f32x4 cs2[2];
#pragma unroll
        for (int q = 0; q < 2; ++q) { const int row = row0 + q; const bool lat = row < ML_ROWS; const int t = lat ? (row & (T - 1)) : 0;
            cs2[q] = (f32x4){1.f, 0.f, 1.f, 0.f}; if (lat) cs2[q] = *(const f32x4*)(ROPE + ((size_t)((l15 < 8) ? (t >> 6) : (t & 63)) * 16 + ((2 * l15) & 15)) * 2); }
#pragma unroll
        for (int q = 0; q < 2; ++q) {
        const int row = row0 + q;
        const bool lat = row < ML_ROWS; const int b = lat ? (row >> 13) : ((row - ML_ROWS) >> 8); const int t = lat ? (row & (T - 1)) : 0;
        const int pos = lat ? t : T + ((row - ML_ROWS) & (CTXL - 1));
        const f32x4 cssn = cs2[q];
#pragma unroll
        for (int grp = 0; grp < 6; ++grp) {
            const bool qgrp = (grp != 2) && (grp != 5);
            if (qgrp && !lat) continue;
            f32x4 x; { const u32x2v xb = xin[q][grp]; x[0] = __uint_as_float(xb.x << 16); x[1] = __uint_as_float(xb.x & 0xffff0000u); x[2] = __uint_as_float(xb.y << 16); x[3] = __uint_as_float(xb.y & 0xffff0000u); }
            const bool isv = !qgrp && hg >= 2;
            const f32x4 g = grp < 2 ? gwq : grp == 2 ? gwk : grp < 5 ? ggq : ggk;
            const float ss = sum16((x[0] * x[0] + x[1] * x[1]) + (x[2] * x[2] + x[3] * x[3]));
            if (!isv) {
                const float rs = __builtin_amdgcn_rsqf(ss * (1.f / 64.f) + NORM_EPS);
                x = x * rs * g;
                const f32x4 y = {x[0] * cssn[0] - x[1] * cssn[1], x[0] * cssn[1] + x[1] * cssn[0], x[2] * cssn[2] - x[3] * cssn[3], x[2] * cssn[3] + x[3] * cssn[2]};
                x = qgrp ? y * attn_body::C2 : y;
            }
            u32x2v o; o.x = pk2(x[0], x[1]); o.y = pk2(x[2], x[3]);
            if (qgrp) *(u32x2v*)(QB + (size_t)row * D + (grp < 2 ? 256 * grp : 512 + 256 * (grp - 3)) + 4 * lane) = o;
            else { bf16* dst = (grp == 2) ? (hg < 2 ? KW : VW) : (hg < 2 ? KG : VG); *(u32x2v*)(dst + ((size_t)(b * 2 + (hg & 1)) * KV_LEN + pos) * 64 + 4 * l15) = o; }
        }
        }
    }
}

__device__ __forceinline__ void attn_phase(Frame& F, const Args& A, char* lds_generic) {
    unsigned char* ws = F.ws;
    const attn_body::bf16* QB = (const attn_body::bf16*)(ws + R_QB);
    for (int k = 0; k < 4; ++k) {
        const int uid = k * F.G + F.vcu; if (uid >= 1024) break;
        const int grp = uid >> 9, gi = uid & 511;
        int bh, qb;
        if (F.G == 256) { bh = (gi & 255) >> 4; qb = 2 * ((gi & 255) & 15) + (gi >> 8); } else { bh = gi >> 5; qb = gi & 31; }
        const int b = bh >> 3, hq = bh & 7, kvh = hq >> 2;
        if (grp == 0) {
            const attn_body::bf16* Kh = (const attn_body::bf16*)(ws + R_KG) + (size_t)(b * 2 + kvh) * KV_LEN * 64; const attn_body::bf16* Vh = (const attn_body::bf16*)(ws + R_VG) + (size_t)(b * 2 + kvh) * KV_LEN * 64;
            attn_body::attn_unit<8, 0>(b, 8 + hq, qb, QB, Kh, Vh, (attn_body::bf16*)QB, lds_generic, 0.f);
        } else {
            const attn_body::bf16* Kh = (const attn_body::bf16*)(ws + R_KW) + (size_t)(b * 2 + kvh) * KV_LEN * 64; const attn_body::bf16* Vh = (const attn_body::bf16*)(ws + R_VW) + (size_t)(b * 2 + kvh) * KV_LEN * 64;
            attn_body::attn_unit<8, 1>(b, hq, qb, QB, Kh, Vh, (attn_body::bf16*)QB, lds_generic, A.in[I_WIN_SINK][hq] * 1.4426950408889634f);
        }
    }
}
constexpr int RW_NCH = 132;
constexpr int RW_NITEM = NCHAIN_RW * RW_NCH;
constexpr size_t RW_LCT = R_QM, RW_NC = R_VM, RW_PL = R_GATES;
static_assert((size_t)RW_NITEM * 4096 * 2 <= 2 * SZ_A && (size_t)RW_NITEM * 64 * 4 <= (size_t)MA_ROWS * 16 * 4 && WS_W2T + 2 * 2 * 8 * 64 * 64 * 2 <= WS_XC, "rwkv chunk scratch map");

template <int MODE> __device__ __forceinline__ void rw_chunk_pass(Frame& F, const Args& A) {
    constexpr int TP = 72;
    unsigned char* ws = F.ws;
    const bf16* RAWb = (const bf16*)(ws + R_RAW); const bf16* TWAD = (const bf16*)(ws + R_TWAD); const bf16* W2T = (const bf16*)(ws + WS_W2T);
    bf16* LCT = (bf16*)(ws + RW_LCT); bf16* NCG = (bf16*)(ws + RW_NC); float* PLG = (float*)(ws + RW_PL);
    const bf16* SCG = (const bf16*)((unsigned char*)F.out + DO_CST);
    LAS unsigned char* Lb = F.lds;
    LAS bf16* tKT = (LAS bf16*)(Lb + 0); LAS bf16* tRT = (LAS bf16*)(Lb + 9216); LAS bf16* tKH = (LAS bf16*)(Lb + 18432); LAS bf16* tBH = (LAS bf16*)(Lb + 27648);
    LAS bf16* tKTT = (LAS bf16*)(Lb + 36864); LAS bf16* tKBT = (LAS bf16*)(Lb + 46080); LAS bf16* tBBT = (LAS bf16*)(Lb + 55296); LAS bf16* tVT = (LAS bf16*)(Lb + 64512);
    LAS float* WA = (LAS float*)(Lb + 73728);
    LAS float* ABK = (LAS float*)(Lb + 73728);
    LAS bf16* tAKK = (LAS bf16*)(Lb + 91136); LAS bf16* tAKRT = (LAS bf16*)(Lb + 100352); LAS bf16* tABRT = (LAS bf16*)(Lb + 109568); LAS bf16* tW = (LAS bf16*)(Lb + 118784);
    LAS float* CLL = (LAS float*)(Lb + 128000);
    LAS bf16* tTT = tKH; LAS bf16* tX = tBH; LAS bf16* tUL = tKT;
    LAS bf16* tE1 = MODE == 0 ? (LAS bf16*)(Lb + 154112) : tKBT; LAS bf16* tE2 = MODE == 0 ? (LAS bf16*)(Lb + 73728) : tBBT;
    const int tid = F.tid, lane = F.lane, w = F.wave, l15 = lane & 15, l4 = lane >> 4;
#ifdef TS_RWC
    unsigned long long tst[12] = {0,0,0,0,0,0,0,0,0,0,0,0}, tprev = __builtin_amdgcn_s_memtime();
#define STG(k) do { const unsigned long long tn_ = __builtin_amdgcn_s_memtime(); tst[k] += tn_ - tprev; tprev = tn_; } while (0)
#else
#define STG(k) do {} while (0)
#endif
    LAS float* cst = (LAS float*)(Lb + LDSX_OFF); LAS bf16* W2L = (LAS bf16*)(Lb + LDSX_OFF + 3584);
    const int pos = tid >> 3, part = tid & 7, ch0 = 8 * part;
    constexpr int IPW = 17;
    const int item_lo = F.vcu * IPW, item_hi = (item_lo + IPW < RW_NITEM) ? item_lo + IPW : RW_NITEM;
    v4u pf_a0, pf_a1, pf_raw[3][3]; int pf_valid = 0;
    v4u pf_s[6];
#define RWC_PREFETCH(itn) do { const int ch_ = (itn) / RW_NCH, c_ = (itn) % RW_NCH, d_ = ch_ >> 4, b_ = (ch_ >> 3) & 1; \
        int R, idx, len, sbase; rw_seq_rows(d_, b_, 64 * c_ + 16 * (w & 3) + l15, R, idx, len, sbase); const bf16* ap = TWAD + (size_t)R * 256 + (w >> 2) * 128 + d_ * 64 + 8 * l4; \
        pf_a0 = *(const GAS v4u*)ap; pf_a1 = *(const GAS v4u*)(ap + 32); } while (0)
#define RWC_LOADRAW(itn) do { const int ch_ = (itn) / RW_NCH, c_ = (itn) % RW_NCH, d_ = ch_ >> 4, b_ = (ch_ >> 3) & 1, h_ = ch_ & 7; \
        int R, idx, len, sbase; rw_seq_rows(d_, b_, 64 * c_ + pos, R, idx, len, sbase); pf_valid = 0; \
        _Pragma("unroll") for (int k = 0; k < 3; ++k) { const int ii = idx + k - 1; const bool ok = ii >= 0 && ii < len; pf_valid |= ok ? (1 << k) : 0; const int iic = ok ? ii : idx; \
            _Pragma("unroll") for (int g = 0; g < 3; ++g) pf_raw[k][g] = *(const GAS v4u*)(RAWb + (size_t)(sbase + iic) * 1536 + g * 512 + h_ * 64 + ch0); } } while (0)
#define RWC_BAR() asm volatile("s_waitcnt lgkmcnt(0)\n\ts_barrier" ::: "memory")
    int cur_chain = -1;
    if (item_lo < item_hi) RWC_PREFETCH(item_lo);
    for (int item = item_lo; item < item_hi; ++item) {
        const int chain = item / RW_NCH, c = item % RW_NCH, d = chain >> 4, b = (chain >> 3) & 1, h = chain & 7;
        int lz = 0; asm volatile("" : "+s"(lz));
        const int tid = F.tid + lz, lane = tid & 63, l15 = lane & 15, l4 = lane >> 4, pos = tid >> 3, part = tid & 7, ch0 = 8 * part;
        RWC_LOADRAW(item);
        RWC_BAR();
        if (chain != cur_chain) {
            cur_chain = chain;
            for (int i = tid; i < 896; i += NTHREADS) {
                float v;
                if (i < 576) v = A.in[I_RW_CONV][((i >> 6) / 3) * 1536 + ((i >> 6) % 3) * 512 + h * 64 + (i & 63)];
                else if (i < 640) v = A.in[I_RW_KK][h * 64 + (i & 63)];
                else if (i < 704) v = A.in[I_RW_KA][h * 64 + (i & 63)];
                else if (i < 768) v = A.in[I_RW_W0][d * 512 + h * 64 + (i & 63)];
                else if (i < 832) v = A.in[I_RW_A0][d * 512 + h * 64 + (i & 63)];
                else v = A.in[I_RW_RK][h * 64 + (i & 63)];
                cst[i] = v;
            }
            for (int i = tid; i < 2 * 64 * 8; i += NTHREADS) {
                const int which = i >> 9, ch = (i >> 3) & 63, pc = i & 7;
                *(LAS v4u*)(W2L + which * (64 * TP) + ch * TP + 8 * pc) = *(const GAS v4u*)(W2T + ((size_t)((which * 2 + d) * 8 + h) * 64 + ch) * 64 + 8 * pc);
            }
            RWC_BAR();
        }
        STG(0);
        {
            const int which = w >> 2, mt = w & 3;
            const bf16x8 a0 = __builtin_bit_cast(bf16x8, pf_a0), a1 = __builtin_bit_cast(bf16x8, pf_a1);
            const LAS bf16* bt = W2L + which * (64 * TP);
#pragma unroll
            for (int nt = 0; nt < 4; ++nt) {
                f32x4 acc = {0.f, 0.f, 0.f, 0.f};
                acc = MFMA16(a0, ldsfrag(bt, 16 * nt + l15, 8 * l4), acc); acc = MFMA16(a1, ldsfrag(bt, 16 * nt + l15, 32 + 8 * l4), acc);
                const float bv = cst[704 + which * 64 + 16 * nt + l15];
#pragma unroll
                for (int r = 0; r < 4; ++r) WA[which * (64 * 65) + (16 * mt + 4 * l4 + r) * 65 + 16 * nt + l15] = acc[r] + bv;
            }
        }
        RWC_BAR();
        STG(1);
        float kkv[8], keyv[8], betv[8], rv[8], vv[8], lamv[8];
        {
            float cv[3][8];
            {
                f32x2v c2[3][4];
#pragma unroll
                for (int g = 0; g < 3; ++g)
#pragma unroll
                    for (int q = 0; q < 4; ++q) c2[g][q] = (f32x2v){0.f, 0.f};
#pragma unroll
                for (int k = 0; k < 3; ++k) { const bool okk = (pf_valid >> k) & 1;
#pragma unroll
                    for (int g = 0; g < 3; ++g) { const unsigned* px = (const unsigned*)&pf_raw[k][g];
                        const LAS f32x2v* cp = (const LAS f32x2v*)(cst + (k * 3 + g) * 64 + ch0);
#pragma unroll
                        for (int q = 0; q < 4; ++q) { const unsigned xw = (k == 1 || okk) ? px[q] : 0u;
                            const f32x2v x2 = {__uint_as_float(xw << 16), __uint_as_float(xw & 0xffff0000u)};
                            c2[g][q] += cp[q] * x2; } } }
#pragma unroll
                for (int g = 0; g < 3; ++g)
#pragma unroll
                    for (int q = 0; q < 4; ++q) { cv[g][2 * q] = c2[g][q].x; cv[g][2 * q + 1] = c2[g][q].y; }
            }
            if (d == 0) {
                float bs = 0.f;
#pragma unroll
                for (int e = 0; e < 8; ++e) bs += cv[0][e] * cv[1][e] * cst[832 + ch0 + e];
                bs = sum8(bs);
                if (part == 0) { int R, idx, len, sbase; rw_seq_rows(d, b, 64 * c + pos, R, idx, len, sbase); ((float*)(ws + WS_SS))[(size_t)R * 8 + h] = bs; }
            }
            float ss = 0.f;
#pragma unroll
            for (int e = 0; e < 8; ++e) { kkv[e] = cv[1][e] * cst[576 + ch0 + e]; ss += kkv[e] * kkv[e]; }
            ss = sum8(ss);
            const float rn = __builtin_amdgcn_rsqf(ss + NORM_EPS);
#pragma unroll
            for (int e = 0; e < 8; ++e) {
                const float wl_ = WA[pos * 65 + ch0 + e], al_ = WA[64 * 65 + pos * 65 + ch0 + e];
                const float a = sigmoidf_(al_); lamv[e] = (0.6065306597126334f * 1.4426950408889634f) * sigmoidf_(wl_);
                kkv[e] *= rn; betv[e] = kkv[e] * a; keyv[e] = cv[1][e] * (1.0f + (a - 1.0f) * cst[640 + ch0 + e]); rv[e] = cv[0][e]; vv[e] = cv[2][e];
                WA[pos * 65 + ch0 + e] = lamv[e];
            }
        }
        RWC_BAR();
        STG(2);
        {
            const int ch = tid >> 3; float x[8]; float run = 0.f;
#pragma unroll
            for (int q = 0; q < 8; ++q) { run += WA[(8 * part + q) * 65 + ch]; x[q] = run; }
            float inc = run;
            { float t_ = dpp_mov<0x111>(inc); if (part >= 1) inc += t_; t_ = dpp_mov<0x112>(inc); if (part >= 2) inc += t_; t_ = dpp_mov<0x114>(inc); if (part >= 4) inc += t_; }
            const float excl = inc - run;
#pragma unroll
            for (int q = 0; q < 8; ++q) WA[(8 * part + q) * 65 + ch] = x[q] + excl;
            if (part == 7) { CLL[ch] = inc; CLL[64 + ch] = __builtin_amdgcn_exp2f(-inc); }
        }
        RWC_BAR();
        STG(3);
        {
            float kt[8], rt[8], kh[8], bh[8], kb[8], bbn[8];
#pragma unroll
            for (int e = 0; e < 8; ++e) {
                const float cl = WA[pos * 65 + ch0 + e];
                const float eI = __builtin_amdgcn_exp2f(cl), eB = eI * CLL[64 + ch0 + e];
                kt[e] = kkv[e] * __builtin_amdgcn_exp2f(lamv[e] - cl); rt[e] = rv[e] * __builtin_amdgcn_exp2f(-cl); kh[e] = keyv[e] * eI; bh[e] = betv[e] * eI; kb[e] = keyv[e] * eB; bbn[e] = -betv[e] * eB;
            }
            v4u o;
            o.x = pk2(kt[0], kt[1]); o.y = pk2(kt[2], kt[3]); o.z = pk2(kt[4], kt[5]); o.w = pk2(kt[6], kt[7]); *(LAS v4u*)(tKT + pos * TP + ch0) = o; *(LAS v4u*)(tKTT + pos * TP + ch0) = o;
            o.x = pk2(rt[0], rt[1]); o.y = pk2(rt[2], rt[3]); o.z = pk2(rt[4], rt[5]); o.w = pk2(rt[6], rt[7]); *(LAS v4u*)(tRT + pos * TP + ch0) = o;
            o.x = pk2(kh[0], kh[1]); o.y = pk2(kh[2], kh[3]); o.z = pk2(kh[4], kh[5]); o.w = pk2(kh[6], kh[7]); *(LAS v4u*)(tKH + pos * TP + ch0) = o;
            o.x = pk2(bh[0], bh[1]); o.y = pk2(bh[2], bh[3]); o.z = pk2(bh[4], bh[5]); o.w = pk2(bh[6], bh[7]); *(LAS v4u*)(tBH + pos * TP + ch0) = o;
            o.x = pk2(vv[0], vv[1]); o.y = pk2(vv[2], vv[3]); o.z = pk2(vv[4], vv[5]); o.w = pk2(vv[6], vv[7]); *(LAS v4u*)(tVT + pos * TP + ch0) = o;
            if (MODE == 0) {
                o.x = pk2(kb[0], kb[1]); o.y = pk2(kb[2], kb[3]); o.z = pk2(kb[4], kb[5]); o.w = pk2(kb[6], kb[7]); *(LAS v4u*)(tKBT + pos * TP + ch0) = o;
                o.x = pk2(bbn[0], bbn[1]); o.y = pk2(bbn[2], bbn[3]); o.z = pk2(bbn[4], bbn[5]); o.w = pk2(bbn[6], bbn[7]); *(LAS v4u*)(tBBT + pos * TP + ch0) = o;
            }
        }
        RWC_BAR();
        STG(4);
        {
            const int st = w & 3;
            if (w < 4) {
                const bf16x8 a0 = ldsfrag(tBH, 16 * st + l15, 8 * l4), a1 = ldsfrag(tBH, 16 * st + l15, 32 + 8 * l4);
#pragma unroll
                for (int tt = 0; tt < 4; ++tt) {
                    f32x4 acc = {0.f, 0.f, 0.f, 0.f};
                    acc = MFMA16(a0, ldsfrag(tKT, 16 * tt + l15, 8 * l4), acc); acc = MFMA16(a1, ldsfrag(tKT, 16 * tt + l15, 32 + 8 * l4), acc);
                    const int t = 16 * tt + l15, s0 = 16 * st + 4 * l4;
#pragma unroll
                    for (int r = 0; r < 4; ++r) if (s0 + r >= t) acc[r] = 0.f;
                    *(LAS f32x4*)(ABK + t * 68 + s0) = acc; *(LAS u32x2v*)(tE1 + t * TP + s0) = pk4(acc);
                    {
                        f32x4 ac2 = {0.f, 0.f, 0.f, 0.f};
                        ac2 = MFMA16(a0, ldsfrag(tRT, 16 * tt + l15, 8 * l4), ac2); ac2 = MFMA16(a1, ldsfrag(tRT, 16 * tt + l15, 32 + 8 * l4), ac2);
#pragma unroll
                        for (int r = 0; r < 4; ++r) ac2[r] = (s0 + r > t) ? 0.f : -ac2[r];
                        *(LAS u32x2v*)(tABRT + t * TP + s0) = pk4(ac2);
                    }
                }
            } else {
                const bf16x8 b0 = ldsfrag(tKH, 16 * st + l15, 8 * l4), b1 = ldsfrag(tKH, 16 * st + l15, 32 + 8 * l4);
#pragma unroll
                for (int tt = 0; tt < 4; ++tt) {
                    f32x4 acc = {0.f, 0.f, 0.f, 0.f};
                    acc = MFMA16(ldsfrag(tKT, 16 * tt + l15, 8 * l4), b0, acc); acc = MFMA16(ldsfrag(tKT, 16 * tt + l15, 32 + 8 * l4), b1, acc);
                    const int s = 16 * st + l15, t0 = 16 * tt + 4 * l4;
#pragma unroll
                    for (int r = 0; r < 4; ++r) if (s >= t0 + r) acc[r] = 0.f;
                    *(LAS u32x2v*)(tAKK + s * TP + t0) = pk4(acc);
                    {
                        f32x4 ac2 = {0.f, 0.f, 0.f, 0.f};
                        ac2 = MFMA16(b0, ldsfrag(tRT, 16 * tt + l15, 8 * l4), ac2); ac2 = MFMA16(b1, ldsfrag(tRT, 16 * tt + l15, 32 + 8 * l4), ac2);
                        const int t = 16 * tt + l15, s0 = 16 * st + 4 * l4;
#pragma unroll
                        for (int r = 0; r < 4; ++r) if (s0 + r > t) ac2[r] = 0.f;
                        *(LAS u32x2v*)(tAKRT + t * TP + s0) = pk4(ac2);
                    }
                }
            }
        }
        RWC_BAR();
        STG(5);
        { const int itn = (item + 1 < item_hi) ? item + 1 : item; RWC_PREFETCH(itn); }
        if (MODE == 1) { const bf16* Sg_ = SCG + (size_t)item * 4096; const int mt_ = w & 3, n0_ = 2 * (w >> 2);
#pragma unroll
            for (int q = 0; q < 2; ++q) { pf_s[2 * q] = *(const GAS v4u*)(Sg_ + (size_t)(16 * (n0_ + q) + l15) * 64 + 8 * l4); pf_s[2 * q + 1] = *(const GAS v4u*)(Sg_ + (size_t)(16 * (n0_ + q) + l15) * 64 + 32 + 8 * l4); }
            pf_s[4] = *(const GAS v4u*)(Sg_ + (size_t)(16 * mt_ + l15) * 64 + 8 * l4); pf_s[5] = *(const GAS v4u*)(Sg_ + (size_t)(16 * mt_ + l15) * 64 + 32 + 8 * l4); }
        if (tid < 128) {
            const int kind = tid >> 6, bb_ = (tid >> 4) & 3, x = tid & 15; float u[16];
            if (kind == 0) {
#pragma unroll
                for (int y = 0; y < 16; ++y) { float s = (y == x) ? 1.f : 0.f; const LAS float* ar = ABK + (16 * bb_ + y) * 68 + 16 * bb_;
#pragma unroll
                    for (int z = 0; z < y; ++z) s -= u[z] * ar[z];
                    u[y] = s; }
            } else {
#pragma unroll
                for (int z = 15; z >= 0; --z) { float s = (z == x) ? 1.f : 0.f;
#pragma unroll
                    for (int z2 = z + 1; z2 < 16; ++z2) s -= ABK[(16 * bb_ + z2) * 68 + 16 * bb_ + z] * u[z2];
                    u[z] = s; }
            }
            LAS bf16* dst = (kind == 0 ? tKT : tKH) + (16 * bb_ + x) * TP;
            const v4u zz = {0u, 0u, 0u, 0u};
#pragma unroll
            for (int q = 0; q < 8; ++q) *(LAS v4u*)(dst + 8 * q) = zz;
            v4u o0, o1; o0.x = pk2(u[0], u[1]); o0.y = pk2(u[2], u[3]); o0.z = pk2(u[4], u[5]); o0.w = pk2(u[6], u[7]); o1.x = pk2(u[8], u[9]); o1.y = pk2(u[10], u[11]); o1.z = pk2(u[12], u[13]); o1.w = pk2(u[14], u[15]);
            asm volatile("" ::: "memory");
            *(LAS v4u*)(dst + 16 * bb_) = o0; *(LAS v4u*)(dst + 16 * bb_ + 8) = o1;
        } else {
            for (int tl = w - 2; tl < 16; tl += 6) { const int it_ = tl >> 2, stl = tl & 3;
                f32x4 acc = {0.f, 0.f, 0.f, 0.f};
                acc = MFMA16(trfrag(tAKK, 16 * stl, 0, l15, l4), trfrag(tVT, 16 * it_, 0, l15, l4), acc); acc = MFMA16(trfrag(tAKK, 16 * stl, 32, l15, l4), trfrag(tVT, 16 * it_, 32, l15, l4), acc);
                *(LAS u32x2v*)(tX + (16 * it_ + l15) * TP + 16 * stl + 4 * l4) = pk4(acc); }
        }
        RWC_BAR();
        STG(10);
        {
            const int mt5 = w & 3, n50 = 2 * (w >> 2);
            const bf16x8 zf = {0, 0, 0, 0, 0, 0, 0, 0};
            {
                bf16x8 a0 = ldsfrag(tE1, 16 * mt5 + l15, 8 * l4), a1 = ldsfrag(tE1, 16 * mt5 + l15, 32 + 8 * l4);
                if (!((mt5 & 1) && (mt5 >> 1) == 0 && l4 < 2)) a0 = zf;
                if (!((mt5 & 1) && (mt5 >> 1) == 1 && l4 < 2)) a1 = zf;
#pragma unroll
                for (int q = 0; q < 2; ++q) { const int nt = n50 + q; f32x4 acc = {0.f, 0.f, 0.f, 0.f};
                    acc = MFMA16(a0, ldsfrag(tKT, 16 * nt + l15, 8 * l4), acc); acc = MFMA16(a1, ldsfrag(tKT, 16 * nt + l15, 32 + 8 * l4), acc);
                    *(LAS u32x2v*)(tE2 + (16 * nt + l15) * TP + 16 * mt5 + 4 * l4) = pk4(acc); }
            }
            RWC_BAR();
            {
                const bf16x8 g0 = ldsfrag(tKH, 16 * mt5 + l15, 8 * l4), g1 = ldsfrag(tKH, 16 * mt5 + l15, 32 + 8 * l4);
                const bf16x8 p0 = ldsfrag(tE2, 16 * mt5 + l15, 8 * l4), p1 = ldsfrag(tE2, 16 * mt5 + l15, 32 + 8 * l4);
                f32x4 accA[2], accB[2];
#pragma unroll
                for (int q = 0; q < 2; ++q) { const int nt = n50 + q;
                    accA[q] = (f32x4){0.f, 0.f, 0.f, 0.f}; accA[q] = MFMA16(g0, ldsfrag(tE2, 16 * nt + l15, 8 * l4), accA[q]); accA[q] = MFMA16(g1, ldsfrag(tE2, 16 * nt + l15, 32 + 8 * l4), accA[q]);
                    accB[q] = (f32x4){0.f, 0.f, 0.f, 0.f}; accB[q] = MFMA16(p0, ldsfrag(tKH, 16 * nt + l15, 8 * l4), accB[q]); accB[q] = MFMA16(p1, ldsfrag(tKH, 16 * nt + l15, 32 + 8 * l4), accB[q]); }
#pragma unroll
                for (int q = 0; q < 2; ++q) { const int nt = n50 + q;
                    { LAS u32x2v* tp = (LAS u32x2v*)(tKT + (16 * nt + l15) * TP + 16 * mt5 + 4 * l4); const u32x2v old = *tp; f32x4 v;
                      v[0] = __uint_as_float(old.x << 16) - accA[q][0]; v[1] = __uint_as_float(old.x & 0xffff0000u) - accA[q][1]; v[2] = __uint_as_float(old.y << 16) - accA[q][2]; v[3] = __uint_as_float(old.y & 0xffff0000u) - accA[q][3]; *tp = pk4(v); }
                    { const u32x2v old = *(const LAS u32x2v*)(tKH + (16 * nt + l15) * TP + 16 * mt5 + 4 * l4); f32x4 v;
                      v[0] = __uint_as_float(old.x << 16) - accB[q][0]; v[1] = __uint_as_float(old.x & 0xffff0000u) - accB[q][1]; v[2] = __uint_as_float(old.y << 16) - accB[q][2]; v[3] = __uint_as_float(old.y & 0xffff0000u) - accB[q][3];
                      *(LAS u32x2v*)(tW + (16 * nt + l15) * TP + 16 * mt5 + 4 * l4) = pk4(v); } }
            }
            RWC_BAR();
            {
                bf16x8 a0 = ldsfrag(tE1, 16 * mt5 + l15, 8 * l4);
                if (mt5 < 2) a0 = zf;
#pragma unroll
                for (int q = 0; q < 2; ++q) { const int nt = n50 + q; f32x4 acc = {0.f, 0.f, 0.f, 0.f};
                    acc = MFMA16(a0, ldsfrag(tKT, 16 * nt + l15, 8 * l4), acc);
                    *(LAS u32x2v*)(tE2 + (16 * nt + l15) * TP + 16 * mt5 + 4 * l4) = pk4(acc); }
            }
            RWC_BAR();
            {
                const bf16x8 p0 = ldsfrag(tE2, 16 * mt5 + l15, 8 * l4), p1 = ldsfrag(tE2, 16 * mt5 + l15, 32 + 8 * l4);
#pragma unroll
                for (int q = 0; q < 2; ++q) { const int nt = n50 + q; f32x4 acc = {0.f, 0.f, 0.f, 0.f};
                    acc = MFMA16(p0, ldsfrag(tW, 16 * nt + l15, 8 * l4), acc); acc = MFMA16(p1, ldsfrag(tW, 16 * nt + l15, 32 + 8 * l4), acc);
                    const u32x2v old = *(const LAS u32x2v*)(tW + (16 * nt + l15) * TP + 16 * mt5 + 4 * l4); f32x4 v;
                    v[0] = __uint_as_float(old.x << 16) - acc[0]; v[1] = __uint_as_float(old.x & 0xffff0000u) - acc[1]; v[2] = __uint_as_float(old.y << 16) - acc[2]; v[3] = __uint_as_float(old.y & 0xffff0000u) - acc[3];
                    *(LAS u32x2v*)(tTT + (16 * nt + l15) * TP + 16 * mt5 + 4 * l4) = pk4(v); }
            }
        }
        RWC_BAR();
        STG(6);
        if (w < 4) {
            const bf16x8 a0 = MODE == 0 ? ldsfrag(tTT, 16 * w + l15, 8 * l4) : trfrag(tKTT, 16 * w, 0, l15, l4), a1 = MODE == 0 ? ldsfrag(tTT, 16 * w + l15, 32 + 8 * l4) : trfrag(tKTT, 16 * w, 32, l15, l4);
#pragma unroll
            for (int nt = 0; nt < 4; ++nt) {
                f32x4 acc = {0.f, 0.f, 0.f, 0.f};
                const bf16x8 b0 = MODE == 0 ? trfrag(tKTT, 16 * nt, 0, l15, l4) : ldsfrag(tTT, 16 * nt + l15, 8 * l4), b1 = MODE == 0 ? trfrag(tKTT, 16 * nt, 32, l15, l4) : ldsfrag(tTT, 16 * nt + l15, 32 + 8 * l4);
                acc = MFMA16(a0, b0, acc); acc = MFMA16(a1, b1, acc);
                *(LAS u32x2v*)(tW + (16 * nt + l15) * TP + 16 * w + 4 * l4) = pk4(acc);
            }
        } else {
            const int mtu = w - 4;
            const bf16x8 a0 = ldsfrag(tTT, 16 * mtu + l15, 8 * l4), a1 = ldsfrag(tTT, 16 * mtu + l15, 32 + 8 * l4);
#pragma unroll
            for (int nt = 0; nt < 4; ++nt) {
                f32x4 acc = {0.f, 0.f, 0.f, 0.f};
                acc = MFMA16(a0, ldsfrag(tX, 16 * nt + l15, 8 * l4), acc); acc = MFMA16(a1, ldsfrag(tX, 16 * nt + l15, 32 + 8 * l4), acc);
                *(LAS u32x2v*)(tUL + (16 * nt + l15) * TP + 16 * mtu + 4 * l4) = pk4(acc);
            }
        }
        STG(7);
        const int mt = w & 3, nt0 = 2 * (w >> 2);
        RWC_BAR();
        STG(8);
        if (MODE == 0) {
            const bf16x8 k0 = trfrag(tKBT, 16 * mt, 0, l15, l4), k1 = trfrag(tKBT, 16 * mt, 32, l15, l4), bb0 = trfrag(tBBT, 16 * mt, 0, l15, l4), bb1 = trfrag(tBBT, 16 * mt, 32, l15, l4);
            const bf16x8 w0 = ldsfrag(tW, 16 * mt + l15, 8 * l4), w1 = ldsfrag(tW, 16 * mt + l15, 32 + 8 * l4);
            const bf16x8 v0 = trfrag(tVT, 16 * mt, 0, l15, l4), v1 = trfrag(tVT, 16 * mt, 32, l15, l4), u0 = ldsfrag(tUL, 16 * mt + l15, 8 * l4), u1 = ldsfrag(tUL, 16 * mt + l15, 32 + 8 * l4);
            bf16* YRW = d == 0 ? (bf16*)(ws + R_YRW0) : (bf16*)((unsigned char*)F.out + DO_YRW1);
            bf16* RWTG = (bf16*)((unsigned char*)F.out + DO_CST);
#pragma unroll
            for (int q = 0; q < 2; ++q) { const int nt = nt0 + q;
                f32x4 acc = {0.f, 0.f, 0.f, 0.f};
                acc = MFMA16(k0, trfrag(tVT, 16 * nt, 0, l15, l4), acc); acc = MFMA16(k1, trfrag(tVT, 16 * nt, 32, l15, l4), acc);
                acc = MFMA16(bb0, ldsfrag(tUL, 16 * nt + l15, 8 * l4), acc); acc = MFMA16(bb1, ldsfrag(tUL, 16 * nt + l15, 32 + 8 * l4), acc);
                *(u32x2v*)(NCG + ((size_t)item * 64 + 16 * nt + l15) * 64 + 16 * mt + 4 * l4) = pk4(acc);
                f32x4 ac2 = {0.f, 0.f, 0.f, 0.f};
                ac2 = MFMA16(w0, trfrag(tBBT, 16 * nt, 0, l15, l4), ac2); ac2 = MFMA16(w1, trfrag(tBBT, 16 * nt, 32, l15, l4), ac2);
                *(u32x2v*)(LCT + ((size_t)item * 64 + 16 * nt + l15) * 64 + 32 * (mt >> 1) + 8 * l4 + 4 * (mt & 1)) = pk4(ac2);
                const bf16x8 ab0 = ldsfrag(tABRT, 16 * nt + l15, 8 * l4), ab1 = ldsfrag(tABRT, 16 * nt + l15, 32 + 8 * l4);
                { const u32x2v rr = *(const LAS u32x2v*)(tRT + (16 * nt + l15) * TP + 16 * mt + 4 * l4);
                  f32x4 a3 = {__uint_as_float(rr.x << 16), __uint_as_float(rr.x & 0xffff0000u), __uint_as_float(rr.y << 16), __uint_as_float(rr.y & 0xffff0000u)};
                  a3 = MFMA16(w0, ab0, a3); a3 = MFMA16(w1, ab1, a3);
                  *(u32x2v*)(RWTG + ((size_t)item * 64 + 16 * nt + l15) * 64 + 16 * mt + 4 * l4) = pk4(a3); }
                { f32x4 a4 = {0.f, 0.f, 0.f, 0.f};
                  a4 = MFMA16(v0, ldsfrag(tAKRT, 16 * nt + l15, 8 * l4), a4); a4 = MFMA16(v1, ldsfrag(tAKRT, 16 * nt + l15, 32 + 8 * l4), a4);
                  a4 = MFMA16(u0, ab0, a4); a4 = MFMA16(u1, ab1, a4);
                  int R, idx, len, sbase; rw_seq_rows(d, b, 64 * c + 16 * nt + l15, R, idx, len, sbase);
                  *(u32x2v*)(YRW + (size_t)R * 512 + h * 64 + 16 * mt + 4 * l4) = pk4(a4); }
            }
            if (tid < 64) PLG[(size_t)item * 64 + tid] = CLL[64 + tid];
        } else {
            {
                const bf16x8 a0 = ldsfrag(tW, 16 * mt + l15, 8 * l4), a1 = ldsfrag(tW, 16 * mt + l15, 32 + 8 * l4);
#pragma unroll
                for (int q = 0; q < 2; ++q) { const int nt = nt0 + q;
                    f32x4 acc = {0.f, 0.f, 0.f, 0.f};
                    acc = MFMA16(a0, __builtin_bit_cast(bf16x8, pf_s[2 * q]), acc); acc = MFMA16(a1, __builtin_bit_cast(bf16x8, pf_s[2 * q + 1]), acc);
                    LAS u32x2v* up = (LAS u32x2v*)(tUL + (16 * nt + l15) * TP + 16 * mt + 4 * l4); const u32x2v ul = *up;
                    acc[0] += __uint_as_float(ul.x << 16); acc[1] += __uint_as_float(ul.x & 0xffff0000u); acc[2] += __uint_as_float(ul.y << 16); acc[3] += __uint_as_float(ul.y & 0xffff0000u);
                    *up = pk4(acc);
                }
            }
            RWC_BAR();
            {
                bf16* YRW = d == 0 ? (bf16*)(ws + R_YRW0) : (bf16*)((unsigned char*)F.out + DO_YRW1);
                const bf16x8 s0 = __builtin_bit_cast(bf16x8, pf_s[4]), s1 = __builtin_bit_cast(bf16x8, pf_s[5]);
                const bf16x8 v0 = trfrag(tVT, 16 * mt, 0, l15, l4), v1 = trfrag(tVT, 16 * mt, 32, l15, l4), u0 = ldsfrag(tUL, 16 * mt + l15, 8 * l4), u1 = ldsfrag(tUL, 16 * mt + l15, 32 + 8 * l4);
#pragma unroll
                for (int q = 0; q < 2; ++q) { const int nt = nt0 + q;
                    f32x4 acc = {0.f, 0.f, 0.f, 0.f};
                    acc = MFMA16(s0, ldsfrag(tRT, 16 * nt + l15, 8 * l4), acc); acc = MFMA16(s1, ldsfrag(tRT, 16 * nt + l15, 32 + 8 * l4), acc);
                    acc = MFMA16(v0, ldsfrag(tAKRT, 16 * nt + l15, 8 * l4), acc); acc = MFMA16(v1, ldsfrag(tAKRT, 16 * nt + l15, 32 + 8 * l4), acc);
                    acc = MFMA16(u0, ldsfrag(tABRT, 16 * nt + l15, 8 * l4), acc); acc = MFMA16(u1, ldsfrag(tABRT, 16 * nt + l15, 32 + 8 * l4), acc);
                    int R, idx, len, sbase; rw_seq_rows(d, b, 64 * c + 16 * nt + l15, R, idx, len, sbase);
                    *(u32x2v*)(YRW + (size_t)R * 512 + h * 64 + 16 * mt + 4 * l4) = pk4(acc);
                }
            }
        }
        STG(9);
    }
#ifdef TS_RWC
    if (MODE == TS_RWC - 1 && blockIdx.x == 0 && F.tid == 0) { unsigned long long* ts = (unsigned long long*)(ws + WS_CTL + 512 * 1024); for (int k = 0; k < 11; ++k) ts[40 + k] = tst[k] / 10; }
#endif
#undef STG
#undef RWC_PREFETCH
#undef RWC_LOADRAW
#undef RWC_BAR
    __syncthreads();
}

#ifdef TS_PASSB
#define TSB(...) __VA_ARGS__
#else
#define TSB(...)
#endif
__device__ __forceinline__ void rw_pass_b(Frame& F, const Args& A) {
    constexpr int TP = 72, SLOT = 2 * 64 * TP * 2 + 256;
    unsigned char* ws = F.ws;
    const bf16* LCT = (const bf16*)(ws + RW_LCT); const bf16* NCG = (const bf16*)(ws + RW_NC); const float* PLG = (const float*)(ws + RW_PL);
    const int lane = F.lane, w = F.wave, l15 = lane & 15, l4 = lane >> 4;
    const bool spread = (F.G >= 256) && (F.G % 2 == 0);
    const int pair0 = spread ? ((F.vcu & 1) ? 4 * NCHAIN_RW : (F.vcu >> 1)) : F.vcu, pstep = spread ? (F.G >> 1) : F.G;
#define RWB_BAR() asm volatile("s_waitcnt lgkmcnt(0)\n\ts_barrier" ::: "memory")
    for (int pair = pair0; pair < 4 * NCHAIN_RW; pair += pstep) {
        const int chain = pair >> 2, nt = pair & 3;
        const size_t it0 = (size_t)chain * RW_NCH;
        __syncthreads();
        if (w == 0) {
            f32x4 acc[4];
#pragma unroll
            for (int m = 0; m < 4; ++m) acc[m] = (f32x4){0.f, 0.f, 0.f, 0.f};
            bf16* sg = (bf16*)(ws + RW_NC) + it0 * 4096 + (size_t)(16 * nt + l15) * 64 + 4 * l4; const size_t sdummy = ((size_t)RW_NITEM - it0) * 4096;
            struct OpRegs { bf16x8 a[4][2]; f32x4 pl[4]; u32x2v nc[4]; };
            OpRegs RA, RB;
#define RWB_FETCH(R, slot) do { const LAS bf16* Ls = (const LAS bf16*)(F.lds + (slot) * SLOT); const LAS bf16* Ns = Ls + 64 * TP; const LAS float* Ps = (const LAS float*)(F.lds + (slot) * SLOT + 2 * 64 * TP * 2); \
            _Pragma("unroll") for (int m = 0; m < 4; ++m) { R.a[m][0] = ldsfrag(Ls, 16 * m + l15, 8 * l4); R.a[m][1] = ldsfrag(Ls, 16 * m + l15, 32 + 8 * l4); \
                R.pl[m] = *(const LAS f32x4*)(Ps + 16 * m + 4 * l4); R.nc[m] = *(const LAS u32x2v*)(Ns + l15 * TP + 16 * m + 4 * l4); } } while (0)
#define RWB_STEP(CUR, NXT, cc, nslot) do { u32x2v sb[4]; TSB(tq0 = __builtin_amdgcn_s_memtime(); tacc2 += tq0 - tq2;) \
            _Pragma("unroll") for (int m = 0; m < 4; ++m) { sb[m] = pk4(acc[m]); *(u32x2v*)(sg + ((cc) > 0 ? (size_t)((cc) - 1) * 4096 : sdummy) + 16 * m) = sb[m]; } \
            const v4u q0 = {sb[0].x, sb[0].y, sb[1].x, sb[1].y}, q1 = {sb[2].x, sb[2].y, sb[3].x, sb[3].y}; \
            const bf16x8 b0 = __builtin_bit_cast(bf16x8, q0), b1 = __builtin_bit_cast(bf16x8, q1); \
            f32x4 dl[4]; \
            _Pragma("unroll") for (int m = 0; m < 4; ++m) { dl[m] = (f32x4){0.f, 0.f, 0.f, 0.f}; dl[m] = MFMA16(CUR.a[m][0], b0, dl[m]); dl[m] = MFMA16(CUR.a[m][1], b1, dl[m]); } \
            TSB(asm volatile("" :: "v"(dl[0]), "v"(dl[1]), "v"(dl[2]), "v"(dl[3])); tq1 = __builtin_amdgcn_s_memtime(); tacc0 += tq1 - tq0;) RWB_BAR(); TSB(tq2 = __builtin_amdgcn_s_memtime(); tacc1 += tq2 - tq1;) RWB_FETCH(NXT, nslot); \
            _Pragma("unroll") for (int m = 0; m < 4; ++m) { \
                acc[m][0] = acc[m][0] * CUR.pl[m][0] + dl[m][0] + __uint_as_float(CUR.nc[m].x << 16); acc[m][1] = acc[m][1] * CUR.pl[m][1] + dl[m][1] + __uint_as_float(CUR.nc[m].x & 0xffff0000u); \
                acc[m][2] = acc[m][2] * CUR.pl[m][2] + dl[m][2] + __uint_as_float(CUR.nc[m].y << 16); acc[m][3] = acc[m][3] * CUR.pl[m][3] + dl[m][3] + __uint_as_float(CUR.nc[m].y & 0xffff0000u); } } while (0)
            RWB_BAR();
            TSB(unsigned long long tq0 = 0, tq1 = 0, tq2 = __builtin_amdgcn_s_memtime(), tacc0 = 0, tacc1 = 0, tacc2 = 0;)
            RWB_FETCH(RA, 0);
            for (int c6 = 0; c6 < RW_NCH; c6 += 6) {
                RWB_STEP(RA, RB, c6 + 0, 1); RWB_STEP(RB, RA, c6 + 1, 2); RWB_STEP(RA, RB, c6 + 2, 0);
                RWB_STEP(RB, RA, c6 + 3, 1); RWB_STEP(RA, RB, c6 + 4, 2); RWB_STEP(RB, RA, c6 + 5, 0);
            }
            TSB(if (blockIdx.x == 0 && F.tid == 0) { unsigned long long* ts = (unsigned long long*)(ws + WS_CTL + 512 * 1024); ts[40] = tacc0 / 10; ts[41] = tacc1 / 10; ts[42] = tacc2 / 10; })
#undef RWB_FETCH
#undef RWB_STEP
        } else if (w < 4) {
            RWB_BAR();
            for (int c = 0; c < RW_NCH; ++c) RWB_BAR();
        } else {
            const int t = F.tid - 256, row = t >> 2, cp = (t & 3) * 16;
            v4u L0[6], L1[6], N0[6], P0[6];
#define RWB_LOADG(k, cc) do { const size_t it_ = it0 + ((cc) < RW_NCH ? (cc) : RW_NCH - 1); \
            L0[k] = *(const GAS v4u*)(LCT + it_ * 4096 + t * 16); L1[k] = *(const GAS v4u*)(LCT + it_ * 4096 + t * 16 + 8); \
            if (t < 128) N0[k] = *(const GAS v4u*)(NCG + (it_ * 64 + 16 * nt + (t >> 3)) * 64 + 8 * (t & 7)); \
            if (t < 16) P0[k] = *(const GAS v4u*)(PLG + it_ * 64 + 4 * t); } while (0)
#define RWB_WRITEL(k, slot) do { LAS bf16* Ls = (LAS bf16*)(F.lds + (slot) * SLOT); LAS bf16* Ns = Ls + 64 * TP; \
            *(LAS v4u*)(Ls + row * TP + cp) = L0[k]; *(LAS v4u*)(Ls + row * TP + cp + 8) = L1[k]; if (t < 128) *(LAS v4u*)(Ns + (t >> 3) * TP + 8 * (t & 7)) = N0[k]; \
            if (t < 16) *(LAS v4u*)(F.lds + (slot) * SLOT + 2 * 64 * TP * 2 + 16 * t) = P0[k]; } while (0)
#pragma unroll
            for (int k = 0; k < 6; ++k) RWB_LOADG(k, k);
            RWB_WRITEL(0, 0); RWB_LOADG(0, 6); RWB_WRITEL(1, 1); RWB_LOADG(1, 7);
            RWB_BAR();
            TSB(unsigned long long lq0 = 0, lq1 = 0, lq2 = __builtin_amdgcn_s_memtime(), lacc0 = 0, lacc1 = 0, lacc2 = 0;)
            for (int c6 = 0; c6 < RW_NCH; c6 += 6) {
#pragma unroll
                for (int k = 0; k < 6; ++k) {
                    TSB(lq0 = __builtin_amdgcn_s_memtime(); lacc2 += lq0 - lq2;) RWB_BAR(); TSB(lq1 = __builtin_amdgcn_s_memtime(); lacc0 += lq1 - lq0;)
                    RWB_WRITEL((k + 2) % 6, (k + 2) % 3); TSB(asm volatile("s_waitcnt lgkmcnt(0)" ::: "memory"); lq2 = __builtin_amdgcn_s_memtime(); lacc1 += lq2 - lq1;) RWB_LOADG((k + 2) % 6, c6 + k + 8);
                }
            }
            TSB(if (blockIdx.x == 0 && t == 0) { unsigned long long* ts = (unsigned long long*)(ws + WS_CTL + 512 * 1024); ts[44] = lacc0 / 10; ts[45] = lacc1 / 10; ts[46] = lacc2 / 10; })
#undef RWB_LOADG
#undef RWB_WRITEL
        }
    }
#undef RWB_BAR
    __syncthreads();
}

__device__ __forceinline__ void rw_pass_c2(Frame& F, const Args& A) {
    unsigned char* ws = F.ws;
    const bf16* NCG = (const bf16*)(ws + RW_NC); const bf16* RWTG = (const bf16*)((unsigned char*)F.out + DO_CST);
    const int lane = F.lane, l15 = lane & 15, l4 = lane >> 4;
    const int gw = F.vcu * NWAVES + F.wave, nw = F.G * NWAVES;
    const int srow = 4 * (((l15 >> 2) & 1) * 2 + (l15 >> 3)) + (l15 & 3);
    const int ycol = 16 * (l4 >> 1) + 8 * (l4 & 1);
    for (int u = gw; u < RW_NITEM * 4; u += nw) {
        const int item = u >> 2, nt = u & 3;
        const int chain = item / RW_NCH, c = item % RW_NCH, d = chain >> 4, b = (chain >> 3) & 1, h = chain & 7;
        if (c == 0) continue;
        bf16* YRW = d == 0 ? (bf16*)(ws + R_YRW0) : (bf16*)((unsigned char*)F.out + DO_YRW1);
        int R, idx, len, sbase; rw_seq_rows(d, b, 64 * c + 16 * nt + l15, R, idx, len, sbase);
        bf16* yp = YRW + (size_t)R * 512 + h * 64 + ycol;
        const bf16* rp = RWTG + ((size_t)item * 64 + 16 * nt + l15) * 64 + 8 * l4;
        const bf16* sp = NCG + (size_t)(item - 1) * 4096 + srow * 64 + 8 * l4;
        const v4u b0 = *(const GAS v4u*)rp, b1 = *(const GAS v4u*)(rp + 32);
        v4u a0[4], a1[4], cq[2];
#pragma unroll
        for (int mt = 0; mt < 4; ++mt) { a0[mt] = *(const GAS v4u*)(sp + mt * 1024); a1[mt] = *(const GAS v4u*)(sp + mt * 1024 + 32); }
#pragma unroll
        for (int p = 0; p < 2; ++p) cq[p] = *(const GAS v4u*)(yp + 32 * p);
#pragma unroll
        for (int p = 0; p < 2; ++p) {
            unsigned ax = cq[p].x, ay = cq[p].y, bx = cq[p].z, by = cq[p].w;
            { auto r = __builtin_amdgcn_permlane32_swap(ax, bx, false, false); ax = r[0]; bx = r[1]; } { auto r = __builtin_amdgcn_permlane32_swap(ay, by, false, false); ay = r[0]; by = r[1]; }
            f32x4 accA = {__uint_as_float(ax << 16), __uint_as_float(ax & 0xffff0000u), __uint_as_float(ay << 16), __uint_as_float(ay & 0xffff0000u)};
            f32x4 accB = {__uint_as_float(bx << 16), __uint_as_float(bx & 0xffff0000u), __uint_as_float(by << 16), __uint_as_float(by & 0xffff0000u)};
            accA = MFMA16(__builtin_bit_cast(bf16x8, a0[2 * p]), __builtin_bit_cast(bf16x8, b0), accA); accA = MFMA16(__builtin_bit_cast(bf16x8, a1[2 * p]), __builtin_bit_cast(bf16x8, b1), accA);
            accB = MFMA16(__builtin_bit_cast(bf16x8, a0[2 * p + 1]), __builtin_bit_cast(bf16x8, b0), accB); accB = MFMA16(__builtin_bit_cast(bf16x8, a1[2 * p + 1]), __builtin_bit_cast(bf16x8, b1), accB);
            u32x2v pa = pk4(accA), pb = pk4(accB);
            { auto r = __builtin_amdgcn_permlane32_swap(pa.x, pb.x, false, false); pa.x = r[0]; pb.x = r[1]; } { auto r = __builtin_amdgcn_permlane32_swap(pa.y, pb.y, false, false); pa.y = r[0]; pb.y = r[1]; }
            const v4u o = {pa.x, pa.y, pb.x, pb.y};
            *(GAS v4u*)(yp + 32 * p) = o;
        }
    }
    __syncthreads();
}
#ifndef MK_N_LAUNCHES
#define MK_N_LAUNCHES 1
#endif
constexpr int NPHASE = 23;
#ifndef PHMASK
#define PHMASK 0xffffffffu
#endif
#define PH_ON(k) (((PHMASK) >> (k)) & 1u)
__global__ void __launch_bounds__(NTHREADS, 2) mk_fwd(Args args) {
    extern __shared__ __attribute__((aligned(16))) unsigned char lds[];
    Frame F;
    F.lds = (LAS unsigned char*)lds;
    F.MISC = (volatile LAS unsigned*)(F.lds + MISC_OFF);
    F.tid = threadIdx.x; F.lane = F.tid & 63; F.wave = __builtin_amdgcn_readfirstlane(F.tid >> 6);
    F.G = gridDim.x; { const int bx = blockIdx.x; F.vcu = (F.G % 8 == 0) ? (bx % 8) * (F.G / 8) + bx / 8 : bx; }
    F.ws = args.ws; F.out = args.out; const Args& A = args;
    unsigned char* ws = args.ws;
    F.ctl = (gu32*)(ws + WS_CTL);
    for (int u = F.tid; u < (LDS_BYTES - LDSCTL_OFF) / 4; u += NTHREADS) ((LAS unsigned*)(F.lds + LDSCTL_OFF))[u] = 0u;
    __syncthreads();
    const bool use_bar = (args.ph_hi - args.ph_lo) > 1;
    XcdBarrier bar; bar.bar = (unsigned*)(F.ctl + CW_BAR) + args.li * XCD_BAR_WORDS; bar.x = 0; bar.st = nullptr;
    if (use_bar) bar = xcd_barrier_post((unsigned*)(F.ctl + CW_BAR) + args.li * XCD_BAR_WORDS, F.MISC + 8);
    const float* MOD = (const float*)(ws + WS_MOD);
    bf16* XN = (bf16*)(ws + WS_XN);
    float* XC = (float*)(ws + WS_XC);
    const int bid = (int)blockIdx.x;
    const int lo = args.ph_lo, hi = args.ph_hi;
#define IN(k) (PH_ON(k) && lo <= (k) && (k) < hi)
#ifdef TS_A
#define TSTAMP(i) do { if (blockIdx.x == TS_BLK && F.tid == 0) ((unsigned long long*)(ws + WS_CTL + 512 * 1024))[i] = __builtin_amdgcn_s_memrealtime(); } while (0)
#else
#define TSTAMP(i) do {} while (0)
#endif
#ifndef TS_OFF
#define TS_OFF 0
#endif
#ifndef TS_BLK
#define TS_BLK 0
#endif
#define SEAM(k) do { if ((k) + 1 < hi) xcd_barrier(bar); TSTAMP((k) + 1); } while (0)
    TSTAMP(0);
    if (IN(0)) { p0_prologue(F, A); SEAM(0); }
    if (IN(1)) { p1_mod_finalize(F, A); SEAM(1); }
    if (IN(2)) { norm_rows(F, A, A.in[I_X], A.in[I_CTX], MA_ROWS, A.in[I_NORM_MIX], MOD, 0, 1, XN); SEAM(2); }
    if (IN(3)) { { const pg8::RecInDst rd{(bf16*)(ws + R_QM), (R_KM - R_QM) / 2, (R_VM - R_QM) / 2, (R_OM - R_QM) / 2, (bf16*)(ws + R_RAW), (bf16*)(ws + R_TWAD), (bf16*)(ws + R_SGD), (float*)(ws + R_GATES)};
            { pg8::Gemm g{XN, (const bf16*)(ws + WS_WREC), ML_ROWS, REC_N, D}; pg8::StaticOrder S; S.init(ML_ROWS, REC_N, F.G, bid);
              pg8::EpiRecIn E{rd};
              pg8::gemm_phase<pg8::EpiRecIn, pg8::StaticOrder, true, true>(F.lds + RING_OFF, g, S, E); }
            ctx_gemm2(F, XN + (size_t)ML_ROWS * D, D, (const bf16*)(ws + WS_WREC), D, MC_ROWS, REC_N, D, [=](int row, int col, float v) { pg8::recin_store1(rd, (size_t)(ML_ROWS + row), col, v); });
        } SEAM(3); }
    if (IN(4)) { ml_pass_a(F, A); p0_weights_tail<3>(F, A, NITEM_ML, F.vcu); SEAM(4); }
    if (IN(5)) { ml_pass_b(F, A); SEAM(5); }
    if (IN(6)) { ml_pass_c(F, A); p0_weights_tail<4>(F, A, NITEM_ML, F.vcu); SEAM(6); }
    if (IN(7)) { rw_chunk_pass<0>(F, A); SEAM(7); }
    if (IN(8)) { rw_pass_b(F, A);
            { const bool spread = (F.G >= 256) && (F.G % 2 == 0);
              if (!spread || (F.vcu & 1)) {
                int kg = 128; asm volatile("" : "+s"(kg)); pg8::Gemm g{(const bf16*)(ws + R_SGD), (const bf16*)(ws + WS_WG2), MA_ROWS, 512, kg}; pg8::StaticOrder S; S.init(MA_ROWS, 512, spread ? F.G / 2 : F.G, spread ? (F.vcu >> 1) : F.vcu);
                pg8::EpiStoreBf16<1536> E{(bf16*)(ws + R_RAW), 0, 1.f};
                pg8::gemm_phase<pg8::EpiStoreBf16<1536>, pg8::StaticOrder, true, true>(F.lds + RING_OFF, g, S, E); } }
        SEAM(8); }
    if (IN(9)) { rw_pass_c2(F, A); SEAM(9); }
    if (IN(10)) { merge_rows(F, A); SEAM(10); }
    if (IN(11)) { { pg8::Gemm g{(const bf16*)(ws + R_MIX), (const bf16*)(ws + WS_WOUT), ML_ROWS, D, D}; pg8::StaticOrder S; S.init(ML_ROWS, D, F.G, bid);
            pg8::EpiResid E{A.in[I_X], A.in[I_CTX], F.out, XC, MOD + 2 * 1024};
            pg8::gemm_phase<pg8::EpiResid, pg8::StaticOrder, true, true>(F.lds + RING_OFF, g, S, E);
            { const float* src = A.in[I_CTX]; const float* gate = MOD + 2 * 6144 + 2 * 1024;
              ctx_gemm2(F, (const bf16*)(ws + R_MIX) + (size_t)ML_ROWS * D, D, (const bf16*)(ws + WS_WOUT), D, MC_ROWS, D, D, [=](int row, int col, float v) { XC[(size_t)row * D + col] = src[(size_t)row * D + col] + gate[col] * v; }); } } SEAM(11); }
    if (IN(12)) { norm_rows(F, A, F.out, XC, MA_ROWS, A.in[I_NORM_FFN], MOD, 3, 4, XN); SEAM(12); }
    if (IN(13)) { { pg8::Gemm g{XN, (const bf16*)(ws + WS_W1), MA_ROWS, FF, D}; pg8::StaticOrder S; S.init(MA_ROWS, FF, F.G, bid);
            pg8::EpiSqRelu<FF> E{(bf16*)(ws + R_H)};
            pg8::gemm_phase<pg8::EpiSqRelu<FF>, pg8::StaticOrder, true, true>(F.lds + RING_OFF, g, S, E);
            p0_weights_tail<1>(F, A, (MA_ROWS / 256) * (FF / 256), bid); } SEAM(13); }
    if (IN(14)) { { pg8::Gemm g{(const bf16*)(ws + R_H), (const bf16*)(ws + WS_W2), ML_ROWS, D, FF}; pg8::StaticOrder S; S.init(ML_ROWS, D, F.G, bid);
            pg8::EpiResid E{F.out, XC, F.out, XC, MOD + 5 * 1024};
            pg8::gemm_phase<pg8::EpiResid, pg8::StaticOrder, true, true>(F.lds + RING_OFF, g, S, E);
            { const float* gate = MOD + 2 * 6144 + 5 * 1024; TSTAMP(40);
              ctx_gemm(F, (const bf16*)(ws + R_H) + (size_t)ML_ROWS * FF, FF, (const bf16*)(ws + WS_W2), FF, MC_ROWS, D, FF, [=](int row, int col, float v) { XC[(size_t)row * D + col] += gate[col] * v; }); TSTAMP(41); } } SEAM(14); }
    if (IN(15)) { norm_rows(F, A, F.out, XC, MA_ROWS, A.in[I_NORM_MIX] + D, MOD + 3 * 6144, 0, 1, XN); SEAM(15); }
    if (IN(16)) { { pg8::Gemm g{XN, (const bf16*)(ws + WS_WATT), MA_ROWS, ATT_N, D}; pg8::StaticOrder S; S.init(MA_ROWS, ATT_N, F.G, bid);
            pg8::EpiStoreBf16<ATT_N> E{(bf16*)(ws + R_ATT), 0, 1.f};
            pg8::gemm_phase<pg8::EpiStoreBf16<ATT_N>, pg8::StaticOrder, true, true>(F.lds + RING_OFF, g, S, E);
            p0_weights_tail<2>(F, A, (MA_ROWS / 256) * (ATT_N / 256), bid); } SEAM(16); }
    if (IN(17)) { qk_prep(F, A); SEAM(17); }
    if (IN(18)) { attn_phase(F, A, (char*)lds + RING_OFF); SEAM(18); }
    if (IN(19)) { { pg8::Gemm g{(const bf16*)(ws + R_QB), (const bf16*)(ws + WS_WOUT) + (size_t)D * D, ML_ROWS, D, D}; pg8::StaticOrder S; S.init(ML_ROWS, D, F.G, bid);
            pg8::EpiResid E{F.out, XC, F.out, XC, MOD + 3 * 6144 + 2 * 1024};
            pg8::gemm_phase<pg8::EpiResid, pg8::StaticOrder, true, true>(F.lds + RING_OFF, g, S, E); } SEAM(19); }
    if (IN(20)) { norm_rows(F, A, F.out, XC, ML_ROWS, A.in[I_NORM_FFN] + D, MOD + 3 * 6144, 3, 4, XN); SEAM(20); }
    if (IN(21)) { { pg8::Gemm g{XN, (const bf16*)(ws + WS_W1) + (size_t)D * FF, ML_ROWS, FF, D}; pg8::StaticOrder S; S.init(ML_ROWS, FF, F.G, bid);
            pg8::EpiSqRelu<FF> E{(bf16*)(ws + R_H)};
            pg8::gemm_phase<pg8::EpiSqRelu<FF>, pg8::StaticOrder, true, true>(F.lds + RING_OFF, g, S, E); } SEAM(21); }
    if (IN(22)) { { pg8::Gemm g{(const bf16*)(ws + R_H), (const bf16*)(ws + WS_W2) + (size_t)D * FF, ML_ROWS, D, FF}; pg8::StaticOrder S; S.init(ML_ROWS, D, F.G, bid);
            pg8::EpiResid E{F.out, XC, F.out, XC, MOD + 3 * 6144 + 5 * 1024};
            pg8::gemm_phase<pg8::EpiResid, pg8::StaticOrder, true, true>(F.lds + RING_OFF, g, S, E); } SEAM(22); }
#ifdef TS_A
    if (blockIdx.x == TS_BLK && F.tid == 0) { const unsigned long long* ts = (const unsigned long long*)(ws + WS_CTL + 512 * 1024);
        __builtin_amdgcn_s_waitcnt(0); F.out[0] += ((float)(ts[TS_B] - ts[TS_A]) - (float)(TS_OFF)) * 0.001f; }
#endif
#undef IN
#undef SEAM
}

extern "C" void kernel_launch(void* const* d_in, const int* in_sizes, int n_in, void* d_out, int out_size, void* d_ws, size_t ws_size, hipStream_t stream) {
    static int grid = 0;
    if (grid == 0) {
        if (n_in != N_IN || out_size != ML_ROWS * D || ws_size < WS_END) { fprintf(stderr, "kernel_launch: unexpected shapes (n_in %d, out %d, ws %zu); nothing launched\n", n_in, out_size, ws_size); grid = -1; return; }
        int dev = 0, cus = 0, per_cu = 0;
        if (hipGetDevice(&dev) != hipSuccess || hipDeviceGetAttribute(&cus, hipDeviceAttributeMultiprocessorCount, dev) != hipSuccess) { grid = -1; return; }
        if (hipFuncSetAttribute((const void*)mk_fwd, hipFuncAttributeMaxDynamicSharedMemorySize, LDS_BYTES) != hipSuccess) { fprintf(stderr, "kernel_launch: hipFuncSetAttribute failed\n"); grid = -1; return; }
        if (hipOccupancyMaxActiveBlocksPerMultiprocessor(&per_cu, (const void*)mk_fwd, NTHREADS, LDS_BYTES) != hipSuccess || per_cu < 1) { fprintf(stderr, "kernel_launch: occupancy query says %d blocks per CU\n", per_cu); per_cu = 1; }
        (void)hipGetLastError();
        grid = cus;
    }
    if (grid < 0) return;
    (void)hipMemsetAsync((char*)d_ws + WS_CTL, 0, CTL_ZERO_BYTES, stream);
    Args a{};
    for (int i = 0; i < N_IN; ++i) a.in[i] = (const float*)d_in[i];
    a.out = (float*)d_out; a.ws = (unsigned char*)d_ws;
#if MK_N_LAUNCHES == 1
    a.ph_lo = 0; a.ph_hi = NPHASE; a.li = 0;
    { void* kargs[] = {&a}; hipError_t e = hipLaunchCooperativeKernel((const void*)mk_fwd, dim3(grid), dim3(NTHREADS), kargs, LDS_BYTES, stream);
      if (e != hipSuccess) fprintf(stderr, "kernel_launch: cooperative launch failed: %s\n", hipGetErrorString(e)); }
#else
    for (int p = 0; p < NPHASE; ++p) { a.ph_lo = p; a.ph_hi = p + 1; a.li = 0; hipLaunchKernelGGL(mk_fwd, dim3(grid), dim3(NTHREADS), LDS_BYTES, stream, a); }
#endif
}
```
